# Optimizing an MI355X kernel written in HIP

```python
import math
import jax, jax.numpy as jnp
from jax import lax
import numpy as np

D_MODEL = 2048
BATCH = 4
SEQ = 8192
DEPTH = 1

CHUNK = 64
QBLK = 128
HEAD_DIM = 128
N_SB_HEADS = D_MODEL // 2 // HEAD_DIM
SB_WIDTH = N_SB_HEADS * HEAD_DIM
DIFF_V_DIM = 128
DIFF_QK_DIM = DIFF_V_DIM // 2
N_DIFF_HEADS = D_MODEL // 2 // DIFF_V_DIM
DIFF_WIDTH = N_DIFF_HEADS * DIFF_V_DIM
MIX_WIDTH = SB_WIDTH + DIFF_WIDTH
DIFF_QK_WIDTH = N_DIFF_HEADS * 2 * DIFF_QK_DIM
QKV_COLS = 3 * SB_WIDTH + 2 * DIFF_QK_WIDTH + DIFF_WIDTH
ROPE_THETA = 500000.0
ROT_DIM = DIFF_QK_DIM // 4
N_GROUPS = 4
EXPERTS_PER_GROUP = 8
N_EXPERTS = N_GROUPS * EXPERTS_PER_GROUP
TOP_K_INNER = 2
D_EXPERT = D_MODEL // 4
MOE_BLK = 128
PLE_DIM = 256
EPS = 1e-6

kernel_name = "hybrid_stickbreak_diffattn_hmoe_block"


def rmsnorm(x, g):
    x32 = x.astype(jnp.float32)
    y = x32 * lax.rsqrt(jnp.mean(x32 * x32, axis=-1, keepdims=True) + EPS)
    return (y * g.astype(jnp.float32)).astype(x.dtype)


def partial_rope(x, pos):
    half = ROT_DIM // 2
    inv = ROPE_THETA ** (-jnp.arange(0, ROT_DIM, 2, dtype=jnp.float32) / ROT_DIM)
    ang = pos.astype(jnp.float32)[:, None] * inv[None, :]
    cos, sin = jnp.cos(ang), jnp.sin(ang)
    x1 = x[..., :half].astype(jnp.float32)
    x2 = x[..., half:ROT_DIM].astype(jnp.float32)
    r1 = (x1 * cos - x2 * sin).astype(x.dtype)
    r2 = (x2 * cos + x1 * sin).astype(x.dtype)
    return jnp.concatenate([r1, r2, x[..., ROT_DIM:]], axis=-1)


def stick_breaking_attention(q, k, v):
    S = q.shape[2]
    scale = 1.0 / math.sqrt(HEAD_DIM)
    outs = []
    for start in range(0, S, QBLK):
        end = start + QBLK
        qb = q[:, :, start:end]
        kb = k[:, :, :end]
        vb = v[:, :, :end]
        z = jnp.einsum('bhqd,bhkd->bhqk', qb, kb).astype(jnp.float32) * scale
        t_idx = start + jnp.arange(QBLK)
        s_idx = jnp.arange(end)
        mask = s_idx[None, :] < t_idx[:, None]
        log_beta = jax.nn.log_sigmoid(z)
        log_1mb = jnp.where(mask, jax.nn.log_sigmoid(-z), 0.0)
        suffix = lax.cumsum(log_1mb, axis=3, reverse=True) - log_1mb
        a = jnp.where(mask, jnp.exp(log_beta + suffix), 0.0)
        outs.append(jnp.einsum('bhqk,bhkd->bhqd', a.astype(vb.dtype), vb))
    return jnp.concatenate(outs, axis=2)


def differential_attention(q, k, v, lam):
    S = q.shape[3]
    scale = 1.0 / math.sqrt(DIFF_QK_DIM)
    outs = []
    for start in range(0, S, QBLK):
        end = start + QBLK
        qb = q[:, :, :, start:end]
        kb = k[:, :, :, :end]
        vb = v[:, :, :end]
        s = jnp.einsum('bhmqd,bhmkd->bhmqk', qb, kb).astype(jnp.float32) * scale
        t_chunk = (start + jnp.arange(QBLK)) // CHUNK
        s_chunk = jnp.arange(end) // CHUNK
        mask = s_chunk[None, :] <= t_chunk[:, None]
        s = jnp.where(mask, s, -1e30)
        p = jax.nn.softmax(s, axis=-1)
        w = p[:, :, 0] - lam * p[:, :, 1]
        outs.append(jnp.einsum('bhqk,bhkd->bhqd', w.astype(vb.dtype), vb))
    return jnp.concatenate(outs, axis=2)


def hierarchical_moe(h, w_rg, w_re, w_gate, w_up, w_down):
    B, S, D = h.shape
    N = B * S
    xf = h.reshape(N, D)
    p_grp = jax.nn.softmax((xf @ w_rg).astype(jnp.float32), axis=-1)
    grp = jnp.argmax(p_grp, axis=-1)
    p_sel = jnp.take_along_axis(p_grp, grp[:, None], axis=1)[:, 0]
    e_logits = (xf @ w_re).astype(jnp.float32).reshape(N, N_GROUPS, EXPERTS_PER_GROUP)
    in_grp = jnp.take_along_axis(e_logits, grp[:, None, None], axis=1)[:, 0]
    top_v, top_i = lax.top_k(in_grp, TOP_K_INNER)
    gates = jax.nn.softmax(top_v, axis=-1) * p_sel[:, None]
    expert = grp[:, None] * EXPERTS_PER_GROUP + top_i

    NK = N * TOP_K_INNER
    flat_e = expert.reshape(NK)
    flat_w = gates.reshape(NK).astype(h.dtype)
    flat_tok = jnp.repeat(jnp.arange(N, dtype=jnp.int32), TOP_K_INNER)
    order = jnp.argsort(flat_e)
    se, stok, sw = flat_e[order], flat_tok[order], flat_w[order]
    counts = jnp.bincount(flat_e, length=N_EXPERTS)
    starts = jnp.cumsum(counts) - counts
    padded = ((counts + MOE_BLK - 1) // MOE_BLK) * MOE_BLK
    pends = jnp.cumsum(padded)
    pstarts = pends - padded
    dest = pstarts[se] + (jnp.arange(NK) - starts[se])
    P = NK + N_EXPERTS * MOE_BLK
    nb = P // MOE_BLK
    rows = jnp.zeros((P,), jnp.int32).at[dest].set(stok)
    wbuf = jnp.zeros((P,), h.dtype).at[dest].set(sw)
    blk_e = jnp.clip(jnp.searchsorted(pends, jnp.arange(nb) * MOE_BLK, side='right'), 0, N_EXPERTS - 1)
    xs = xf[rows].reshape(nb, MOE_BLK, D)

    def expert_block(args):
        xb, e = args
        g = xb @ w_gate[e]
        u = xb @ w_up[e]
        return (jax.nn.silu(g) * u) @ w_down[e]

    ys = lax.map(expert_block, (xs, blk_e)).reshape(P, D)
    out = jnp.zeros((N, D), h.dtype).at[rows].add(ys * wbuf[:, None])
    return out.reshape(B, S, D)


def setup_inputs(seed: int = 0) -> dict:
    key = jax.random.key(seed)
    ks = jax.random.split(key, 24)
    f32 = jnp.float32
    nrm = lambda k, shape, s: jax.random.normal(k, shape, f32) * s
    gain = lambda k, shape: 1.0 + 0.01 * jax.random.normal(k, shape, f32)
    return {
        "x": nrm(ks[0], (BATCH, SEQ, D_MODEL), 1.0),
        "p": nrm(ks[1], (DEPTH, BATCH, SEQ, PLE_DIM), 1.0),
        "g_attn": gain(ks[2], (DEPTH, D_MODEL)),
        "w_in": nrm(ks[3], (DEPTH, D_MODEL, QKV_COLS), D_MODEL ** -0.5),
        "g_sb": gain(ks[4], (DEPTH, HEAD_DIM)),
        "g_diff": gain(ks[5], (DEPTH, DIFF_V_DIM)),
        "lam_q1": nrm(ks[6], (DEPTH, DIFF_QK_DIM), 0.1),
        "lam_k1": nrm(ks[7], (DEPTH, DIFF_QK_DIM), 0.1),
        "lam_q2": nrm(ks[8], (DEPTH, DIFF_QK_DIM), 0.1),
        "lam_k2": nrm(ks[9], (DEPTH, DIFF_QK_DIM), 0.1),
        "w_out": nrm(ks[10], (DEPTH, MIX_WIDTH, D_MODEL), MIX_WIDTH ** -0.5),
        "g_moe": gain(ks[11], (DEPTH, D_MODEL)),
        "w_router_group": nrm(ks[12], (DEPTH, D_MODEL, N_GROUPS), D_MODEL ** -0.5),
        "w_router_expert": nrm(ks[13], (DEPTH, D_MODEL, N_EXPERTS), D_MODEL ** -0.5),
        "w_gate": nrm(ks[14], (DEPTH, N_EXPERTS, D_MODEL, D_EXPERT), D_MODEL ** -0.5),
        "w_up": nrm(ks[15], (DEPTH, N_EXPERTS, D_MODEL, D_EXPERT), D_MODEL ** -0.5),
        "w_down": nrm(ks[16], (DEPTH, N_EXPERTS, D_EXPERT, D_MODEL), D_EXPERT ** -0.5),
        "g_ple": gain(ks[17], (DEPTH, D_MODEL)),
        "w_ple": nrm(ks[18], (DEPTH, PLE_DIM, D_MODEL), PLE_DIM ** -0.5),
        "w_ple_gate": nrm(ks[19], (DEPTH, D_MODEL, D_MODEL), D_MODEL ** -0.5),
        "g_final": gain(ks[20], (D_MODEL,)),
    }


def reference(x, p, g_attn, w_in, g_sb, g_diff, lam_q1, lam_k1, lam_q2, lam_k2, w_out,
              g_moe, w_router_group, w_router_expert, w_gate, w_up, w_down,
              g_ple, w_ple, w_ple_gate, g_final):
    B, S, _ = x.shape
    pos = jnp.arange(S, dtype=jnp.int32)
    h = x
    for i in range(DEPTH):
        a = rmsnorm(h, g_attn[i])
        qkv = a @ w_in[i]
        o = 0
        q_sb = qkv[..., o:o + SB_WIDTH]; o += SB_WIDTH
        k_sb = qkv[..., o:o + SB_WIDTH]; o += SB_WIDTH
        v_sb = qkv[..., o:o + SB_WIDTH]; o += SB_WIDTH
        q_df = qkv[..., o:o + DIFF_QK_WIDTH]; o += DIFF_QK_WIDTH
        k_df = qkv[..., o:o + DIFF_QK_WIDTH]; o += DIFF_QK_WIDTH
        v_df = qkv[..., o:o + DIFF_WIDTH]

        heads = lambda t, H, d: t.reshape(B, S, H, d).transpose(0, 2, 1, 3)
        o_sb = stick_breaking_attention(heads(q_sb, N_SB_HEADS, HEAD_DIM),
                                        heads(k_sb, N_SB_HEADS, HEAD_DIM),
                                        heads(v_sb, N_SB_HEADS, HEAD_DIM))
        o_sb = rmsnorm(o_sb, g_sb[i]).transpose(0, 2, 1, 3).reshape(B, S, SB_WIDTH)

        qk2 = lambda t: t.reshape(B, S, N_DIFF_HEADS, 2, DIFF_QK_DIM).transpose(0, 2, 3, 1, 4)
        qd = partial_rope(qk2(q_df), pos)
        kd = partial_rope(qk2(k_df), pos)
        vd = heads(v_df, N_DIFF_HEADS, DIFF_V_DIM)
        lam_init = 0.8 - 0.6 * math.exp(-0.3 * i)
        lam = (jnp.exp(jnp.sum(lam_q1[i].astype(jnp.float32) * lam_k1[i].astype(jnp.float32)))
               - jnp.exp(jnp.sum(lam_q2[i].astype(jnp.float32) * lam_k2[i].astype(jnp.float32)))
               + lam_init)
        o_df = differential_attention(qd, kd, vd, lam)
        o_df = (rmsnorm(o_df, g_diff[i]) * (1.0 - lam_init)).astype(h.dtype)
        o_df = o_df.transpose(0, 2, 1, 3).reshape(B, S, DIFF_WIDTH)

        h = h + jnp.concatenate([o_sb, o_df], axis=-1) @ w_out[i]

        m = rmsnorm(h, g_moe[i])
        h = h + hierarchical_moe(m, w_router_group[i], w_router_expert[i],
                                 w_gate[i], w_up[i], w_down[i])

        e = rmsnorm(h, g_ple[i])
        h = h + (p[i] @ w_ple[i]) * jax.nn.sigmoid(e @ w_ple_gate[i])
    return rmsnorm(h, g_final)
```

```cpp
#include <hip/hip_runtime.h>
#include <hip/hip_bf16.h>
#include <cstdio>
#include <cstdint>
namespace pg8 {
#define PG8_LAS __attribute__((address_space(3)))
typedef unsigned short bf16_t;
typedef short bf16x8 __attribute__((ext_vector_type(8)));
typedef float f32x4 __attribute__((ext_vector_type(4)));
typedef unsigned u32x4 __attribute__((ext_vector_type(4)));
constexpr int BM = 256, BK = 64, HALF = 128, HTB = HALF * BK * 2  , STAGE_BYTES = 8 * HTB, NXCD = 8, WGM = 8;

__host__ __device__ __forceinline__ int lds_byte(int r, int c) { const int st = (r >> 4) * 2 + (c >> 5), rr = r & 15, cc = c & 31, ob = rr * 64 + cc * 2; return st * 1024 + (ob ^ (((ob >> 9) & 1) << 5)); }
__host__ __device__ __forceinline__ void stage_rc(int b, int& R, int& C) { const int st = b / 1024, sb = b % 1024, swz = sb ^ (((sb >> 9) & 1) << 5); R = (st >> 1) * 16 + swz / 64; C = (st & 1) * 32 + (swz % 64) / 2; }
__host__ __device__ __forceinline__ int perm32(int rho) { const int n = rho >> 4, i = rho & 15; return 8 * (i >> 2) + 4 * n + (i & 3); }

struct Unit { int pm, pn, pb, aux0, aux1; };
struct Gemm { const bf16_t* A; const bf16_t* Bt; int M, N, K; };

struct StaticOrder {
    int nM, nN, nwg, G, c;
    __host__ __device__ void init(int M, int N, int G_, int c_) { nM = M / BM; nN = N / BM; nwg = nM * nN; G = G_; c = c_; }
    __host__ __device__ bool next(int i, Unit& u) const {
        const long L = (long)i * G + c; if (L >= nwg) return false;
        int wgid = (int)L; { const int q = nwg / NXCD, r = nwg % NXCD, xcd = wgid % NXCD, off = wgid / NXCD; wgid = (xcd < r ? xcd * (q + 1) : r * (q + 1) + (xcd - r) * q) + off; }
        const int nig = WGM * nN, gid = wgid / nig, fm = gid * WGM, gsz = (nM - fm) < WGM ? (nM - fm) : WGM;
        u.pm = fm + ((wgid % nig) % gsz); u.pn = (wgid % nig) / gsz; u.pb = u.pn; u.aux0 = 0; u.aux1 = 0; return true;
    }
    __device__ __forceinline__ void a_ready(const Unit&) const {}
    __device__ __forceinline__ void done(const Unit&) const {}
};

__device__ __forceinline__ unsigned cvt_pk_bf16(float lo, float hi) { unsigned r; asm volatile("v_cvt_pk_bf16_f32 %0, %1, %2" : "=v"(r) : "v"(lo), "v"(hi)); return r; }
typedef float f32x2 __attribute__((ext_vector_type(2)));
#define PG8_FRESH_LANE(fr, fq) int l__; asm volatile("v_mbcnt_lo_u32_b32 %0, -1, 0\n\tv_mbcnt_hi_u32_b32 %0, -1, %0" : "=v"(l__)); const int fr = l__ & 15, fq = l__ >> 4; (void)fr_; (void)fq_
typedef unsigned u32x2 __attribute__((ext_vector_type(2)));
__device__ __forceinline__ float bf_lo(unsigned w) { return __uint_as_float(w << 16); }
__device__ __forceinline__ float bf_hi(unsigned w) { return __uint_as_float(w & 0xffff0000u); }

struct EpiQKV {
    static constexpr bool PERM = true, AFTER_DRAIN = false;
    bf16_t* O; const float* rope;
    __device__ __forceinline__ void operator()(const f32x4 (&acc)[2][2][4][2], const Unit& u, int wr, int wc, int fr_, int fq_) const {
        PG8_FRESH_LANE(fr, fq);
        const int row0 = u.pm * BM + wr * 64 + fr, col0 = u.pn * BM + wc * 32 + 8 * fq;
        const bool rot = (u.pn >= 12) && (u.pn < 20) && ((wc & 1) == 0);
#pragma unroll
        for (int ai = 0; ai < 2; ++ai)
#pragma unroll
            for (int m = 0; m < 4; ++m) { const int row = row0 + ai * HALF + m * 16; bf16_t* rowp = O + (size_t)row * 6144 + col0;
                f32x4 c0 = {1.f, 1.f, 1.f, 1.f}, c1 = c0, s0 = {0.f, 0.f, 0.f, 0.f}, s1 = s0;
                if (rot) { const float* t = rope + (size_t)(row & 8191) * 16; c0 = *(const f32x4*)(t); c1 = *(const f32x4*)(t + 4); s0 = *(const f32x4*)(t + 8); s1 = *(const f32x4*)(t + 12);
                    if (fq == 0) { s0 = -s0; s1 = -s1; } else if (fq != 1) { s0 = (f32x4){0.f, 0.f, 0.f, 0.f}; s1 = s0; c0 = (f32x4){1.f, 1.f, 1.f, 1.f}; c1 = c0; } }
#pragma unroll
                for (int bj = 0; bj < 2; ++bj) { f32x4 v0 = acc[ai][bj][m][0], v1 = acc[ai][bj][m][1];
                    if (rot) { f32x4 p0, p1;
#pragma unroll
                        for (int j = 0; j < 4; ++j) { p0[j] = __shfl_xor(v0[j], 16); p1[j] = __shfl_xor(v1[j], 16); }
                        v0 = v0 * c0 + p0 * s0; v1 = v1 * c1 + p1 * s1; }
                    u32x4 w; w.x = cvt_pk_bf16(v0[0], v0[1]); w.y = cvt_pk_bf16(v0[2], v0[3]); w.z = cvt_pk_bf16(v1[0], v1[1]); w.w = cvt_pk_bf16(v1[2], v1[3]);
                    *(u32x4*)(rowp + bj * HALF) = w; } }
    }
};
struct EpiBf16 {
    static constexpr bool PERM = true, AFTER_DRAIN = false;
    bf16_t* O; int ldc;
    __device__ __forceinline__ void operator()(const f32x4 (&acc)[2][2][4][2], const Unit& u, int wr, int wc, int fr_, int fq_) const {
        PG8_FRESH_LANE(fr, fq);
        const int row0 = u.pm * BM + wr * 64 + fr, col0 = u.pn * BM + wc * 32 + 8 * fq;
#pragma unroll
        for (int ai = 0; ai < 2; ++ai)
#pragma unroll
            for (int m = 0; m < 4; ++m) { bf16_t* rowp = O + (size_t)(row0 + ai * HALF + m * 16) * ldc + col0;
#pragma unroll
                for (int bj = 0; bj < 2; ++bj) { const f32x4 v0 = acc[ai][bj][m][0], v1 = acc[ai][bj][m][1];
                    u32x4 w; w.x = cvt_pk_bf16(v0[0], v0[1]); w.y = cvt_pk_bf16(v0[2], v0[3]); w.z = cvt_pk_bf16(v1[0], v1[1]); w.w = cvt_pk_bf16(v1[2], v1[3]);
                    *(u32x4*)(rowp + bj * HALF) = w; } }
    }
};
struct EpiResF32 {
    static constexpr bool PERM = false, AFTER_DRAIN = false;
    const float* base; float* out; int ldc;
    __device__ __forceinline__ void operator()(const f32x4 (&acc)[2][2][4][2], const Unit& u, int wr, int wc, int fr_, int fq_) const {
        PG8_FRESH_LANE(fr, fq);
        const int row0 = u.pm * BM + wr * 64 + fr, col0 = u.pn * BM + wc * 32 + 4 * fq;
#pragma unroll
        for (int ai = 0; ai < 2; ++ai)
#pragma unroll
            for (int m = 0; m < 4; ++m) { const size_t off = (size_t)(row0 + ai * HALF + m * 16) * ldc + col0;
#pragma unroll
                for (int bj = 0; bj < 2; ++bj)
#pragma unroll
                    for (int n = 0; n < 2; ++n) { const f32x4 b = *(const f32x4*)(base + off + bj * HALF + n * 16); *(f32x4*)(out + off + bj * HALF + n * 16) = b + acc[ai][bj][m][n]; }
                asm volatile("" ::: "memory"); }
    }
};
struct EpiPle {
    static constexpr bool PERM = false, AFTER_DRAIN = false;
    float* io; const bf16_t* U; int ldc;
    __device__ __forceinline__ void operator()(const f32x4 (&acc)[2][2][4][2], const Unit& u, int wr, int wc, int fr_, int fq_) const {
        PG8_FRESH_LANE(fr, fq);
        const int row0 = u.pm * BM + wr * 64 + fr, col0 = u.pn * BM + wc * 32 + 4 * fq;
#pragma unroll
        for (int ai = 0; ai < 2; ++ai)
#pragma unroll
            for (int m = 0; m < 4; ++m) { const size_t off = (size_t)(row0 + ai * HALF + m * 16) * ldc + col0;
#pragma unroll
                for (int bj = 0; bj < 2; ++bj)
#pragma unroll
                    for (int n = 0; n < 2; ++n) { const size_t o = off + bj * HALF + n * 16; const f32x4 b = *(const f32x4*)(io + o); const u32x2 uw = *(const u32x2*)(U + o); const f32x4 a = acc[ai][bj][m][n];
                        f32x4 r; r[0] = b[0] + bf_lo(uw.x) * __builtin_amdgcn_rcpf(1.f + __builtin_amdgcn_exp2f(-1.4426950408889634f * a[0]));
                        r[1] = b[1] + bf_hi(uw.x) * __builtin_amdgcn_rcpf(1.f + __builtin_amdgcn_exp2f(-1.4426950408889634f * a[1]));
                        r[2] = b[2] + bf_lo(uw.y) * __builtin_amdgcn_rcpf(1.f + __builtin_amdgcn_exp2f(-1.4426950408889634f * a[2]));
                        r[3] = b[3] + bf_hi(uw.y) * __builtin_amdgcn_rcpf(1.f + __builtin_amdgcn_exp2f(-1.4426950408889634f * a[3]));
                        *(f32x4*)(io + o) = r; }
                asm volatile("" ::: "memory"); }
    }
};
struct EpiSwiglu {
    static constexpr bool PERM = true, AFTER_DRAIN = false;
    bf16_t* H;
    __device__ __forceinline__ void operator()(const f32x4 (&acc)[2][2][4][2], const Unit& u, int wr, int wc, int fr_, int fq_) const {
        PG8_FRESH_LANE(fr, fq);
        const int row0 = u.pm * BM + wr * 64 + fr, col0 = u.pn * HALF + wc * 32 + 8 * fq;
#pragma unroll
        for (int ai = 0; ai < 2; ++ai)
#pragma unroll
            for (int m = 0; m < 4; ++m) { bf16_t* rowp = H + (size_t)(row0 + ai * HALF + m * 16) * 512 + col0; float h[8];
#pragma unroll
                for (int n = 0; n < 2; ++n)
#pragma unroll
                    for (int j = 0; j < 4; ++j) { const float g = acc[ai][0][m][n][j], up = acc[ai][1][m][n][j];
                        h[n * 4 + j] = g * up * __builtin_amdgcn_rcpf(1.f + __builtin_amdgcn_exp2f(-1.4426950408889634f * g)); }
                u32x4 w; w.x = cvt_pk_bf16(h[0], h[1]); w.y = cvt_pk_bf16(h[2], h[3]); w.z = cvt_pk_bf16(h[4], h[5]); w.w = cvt_pk_bf16(h[6], h[7]);
                *(u32x4*)rowp = w; asm volatile("" ::: "memory"); }
    }
};
struct EpiScatter {
    static constexpr bool PERM = true, AFTER_DRAIN = false;
    bf16_t* Y; const int* lslot; const float* lgate;
    __device__ __forceinline__ void operator()(const f32x4 (&acc)[2][2][4][2], const Unit& u, int wr, int wc, int fr_, int fq_) const {
        PG8_FRESH_LANE(fr, fq);
        const int r0 = wr * 64 + fr, col0 = u.pn * BM + wc * 32 + 8 * fq;
#pragma unroll
        for (int ai = 0; ai < 2; ++ai)
#pragma unroll
            for (int m = 0; m < 4; ++m) { const int r = r0 + ai * HALF + m * 16;
                if (r < u.aux1) { const int slot = lslot[u.aux0 + r]; const float g = lgate[u.aux0 + r]; bf16_t* rowp = Y + (size_t)slot * 2048 + col0;
#pragma unroll
                    for (int bj = 0; bj < 2; ++bj) { const f32x4 v0 = acc[ai][bj][m][0] * g, v1 = acc[ai][bj][m][1] * g;
                        u32x4 w; w.x = cvt_pk_bf16(v0[0], v0[1]); w.y = cvt_pk_bf16(v0[2], v0[3]); w.z = cvt_pk_bf16(v1[0], v1[1]); w.w = cvt_pk_bf16(v1[2], v1[3]);
                        *(u32x4*)(rowp + bj * HALF) = w; } }
                asm volatile("" ::: "memory"); }
    }
};
struct MoeOrder {
    int nM, nN, nwg, G, c; const PG8_LAS int* tstart; const PG8_LAS int* cnt;
    __device__ void init(int nM_, int nN_, int G_, int c_, const PG8_LAS int* ts, const PG8_LAS int* cn) { nM = nM_; nN = nN_; nwg = nM * nN; G = G_; c = c_; tstart = ts; cnt = cn; }
    __device__ bool next(int i, Unit& u) const {
        const long L = (long)i * G + c; if (L >= nwg) return false;
        int wgid = (int)L; { const int q = nwg / NXCD, r = nwg % NXCD, xcd = wgid % NXCD, off = wgid / NXCD; wgid = (xcd < r ? xcd * (q + 1) : r * (q + 1) + (xcd - r) * q) + off; }
        const int nig = WGM * nN, gid = wgid / nig, fm = gid * WGM, gsz = (nM - fm) < WGM ? (nM - fm) : WGM;
        const int pm = fm + ((wgid % nig) % gsz), pn = (wgid % nig) / gsz;
        int e = 0;
        for (int k = 1; k < 32; ++k) e += (__builtin_amdgcn_readfirstlane(tstart[k]) <= pm) ? 1 : 0;
        const int t = pm - __builtin_amdgcn_readfirstlane(tstart[e]); const int left = __builtin_amdgcn_readfirstlane(cnt[e]) - t * 256;
        u.pm = pm; u.pn = pn; u.pb = e * nN + pn; u.aux0 = e * 65536 + t * 256; u.aux1 = left < 256 ? left : 256; return true;
    }
    __device__ __forceinline__ void a_ready(const Unit&) const {}
    __device__ __forceinline__ void done(const Unit&) const {}
};
template <class Epi, class Sched, bool ALIGN_EPI = false, bool SP2 = false>
__device__ __forceinline__ void gemm_phase(PG8_LAS unsigned char* lds, const Gemm g, const Sched& S, const Epi& E) {
    const int tid = threadIdx.x, wid = __builtin_amdgcn_readfirstlane(tid >> 6), lane = tid & 63, wr = wid >> 2, wc = wid & 3, fr = lane & 15, fq = lane >> 4;
    const int K = g.K, nt = K / BK;
    unsigned voffA[2], voffB[2];
#pragma unroll
    for (int i = 0; i < 2; ++i) { int R, C; stage_rc(tid * 16 + i * 8192, R, C); const int Rb = Epi::PERM ? ((R & ~31) + perm32(R & 31)) : R;
        voffA[i] = (unsigned)(R * K + C) * 2u; voffB[i] = (unsigned)(Rb * K + C) * 2u; }
    const size_t kstep = (size_t)(BK * 2);
    const size_t hstep = (size_t)HALF * K * 2;
    const size_t tstep = 2 * hstep;
    const unsigned ldsw = (unsigned)wid * 1024u;
    const int aoff = lds_byte(wr * 64 + fr, fq * 8), boff = lds_byte(wc * 32 + fr, fq * 8);
#define PG8_SA(b, h) (((b) * 2 + (h)) * HTB)
#define PG8_SB(b, h) ((4 + (b) * 2 + (h)) * HTB)
#define PG8_STAGE(bufoff, gbase, voff) do { _Pragma("unroll") for (int _i = 0; _i < 2; ++_i) \
        __builtin_amdgcn_global_load_lds((const unsigned*)((const char*)(gbase) + (voff)[_i]), (PG8_LAS unsigned*)(lds + (bufoff) + ldsw + _i * 8192), 16, 0, 0); } while (0)
#define PG8_LDA(dst, b, h) do { _Pragma("unroll") for (int m = 0; m < 4; ++m) _Pragma("unroll") for (int k = 0; k < 2; ++k) dst[m][k] = *(const PG8_LAS bf16x8*)(lds + PG8_SA(b, h) + aoff + m * 2048 + k * 1024); } while (0)
#define PG8_LDB(dst, b, h) do { _Pragma("unroll") for (int n = 0; n < 2; ++n) _Pragma("unroll") for (int k = 0; k < 2; ++k) dst[n][k] = *(const PG8_LAS bf16x8*)(lds + PG8_SB(b, h) + boff + n * 2048 + k * 1024); } while (0)
#define PG8_MMA(ai, bj, At, Bt) do { __builtin_amdgcn_s_setprio(1); _Pragma("unroll") for (int m = 0; m < 4; ++m) _Pragma("unroll") for (int n = 0; n < 2; ++n) _Pragma("unroll") for (int k = 0; k < 2; ++k) \
        acc[ai][bj][m][n] = __builtin_amdgcn_mfma_f32_16x16x32_bf16(Bt[n][k], At[m][k], acc[ai][bj][m][n], 0, 0, 0); __builtin_amdgcn_s_setprio(0); } while (0)
#define PG8_WAIT_V(n) asm volatile("s_waitcnt vmcnt(" #n ")" ::: "memory")
#define PG8_WAIT_L(n) asm volatile("s_waitcnt lgkmcnt(" #n ")" ::: "memory")
#define PG8_BAR __builtin_amdgcn_s_barrier()
#define PG8_SCHED __builtin_amdgcn_sched_barrier(0)
    Unit cur, nxt; int ui = 0;
    if (!S.next(0, cur)) return;
    f32x4 acc[2][2][4][2];
#pragma unroll
    for (int a = 0; a < 2; ++a)
#pragma unroll
        for (int b = 0; b < 2; ++b)
#pragma unroll
            for (int m = 0; m < 4; ++m)
#pragma unroll
                for (int n = 0; n < 2; ++n) acc[a][b][m][n] = (f32x4){0.f, 0.f, 0.f, 0.f};
    bf16x8 At[4][2], B0[2][2], B1[2][2];
    const char* cA = (const char*)g.A + (size_t)cur.pm * tstep; const char* cB = (const char*)g.Bt + (size_t)cur.pb * tstep;
    S.a_ready(cur);
    if constexpr (SP2) {
        PG8_STAGE(PG8_SB(0, 0), cB, voffB); PG8_STAGE(PG8_SB(0, 1), cB + hstep, voffB); PG8_STAGE(PG8_SA(0, 0), cA, voffA); PG8_STAGE(PG8_SA(0, 1), cA + hstep, voffA);
        if (wr == 1) PG8_BAR;
        PG8_WAIT_V(2); PG8_BAR;
        PG8_STAGE(PG8_SB(1, 0), cB + kstep, voffB); PG8_STAGE(PG8_SA(1, 0), cA + kstep, voffA); PG8_STAGE(PG8_SB(1, 1), cB + hstep + kstep, voffB);
        PG8_WAIT_V(6); PG8_BAR;
    } else {
        PG8_STAGE(PG8_SB(0, 0), cB, voffB); PG8_STAGE(PG8_SA(0, 0), cA, voffA); PG8_STAGE(PG8_SB(0, 1), cB + hstep, voffB); PG8_STAGE(PG8_SA(0, 1), cA + hstep, voffA);
        if (wr == 1) PG8_BAR;
        PG8_WAIT_V(4); PG8_BAR;
        PG8_STAGE(PG8_SB(1, 0), cB + kstep, voffB); PG8_STAGE(PG8_SA(1, 0), cA + kstep, voffA); PG8_STAGE(PG8_SB(1, 1), cB + hstep + kstep, voffB);
        PG8_WAIT_V(6); PG8_BAR;
    }
    for (;;) {
        const bool has_next = S.next(ui + 1, nxt);
        const char* nA = has_next ? (const char*)g.A + (size_t)nxt.pm * tstep : cA; const char* nB = has_next ? (const char*)g.Bt + (size_t)nxt.pb * tstep : cB;
#pragma unroll 1
        for (int t = 0; t < nt; t += 2) {
            const bool last = (t == nt - 2);
            const char* a1 = cA + (size_t)(t + 1) * kstep;
            const char* a2 = last ? nA : cA + (size_t)(t + 2) * kstep; const char* b2 = last ? nB : cB + (size_t)(t + 2) * kstep;
            const char* a3 = a2 + kstep; const char* b3 = b2 + kstep;
            if (last && has_next) S.a_ready(nxt);
            if constexpr (SP2) {
            PG8_LDB(B0, 0, 0); PG8_LDB(B1, 0, 1); PG8_SCHED; PG8_LDA(At, 0, 0); PG8_STAGE(PG8_SA(1, 1), a1 + hstep, voffA);
            PG8_WAIT_V(8); PG8_WAIT_L(0); PG8_BAR; PG8_MMA(0, 0, At, B0); PG8_MMA(0, 1, At, B1); PG8_BAR; PG8_SCHED;
            PG8_LDA(At, 0, 1); PG8_STAGE(PG8_SB(0, 0), b2, voffB); PG8_STAGE(PG8_SB(0, 1), b2 + hstep, voffB); PG8_STAGE(PG8_SA(0, 0), a2, voffA);
            PG8_WAIT_V(8); PG8_WAIT_L(0); PG8_BAR; PG8_MMA(1, 0, At, B0); PG8_MMA(1, 1, At, B1); PG8_BAR; PG8_SCHED;
            PG8_LDB(B0, 1, 0); PG8_LDB(B1, 1, 1); PG8_SCHED; PG8_LDA(At, 1, 0); PG8_STAGE(PG8_SA(0, 1), a2 + hstep, voffA);
            PG8_WAIT_V(8); PG8_WAIT_L(0); PG8_BAR; PG8_MMA(0, 0, At, B0); PG8_MMA(0, 1, At, B1); PG8_BAR; PG8_SCHED;
            PG8_LDA(At, 1, 1); PG8_STAGE(PG8_SB(1, 0), b3, voffB); PG8_STAGE(PG8_SB(1, 1), b3 + hstep, voffB); PG8_STAGE(PG8_SA(1, 0), a3, voffA);
            PG8_WAIT_V(8); PG8_WAIT_L(0); PG8_BAR; PG8_MMA(1, 0, At, B0); PG8_MMA(1, 1, At, B1); PG8_BAR; PG8_SCHED;
            } else {
            PG8_LDB(B0, 0, 0); PG8_SCHED; PG8_LDA(At, 0, 0); PG8_STAGE(PG8_SA(1, 1), a1 + hstep, voffA);
            PG8_WAIT_L(8); PG8_BAR; PG8_WAIT_L(0); PG8_MMA(0, 0, At, B0); PG8_BAR; PG8_SCHED;
            PG8_LDB(B1, 0, 1); PG8_STAGE(PG8_SB(0, 0), b2, voffB);
            PG8_BAR; PG8_WAIT_L(0); PG8_MMA(0, 1, At, B1); PG8_BAR;
            PG8_LDA(At, 0, 1); PG8_STAGE(PG8_SA(0, 0), a2, voffA);
            PG8_BAR; PG8_WAIT_L(0); PG8_MMA(1, 0, At, B0); PG8_BAR; PG8_SCHED;
            PG8_STAGE(PG8_SB(0, 1), b2 + hstep, voffB);
            PG8_WAIT_V(6); PG8_BAR; PG8_MMA(1, 1, At, B1); PG8_BAR;
            PG8_LDB(B0, 1, 0); PG8_SCHED; PG8_LDA(At, 1, 0); PG8_STAGE(PG8_SA(0, 1), a2 + hstep, voffA);
            PG8_WAIT_L(8); PG8_BAR; PG8_WAIT_L(0); PG8_MMA(0, 0, At, B0); PG8_BAR; PG8_SCHED;
            PG8_LDB(B1, 1, 1); PG8_STAGE(PG8_SB(1, 0), b3, voffB);
            PG8_BAR; PG8_WAIT_L(0); PG8_MMA(0, 1, At, B1); PG8_BAR;
            PG8_LDA(At, 1, 1); PG8_STAGE(PG8_SA(1, 0), a3, voffA);
            PG8_BAR; PG8_WAIT_L(0); PG8_MMA(1, 0, At, B0); PG8_BAR; PG8_SCHED;
            PG8_STAGE(PG8_SB(1, 1), b3 + hstep, voffB);
            PG8_WAIT_V(6); PG8_BAR; PG8_MMA(1, 1, At, B1); PG8_BAR;
            }
        }
        if constexpr (ALIGN_EPI) { if (wr == 0) PG8_BAR; }
        if constexpr (!Epi::AFTER_DRAIN) { E(acc, cur, wr, wc, fr, fq); S.done(cur); }
        if (!has_next) break;
#pragma unroll
        for (int a = 0; a < 2; ++a)
#pragma unroll
            for (int b = 0; b < 2; ++b)
#pragma unroll
                for (int m = 0; m < 4; ++m)
#pragma unroll
                    for (int n = 0; n < 2; ++n) acc[a][b][m][n] = (f32x4){0.f, 0.f, 0.f, 0.f};
        cur = nxt; cA = nA; cB = nB; ++ui;
        if constexpr (ALIGN_EPI) { if (wr == 1) PG8_BAR; }
    }
    PG8_WAIT_V(0);
    if constexpr (!ALIGN_EPI) { if (wr == 0) PG8_BAR; }
    PG8_BAR;
    if constexpr (Epi::AFTER_DRAIN) { E.fused(acc, cur, wr, wc, fr, fq, lds, wid, lane); S.done(cur); }
#undef PG8_SA
#undef PG8_SB
#undef PG8_STAGE
#undef PG8_LDA
#undef PG8_LDB
#undef PG8_MMA
#undef PG8_WAIT_V
#undef PG8_WAIT_L
#undef PG8_BAR
#undef PG8_SCHED
}
}
namespace att {
using bf16 = unsigned short;
using bf16x8 = __attribute__((ext_vector_type(8))) short;
using s16x4  = __attribute__((ext_vector_type(4))) short;
using f32x16 = __attribute__((ext_vector_type(16))) float;
using u32x4  = __attribute__((ext_vector_type(4))) unsigned;
constexpr int LDQKV = 6144;
constexpr int SEQ_ = 8192;
constexpr size_t SHM_V = 64 * 128 * 2, SHM_K = 64 * 128 * 2, SHM_ATTN = 2 * SHM_V + 2 * SHM_K + 8 * 64 * 4 + 64;
#define KSWZ(row, colB) ((row) * 256 + ((colB) ^ (((row) & 7) << 4)))
#define SBAR() __builtin_amdgcn_sched_barrier(0)
__device__ __forceinline__ int crow(int r, int hi) { return (r & 3) + 8 * (r >> 2) + 4 * hi; }
__device__ __forceinline__ unsigned cvtpk(float lo, float hi) { unsigned r; asm volatile("v_cvt_pk_bf16_f32 %0, %1, %2" : "=v"(r) : "v"(lo), "v"(hi)); return r; }
__device__ __forceinline__ int v_st(int k, int c) { const int kk = (k & ~0xC) | ((k & 4) << 1) | ((k & 8) >> 1); return ((kk >> 3) * 4 + (c >> 5)) * 512 + ((kk & 7) * 32 + (c & 31)) * 2; }
__device__ __forceinline__ int v_rd_base(int lane) { return ((lane & 3) << 3) | (((lane >> 2) & 3) << 6) | (((lane >> 4) & 1) << 5) | (((lane >> 5) & 1) << 8); }
constexpr int v_rd_off(int d0, int ks, int half) { return d0 * 512 + ks * 4096 + half * 2048; }
template <int OFF> __device__ __forceinline__ s16x4 tr_read(int vb) { s16x4 r; asm volatile("ds_read_b64_tr_b16 %0, %1 offset:%2" : "=&v"(r) : "v"(vb), "i"(OFF) : "memory"); return r; }
template <int D0> __device__ __forceinline__ void pv_one(f32x16& od, int vb, bf16x8 pa0, bf16x8 pa1, bf16x8 pa2, bf16x8 pa3) {
  const s16x4 l0 = tr_read<v_rd_off(D0, 0, 0)>(vb), h0 = tr_read<v_rd_off(D0, 0, 1)>(vb), l1 = tr_read<v_rd_off(D0, 1, 0)>(vb), h1 = tr_read<v_rd_off(D0, 1, 1)>(vb);
  const s16x4 l2 = tr_read<v_rd_off(D0, 2, 0)>(vb), h2 = tr_read<v_rd_off(D0, 2, 1)>(vb), l3 = tr_read<v_rd_off(D0, 3, 0)>(vb), h3 = tr_read<v_rd_off(D0, 3, 1)>(vb);
  asm volatile("s_waitcnt lgkmcnt(0)" ::: "memory"); SBAR();
#define PK(L, H) (bf16x8){L[0], L[1], L[2], L[3], H[0], H[1], H[2], H[3]}
  od = __builtin_amdgcn_mfma_f32_32x32x16_bf16(pa0, PK(l0, h0), od, 0, 0, 0);
  od = __builtin_amdgcn_mfma_f32_32x32x16_bf16(pa1, PK(l1, h1), od, 0, 0, 0);
  od = __builtin_amdgcn_mfma_f32_32x32x16_bf16(pa2, PK(l2, h2), od, 0, 0, 0);
  od = __builtin_amdgcn_mfma_f32_32x32x16_bf16(pa3, PK(l3, h3), od, 0, 0, 0);
#undef PK
}
__device__ __forceinline__ void pv_d0(f32x16* o, int vb, bf16x8 pa0, bf16x8 pa1, bf16x8 pa2, bf16x8 pa3) {
  pv_one<0>(o[0], vb, pa0, pa1, pa2, pa3); pv_one<1>(o[1], vb, pa0, pa1, pa2, pa3); pv_one<2>(o[2], vb, pa0, pa1, pa2, pa3); pv_one<3>(o[3], vb, pa0, pa1, pa2, pa3);
}
__device__ __forceinline__ void pack_p(const f32x16& p0, const f32x16& p1, bf16x8& pa0, bf16x8& pa1, bf16x8& pa2, bf16x8& pa3) {
#define PK4(P, BASE, OUT) do { unsigned a0 = cvtpk(P[BASE + 0], P[BASE + 1]), a1 = cvtpk(P[BASE + 2], P[BASE + 3]);   \
    unsigned b0 = cvtpk(P[BASE + 4], P[BASE + 5]), b1 = cvtpk(P[BASE + 6], P[BASE + 7]);                              \
    auto r0 = __builtin_amdgcn_permlane32_swap(a0, b0, false, false); auto r1 = __builtin_amdgcn_permlane32_swap(a1, b1, false, false); \
    u32x4 w = {r0[0], r1[0], r0[1], r1[1]}; OUT = *reinterpret_cast<bf16x8*>(&w); } while (0)
  PK4(p0, 0, pa0); PK4(p0, 8, pa1); PK4(p1, 0, pa2); PK4(p1, 8, pa3);
#undef PK4
}
template <int ND> __device__ __forceinline__ void qkt(f32x16& p0, f32x16& p1, const char* Ks, const bf16x8* qr, int cb0, int r32, int hi) {
  p0 = f32x16{}; p1 = f32x16{};
#pragma unroll
  for (int d0 = 0; d0 < ND; ++d0) { const int cb = cb0 + (d0 * 16 + hi * 8) * 2;
    const bf16x8 b0 = *reinterpret_cast<const bf16x8*>(Ks + KSWZ(r32, cb));
    const bf16x8 b1 = *reinterpret_cast<const bf16x8*>(Ks + KSWZ(32 + r32, cb));
    p0 = __builtin_amdgcn_mfma_f32_32x32x16_bf16(b0, qr[d0], p0, 0, 0, 0);
    p1 = __builtin_amdgcn_mfma_f32_32x32x16_bf16(b1, qr[d0], p1, 0, 0, 0); }
}
constexpr float THRL = 11.5f;
__device__ __forceinline__ void partialSM(f32x16& p0, f32x16& p1, float& m_reg, float& mn, float& alpha) {
  float pmax = p0[0];
#pragma unroll
  for (int r = 1; r < 16; ++r) pmax = fmaxf(pmax, p0[r]);
#pragma unroll
  for (int r = 0; r < 16; ++r) pmax = fmaxf(pmax, p1[r]);
  { auto rr = __builtin_amdgcn_permlane32_swap(__float_as_uint(pmax), __float_as_uint(pmax), false, false); pmax = fmaxf(__uint_as_float(rr[0]), __uint_as_float(rr[1])); }
  if (__builtin_expect(__all(pmax - m_reg <= THRL), 1)) { mn = m_reg; alpha = 1.f; }
  else { mn = fmaxf(m_reg, pmax); alpha = __builtin_amdgcn_exp2f(m_reg - mn); m_reg = mn; }
#pragma unroll
  for (int r = 0; r < 16; ++r) p0[r] = p0[r] - mn;
#pragma unroll
  for (int r = 0; r < 16; ++r) p1[r] = p1[r] - mn;
#pragma unroll
  for (int r = 0; r < 16; ++r) p0[r] = __builtin_amdgcn_exp2f(p0[r]);
}
__device__ __forceinline__ void finishSM(f32x16& p0, f32x16& p1, float alpha, float& l_reg, bf16x8& pa0, bf16x8& pa1, bf16x8& pa2, bf16x8& pa3) {
#pragma unroll
  for (int r = 0; r < 16; ++r) p1[r] = __builtin_amdgcn_exp2f(p1[r]);
  float ps = 0;
#pragma unroll
  for (int r = 0; r < 16; ++r) ps += p0[r];
#pragma unroll
  for (int r = 0; r < 16; ++r) ps += p1[r];
  { auto rr = __builtin_amdgcn_permlane32_swap(__float_as_uint(ps), __float_as_uint(ps), false, false); ps = __uint_as_float(rr[0]) + __uint_as_float(rr[1]); }
  l_reg = l_reg * alpha + ps;
  pack_p(p0, p1, pa0, pa1, pa2, pa3);
}
__device__ __forceinline__ float half_sum32(float v) {
#pragma unroll
  for (int o = 1; o < 32; o <<= 1) v += __shfl_xor(v, o);
  return v;
}

__device__ __forceinline__ void diff_unit(int b, int h, int qb, const bf16* __restrict__ QKV, bf16* __restrict__ Oout, const float* __restrict__ gdiff, float lam, float oscale, char* lds) {
  const int tid = threadIdx.x, lane = tid & 63, r32 = lane & 31, hi = lane >> 5; const int wid = __builtin_amdgcn_readfirstlane(tid >> 6);
  const int map = wid >> 2, wq = wid & 3;
  bf16* V_lds = (bf16*)lds; bf16* K_lds = (bf16*)(lds + 2 * SHM_V);
  float* ws = (float*)(lds + 2 * SHM_V + 2 * SHM_K) + wid * 64; float* li_l = ws; float* al_l = ws + 32;
  float m_reg = -1e30f, l_reg = 0; f32x16 o[4] = {}; bf16x8 qr[4];
  const size_t rowb = (size_t)b * SEQ_;
  const bf16* Qw = QKV + (rowb + qb * 128 + wq * 32 + r32) * LDQKV + 3072 + h * 128 + map * 64 + hi * 8;
#pragma unroll
  for (int d0 = 0; d0 < 4; ++d0) qr[d0] = *reinterpret_cast<const bf16x8*>(Qw + d0 * 16);
  const bf16* Kh = QKV + rowb * LDQKV + 4096 + h * 128; const bf16* Vh = QKV + rowb * LDQKV + 5120 + h * 128;
  const int sr = tid >> 4, sc = (tid & 15) * 8, vst0 = v_st(sr, sc), vst1 = v_st(32 + sr, sc);
  const int vb0 = (int)(uintptr_t)V_lds + v_rd_base(lane);
  const int cbm = map * 128;
  struct { bf16x8 vs0, vs1, ks0, ks1; } sr_[1];
  const unsigned toff0 = (unsigned)(sr * LDQKV + sc), toff1 = toff0 + 32u * LDQKV;
#define SLOAD(i, k0) do { const bf16* vt_ = Vh + (size_t)(k0) * LDQKV; const bf16* kt_ = Kh + (size_t)(k0) * LDQKV; \
    sr_[i].vs0 = *reinterpret_cast<const bf16x8*>(vt_ + toff0); sr_[i].vs1 = *reinterpret_cast<const bf16x8*>(vt_ + toff1); \
    sr_[i].ks0 = *reinterpret_cast<const bf16x8*>(kt_ + toff0); sr_[i].ks1 = *reinterpret_cast<const bf16x8*>(kt_ + toff1); } while (0)
#define SWRITE(bb, i) do { *(bf16x8*)((char*)V_lds + (bb) * SHM_V + vst0) = sr_[i].vs0; *(bf16x8*)((char*)V_lds + (bb) * SHM_V + vst1) = sr_[i].vs1; const int kc = sc * 2; \
    *(bf16x8*)((char*)K_lds + (bb) * SHM_K + KSWZ(sr, kc)) = sr_[i].ks0; *(bf16x8*)((char*)K_lds + (bb) * SHM_K + KSWZ(32 + sr, kc)) = sr_[i].ks1; } while (0)
#define SWAIT() asm volatile("s_waitcnt vmcnt(0)" ::: "memory")
#define RESC(a) do { if (__any((a) < 1.f)) { if (hi == 0) al_l[r32] = (a); asm volatile("s_waitcnt lgkmcnt(0)" ::: "memory"); \
    _Pragma("unroll") for (int d = 0; d < 4; ++d) _Pragma("unroll") for (int r = 0; r < 16; ++r) o[d][r] *= al_l[crow(r, hi)]; } } while (0)
  f32x16 pA0, pA1, pB0, pB1; float mnA, mnB, alA, alB; bf16x8 pa0, pa1, pa2, pa3; const int NT = 2 * qb + 2;
  __syncthreads();
  SLOAD(0, 0); asm volatile("s_waitcnt vmcnt(0)" ::: "memory"); SWRITE(0, 0); __syncthreads();
  qkt<4>(pA0, pA1, (const char*)K_lds, qr, cbm, r32, hi); partialSM(pA0, pA1, m_reg, mnA, alA);
  SLOAD(0, 64);
  SWAIT(); SWRITE(1, 0); __syncthreads();
  for (int j = 1; j + 1 < NT; j += 2) {
    SBAR(); qkt<4>(pB0, pB1, (const char*)K_lds + SHM_K, qr, cbm, r32, hi);
    finishSM(pA0, pA1, alA, l_reg, pa0, pa1, pa2, pa3); SBAR();
    SLOAD(0, (j + 1) * 64); SBAR();
    pv_d0(o, vb0, pa0, pa1, pa2, pa3); partialSM(pB0, pB1, m_reg, mnB, alB);
    __syncthreads(); SWAIT(); SWRITE(0, 0);
    RESC(alB); __syncthreads();
    SBAR(); qkt<4>(pA0, pA1, (const char*)K_lds, qr, cbm, r32, hi);
    finishSM(pB0, pB1, alB, l_reg, pa0, pa1, pa2, pa3); SBAR();
    SLOAD(0, (j + 2) * 64); SBAR();
    pv_d0(o, vb0 + (int)SHM_V, pa0, pa1, pa2, pa3); partialSM(pA0, pA1, m_reg, mnA, alA);
    __syncthreads(); SWAIT(); SWRITE(1, 0);
    RESC(alA); __syncthreads();
  }
  SBAR(); qkt<4>(pB0, pB1, (const char*)K_lds + SHM_K, qr, cbm, r32, hi);
  if (wq < 2) {
#pragma unroll
    for (int r = 0; r < 16; ++r) { pB0[r] = -1e30f; pB1[r] = -1e30f; } }
  finishSM(pA0, pA1, alA, l_reg, pa0, pa1, pa2, pa3); SBAR();
  pv_d0(o, vb0, pa0, pa1, pa2, pa3); partialSM(pB0, pB1, m_reg, mnB, alB);
  __syncthreads(); RESC(alB);
  finishSM(pB0, pB1, alB, l_reg, pa0, pa1, pa2, pa3); SBAR();
  pv_d0(o, vb0 + (int)SHM_V, pa0, pa1, pa2, pa3);
  if (hi == 0) li_l[r32] = l_reg; asm volatile("s_waitcnt lgkmcnt(0)" ::: "memory");
  float rli[16];
#pragma unroll
  for (int r = 0; r < 16; ++r) rli[r] = __builtin_amdgcn_rcpf(li_l[crow(r, hi)]);
  __syncthreads();
  float* xch = (float*)lds + (size_t)wq * 4096;
  if (map == 1) {
#pragma unroll
    for (int d0 = 0; d0 < 4; ++d0)
#pragma unroll
      for (int r = 0; r < 16; ++r) xch[(d0 * 16 + r) * 64 + lane] = o[d0][r] * rli[r] * lam;
  }
  __syncthreads();
  if (map == 0) {
    float ss[16];
#pragma unroll
    for (int r = 0; r < 16; ++r) { float s = 0.f;
#pragma unroll
      for (int d0 = 0; d0 < 4; ++d0) { const float v = o[d0][r] * rli[r] - xch[(d0 * 16 + r) * 64 + lane]; o[d0][r] = v; s += v * v; }
      ss[r] = s; }
#pragma unroll
    for (int r = 0; r < 16; ++r) ss[r] = half_sum32(ss[r]);
    bf16* Ow = Oout + (rowb + qb * 128 + wq * 32) * 2048 + 1024 + h * 128;
    float gv[4];
#pragma unroll
    for (int d0 = 0; d0 < 4; ++d0) gv[d0] = gdiff[d0 * 32 + r32] * oscale;
#pragma unroll
    for (int r = 0; r < 16; ++r) { const int orow = crow(r, hi); const float rs = rsqrtf(ss[r] * (1.f / 128.f) + 1e-6f);
#pragma unroll
      for (int d0 = 0; d0 < 4; ++d0) { const float y = o[d0][r] * rs * gv[d0]; const unsigned w = cvtpk(y, y); Ow[(size_t)orow * 2048 + d0 * 32 + r32] = (bf16)(w & 0xffffu); } }
  }
#undef SLOAD
#undef SWRITE
#undef SWAIT
#undef RESC
}
__device__ __forceinline__ void sb_unit(int b, int h, int qb, const bf16* __restrict__ QKV, bf16* __restrict__ Oout, const float* __restrict__ gsb, char* lds) {
  const int tid = threadIdx.x, lane = tid & 63, r32 = lane & 31, hi = lane >> 5; const int wid = __builtin_amdgcn_readfirstlane(tid >> 6);
  bf16* V_lds = (bf16*)lds; bf16* K_lds = (bf16*)(lds + 2 * SHM_V);
  volatile __attribute__((address_space(3))) int* flags = (volatile __attribute__((address_space(3))) int*)(lds + 2 * SHM_V + 2 * SHM_K + 8 * 64 * 4);
  f32x16 o[4] = {}; bf16x8 qr[8];
  const size_t rowb = (size_t)b * SEQ_;
  const int R = qb * 256, Q0 = R + wid * 32, tq = Q0 + r32;
  const bf16* Qw = QKV + (rowb + tq) * LDQKV + h * 128 + hi * 8;
#pragma unroll
  for (int d0 = 0; d0 < 8; ++d0) qr[d0] = *reinterpret_cast<const bf16x8*>(Qw + d0 * 16);
  const bf16* Kh = QKV + rowb * LDQKV + 1024 + h * 128; const bf16* Vh = QKV + rowb * LDQKV + 2048 + h * 128;
  const int sr = tid >> 4, sc = (tid & 15) * 8, vst0 = v_st(sr, sc), vst1 = v_st(32 + sr, sc);
  const int vb0 = (int)(uintptr_t)V_lds + v_rd_base(lane);
  const int jd = Q0 >> 6;
  float carry = 0.f;
  if (tid < 8) flags[tid] = 0;
  for (int j = (R + 255) >> 6; j >= 0; --j) {
    __syncthreads();
    { const int k0 = j * 64;
      const bf16x8 vs0 = *reinterpret_cast<const bf16x8*>(&Vh[(size_t)(k0 + sr) * LDQKV + sc]), vs1 = *reinterpret_cast<const bf16x8*>(&Vh[(size_t)(k0 + 32 + sr) * LDQKV + sc]);
      const bf16x8 ks0 = *reinterpret_cast<const bf16x8*>(&Kh[(size_t)(k0 + sr) * LDQKV + sc]), ks1 = *reinterpret_cast<const bf16x8*>(&Kh[(size_t)(k0 + 32 + sr) * LDQKV + sc]);
      *(bf16x8*)((char*)V_lds + vst0) = vs0; *(bf16x8*)((char*)V_lds + vst1) = vs1; const int kc = sc * 2;
      *(bf16x8*)((char*)K_lds + KSWZ(sr, kc)) = ks0; *(bf16x8*)((char*)K_lds + KSWZ(32 + sr, kc)) = ks1; }
    __syncthreads();
    if (j <= jd) {
      f32x16 p0, p1;
      qkt<8>(p0, p1, (const char*)K_lds, qr, 0, r32, hi);
      const bool diag = (j == jd);
      const int kb = j * 64 + 4 * hi;
      f32x16 q0, q1;
#pragma unroll
      for (int r = 0; r < 16; ++r) {
        const float z0 = __builtin_amdgcn_fmed3f(p0[r], -120.f, 120.f), z1 = __builtin_amdgcn_fmed3f(p1[r], -120.f, 120.f);
        float a0 = -__builtin_amdgcn_logf(1.f + __builtin_amdgcn_exp2f(z0)), a1 = -__builtin_amdgcn_logf(1.f + __builtin_amdgcn_exp2f(z1));
        float b0 = z0 + a0, b1 = z1 + a1;
        if (diag) { const int kv = kb + (r & 3) + 8 * (r >> 2); if (kv >= tq) { a0 = 0.f; b0 = -1e30f; } if (kv + 32 >= tq) { a1 = 0.f; b1 = -1e30f; } }
        q0[r] = a0; q1[r] = a1; p0[r] = b0; p1[r] = b1; }
      float G[8], PG[8], SUF[8];
#pragma unroll
      for (int g = 0; g < 4; ++g) { G[g] = (q0[4 * g] + q0[4 * g + 1]) + (q0[4 * g + 2] + q0[4 * g + 3]); G[4 + g] = (q1[4 * g] + q1[4 * g + 1]) + (q1[4 * g + 2] + q1[4 * g + 3]); }
#pragma unroll
      for (int g = 0; g < 8; ++g) PG[g] = __shfl_xor(G[g], 32);
      float run = carry;
#pragma unroll
      for (int g = 7; g >= 0; --g) { SUF[g] = run; run += G[g] + PG[g]; }
      carry = run;
#pragma unroll
      for (int g = 0; g < 8; ++g) SUF[g] += (hi == 0) ? PG[g] : 0.f;
#pragma unroll
      for (int g = 0; g < 4; ++g) {
        float s = SUF[g];
        p0[4 * g + 3] = __builtin_amdgcn_exp2f(p0[4 * g + 3] + s); s += q0[4 * g + 3];
        p0[4 * g + 2] = __builtin_amdgcn_exp2f(p0[4 * g + 2] + s); s += q0[4 * g + 2];
        p0[4 * g + 1] = __builtin_amdgcn_exp2f(p0[4 * g + 1] + s); s += q0[4 * g + 1];
        p0[4 * g + 0] = __builtin_amdgcn_exp2f(p0[4 * g + 0] + s);
        float s2 = SUF[4 + g];
        p1[4 * g + 3] = __builtin_amdgcn_exp2f(p1[4 * g + 3] + s2); s2 += q1[4 * g + 3];
        p1[4 * g + 2] = __builtin_amdgcn_exp2f(p1[4 * g + 2] + s2); s2 += q1[4 * g + 2];
        p1[4 * g + 1] = __builtin_amdgcn_exp2f(p1[4 * g + 1] + s2); s2 += q1[4 * g + 1];
        p1[4 * g + 0] = __builtin_amdgcn_exp2f(p1[4 * g + 0] + s2);
      }
      bf16x8 pa0, pa1, pa2, pa3;
      pack_p(p0, p1, pa0, pa1, pa2, pa3);
      pv_d0(o, vb0, pa0, pa1, pa2, pa3);
      if (__all(carry < -160.f)) { if (lane == 0) flags[wid] = 1; }
    }
    __syncthreads();
    int alld = 1;
#pragma unroll
    for (int w = 0; w < 8; ++w) alld &= flags[w];
    if (alld) break;
  }
  { float ss[16];
#pragma unroll
    for (int r = 0; r < 16; ++r) { float s = 0.f;
#pragma unroll
      for (int d0 = 0; d0 < 4; ++d0) s += o[d0][r] * o[d0][r];
      ss[r] = half_sum32(s); }
    bf16* Ow = Oout + (rowb + Q0) * 2048 + h * 128;
    float gv[4];
#pragma unroll
    for (int d0 = 0; d0 < 4; ++d0) gv[d0] = gsb[d0 * 32 + r32];
#pragma unroll
    for (int r = 0; r < 16; ++r) { const int orow = crow(r, hi); const float rs = rsqrtf(ss[r] * (1.f / 128.f) + 1e-6f);
#pragma unroll
      for (int d0 = 0; d0 < 4; ++d0) { const float y = o[d0][r] * rs * gv[d0]; const unsigned w = cvtpk(y, y); Ow[(size_t)orow * 2048 + d0 * 32 + r32] = (bf16)(w & 0xffffu); } }
  }
  __syncthreads();
}
#undef KSWZ
#undef SBAR
}
constexpr int NWAVES = 8;
constexpr int BATCH = 4, SEQ = 8192, DM = 2048, NTOK = BATCH * SEQ;
constexpr int QKVC = 6144, NEXP = 32, DEXP = 512, PLED = 256, LCAP = 65536;
constexpr float EPS = 1e-6f;
constexpr float QSCALE_SB = 0.08838834764831845f * 1.4426950408889634f;
constexpr float QSCALE_DF = 0.125f * 1.4426950408889634f;
constexpr size_t MiB = 1u << 20;
constexpr size_t WS_CTL = 0, CTL_ZERO_BYTES = 1 * MiB;
constexpr size_t WS_ROPE = 1 * MiB;
constexpr size_t WS_WRT = 1 * MiB + 512 * 1024;
constexpr size_t WS_WIN = 2 * MiB;
constexpr size_t WS_WOUT = 26 * MiB;
constexpr size_t WS_WPG = 34 * MiB;
constexpr size_t WS_WPLE = 42 * MiB;
constexpr size_t WS_WGU = 44 * MiB;
constexpr size_t WS_WD = 172 * MiB;
constexpr size_t WS_LSLOT = 236 * MiB;
constexpr size_t WS_LGATE = 244 * MiB;
constexpr size_t WS_PB = 252 * MiB;
constexpr size_t WS_A1 = 268 * MiB;
constexpr size_t WS_QKV = 396 * MiB;
constexpr size_t WS_XS = WS_QKV;
constexpr size_t WS_H = WS_QKV + 288 * MiB;
constexpr size_t WS_Y = WS_QKV;
constexpr size_t WS_U = 780 * MiB;
constexpr size_t WS_END = 908 * MiB;
constexpr int CW_TMO = 0, CW_CODE = 1;
constexpr int CW_BAR = 4096;
constexpr int CW_CNT = 16384;
constexpr int RING_OFF = 0, RING_BYTES = 131072;
constexpr int LDSCTL_OFF = RING_BYTES;
constexpr int TST_OFF = LDSCTL_OFF;
constexpr int CNT_OFF = LDSCTL_OFF + 160;
constexpr int MISC_OFF = LDSCTL_OFF + 320;
constexpr int LDS_BYTES = 147456;

#define GAS __attribute__((address_space(1)))
#define LAS __attribute__((address_space(3)))
typedef unsigned short bf16;
typedef unsigned v4u __attribute__((ext_vector_type(4)));
typedef unsigned v2u __attribute__((ext_vector_type(2)));
typedef float f32x4 __attribute__((ext_vector_type(4)));
typedef GAS unsigned gu32;
#define RLX_AGENT __ATOMIC_RELAXED, __HIP_MEMORY_SCOPE_AGENT
#define LDS_WAIT() asm volatile("s_waitcnt lgkmcnt(0)" ::: "memory")
#define VM_WAIT() asm volatile("s_waitcnt vmcnt(0)" ::: "memory")
__device__ __forceinline__ unsigned pk2(float lo, float hi) { return pg8::cvt_pk_bf16(lo, hi); }
#define XB_TMO      128
#define XB_XCNT(j)  (256  + 64 * (j))
#define XB_XSUB(j)  (1280 + 64 * (j))
#define XB_XGEN(j)  (2304 + 64 * (j))
#define XB_TOP      3328
#define XB_TOPGEN   3392
#define XCD_BAR_WORDS 3456
#define XB_SPIN_CAP (1u << 18)

__device__ __forceinline__ unsigned xb_ld(unsigned* p)              { return __hip_atomic_load(p, __ATOMIC_RELAXED, __HIP_MEMORY_SCOPE_AGENT); }
__device__ __forceinline__ unsigned xb_add(unsigned* p, unsigned v) { return __hip_atomic_fetch_add(p, v, __ATOMIC_RELAXED, __HIP_MEMORY_SCOPE_AGENT); }
__device__ __forceinline__ unsigned xb_xcc_id() { return (unsigned)__builtin_amdgcn_s_getreg((3 << 11) | 20) & 0xFu; }
#define XB_SPIN(cond, bar) do { unsigned _sp = 0; while (cond) { __builtin_amdgcn_s_sleep(1); \
    if ((++_sp & 255u) == 0u) { if (xb_ld(&(bar)[XB_TMO])) break; if (_sp > XB_SPIN_CAP) { atomicAdd(&(bar)[XB_TMO], 1u); break; } } } } while (0)

struct XcdBarrier {
    unsigned* bar; unsigned x;
    volatile LAS unsigned* st;
};

__device__ __forceinline__ XcdBarrier xcd_barrier_post(unsigned* bar, volatile LAS unsigned* st) {
    XcdBarrier b; b.bar = bar; b.x = xb_xcc_id(); b.st = st;
    if (threadIdx.x == 0) (void)xb_add(&bar[XB_XCNT(b.x)], 1u);
    return b;
}
__device__ __forceinline__ void xcd_barrier_complete(unsigned* bar, unsigned x, unsigned& nloc, unsigned& nx) {
    const unsigned G = gridDim.x * gridDim.y * gridDim.z;
    unsigned sum, cnt, mine, sp = 0u;
    for (;;) {
        sum = 0u; cnt = 0u; mine = 0u;
#pragma unroll
        for (unsigned j = 0; j < 16; ++j) { const unsigned c = xb_ld(&bar[XB_XCNT(j)]); sum += c; cnt += (c > 0u) ? 1u : 0u; mine = (j == x) ? c : mine; }
        if (sum == G) break;
        __builtin_amdgcn_s_sleep(1);
        if ((++sp & 255u) == 0u) { if (xb_ld(&bar[XB_TMO])) break; if (sp > XB_SPIN_CAP) { atomicAdd(&bar[XB_TMO], 1u); break; } }
    }
    nloc = mine > 0u ? mine : 1u; nx = cnt > 0u ? cnt : 1u;
}

__device__ __forceinline__ void xcd_barrier(const XcdBarrier& b) {
    asm volatile("s_waitcnt vmcnt(0)" ::: "memory");
    __syncthreads();
    if (threadIdx.x == 0) {
        unsigned* bar = b.bar;
        __builtin_amdgcn_s_waitcnt(0);
        unsigned nloc = b.st[0], nx = b.st[1];
        if (nloc == 0u) { xcd_barrier_complete(bar, b.x, nloc, nx); b.st[0] = nloc; b.st[1] = nx; }
        const unsigned old = xb_add(&bar[XB_XSUB(b.x)], 1u);
        const unsigned gen = old / nloc;
        if (old + 1u == (gen + 1u) * nloc) {
            __builtin_amdgcn_fence(__ATOMIC_RELEASE, "agent");
            asm volatile("s_waitcnt vmcnt(0)" ::: "memory");
            const unsigned og = xb_add(&bar[XB_TOP], 1u);
            const unsigned tg = og / nx;
            if (og + 1u == (tg + 1u) * nx) xb_add(&bar[XB_TOPGEN], 1u);
            else XB_SPIN(xb_ld(&bar[XB_TOPGEN]) == tg, bar);
            __builtin_amdgcn_fence(__ATOMIC_ACQUIRE, "agent");
            xb_add(&bar[XB_XGEN(b.x)], 1u);
            asm volatile("s_waitcnt vmcnt(0)" ::: "memory");
        } else {
            XB_SPIN(xb_ld(&bar[XB_XGEN(b.x)]) == gen, bar);
            __builtin_amdgcn_fence(__ATOMIC_ACQUIRE, "agent");
            asm volatile("s_waitcnt vmcnt(0)" ::: "memory");
        }
    }
    __syncthreads();
}
struct Frame {
    LAS unsigned char* lds;
    volatile LAS unsigned* MISC;
    gu32* ctl;
    int tid, lane, wave;
    int vcu, G;
};
__device__ __forceinline__ float wave_sum(float v) {
#pragma unroll
    for (int o = 1; o < 64; o <<= 1) v += __shfl_xor(v, o);
    return v;
}
__device__ __forceinline__ void tr_item(const float* W, int ldw, int k0, int n0, bf16* dst, int dpitch, float scale, LAS float* scr, int lane) {
#pragma unroll 8
    for (int i = 0; i < 32; ++i) { const int kk = 2 * i + (lane >> 5); scr[kk * 33 + (lane & 31)] = W[(size_t)(k0 + kk) * ldw + n0 + (lane & 31)]; }
    LDS_WAIT(); asm volatile("" ::: "memory");
    const int c = lane & 7;
#pragma unroll
    for (int j = 0; j < 4; ++j) { const int n = (lane >> 3) + 8 * j; const LAS float* s = scr + (8 * c) * 33 + n;
        v4u o; o.x = pk2(s[0 * 33] * scale, s[1 * 33] * scale); o.y = pk2(s[2 * 33] * scale, s[3 * 33] * scale); o.z = pk2(s[4 * 33] * scale, s[5 * 33] * scale); o.w = pk2(s[6 * 33] * scale, s[7 * 33] * scale);
        *(GAS v4u*)(dst + (size_t)n * dpitch + 8 * c) = o; }
    LDS_WAIT(); asm volatile("" ::: "memory");
}
__device__ __forceinline__ void rms_row_to_bf16(const float* xrow, const float* g, bf16* orow, int lane) {
    const GAS f32x4* xr = (const GAS f32x4*)xrow + lane;
    f32x4 v[8]; float s = 0.f;
#pragma unroll
    for (int j = 0; j < 8; ++j) { v[j] = xr[64 * j]; s += (v[j].x * v[j].x + v[j].y * v[j].y) + (v[j].z * v[j].z + v[j].w * v[j].w); }
    const float rstd = rsqrtf(wave_sum(s) * (1.f / DM) + EPS);
    GAS v2u* o8 = (GAS v2u*)orow + lane;
#pragma unroll
    for (int j = 0; j < 8; ++j) { const f32x4 gg = *((const GAS f32x4*)g + lane + 64 * j); v2u w; w.x = pk2(v[j].x * rstd * gg.x, v[j].y * rstd * gg.y); w.y = pk2(v[j].z * rstd * gg.z, v[j].w * rstd * gg.w); o8[64 * j] = w; }
}

struct Args { const float* in[21]; float* out; unsigned char* ws; int ph_lo, ph_hi; };


#define x_ (args.in[0])
#define p_in (args.in[1])
#define g_attn (args.in[2])
#define w_in (args.in[3])
#define g_sb (args.in[4])
#define g_diff (args.in[5])
#define lam_q1 (args.in[6])
#define lam_k1 (args.in[7])
#define lam_q2 (args.in[8])
#define lam_k2 (args.in[9])
#define w_out (args.in[10])
#define g_moe (args.in[11])
#define w_rg (args.in[12])
#define w_re (args.in[13])
#define w_gate (args.in[14])
#define w_up (args.in[15])
#define w_down (args.in[16])
#define g_ple (args.in[17])
#define w_ple (args.in[18])
#define w_pg (args.in[19])
#define g_final (args.in[20])
#define rope ((float*)(ws + WS_ROPE))
#define wrt ((float*)(ws + WS_WRT))
#define WIN ((bf16*)(ws + WS_WIN))
#define WOUT ((bf16*)(ws + WS_WOUT))
#define WPG ((bf16*)(ws + WS_WPG))
#define WPLE ((bf16*)(ws + WS_WPLE))
#define WGU ((bf16*)(ws + WS_WGU))
#define WD ((bf16*)(ws + WS_WD))
#define LSLOT ((int*)(ws + WS_LSLOT))
#define LGATE ((float*)(ws + WS_LGATE))
#define PB ((bf16*)(ws + WS_PB))
#define A1 ((bf16*)(ws + WS_A1))
#define QKV ((bf16*)(ws + WS_QKV))
#define XS ((bf16*)(ws + WS_XS))
#define HB ((bf16*)(ws + WS_H))
#define YB ((bf16*)(ws + WS_Y))
#define UB ((bf16*)(ws + WS_U))
#define ecnt (F.ctl + CW_CNT)
__global__ void __launch_bounds__(NWAVES * 64, 2) mega_fwd(Args args) {
    extern __shared__ __attribute__((aligned(16))) unsigned char lds[];
    Frame F;
    F.lds = (LAS unsigned char*)lds;
    F.MISC = (volatile LAS unsigned*)(F.lds + MISC_OFF);
    F.tid = threadIdx.x; F.lane = F.tid & 63; F.wave = __builtin_amdgcn_readfirstlane(F.tid >> 6);
    F.G = gridDim.x; { const int bx = blockIdx.x; F.vcu = (F.G % 8 == 0) ? (bx % 8) * (F.G / 8) + bx / 8 : bx; }
    unsigned char* ws = args.ws;
    F.ctl = (gu32*)(ws + WS_CTL);
    float* const out = args.out;
    for (int u = F.tid; u < (LDS_BYTES - LDSCTL_OFF) / 4; u += NWAVES * 64) ((LAS unsigned*)(F.lds + LDSCTL_OFF))[u] = 0u;
    __syncthreads();
    XcdBarrier bar = xcd_barrier_post((unsigned*)(F.ctl + CW_BAR), F.MISC + 8);
    const int lo = args.ph_lo, hi = args.ph_hi;
#ifndef PH_MASK
#define PH_MASK 0x7ff
#endif
#define IN(k) ((((PH_MASK) >> (k)) & 1) && lo <= (k) && (k) < hi)
#define SEAM(k) do { if (IN(k) && IN((k) + 1)) xcd_barrier(bar); } while (0)
    const int gw = F.vcu * NWAVES + F.wave, NGW = F.G * NWAVES;
    LAS int* tstart = (LAS int*)(F.lds + TST_OFF); LAS int* lcnt = (LAS int*)(F.lds + CNT_OFF);

    if (IN(0)) {
        LAS float* scr = (LAS float*)(F.lds + RING_OFF + F.wave * 16384);
        constexpr int I_IN = 32 * 192, I_OUT = 32 * 64, I_PG = 32 * 64, I_PLE = 4 * 64, I_G = 32 * 32 * 16, I_U = I_G, I_D = 32 * 8 * 64;
        constexpr int NITEMS = I_IN + I_OUT + I_PG + I_PLE + I_G + I_U + I_D;
        for (int it = gw; it < NITEMS; it += NGW) {
            int r = it;
            if (r < I_IN) { const int kb = r / 192, nb = r % 192, n0 = 32 * nb, k0 = 64 * kb; const float sc = (n0 < 1024) ? QSCALE_SB : ((n0 >= 3072 && n0 < 4096) ? QSCALE_DF : 1.f);
                tr_item(w_in, QKVC, k0, n0, WIN + (size_t)n0 * DM + k0, DM, sc, scr, F.lane); continue; } r -= I_IN;
            if (r < I_OUT) { const int kb = r / 64, nb = r % 64; tr_item(w_out, DM, 64 * kb, 32 * nb, WOUT + (size_t)(32 * nb) * DM + 64 * kb, DM, 1.f, scr, F.lane); continue; } r -= I_OUT;
            if (r < I_PG) { const int kb = r / 64, nb = r % 64; tr_item(w_pg, DM, 64 * kb, 32 * nb, WPG + (size_t)(32 * nb) * DM + 64 * kb, DM, 1.f, scr, F.lane); continue; } r -= I_PG;
            if (r < I_PLE) { const int kb = r / 64, nb = r % 64; tr_item(w_ple, DM, 64 * kb, 32 * nb, WPLE + (size_t)(32 * nb) * PLED + 64 * kb, PLED, 1.f, scr, F.lane); continue; } r -= I_PLE;
            if (r < I_G + I_U) { const bool isu = r >= I_G; if (isu) r -= I_G; const int e = r / 512, q = r % 512, kb = q / 16, nb = q % 16, n0 = 32 * nb, k0 = 64 * kb;
                const int drow = e * 1024 + (n0 >> 7) * 256 + (isu ? 128 : 0) + (n0 & 127);
                tr_item((isu ? w_up : w_gate) + (size_t)e * DM * DEXP, DEXP, k0, n0, WGU + (size_t)drow * DM + k0, DM, 1.f, scr, F.lane); continue; } r -= I_G + I_U;
            { const int e = r / 512, q = r % 512, kb = q / 64, nb = q % 64, n0 = 32 * nb, k0 = 64 * kb;
                tr_item(w_down + (size_t)e * DEXP * DM, DM, k0, n0, WD + ((size_t)e * DM + n0) * DEXP + k0, DEXP, 1.f, scr, F.lane); }
        }
        for (int i = gw * 64 + F.lane; i < SEQ * 8; i += NGW * 64) { const int pos = i >> 3, k = i & 7;
            const float inv = exp2f(-(float)k * (18.931568569324174f / 8.f));
            const float ang = (float)pos * inv;
            const double rev = (double)ang * 0.15915494309189535; const float fr = (float)(rev - floor(rev));
            rope[pos * 16 + k] = __builtin_amdgcn_cosf(fr); rope[pos * 16 + 8 + k] = __builtin_amdgcn_sinf(fr); }
        for (int i = gw * 64 + F.lane; i < 36 * DM; i += NGW * 64) { const int c = i / DM, k = i % DM; wrt[i] = (c < 4) ? w_rg[k * 4 + c] : w_re[k * 32 + (c - 4)]; }
        for (size_t i = (size_t)gw * 64 + F.lane; i < (size_t)NTOK * PLED / 4; i += (size_t)NGW * 64) { const f32x4 v = *((const GAS f32x4*)p_in + i); v2u w; w.x = pk2(v.x, v.y); w.y = pk2(v.z, v.w); *((GAS v2u*)PB + i) = w; }
        for (int m = gw; m < NTOK; m += NGW) rms_row_to_bf16(x_ + (size_t)m * DM, g_attn, A1 + (size_t)m * DM, F.lane);
    }
    SEAM(0);
    if (IN(1)) {
        pg8::Gemm g{A1, WIN, NTOK, QKVC, DM}; pg8::StaticOrder S; S.init(NTOK, QKVC, F.G, (int)blockIdx.x);
        pg8::EpiQKV E{QKV, rope};
        pg8::gemm_phase<pg8::EpiQKV, pg8::StaticOrder, true, true>(F.lds + RING_OFF, g, S, E);
    }
    SEAM(1);
    if (IN(2)) {
        float lam;
        { float a = (F.lane < 64) ? lam_q1[F.lane] * lam_k1[F.lane] : 0.f, b2 = lam_q2[F.lane] * lam_k2[F.lane]; a = wave_sum(a); b2 = wave_sum(b2); lam = expf(a) - expf(b2) + 0.2f; }
#ifndef NO_DIFF
        for (int L = F.vcu; L < 1024; L += F.G) { const int bh = L >> 5, pr = L & 31;
#pragma unroll 1
            for (int s2 = 0; s2 < 2; ++s2) att::diff_unit(bh >> 3, bh & 7, s2 ? pr : 63 - pr, QKV, A1, g_diff, lam, 0.8f, (char*)lds + RING_OFF); }
#endif
        __syncthreads();
#ifndef NO_SB
        for (int L = F.vcu; L < 1024; L += F.G) { const int bh = L >> 5, qb = L & 31;
            att::sb_unit(bh >> 3, bh & 7, qb, QKV, A1, g_sb, (char*)lds + RING_OFF); }
#endif
    }
    SEAM(2);
    if (IN(3)) {
#ifndef NO_P3A
        { pg8::Gemm g{A1, WOUT, NTOK, DM, DM}; pg8::StaticOrder S; S.init(NTOK, DM, F.G, (int)blockIdx.x);
          pg8::EpiResF32 E{x_, out, DM};
          pg8::gemm_phase<pg8::EpiResF32, pg8::StaticOrder, true, true>(F.lds + RING_OFF, g, S, E); }
#endif
#ifndef NO_P3B
        { pg8::Gemm g{PB, WPLE, NTOK, DM, PLED}; pg8::StaticOrder S; S.init(NTOK, DM, F.G, (int)blockIdx.x);
          pg8::EpiBf16 E{UB, DM};
          pg8::gemm_phase<pg8::EpiBf16, pg8::StaticOrder, true, true>(F.lds + RING_OFF, g, S, E); }
#endif
    }
    SEAM(3);
    if (IN(4)) {
        LAS int* sel_e = (LAS int*)(F.lds + RING_OFF); LAS float* sel_g = (LAS float*)(F.lds + RING_OFF + 1024); LAS int* lhist = (LAS int*)(F.lds + RING_OFF + 2048); LAS int* lbase = (LAS int*)(F.lds + RING_OFF + 2176);
        LAS int* lrk = (LAS int*)(F.lds + RING_OFF + 2304);
        for (int chunk = blockIdx.x; chunk < NTOK / 128; chunk += F.G) {
            if (F.tid < 32) lhist[F.tid] = 0;
            for (int g4 = 0; g4 < 4; ++g4) {
                const int row0 = chunk * 128 + F.wave * 16 + g4 * 4;
                f32x4 v[4][8]; float rstd[4];
#pragma unroll
                for (int r = 0; r < 4; ++r) { const GAS f32x4* xr = (const GAS f32x4*)(out + (size_t)(row0 + r) * DM) + F.lane; float s = 0.f;
#pragma unroll
                    for (int j = 0; j < 8; ++j) { v[r][j] = xr[64 * j]; s += (v[r][j].x * v[r][j].x + v[r][j].y * v[r][j].y) + (v[r][j].z * v[r][j].z + v[r][j].w * v[r][j].w); }
                    rstd[r] = rsqrtf(wave_sum(s) * (1.f / DM) + EPS); }
#pragma unroll
                for (int j = 0; j < 8; ++j) { const f32x4 gg = *((const GAS f32x4*)g_moe + F.lane + 64 * j);
#pragma unroll
                    for (int r = 0; r < 4; ++r) { v[r][j] = v[r][j] * rstd[r] * gg; v2u w; w.x = pk2(v[r][j].x, v[r][j].y); w.y = pk2(v[r][j].z, v[r][j].w); *((GAS v2u*)(A1 + (size_t)(row0 + r) * DM) + F.lane + 64 * j) = w; } }
                float lg[4] = {0.f, 0.f, 0.f, 0.f};
#pragma unroll 1
                for (int c = 0; c < 36; ++c) { const GAS f32x4* wc = (const GAS f32x4*)(wrt + (size_t)c * DM) + F.lane;
                    float pa[4] = {0.f, 0.f, 0.f, 0.f};
#pragma unroll
                    for (int j = 0; j < 8; ++j) { const f32x4 w = wc[64 * j];
#pragma unroll
                        for (int r = 0; r < 4; ++r) pa[r] += (v[r][j].x * w.x + v[r][j].y * w.y) + (v[r][j].z * w.z + v[r][j].w * w.w); }
#pragma unroll
                    for (int r = 0; r < 4; ++r) { const float t = wave_sum(pa[r]); lg[r] = (F.lane == c) ? t : lg[r]; } }
#pragma unroll
                for (int r = 0; r < 4; ++r) {
                    const float g0 = __shfl(lg[r], 0), g1 = __shfl(lg[r], 1), g2 = __shfl(lg[r], 2), g3 = __shfl(lg[r], 3);
                    int grp = 0; float gm = g0; if (g1 > gm) { gm = g1; grp = 1; } if (g2 > gm) { gm = g2; grp = 2; } if (g3 > gm) { gm = g3; grp = 3; }
                    const float psel = 1.f / (expf(g0 - gm) + expf(g1 - gm) + expf(g2 - gm) + expf(g3 - gm));
                    float ev[8];
#pragma unroll
                    for (int i = 0; i < 8; ++i) ev[i] = __shfl(lg[r], 4 + grp * 8 + i);
                    int i0 = 0; float v0 = ev[0];
#pragma unroll
                    for (int i = 1; i < 8; ++i) if (ev[i] > v0) { v0 = ev[i]; i0 = i; }
                    int i1 = -1; float v1 = 0.f;
#pragma unroll
                    for (int i = 0; i < 8; ++i) if (i != i0 && (i1 < 0 || ev[i] > v1)) { v1 = ev[i]; i1 = i; }
                    const float ga = 1.f / (1.f + expf(v1 - v0)), gb = 1.f - ga;
                    if (F.lane == 0) { const int rl = F.wave * 16 + g4 * 4 + r; sel_e[rl * 2] = grp * 8 + i0; sel_e[rl * 2 + 1] = grp * 8 + i1; sel_g[rl * 2] = ga * psel; sel_g[rl * 2 + 1] = gb * psel; }
                }
            }
            __syncthreads();
            int my_e = 0, my_rk = 0;
            if (F.tid < 256) { my_e = sel_e[F.tid]; my_rk = atomicAdd((int*)(lhist + my_e), 1); }
            __syncthreads();
            if (F.tid < 32) { const int n = lhist[F.tid]; lbase[F.tid] = n ? (int)__hip_atomic_fetch_add(ecnt + 64 * F.tid, (unsigned)n, RLX_AGENT) : 0; }
            __syncthreads();
            if (F.tid < 256) { const int pos = lbase[my_e] + my_rk; LSLOT[(size_t)my_e * LCAP + pos] = (chunk * 128 + (F.tid >> 1)) * 2 + (F.tid & 1); LGATE[(size_t)my_e * LCAP + pos] = sel_g[F.tid]; }
            __syncthreads();
        }
        (void)lrk;
    }
    SEAM(4);
    if (IN(5) || IN(6) || IN(7)) {
        if (F.tid < 32) lcnt[F.tid] = (int)__hip_atomic_load(ecnt + 64 * F.tid, RLX_AGENT);
        __syncthreads();
        if (F.tid == 0) { int acc = 0; for (int e = 0; e < 32; ++e) { tstart[e] = acc; acc += (lcnt[e] + 255) >> 8; } tstart[32] = acc; }
        __syncthreads();
    }
    const int NTILES = (IN(5) || IN(6) || IN(7)) ? __builtin_amdgcn_readfirstlane(tstart[32]) : 0;
    if (IN(5)) {
        for (int d = gw; d < NTILES * 256; d += NGW) { const int tile = d >> 8; int e = 0;
            for (int k = 1; k < 32; ++k) e += (__builtin_amdgcn_readfirstlane(tstart[k]) <= tile) ? 1 : 0;
            const int rank = d - __builtin_amdgcn_readfirstlane(tstart[e]) * 256; const int n = __builtin_amdgcn_readfirstlane(lcnt[e]);
            GAS v4u* dst = (GAS v4u*)(XS + (size_t)d * DM) + F.lane;
            if (rank < n) { const int tok = LSLOT[(size_t)e * LCAP + rank] >> 1; const GAS v4u* src = (const GAS v4u*)(A1 + (size_t)tok * DM) + F.lane;
#pragma unroll
                for (int j = 0; j < 4; ++j) dst[64 * j] = src[64 * j]; }
            else {
#pragma unroll
                for (int j = 0; j < 4; ++j) dst[64 * j] = (v4u){0u, 0u, 0u, 0u}; } }
    }
    SEAM(5);
    if (IN(6)) {
        pg8::Gemm g{XS, WGU, NTILES * 256, 1024, DM}; pg8::MoeOrder S; S.init(NTILES, 4, F.G, (int)blockIdx.x, tstart, lcnt);
        pg8::EpiSwiglu E{HB};
        pg8::gemm_phase<pg8::EpiSwiglu, pg8::MoeOrder, true, true>(F.lds + RING_OFF, g, S, E);
    }
    SEAM(6);
    if (IN(7)) {
        pg8::Gemm g{HB, WD, NTILES * 256, DM, DEXP}; pg8::MoeOrder S; S.init(NTILES, 8, F.G, (int)blockIdx.x, tstart, lcnt);
        pg8::EpiScatter E{YB, LSLOT, LGATE};
        pg8::gemm_phase<pg8::EpiScatter, pg8::MoeOrder, true, true>(F.lds + RING_OFF, g, S, E);
    }
    SEAM(7);
    if (IN(8)) {
        for (int m = gw; m < NTOK; m += NGW) {
            GAS f32x4* hr = (GAS f32x4*)(out + (size_t)m * DM) + F.lane; const GAS v2u* y0 = (const GAS v2u*)(YB + (size_t)(2 * m) * DM) + F.lane; const GAS v2u* y1 = (const GAS v2u*)(YB + (size_t)(2 * m + 1) * DM) + F.lane;
            f32x4 v[8]; float s = 0.f;
#pragma unroll
            for (int j = 0; j < 8; ++j) { const f32x4 h = hr[64 * j]; const v2u a = y0[64 * j], b = y1[64 * j];
                v[j].x = h.x + (pg8::bf_lo(a.x) + pg8::bf_lo(b.x)); v[j].y = h.y + (pg8::bf_hi(a.x) + pg8::bf_hi(b.x)); v[j].z = h.z + (pg8::bf_lo(a.y) + pg8::bf_lo(b.y)); v[j].w = h.w + (pg8::bf_hi(a.y) + pg8::bf_hi(b.y));
                hr[64 * j] = v[j]; s += (v[j].x * v[j].x + v[j].y * v[j].y) + (v[j].z * v[j].z + v[j].w * v[j].w); }
            const float rstd = rsqrtf(wave_sum(s) * (1.f / DM) + EPS);
            GAS v2u* o8 = (GAS v2u*)(A1 + (size_t)m * DM) + F.lane;
#pragma unroll
            for (int j = 0; j < 8; ++j) { const f32x4 gg = *((const GAS f32x4*)g_ple + F.lane + 64 * j); v2u w; w.x = pk2(v[j].x * rstd * gg.x, v[j].y * rstd * gg.y); w.y = pk2(v[j].z * rstd * gg.z, v[j].w * rstd * gg.w); o8[64 * j] = w; }
        }
    }
    SEAM(8);
    if (IN(9)) {
        pg8::Gemm g{A1, WPG, NTOK, DM, DM}; pg8::StaticOrder S; S.init(NTOK, DM, F.G, (int)blockIdx.x);
        pg8::EpiPle E{out, UB, DM};
        pg8::gemm_phase<pg8::EpiPle, pg8::StaticOrder, true, true>(F.lds + RING_OFF, g, S, E);
    }
    SEAM(9);
    if (IN(10)) {
        for (int m = gw; m < NTOK; m += NGW) {
            GAS f32x4* hr = (GAS f32x4*)(out + (size_t)m * DM) + F.lane; f32x4 v[8]; float s = 0.f;
#pragma unroll
            for (int j = 0; j < 8; ++j) { v[j] = hr[64 * j]; s += (v[j].x * v[j].x + v[j].y * v[j].y) + (v[j].z * v[j].z + v[j].w * v[j].w); }
            const float rstd = rsqrtf(wave_sum(s) * (1.f / DM) + EPS);
#pragma unroll
            for (int j = 0; j < 8; ++j) { const f32x4 gg = *((const GAS f32x4*)g_final + F.lane + 64 * j); hr[64 * j] = v[j] * rstd * gg; }
        }
    }
#undef IN
#undef SEAM
}

#ifndef MK_SPLIT
#define MK_SPLIT 0
#endif
extern "C" void kernel_launch(void* const* d_in, const int* in_sizes, int n_in, void* d_out, int out_size, void* d_ws, size_t ws_size, hipStream_t stream) {
    static int grid = 0;
    if (grid == 0) {
        if (n_in != 21 || in_sizes[0] != NTOK * DM || out_size != NTOK * DM || ws_size < WS_END) { fprintf(stderr, "kernel_launch: shape mismatch (n_in %d in0 %d out %d ws %zu)\n", n_in, n_in > 0 ? in_sizes[0] : -1, out_size, ws_size); grid = -1; return; }
        int dev = 0, cus = 0, per_cu = 0;
        if (hipGetDevice(&dev) != hipSuccess || hipDeviceGetAttribute(&cus, hipDeviceAttributeMultiprocessorCount, dev) != hipSuccess) { grid = -1; return; }
        if (hipFuncSetAttribute((const void*)mega_fwd, hipFuncAttributeMaxDynamicSharedMemorySize, LDS_BYTES) != hipSuccess) { fprintf(stderr, "kernel_launch: hipFuncSetAttribute failed\n"); grid = -1; return; }
        if (hipOccupancyMaxActiveBlocksPerMultiprocessor(&per_cu, (const void*)mega_fwd, NWAVES * 64, LDS_BYTES) != hipSuccess || per_cu < 1) fprintf(stderr, "kernel_launch: occupancy query reports %d\n", per_cu);
        (void)hipGetLastError();
        grid = cus;
    }
    if (grid < 0) return;
    if (hipMemsetAsync((char*)d_ws + WS_CTL, 0, CTL_ZERO_BYTES, stream) != hipSuccess) return;
    Args a{};
    for (int i = 0; i < 21; ++i) a.in[i] = (const float*)d_in[i];
    a.out = (float*)d_out; a.ws = (unsigned char*)d_ws;
#if MK_SPLIT
    for (int ph = 0; ph < 11; ++ph) { a.ph_lo = ph; a.ph_hi = ph + 1; hipLaunchKernelGGL(mega_fwd, dim3(grid), dim3(NWAVES * 64), LDS_BYTES, stream, a); }
#else
    a.ph_lo = 0; a.ph_hi = 11;
    hipLaunchKernelGGL(mega_fwd, dim3(grid), dim3(NWAVES * 64), LDS_BYTES, stream, a);
#endif
    const hipError_t le = hipPeekAtLastError();
    if (le != hipSuccess) fprintf(stderr, "kernel_launch: launch failed: %s\n", hipGetErrorName(le));
}
```

```cpp
#include <hip/hip_runtime.h>
#include <hip/hip_bf16.h>
#include <cstdio>
#include <cstdint>
namespace pg8 {
#define PG8_LAS __attribute__((address_space(3)))
typedef unsigned short bf16_t;
typedef short bf16x8 __attribute__((ext_vector_type(8)));
typedef float f32x4 __attribute__((ext_vector_type(4)));
typedef unsigned u32x4 __attribute__((ext_vector_type(4)));
constexpr int BM = 256, BK = 64, HALF = 128, HTB = HALF * BK * 2  , STAGE_BYTES = 8 * HTB, NXCD = 8, WGM = 8;

__host__ __device__ __forceinline__ int lds_byte(int r, int c) { const int st = (r >> 4) * 2 + (c >> 5), rr = r & 15, cc = c & 31, ob = rr * 64 + cc * 2; return st * 1024 + (ob ^ (((ob >> 9) & 1) << 5)); }
__host__ __device__ __forceinline__ void stage_rc(int b, int& R, int& C) { const int st = b / 1024, sb = b % 1024, swz = sb ^ (((sb >> 9) & 1) << 5); R = (st >> 1) * 16 + swz / 64; C = (st & 1) * 32 + (swz % 64) / 2; }
__host__ __device__ __forceinline__ int perm32(int rho) { const int n = rho >> 4, i = rho & 15; return 8 * (i >> 2) + 4 * n + (i & 3); }

struct Unit { int pm, pn, pb, aux0, aux1; };
struct Gemm { const bf16_t* A; const bf16_t* Bt; int M, N, K; };

struct StaticOrder {
    int nM, nN, nwg, G, c;
    __host__ __device__ void init(int M, int N, int G_, int c_) { nM = M / BM; nN = N / BM; nwg = nM * nN; G = G_; c = c_; }
    __host__ __device__ bool next(int i, Unit& u) const {
        const long L = (long)i * G + c; if (L >= nwg) return false;
        int wgid = (int)L; { const int q = nwg / NXCD, r = nwg % NXCD, xcd = wgid % NXCD, off = wgid / NXCD; wgid = (xcd < r ? xcd * (q + 1) : r * (q + 1) + (xcd - r) * q) + off; }
        const int nig = WGM * nN, gid = wgid / nig, fm = gid * WGM, gsz = (nM - fm) < WGM ? (nM - fm) : WGM;
        u.pm = fm + ((wgid % nig) % gsz); u.pn = (wgid % nig) / gsz; u.pb = u.pn; u.aux0 = 0; u.aux1 = 0; return true;
    }
    __device__ __forceinline__ void a_ready(const Unit&) const {}
    __device__ __forceinline__ void done(const Unit&) const {}
};

__device__ __forceinline__ unsigned cvt_pk_bf16(float lo, float hi) { unsigned r; asm volatile("v_cvt_pk_bf16_f32 %0, %1, %2" : "=v"(r) : "v"(lo), "v"(hi)); return r; }
typedef float f32x2 __attribute__((ext_vector_type(2)));
#define PG8_FRESH_LANE(fr, fq) int l__; asm volatile("v_mbcnt_lo_u32_b32 %0, -1, 0\n\tv_mbcnt_hi_u32_b32 %0, -1, %0" : "=v"(l__)); const int fr = l__ & 15, fq = l__ >> 4; (void)fr_; (void)fq_
typedef unsigned u32x2 __attribute__((ext_vector_type(2)));
__device__ __forceinline__ float bf_lo(unsigned w) { return __uint_as_float(w << 16); }
__device__ __forceinline__ float bf_hi(unsigned w) { return __uint_as_float(w & 0xffff0000u); }

struct EpiQKV {
    static constexpr bool PERM = true, AFTER_DRAIN = false;
    bf16_t* O; const float* rope;
    __device__ __forceinline__ void operator()(const f32x4 (&acc)[2][2][4][2], const Unit& u, int wr, int wc, int fr_, int fq_) const {
        PG8_FRESH_LANE(fr, fq);
        const int row0 = u.pm * BM + wr * 64 + fr, col0 = u.pn * BM + wc * 32 + 8 * fq;
        const bool rot = (u.pn >= 12) && (u.pn < 20) && ((wc & 1) == 0);
#pragma unroll
        for (int ai = 0; ai < 2; ++ai)
#pragma unroll
            for (int m = 0; m < 4; ++m) { const int row = row0 + ai * HALF + m * 16; bf16_t* rowp = O + (size_t)row * 6144 + col0;
                f32x4 c0 = {1.f, 1.f, 1.f, 1.f}, c1 = c0, s0 = {0.f, 0.f, 0.f, 0.f}, s1 = s0;
                if (rot) { const float* t = rope + (size_t)(row & 8191) * 16; c0 = *(const f32x4*)(t); c1 = *(const f32x4*)(t + 4); s0 = *(const f32x4*)(t + 8); s1 = *(const f32x4*)(t + 12);
                    if (fq == 0) { s0 = -s0; s1 = -s1; } else if (fq != 1) { s0 = (f32x4){0.f, 0.f, 0.f, 0.f}; s1 = s0; c0 = (f32x4){1.f, 1.f, 1.f, 1.f}; c1 = c0; } }
#pragma unroll
                for (int bj = 0; bj < 2; ++bj) { f32x4 v0 = acc[ai][bj][m][0], v1 = acc[ai][bj][m][1];
                    if (rot) { f32x4 p0, p1;
#pragma unroll
                        for (int j = 0; j < 4; ++j) { p0[j] = __shfl_xor(v0[j], 16); p1[j] = __shfl_xor(v1[j], 16); }
                        v0 = v0 * c0 + p0 * s0; v1 = v1 * c1 + p1 * s1; }
                    u32x4 w; w.x = cvt_pk_bf16(v0[0], v0[1]); w.y = cvt_pk_bf16(v0[2], v0[3]); w.z = cvt_pk_bf16(v1[0], v1[1]); w.w = cvt_pk_bf16(v1[2], v1[3]);
                    *(u32x4*)(rowp + bj * HALF) = w; } }
    }
};
struct EpiBf16 {
    static constexpr bool PERM = true, AFTER_DRAIN = false;
    bf16_t* O; int ldc;
    __device__ __forceinline__ void operator()(const f32x4 (&acc)[2][2][4][2], const Unit& u, int wr, int wc, int fr_, int fq_) const {
        PG8_FRESH_LANE(fr, fq);
        const int row0 = u.pm * BM + wr * 64 + fr, col0 = u.pn * BM + wc * 32 + 8 * fq;
#pragma unroll
        for (int ai = 0; ai < 2; ++ai)
#pragma unroll
            for (int m = 0; m < 4; ++m) { bf16_t* rowp = O + (size_t)(row0 + ai * HALF + m * 16) * ldc + col0;
#pragma unroll
                for (int bj = 0; bj < 2; ++bj) { const f32x4 v0 = acc[ai][bj][m][0], v1 = acc[ai][bj][m][1];
                    u32x4 w; w.x = cvt_pk_bf16(v0[0], v0[1]); w.y = cvt_pk_bf16(v0[2], v0[3]); w.z = cvt_pk_bf16(v1[0], v1[1]); w.w = cvt_pk_bf16(v1[2], v1[3]);
                    *(u32x4*)(rowp + bj * HALF) = w; } }
    }
};
struct EpiResF32 {
    static constexpr bool PERM = false, AFTER_DRAIN = false;
    const float* base; float* out; int ldc;
    __device__ __forceinline__ void operator()(const f32x4 (&acc)[2][2][4][2], const Unit& u, int wr, int wc, int fr_, int fq_) const {
        PG8_FRESH_LANE(fr, fq);
        const int row0 = u.pm * BM + wr * 64 + fr, col0 = u.pn * BM + wc * 32 + 4 * fq;
#pragma unroll
        for (int ai = 0; ai < 2; ++ai)
#pragma unroll
            for (int m = 0; m < 4; ++m) { const size_t off = (size_t)(row0 + ai * HALF + m * 16) * ldc + col0;
#pragma unroll
                for (int bj = 0; bj < 2; ++bj)
#pragma unroll
                    for (int n = 0; n < 2; ++n) { const f32x4 b = *(const f32x4*)(base + off + bj * HALF + n * 16); *(f32x4*)(out + off + bj * HALF + n * 16) = b + acc[ai][bj][m][n]; }
                asm volatile("" ::: "memory"); }
    }
};
struct EpiPle {
    static constexpr bool PERM = false, AFTER_DRAIN = false;
    float* io; const bf16_t* U; int ldc;
    __device__ __forceinline__ void operator()(const f32x4 (&acc)[2][2][4][2], const Unit& u, int wr, int wc, int fr_, int fq_) const {
        PG8_FRESH_LANE(fr, fq);
        const int row0 = u.pm * BM + wr * 64 + fr, col0 = u.pn * BM + wc * 32 + 4 * fq;
#pragma unroll
        for (int ai = 0; ai < 2; ++ai)
#pragma unroll
            for (int m = 0; m < 4; ++m) { const size_t off = (size_t)(row0 + ai * HALF + m * 16) * ldc + col0;
#pragma unroll
                for (int bj = 0; bj < 2; ++bj)
#pragma unroll
                    for (int n = 0; n < 2; ++n) { const size_t o = off + bj * HALF + n * 16; const f32x4 b = *(const f32x4*)(io + o); const u32x2 uw = *(const u32x2*)(U + o); const f32x4 a = acc[ai][bj][m][n];
                        f32x4 r; r[0] = b[0] + bf_lo(uw.x) * __builtin_amdgcn_rcpf(1.f + __builtin_amdgcn_exp2f(-1.4426950408889634f * a[0]));
                        r[1] = b[1] + bf_hi(uw.x) * __builtin_amdgcn_rcpf(1.f + __builtin_amdgcn_exp2f(-1.4426950408889634f * a[1]));
                        r[2] = b[2] + bf_lo(uw.y) * __builtin_amdgcn_rcpf(1.f + __builtin_amdgcn_exp2f(-1.4426950408889634f * a[2]));
                        r[3] = b[3] + bf_hi(uw.y) * __builtin_amdgcn_rcpf(1.f + __builtin_amdgcn_exp2f(-1.4426950408889634f * a[3]));
                        *(f32x4*)(io + o) = r; }
                asm volatile("" ::: "memory"); }
    }
};
struct EpiResBf16 {
    static constexpr bool PERM = true, AFTER_DRAIN = false;
    const float* base; bf16_t* O;
    __device__ __forceinline__ void operator()(const f32x4 (&acc)[2][2][4][2], const Unit& u, int wr, int wc, int fr_, int fq_) const {
        PG8_FRESH_LANE(fr, fq);
        const int row0 = u.pm * BM + wr * 64 + fr, col0 = u.pn * BM + wc * 32 + 8 * fq;
#pragma unroll
        for (int ai = 0; ai < 2; ++ai)
#pragma unroll
            for (int m = 0; m < 4; ++m) { const size_t off = (size_t)(row0 + ai * HALF + m * 16) * 2048 + col0;
#pragma unroll
                for (int bj = 0; bj < 2; ++bj) { const f32x4 b0 = *(const f32x4*)(base + off + bj * HALF), b1 = *(const f32x4*)(base + off + bj * HALF + 4);
                    const f32x4 v0 = acc[ai][bj][m][0] + b0, v1 = acc[ai][bj][m][1] + b1;
                    u32x4 w; w.x = cvt_pk_bf16(v0[0], v0[1]); w.y = cvt_pk_bf16(v0[2], v0[3]); w.z = cvt_pk_bf16(v1[0], v1[1]); w.w = cvt_pk_bf16(v1[2], v1[3]);
                    *(u32x4*)(O + off + bj * HALF) = w; }
                asm volatile("" ::: "memory"); }
    }
};
struct EpiPle2 {
    static constexpr bool PERM = true, AFTER_DRAIN = false;
    bf16_t* Hs; const bf16_t* Y; const bf16_t* U;
    __device__ __forceinline__ void operator()(const f32x4 (&acc)[2][2][4][2], const Unit& u, int wr, int wc, int fr_, int fq_) const {
        PG8_FRESH_LANE(fr, fq);
        const int row0 = u.pm * BM + wr * 64 + fr, col0 = u.pn * BM + wc * 32 + 8 * fq;
#pragma unroll
        for (int ai = 0; ai < 2; ++ai)
#pragma unroll
            for (int m = 0; m < 4; ++m) { const size_t row = (size_t)(row0 + ai * HALF + m * 16); const size_t off = row * 2048 + col0;
#pragma unroll
                for (int bj = 0; bj < 2; ++bj) { const size_t o = off + bj * HALF;
                    const u32x4 hw = *(const u32x4*)(Hs + o), uw = *(const u32x4*)(U + o), ya = *(const u32x4*)(Y + 2 * row * 2048 + col0 + bj * HALF), yb = *(const u32x4*)(Y + (2 * row + 1) * 2048 + col0 + bj * HALF);
                    float r[8];
#pragma unroll
                    for (int q = 0; q < 4; ++q) { const float a0 = acc[ai][bj][m][q >> 1][(q & 1) * 2], a1 = acc[ai][bj][m][q >> 1][(q & 1) * 2 + 1];
                        const float s0 = __builtin_amdgcn_rcpf(1.f + __builtin_amdgcn_exp2f(-1.4426950408889634f * a0)), s1 = __builtin_amdgcn_rcpf(1.f + __builtin_amdgcn_exp2f(-1.4426950408889634f * a1));
                        r[2 * q] = (bf_lo(hw[q]) + (bf_lo(ya[q]) + bf_lo(yb[q]))) + bf_lo(uw[q]) * s0; r[2 * q + 1] = (bf_hi(hw[q]) + (bf_hi(ya[q]) + bf_hi(yb[q]))) + bf_hi(uw[q]) * s1; }
                    u32x4 w; w.x = cvt_pk_bf16(r[0], r[1]); w.y = cvt_pk_bf16(r[2], r[3]); w.z = cvt_pk_bf16(r[4], r[5]); w.w = cvt_pk_bf16(r[6], r[7]);
                    *(u32x4*)(Hs + o) = w; }
                asm volatile("" ::: "memory"); }
    }
};
struct EpiSwiglu {
    static constexpr bool PERM = true, AFTER_DRAIN = false;
    bf16_t* H;
    __device__ __forceinline__ void operator()(const f32x4 (&acc)[2][2][4][2], const Unit& u, int wr, int wc, int fr_, int fq_) const {
        PG8_FRESH_LANE(fr, fq);
        const int row0 = u.pm * BM + wr * 64 + fr, col0 = u.pn * HALF + wc * 32 + 8 * fq;
#pragma unroll
        for (int ai = 0; ai < 2; ++ai)
#pragma unroll
            for (int m = 0; m < 4; ++m) { bf16_t* rowp = H + (size_t)(row0 + ai * HALF + m * 16) * 512 + col0; float h[8];
#pragma unroll
                for (int n = 0; n < 2; ++n)
#pragma unroll
                    for (int j = 0; j < 4; ++j) { const float g = acc[ai][0][m][n][j], up = acc[ai][1][m][n][j];
                        h[n * 4 + j] = g * up * __builtin_amdgcn_rcpf(1.f + __builtin_amdgcn_exp2f(-1.4426950408889634f * g)); }
                u32x4 w; w.x = cvt_pk_bf16(h[0], h[1]); w.y = cvt_pk_bf16(h[2], h[3]); w.z = cvt_pk_bf16(h[4], h[5]); w.w = cvt_pk_bf16(h[6], h[7]);
                *(u32x4*)rowp = w; asm volatile("" ::: "memory"); }
    }
};
struct EpiScatter {
    static constexpr bool PERM = true, AFTER_DRAIN = false;
    bf16_t* Y; const int* lslot; const float* lgate;
    __device__ __forceinline__ void operator()(const f32x4 (&acc)[2][2][4][2], const Unit& u, int wr, int wc, int fr_, int fq_) const {
        PG8_FRESH_LANE(fr, fq);
        const int r0 = wr * 64 + fr, col0 = u.pn * BM + wc * 32 + 8 * fq;
#pragma unroll
        for (int ai = 0; ai < 2; ++ai)
#pragma unroll
            for (int m = 0; m < 4; ++m) { const int r = r0 + ai * HALF + m * 16;
                if (r < u.aux1) { const int slot = lslot[u.aux0 + r]; const float g = lgate[u.aux0 + r]; bf16_t* rowp = Y + (size_t)slot * 2048 + col0;
#pragma unroll
                    for (int bj = 0; bj < 2; ++bj) { const f32x4 v0 = acc[ai][bj][m][0] * g, v1 = acc[ai][bj][m][1] * g;
                        u32x4 w; w.x = cvt_pk_bf16(v0[0], v0[1]); w.y = cvt_pk_bf16(v0[2], v0[3]); w.z = cvt_pk_bf16(v1[0], v1[1]); w.w = cvt_pk_bf16(v1[2], v1[3]);
                        *(u32x4*)(rowp + bj * HALF) = w; } }
                asm volatile("" ::: "memory"); }
    }
};
struct MoeOrder {
    int nM, nN, nwg, G, c; const PG8_LAS int* tstart; const PG8_LAS int* cnt;
    __device__ void init(int nM_, int nN_, int G_, int c_, const PG8_LAS int* ts, const PG8_LAS int* cn) { nM = nM_; nN = nN_; nwg = nM * nN; G = G_; c = c_; tstart = ts; cnt = cn; }
    __device__ bool next(int i, Unit& u) const {
        const long L = (long)i * G + c; if (L >= nwg) return false;
        int wgid = (int)L; { const int q = nwg / NXCD, r = nwg % NXCD, xcd = wgid % NXCD, off = wgid / NXCD; wgid = (xcd < r ? xcd * (q + 1) : r * (q + 1) + (xcd - r) * q) + off; }
        const int nig = WGM * nN, gid = wgid / nig, fm = gid * WGM, gsz = (nM - fm) < WGM ? (nM - fm) : WGM;
        const int pm = fm + ((wgid % nig) % gsz), pn = (wgid % nig) / gsz;
        int e = 0;
        for (int k = 1; k < 32; ++k) e += (__builtin_amdgcn_readfirstlane(tstart[k]) <= pm) ? 1 : 0;
        const int t = pm - __builtin_amdgcn_readfirstlane(tstart[e]); const int left = __builtin_amdgcn_readfirstlane(cnt[e]) - t * 256;
        u.pm = pm; u.pn = pn; u.pb = e * nN + pn; u.aux0 = e * 65536 + t * 256; u.aux1 = left < 256 ? left : 256; return true;
    }
    __device__ __forceinline__ void a_ready(const Unit&) const {}
    __device__ __forceinline__ void done(const Unit&) const {}
};
template <class Epi, class Sched, bool ALIGN_EPI = false, bool SP2 = false>
__device__ __forceinline__ void gemm_phase(PG8_LAS unsigned char* lds, const Gemm g, const Sched& S, const Epi& E) {
    const int tid = threadIdx.x, wid = __builtin_amdgcn_readfirstlane(tid >> 6), lane = tid & 63, wr = wid >> 2, wc = wid & 3, fr = lane & 15, fq = lane >> 4;
    const int K = g.K, nt = K / BK;
    unsigned voffA[2], voffB[2];
#pragma unroll
    for (int i = 0; i < 2; ++i) { int R, C; stage_rc(tid * 16 + i * 8192, R, C); const int Rb = Epi::PERM ? ((R & ~31) + perm32(R & 31)) : R;
        voffA[i] = (unsigned)(R * K + C) * 2u; voffB[i] = (unsigned)(Rb * K + C) * 2u; }
    const size_t kstep = (size_t)(BK * 2);
    const size_t hstep = (size_t)HALF * K * 2;
    const size_t tstep = 2 * hstep;
    const unsigned ldsw = (unsigned)wid * 1024u;
    const int aoff = lds_byte(wr * 64 + fr, fq * 8), boff = lds_byte(wc * 32 + fr, fq * 8);
#define PG8_SA(b, h) (((b) * 2 + (h)) * HTB)
#define PG8_SB(b, h) ((4 + (b) * 2 + (h)) * HTB)
#define PG8_STAGE(bufoff, gbase, voff) do { _Pragma("unroll") for (int _i = 0; _i < 2; ++_i) \
        __builtin_amdgcn_global_load_lds((const unsigned*)((const char*)(gbase) + (voff)[_i]), (PG8_LAS unsigned*)(lds + (bufoff) + ldsw + _i * 8192), 16, 0, 0); } while (0)
#define PG8_LDA(dst, b, h) do { _Pragma("unroll") for (int m = 0; m < 4; ++m) _Pragma("unroll") for (int k = 0; k < 2; ++k) dst[m][k] = *(const PG8_LAS bf16x8*)(lds + PG8_SA(b, h) + aoff + m * 2048 + k * 1024); } while (0)
#define PG8_LDB(dst, b, h) do { _Pragma("unroll") for (int n = 0; n < 2; ++n) _Pragma("unroll") for (int k = 0; k < 2; ++k) dst[n][k] = *(const PG8_LAS bf16x8*)(lds + PG8_SB(b, h) + boff + n * 2048 + k * 1024); } while (0)
#define PG8_MMA(ai, bj, At, Bt) do { __builtin_amdgcn_s_setprio(1); _Pragma("unroll") for (int m = 0; m < 4; ++m) _Pragma("unroll") for (int n = 0; n < 2; ++n) _Pragma("unroll") for (int k = 0; k < 2; ++k) \
        acc[ai][bj][m][n] = __builtin_amdgcn_mfma_f32_16x16x32_bf16(Bt[n][k], At[m][k], acc[ai][bj][m][n], 0, 0, 0); __builtin_amdgcn_s_setprio(0); } while (0)
#define PG8_WAIT_V(n) asm volatile("s_waitcnt vmcnt(" #n ")" ::: "memory")
#define PG8_WAIT_L(n) asm volatile("s_waitcnt lgkmcnt(" #n ")" ::: "memory")
#define PG8_BAR __builtin_amdgcn_s_barrier()
#define PG8_SCHED __builtin_amdgcn_sched_barrier(0)
    Unit cur, nxt; int ui = 0;
    if (!S.next(0, cur)) return;
    f32x4 acc[2][2][4][2];
#pragma unroll
    for (int a = 0; a < 2; ++a)
#pragma unroll
        for (int b = 0; b < 2; ++b)
#pragma unroll
            for (int m = 0; m < 4; ++m)
#pragma unroll
                for (int n = 0; n < 2; ++n) acc[a][b][m][n] = (f32x4){0.f, 0.f, 0.f, 0.f};
    bf16x8 At[4][2], B0[2][2], B1[2][2];
    const char* cA = (const char*)g.A + (size_t)cur.pm * tstep; const char* cB = (const char*)g.Bt + (size_t)cur.pb * tstep;
    S.a_ready(cur);
    if constexpr (SP2) {
        PG8_STAGE(PG8_SB(0, 0), cB, voffB); PG8_STAGE(PG8_SB(0, 1), cB + hstep, voffB); PG8_STAGE(PG8_SA(0, 0), cA, voffA); PG8_STAGE(PG8_SA(0, 1), cA + hstep, voffA);
        if (wr == 1) PG8_BAR;
        PG8_WAIT_V(2); PG8_BAR;
        PG8_STAGE(PG8_SB(1, 0), cB + kstep, voffB); PG8_STAGE(PG8_SA(1, 0), cA + kstep, voffA); PG8_STAGE(PG8_SB(1, 1), cB + hstep + kstep, voffB);
        PG8_WAIT_V(6); PG8_BAR;
    } else {
        PG8_STAGE(PG8_SB(0, 0), cB, voffB); PG8_STAGE(PG8_SA(0, 0), cA, voffA); PG8_STAGE(PG8_SB(0, 1), cB + hstep, voffB); PG8_STAGE(PG8_SA(0, 1), cA + hstep, voffA);
        if (wr == 1) PG8_BAR;
        PG8_WAIT_V(4); PG8_BAR;
        PG8_STAGE(PG8_SB(1, 0), cB + kstep, voffB); PG8_STAGE(PG8_SA(1, 0), cA + kstep, voffA); PG8_STAGE(PG8_SB(1, 1), cB + hstep + kstep, voffB);
        PG8_WAIT_V(6); PG8_BAR;
    }
    for (;;) {
        const bool has_next = S.next(ui + 1, nxt);
        const char* nA = has_next ? (const char*)g.A + (size_t)nxt.pm * tstep : cA; const char* nB = has_next ? (const char*)g.Bt + (size_t)nxt.pb * tstep : cB;
#pragma unroll 1
        for (int t = 0; t < nt; t += 2) {
            const bool last = (t == nt - 2);
            const char* a1 = cA + (size_t)(t + 1) * kstep;
            const char* a2 = last ? nA : cA + (size_t)(t + 2) * kstep; const char* b2 = last ? nB : cB + (size_t)(t + 2) * kstep;
            const char* a3 = a2 + kstep; const char* b3 = b2 + kstep;
            if (last && has_next) S.a_ready(nxt);
            if constexpr (SP2) {
            PG8_LDB(B0, 0, 0); PG8_LDB(B1, 0, 1); PG8_SCHED; PG8_LDA(At, 0, 0); PG8_STAGE(PG8_SA(1, 1), a1 + hstep, voffA);
            PG8_WAIT_V(8); PG8_WAIT_L(0); PG8_BAR; PG8_MMA(0, 0, At, B0); PG8_MMA(0, 1, At, B1); PG8_BAR; PG8_SCHED;
            PG8_LDA(At, 0, 1); PG8_STAGE(PG8_SB(0, 0), b2, voffB); PG8_STAGE(PG8_SB(0, 1), b2 + hstep, voffB); PG8_STAGE(PG8_SA(0, 0), a2, voffA);
            PG8_WAIT_V(8); PG8_WAIT_L(0); PG8_BAR; PG8_MMA(1, 0, At, B0); PG8_MMA(1, 1, At, B1); PG8_BAR; PG8_SCHED;
            PG8_LDB(B0, 1, 0); PG8_LDB(B1, 1, 1); PG8_SCHED; PG8_LDA(At, 1, 0); PG8_STAGE(PG8_SA(0, 1), a2 + hstep, voffA);
            PG8_WAIT_V(8); PG8_WAIT_L(0); PG8_BAR; PG8_MMA(0, 0, At, B0); PG8_MMA(0, 1, At, B1); PG8_BAR; PG8_SCHED;
            PG8_LDA(At, 1, 1); PG8_STAGE(PG8_SB(1, 0), b3, voffB); PG8_STAGE(PG8_SB(1, 1), b3 + hstep, voffB); PG8_STAGE(PG8_SA(1, 0), a3, voffA);
            PG8_WAIT_V(8); PG8_WAIT_L(0); PG8_BAR; PG8_MMA(1, 0, At, B0); PG8_MMA(1, 1, At, B1); PG8_BAR; PG8_SCHED;
            } else {
            PG8_LDB(B0, 0, 0); PG8_SCHED; PG8_LDA(At, 0, 0); PG8_STAGE(PG8_SA(1, 1), a1 + hstep, voffA);
            PG8_WAIT_L(8); PG8_BAR; PG8_WAIT_L(0); PG8_MMA(0, 0, At, B0); PG8_BAR; PG8_SCHED;
            PG8_LDB(B1, 0, 1); PG8_STAGE(PG8_SB(0, 0), b2, voffB);
            PG8_BAR; PG8_WAIT_L(0); PG8_MMA(0, 1, At, B1); PG8_BAR;
            PG8_LDA(At, 0, 1); PG8_STAGE(PG8_SA(0, 0), a2, voffA);
            PG8_BAR; PG8_WAIT_L(0); PG8_MMA(1, 0, At, B0); PG8_BAR; PG8_SCHED;
            PG8_STAGE(PG8_SB(0, 1), b2 + hstep, voffB);
            PG8_WAIT_V(6); PG8_BAR; PG8_MMA(1, 1, At, B1); PG8_BAR;
            PG8_LDB(B0, 1, 0); PG8_SCHED; PG8_LDA(At, 1, 0); PG8_STAGE(PG8_SA(0, 1), a2 + hstep, voffA);
            PG8_WAIT_L(8); PG8_BAR; PG8_WAIT_L(0); PG8_MMA(0, 0, At, B0); PG8_BAR; PG8_SCHED;
            PG8_LDB(B1, 1, 1); PG8_STAGE(PG8_SB(1, 0), b3, voffB);
            PG8_BAR; PG8_WAIT_L(0); PG8_MMA(0, 1, At, B1); PG8_BAR;
            PG8_LDA(At, 1, 1); PG8_STAGE(PG8_SA(1, 0), a3, voffA);
            PG8_BAR; PG8_WAIT_L(0); PG8_MMA(1, 0, At, B0); PG8_BAR; PG8_SCHED;
            PG8_STAGE(PG8_SB(1, 1), b3 + hstep, voffB);
            PG8_WAIT_V(6); PG8_BAR; PG8_MMA(1, 1, At, B1); PG8_BAR;
            }
        }
        if constexpr (ALIGN_EPI) { if (wr == 0) PG8_BAR; }
        if constexpr (!Epi::AFTER_DRAIN) { E(acc, cur, wr, wc, fr, fq); S.done(cur); }
        if (!has_next) break;
#pragma unroll
        for (int a = 0; a < 2; ++a)
#pragma unroll
            for (int b = 0; b < 2; ++b)
#pragma unroll
                for (int m = 0; m < 4; ++m)
#pragma unroll
                    for (int n = 0; n < 2; ++n) acc[a][b][m][n] = (f32x4){0.f, 0.f, 0.f, 0.f};
        cur = nxt; cA = nA; cB = nB; ++ui;
        if constexpr (ALIGN_EPI) { if (wr == 1) PG8_BAR; }
    }
    PG8_WAIT_V(0);
    if constexpr (!ALIGN_EPI) { if (wr == 0) PG8_BAR; }
    PG8_BAR;
    if constexpr (Epi::AFTER_DRAIN) { E.fused(acc, cur, wr, wc, fr, fq, lds, wid, lane); S.done(cur); }
#undef PG8_SA
#undef PG8_SB
#undef PG8_STAGE
#undef PG8_LDA
#undef PG8_LDB
#undef PG8_MMA
#undef PG8_WAIT_V
#undef PG8_WAIT_L
#undef PG8_BAR
#undef PG8_SCHED
}
}
namespace att {
using bf16 = unsigned short;
using bf16x8 = __attribute__((ext_vector_type(8))) short;
using s16x4  = __attribute__((ext_vector_type(4))) short;
using f32x16 = __attribute__((ext_vector_type(16))) float;
using u32x4  = __attribute__((ext_vector_type(4))) unsigned;
constexpr int LDQKV = 6144;
constexpr int SEQ_ = 8192;
constexpr size_t SHM_V = 64 * 128 * 2, SHM_K = 64 * 128 * 2, SHM_ATTN = 2 * SHM_V + 2 * SHM_K + 8 * 64 * 4 + 64;
#define KSWZ(row, colB) ((row) * 256 + ((colB) ^ (((row) & 7) << 4)))
#define SBAR() __builtin_amdgcn_sched_barrier(0)
__device__ __forceinline__ int crow(int r, int hi) { return (r & 3) + 8 * (r >> 2) + 4 * hi; }
__device__ __forceinline__ unsigned cvtpk(float lo, float hi) { unsigned r; asm volatile("v_cvt_pk_bf16_f32 %0, %1, %2" : "=v"(r) : "v"(lo), "v"(hi)); return r; }
__device__ __forceinline__ int v_st(int k, int c) { const int kk = (k & ~0xC) | ((k & 4) << 1) | ((k & 8) >> 1); return ((kk >> 3) * 4 + (c >> 5)) * 512 + ((kk & 7) * 32 + (c & 31)) * 2; }
__device__ __forceinline__ int v_rd_base(int lane) { return ((lane & 3) << 3) | (((lane >> 2) & 3) << 6) | (((lane >> 4) & 1) << 5) | (((lane >> 5) & 1) << 8); }
constexpr int v_rd_off(int d0, int ks, int half) { return d0 * 512 + ks * 4096 + half * 2048; }
template <int OFF> __device__ __forceinline__ s16x4 tr_read(int vb) { s16x4 r; asm volatile("ds_read_b64_tr_b16 %0, %1 offset:%2" : "=&v"(r) : "v"(vb), "i"(OFF) : "memory"); return r; }
template <int D0> __device__ __forceinline__ void pv_one(f32x16& od, int vb, bf16x8 pa0, bf16x8 pa1, bf16x8 pa2, bf16x8 pa3) {
  const s16x4 l0 = tr_read<v_rd_off(D0, 0, 0)>(vb), h0 = tr_read<v_rd_off(D0, 0, 1)>(vb), l1 = tr_read<v_rd_off(D0, 1, 0)>(vb), h1 = tr_read<v_rd_off(D0, 1, 1)>(vb);
  const s16x4 l2 = tr_read<v_rd_off(D0, 2, 0)>(vb), h2 = tr_read<v_rd_off(D0, 2, 1)>(vb), l3 = tr_read<v_rd_off(D0, 3, 0)>(vb), h3 = tr_read<v_rd_off(D0, 3, 1)>(vb);
  asm volatile("s_waitcnt lgkmcnt(0)" ::: "memory"); SBAR();
#define PK(L, H) (bf16x8){L[0], L[1], L[2], L[3], H[0], H[1], H[2], H[3]}
  od = __builtin_amdgcn_mfma_f32_32x32x16_bf16(pa0, PK(l0, h0), od, 0, 0, 0);
  od = __builtin_amdgcn_mfma_f32_32x32x16_bf16(pa1, PK(l1, h1), od, 0, 0, 0);
  od = __builtin_amdgcn_mfma_f32_32x32x16_bf16(pa2, PK(l2, h2), od, 0, 0, 0);
  od = __builtin_amdgcn_mfma_f32_32x32x16_bf16(pa3, PK(l3, h3), od, 0, 0, 0);
#undef PK
}
__device__ __forceinline__ void pv_d0(f32x16* o, int vb, bf16x8 pa0, bf16x8 pa1, bf16x8 pa2, bf16x8 pa3) {
  pv_one<0>(o[0], vb, pa0, pa1, pa2, pa3); pv_one<1>(o[1], vb, pa0, pa1, pa2, pa3); pv_one<2>(o[2], vb, pa0, pa1, pa2, pa3); pv_one<3>(o[3], vb, pa0, pa1, pa2, pa3);
}
__device__ __forceinline__ void pack_p(const f32x16& p0, const f32x16& p1, bf16x8& pa0, bf16x8& pa1, bf16x8& pa2, bf16x8& pa3) {
#define PK4(P, BASE, OUT) do { unsigned a0 = cvtpk(P[BASE + 0], P[BASE + 1]), a1 = cvtpk(P[BASE + 2], P[BASE + 3]);   \
    unsigned b0 = cvtpk(P[BASE + 4], P[BASE + 5]), b1 = cvtpk(P[BASE + 6], P[BASE + 7]);                              \
    auto r0 = __builtin_amdgcn_permlane32_swap(a0, b0, false, false); auto r1 = __builtin_amdgcn_permlane32_swap(a1, b1, false, false); \
    u32x4 w = {r0[0], r1[0], r0[1], r1[1]}; OUT = *reinterpret_cast<bf16x8*>(&w); } while (0)
  PK4(p0, 0, pa0); PK4(p0, 8, pa1); PK4(p1, 0, pa2); PK4(p1, 8, pa3);
#undef PK4
}
template <int ND> __device__ __forceinline__ void qkt(f32x16& p0, f32x16& p1, const char* Ks, const bf16x8* qr, int cb0, int r32, int hi) {
  p0 = f32x16{}; p1 = f32x16{};
#pragma unroll
  for (int d0 = 0; d0 < ND; ++d0) { const int cb = cb0 + (d0 * 16 + hi * 8) * 2;
    const bf16x8 b0 = *reinterpret_cast<const bf16x8*>(Ks + KSWZ(r32, cb));
    const bf16x8 b1 = *reinterpret_cast<const bf16x8*>(Ks + KSWZ(32 + r32, cb));
    p0 = __builtin_amdgcn_mfma_f32_32x32x16_bf16(b0, qr[d0], p0, 0, 0, 0);
    p1 = __builtin_amdgcn_mfma_f32_32x32x16_bf16(b1, qr[d0], p1, 0, 0, 0); }
}
constexpr float THRL = 11.5f;
__device__ __forceinline__ void partialSM(f32x16& p0, f32x16& p1, float& m_reg, float& mn, float& alpha) {
  float pmax = p0[0];
#pragma unroll
  for (int r = 1; r < 16; ++r) pmax = fmaxf(pmax, p0[r]);
#pragma unroll
  for (int r = 0; r < 16; ++r) pmax = fmaxf(pmax, p1[r]);
  { auto rr = __builtin_amdgcn_permlane32_swap(__float_as_uint(pmax), __float_as_uint(pmax), false, false); pmax = fmaxf(__uint_as_float(rr[0]), __uint_as_float(rr[1])); }
  if (__builtin_expect(__all(pmax - m_reg <= THRL), 1)) { mn = m_reg; alpha = 1.f; }
  else { mn = fmaxf(m_reg, pmax); alpha = __builtin_amdgcn_exp2f(m_reg - mn); m_reg = mn; }
#pragma unroll
  for (int r = 0; r < 16; ++r) p0[r] = p0[r] - mn;
#pragma unroll
  for (int r = 0; r < 16; ++r) p1[r] = p1[r] - mn;
#pragma unroll
  for (int r = 0; r < 16; ++r) p0[r] = __builtin_amdgcn_exp2f(p0[r]);
}
__device__ __forceinline__ void finishSM(f32x16& p0, f32x16& p1, float alpha, float& l_reg, bf16x8& pa0, bf16x8& pa1, bf16x8& pa2, bf16x8& pa3) {
#pragma unroll
  for (int r = 0; r < 16; ++r) p1[r] = __builtin_amdgcn_exp2f(p1[r]);
  float ps = 0;
#pragma unroll
  for (int r = 0; r < 16; ++r) ps += p0[r];
#pragma unroll
  for (int r = 0; r < 16; ++r) ps += p1[r];
  { auto rr = __builtin_amdgcn_permlane32_swap(__float_as_uint(ps), __float_as_uint(ps), false, false); ps = __uint_as_float(rr[0]) + __uint_as_float(rr[1]); }
  l_reg = l_reg * alpha + ps;
  pack_p(p0, p1, pa0, pa1, pa2, pa3);
}
__device__ __forceinline__ float half_sum32(float v) {
#pragma unroll
  for (int o = 1; o < 32; o <<= 1) v += __shfl_xor(v, o);
  return v;
}

__device__ __forceinline__ void diff_unit(int b, int h, int qb, const bf16* __restrict__ QKV, bf16* __restrict__ Oout, const float* __restrict__ gdiff, float lam, float oscale, char* lds) {
  const int tid = threadIdx.x, lane = tid & 63, r32 = lane & 31, hi = lane >> 5; const int wid = __builtin_amdgcn_readfirstlane(tid >> 6);
  const int map = wid >> 2, wq = wid & 3;
  bf16* V_lds = (bf16*)lds; bf16* K_lds = (bf16*)(lds + 2 * SHM_V);
  float* ws = (float*)(lds + 2 * SHM_V + 2 * SHM_K) + wid * 64; float* li_l = ws; float* al_l = ws + 32;
  float m_reg = -1e30f, l_reg = 0; f32x16 o[4] = {}; bf16x8 qr[4];
  const size_t rowb = (size_t)b * SEQ_;
  const bf16* Qw = QKV + (rowb + qb * 128 + wq * 32 + r32) * LDQKV + 3072 + h * 128 + map * 64 + hi * 8;
#pragma unroll
  for (int d0 = 0; d0 < 4; ++d0) qr[d0] = *reinterpret_cast<const bf16x8*>(Qw + d0 * 16);
  const bf16* Kh = QKV + rowb * LDQKV + 4096 + h * 128; const bf16* Vh = QKV + rowb * LDQKV + 5120 + h * 128;
  const int sr = tid >> 4, sc = (tid & 15) * 8, vst0 = v_st(sr, sc), vst1 = v_st(32 + sr, sc);
  const int vb0 = (int)(uintptr_t)V_lds + v_rd_base(lane);
  const int cbm = map * 128;
  struct { bf16x8 vs0, vs1, ks0, ks1; } sr_[1];
  const unsigned toff0 = (unsigned)(sr * LDQKV + sc), toff1 = toff0 + 32u * LDQKV;
#define SLOAD(i, k0) do { const bf16* vt_ = Vh + (size_t)(k0) * LDQKV; const bf16* kt_ = Kh + (size_t)(k0) * LDQKV; \
    sr_[i].vs0 = *reinterpret_cast<const bf16x8*>(vt_ + toff0); sr_[i].vs1 = *reinterpret_cast<const bf16x8*>(vt_ + toff1); \
    sr_[i].ks0 = *reinterpret_cast<const bf16x8*>(kt_ + toff0); sr_[i].ks1 = *reinterpret_cast<const bf16x8*>(kt_ + toff1); } while (0)
#define SWRITE(bb, i) do { *(bf16x8*)((char*)V_lds + (bb) * SHM_V + vst0) = sr_[i].vs0; *(bf16x8*)((char*)V_lds + (bb) * SHM_V + vst1) = sr_[i].vs1; const int kc = sc * 2; \
    *(bf16x8*)((char*)K_lds + (bb) * SHM_K + KSWZ(sr, kc)) = sr_[i].ks0; *(bf16x8*)((char*)K_lds + (bb) * SHM_K + KSWZ(32 + sr, kc)) = sr_[i].ks1; } while (0)
#define SWAIT() asm volatile("s_waitcnt vmcnt(0)" ::: "memory")
#define RESC(a) do { if (__any((a) < 1.f)) { if (hi == 0) al_l[r32] = (a); asm volatile("s_waitcnt lgkmcnt(0)" ::: "memory"); \
    _Pragma("unroll") for (int d = 0; d < 4; ++d) _Pragma("unroll") for (int r = 0; r < 16; ++r) o[d][r] *= al_l[crow(r, hi)]; } } while (0)
  f32x16 pA0, pA1, pB0, pB1; float mnA, mnB, alA, alB; bf16x8 pa0, pa1, pa2, pa3; const int NT = 2 * qb + 2;
  __syncthreads();
  SLOAD(0, 0); asm volatile("s_waitcnt vmcnt(0)" ::: "memory"); SWRITE(0, 0); __syncthreads();
  qkt<4>(pA0, pA1, (const char*)K_lds, qr, cbm, r32, hi); partialSM(pA0, pA1, m_reg, mnA, alA);
  SLOAD(0, 64);
  SWAIT(); SWRITE(1, 0); __syncthreads();
  for (int j = 1; j + 1 < NT; j += 2) {
    SBAR(); qkt<4>(pB0, pB1, (const char*)K_lds + SHM_K, qr, cbm, r32, hi);
    finishSM(pA0, pA1, alA, l_reg, pa0, pa1, pa2, pa3); SBAR();
    SLOAD(0, (j + 1) * 64); SBAR();
    pv_d0(o, vb0, pa0, pa1, pa2, pa3); partialSM(pB0, pB1, m_reg, mnB, alB);
    __syncthreads(); SWAIT(); SWRITE(0, 0);
    RESC(alB); __syncthreads();
    SBAR(); qkt<4>(pA0, pA1, (const char*)K_lds, qr, cbm, r32, hi);
    finishSM(pB0, pB1, alB, l_reg, pa0, pa1, pa2, pa3); SBAR();
    SLOAD(0, (j + 2) * 64); SBAR();
    pv_d0(o, vb0 + (int)SHM_V, pa0, pa1, pa2, pa3); partialSM(pA0, pA1, m_reg, mnA, alA);
    __syncthreads(); SWAIT(); SWRITE(1, 0);
    RESC(alA); __syncthreads();
  }
  SBAR(); qkt<4>(pB0, pB1, (const char*)K_lds + SHM_K, qr, cbm, r32, hi);
  if (wq < 2) {
#pragma unroll
    for (int r = 0; r < 16; ++r) { pB0[r] = -1e30f; pB1[r] = -1e30f; } }
  finishSM(pA0, pA1, alA, l_reg, pa0, pa1, pa2, pa3); SBAR();
  pv_d0(o, vb0, pa0, pa1, pa2, pa3); partialSM(pB0, pB1, m_reg, mnB, alB);
  __syncthreads(); RESC(alB);
  finishSM(pB0, pB1, alB, l_reg, pa0, pa1, pa2, pa3); SBAR();
  pv_d0(o, vb0 + (int)SHM_V, pa0, pa1, pa2, pa3);
  if (hi == 0) li_l[r32] = l_reg; asm volatile("s_waitcnt lgkmcnt(0)" ::: "memory");
  float rli[16];
#pragma unroll
  for (int r = 0; r < 16; ++r) rli[r] = __builtin_amdgcn_rcpf(li_l[crow(r, hi)]);
  __syncthreads();
  float* xch = (float*)lds + (size_t)wq * 4096;
  if (map == 1) {
#pragma unroll
    for (int d0 = 0; d0 < 4; ++d0)
#pragma unroll
      for (int r = 0; r < 16; ++r) xch[(d0 * 16 + r) * 64 + lane] = o[d0][r] * rli[r] * lam;
  }
  __syncthreads();
  if (map == 0) {
    float ss[16];
#pragma unroll
    for (int r = 0; r < 16; ++r) { float s = 0.f;
#pragma unroll
      for (int d0 = 0; d0 < 4; ++d0) { const float v = o[d0][r] * rli[r] - xch[(d0 * 16 + r) * 64 + lane]; o[d0][r] = v; s += v * v; }
      ss[r] = s; }
#pragma unroll
    for (int r = 0; r < 16; ++r) ss[r] = half_sum32(ss[r]);
    bf16* Ow = Oout + (rowb + qb * 128 + wq * 32) * 2048 + 1024 + h * 128;
    float gv[4];
#pragma unroll
    for (int d0 = 0; d0 < 4; ++d0) gv[d0] = gdiff[d0 * 32 + r32] * oscale;
#pragma unroll
    for (int r = 0; r < 16; ++r) { const int orow = crow(r, hi); const float rs = rsqrtf(ss[r] * (1.f / 128.f) + 1e-6f);
#pragma unroll
      for (int d0 = 0; d0 < 4; ++d0) { const float y = o[d0][r] * rs * gv[d0]; const unsigned w = cvtpk(y, y); Ow[(size_t)orow * 2048 + d0 * 32 + r32] = (bf16)(w & 0xffffu); } }
  }
#undef SLOAD
#undef SWRITE
#undef SWAIT
#undef RESC
}
__device__ __forceinline__ void sb_unit(int b, int h, int qb, const bf16* __restrict__ QKV, bf16* __restrict__ Oout, const float* __restrict__ gsb, char* lds) {
  const int tid = threadIdx.x, lane = tid & 63, r32 = lane & 31, hi = lane >> 5; const int wid = __builtin_amdgcn_readfirstlane(tid >> 6);
  bf16* V_lds = (bf16*)lds; bf16* K_lds = (bf16*)(lds + 2 * SHM_V);
  volatile __attribute__((address_space(3))) int* flags = (volatile __attribute__((address_space(3))) int*)(lds + 2 * SHM_V + 2 * SHM_K + 8 * 64 * 4);
  f32x16 o[4] = {}; bf16x8 qr[8];
  const size_t rowb = (size_t)b * SEQ_;
  const int R = qb * 256, Q0 = R + wid * 32, tq = Q0 + r32;
  const bf16* Qw = QKV + (rowb + tq) * LDQKV + h * 128 + hi * 8;
#pragma unroll
  for (int d0 = 0; d0 < 8; ++d0) qr[d0] = *reinterpret_cast<const bf16x8*>(Qw + d0 * 16);
  const bf16* Kh = QKV + rowb * LDQKV + 1024 + h * 128; const bf16* Vh = QKV + rowb * LDQKV + 2048 + h * 128;
  const int sr = tid >> 4, sc = (tid & 15) * 8, vst0 = v_st(sr, sc), vst1 = v_st(32 + sr, sc);
  const int vb0 = (int)(uintptr_t)V_lds + v_rd_base(lane);
  const int jd = Q0 >> 6;
  float carry = 0.f;
  if (tid < 8) flags[tid] = 0;
  for (int j = (R + 255) >> 6; j >= 0; --j) {
    __syncthreads();
    { const int k0 = j * 64;
      const bf16x8 vs0 = *reinterpret_cast<const bf16x8*>(&Vh[(size_t)(k0 + sr) * LDQKV + sc]), vs1 = *reinterpret_cast<const bf16x8*>(&Vh[(size_t)(k0 + 32 + sr) * LDQKV + sc]);
      const bf16x8 ks0 = *reinterpret_cast<const bf16x8*>(&Kh[(size_t)(k0 + sr) * LDQKV + sc]), ks1 = *reinterpret_cast<const bf16x8*>(&Kh[(size_t)(k0 + 32 + sr) * LDQKV + sc]);
      *(bf16x8*)((char*)V_lds + vst0) = vs0; *(bf16x8*)((char*)V_lds + vst1) = vs1; const int kc = sc * 2;
      *(bf16x8*)((char*)K_lds + KSWZ(sr, kc)) = ks0; *(bf16x8*)((char*)K_lds + KSWZ(32 + sr, kc)) = ks1; }
    __syncthreads();
    if (j <= jd) {
      f32x16 p0, p1;
      qkt<8>(p0, p1, (const char*)K_lds, qr, 0, r32, hi);
      const bool diag = (j == jd);
      const int kb = j * 64 + 4 * hi;
      f32x16 q0, q1;
#pragma unroll
      for (int r = 0; r < 16; ++r) {
        const float z0 = __builtin_amdgcn_fmed3f(p0[r], -120.f, 120.f), z1 = __builtin_amdgcn_fmed3f(p1[r], -120.f, 120.f);
        float a0 = -__builtin_amdgcn_logf(1.f + __builtin_amdgcn_exp2f(z0)), a1 = -__builtin_amdgcn_logf(1.f + __builtin_amdgcn_exp2f(z1));
        float b0 = z0 + a0, b1 = z1 + a1;
        if (diag) { const int kv = kb + (r & 3) + 8 * (r >> 2); if (kv >= tq) { a0 = 0.f; b0 = -1e30f; } if (kv + 32 >= tq) { a1 = 0.f; b1 = -1e30f; } }
        q0[r] = a0; q1[r] = a1; p0[r] = b0; p1[r] = b1; }
      float G[8], PG[8], SUF[8];
#pragma unroll
      for (int g = 0; g < 4; ++g) { G[g] = (q0[4 * g] + q0[4 * g + 1]) + (q0[4 * g + 2] + q0[4 * g + 3]); G[4 + g] = (q1[4 * g] + q1[4 * g + 1]) + (q1[4 * g + 2] + q1[4 * g + 3]); }
#pragma unroll
      for (int g = 0; g < 8; ++g) PG[g] = __shfl_xor(G[g], 32);
      float run = carry;
#pragma unroll
      for (int g = 7; g >= 0; --g) { SUF[g] = run; run += G[g] + PG[g]; }
      carry = run;
#pragma unroll
      for (int g = 0; g < 8; ++g) SUF[g] += (hi == 0) ? PG[g] : 0.f;
#pragma unroll
      for (int g = 0; g < 4; ++g) {
        float s = SUF[g];
        p0[4 * g + 3] = __builtin_amdgcn_exp2f(p0[4 * g + 3] + s); s += q0[4 * g + 3];
        p0[4 * g + 2] = __builtin_amdgcn_exp2f(p0[4 * g + 2] + s); s += q0[4 * g + 2];
        p0[4 * g + 1] = __builtin_amdgcn_exp2f(p0[4 * g + 1] + s); s += q0[4 * g + 1];
        p0[4 * g + 0] = __builtin_amdgcn_exp2f(p0[4 * g + 0] + s);
        float s2 = SUF[4 + g];
        p1[4 * g + 3] = __builtin_amdgcn_exp2f(p1[4 * g + 3] + s2); s2 += q1[4 * g + 3];
        p1[4 * g + 2] = __builtin_amdgcn_exp2f(p1[4 * g + 2] + s2); s2 += q1[4 * g + 2];
        p1[4 * g + 1] = __builtin_amdgcn_exp2f(p1[4 * g + 1] + s2); s2 += q1[4 * g + 1];
        p1[4 * g + 0] = __builtin_amdgcn_exp2f(p1[4 * g + 0] + s2);
      }
      bf16x8 pa0, pa1, pa2, pa3;
      pack_p(p0, p1, pa0, pa1, pa2, pa3);
      pv_d0(o, vb0, pa0, pa1, pa2, pa3);
      if (__all(carry < -160.f)) { if (lane == 0) flags[wid] = 1; }
    }
    __syncthreads();
    int alld = 1;
#pragma unroll
    for (int w = 0; w < 8; ++w) alld &= flags[w];
    if (alld) break;
  }
  { float ss[16];
#pragma unroll
    for (int r = 0; r < 16; ++r) { float s = 0.f;
#pragma unroll
      for (int d0 = 0; d0 < 4; ++d0) s += o[d0][r] * o[d0][r];
      ss[r] = half_sum32(s); }
    bf16* Ow = Oout + (rowb + Q0) * 2048 + h * 128;
    float gv[4];
#pragma unroll
    for (int d0 = 0; d0 < 4; ++d0) gv[d0] = gsb[d0 * 32 + r32];
#pragma unroll
    for (int r = 0; r < 16; ++r) { const int orow = crow(r, hi); const float rs = rsqrtf(ss[r] * (1.f / 128.f) + 1e-6f);
#pragma unroll
      for (int d0 = 0; d0 < 4; ++d0) { const float y = o[d0][r] * rs * gv[d0]; const unsigned w = cvtpk(y, y); Ow[(size_t)orow * 2048 + d0 * 32 + r32] = (bf16)(w & 0xffffu); } }
  }
  __syncthreads();
}
#undef KSWZ
#undef SBAR
}
constexpr int NWAVES = 8;
constexpr int BATCH = 4, SEQ = 8192, DM = 2048, NTOK = BATCH * SEQ;
constexpr int QKVC = 6144, NEXP = 32, DEXP = 512, PLED = 256, LCAP = 65536;
constexpr float EPS = 1e-6f;
constexpr float QSCALE_SB = 0.08838834764831845f * 1.4426950408889634f;
constexpr float QSCALE_DF = 0.125f * 1.4426950408889634f;
constexpr size_t MiB = 1u << 20;
constexpr size_t WS_CTL = 0, CTL_ZERO_BYTES = 1 * MiB;
constexpr size_t WS_ROPE = 1 * MiB;
constexpr size_t WS_WRT = 1 * MiB + 512 * 1024;
constexpr size_t WS_WIN = 2 * MiB;
constexpr size_t WS_WOUT = 26 * MiB;
constexpr size_t WS_WPG = 34 * MiB;
constexpr size_t WS_WPLE = 42 * MiB;
constexpr size_t WS_WGU = 44 * MiB;
constexpr size_t WS_WD = 172 * MiB;
constexpr size_t WS_LSLOT = 236 * MiB;
constexpr size_t WS_LGATE = 244 * MiB;
constexpr size_t WS_PB = 252 * MiB;
constexpr size_t WS_A1 = 268 * MiB;
constexpr size_t WS_QKV = 396 * MiB;
constexpr size_t WS_XS = WS_QKV;
constexpr size_t WS_H = WS_QKV + 288 * MiB;
constexpr size_t WS_Y = WS_QKV;
constexpr size_t WS_U = 780 * MiB;
constexpr size_t WS_END = 908 * MiB;
constexpr int CW_TMO = 0, CW_CODE = 1;
constexpr int CW_BAR = 4096;
constexpr int CW_CNT = 16384;
constexpr int RING_OFF = 0, RING_BYTES = 131072;
constexpr int LDSCTL_OFF = RING_BYTES;
constexpr int TST_OFF = LDSCTL_OFF;
constexpr int CNT_OFF = LDSCTL_OFF + 160;
constexpr int MISC_OFF = LDSCTL_OFF + 320;
constexpr int LDS_BYTES = 147456;

#define GAS __attribute__((address_space(1)))
#define LAS __attribute__((address_space(3)))
typedef unsigned short bf16;
typedef unsigned v4u __attribute__((ext_vector_type(4)));
typedef unsigned v2u __attribute__((ext_vector_type(2)));
typedef float f32x4 __attribute__((ext_vector_type(4)));
typedef GAS unsigned gu32;
#define RLX_AGENT __ATOMIC_RELAXED, __HIP_MEMORY_SCOPE_AGENT
#define LDS_WAIT() asm volatile("s_waitcnt lgkmcnt(0)" ::: "memory")
#define VM_WAIT() asm volatile("s_waitcnt vmcnt(0)" ::: "memory")
__device__ __forceinline__ unsigned pk2(float lo, float hi) { return pg8::cvt_pk_bf16(lo, hi); }
#define XB_TMO      128
#define XB_XCNT(j)  (256  + 64 * (j))
#define XB_XSUB(j)  (1280 + 64 * (j))
#define XB_XGEN(j)  (2304 + 64 * (j))
#define XB_TOP      3328
#define XB_TOPGEN   3392
#define XCD_BAR_WORDS 3456
#define XB_SPIN_CAP (1u << 18)

__device__ __forceinline__ unsigned xb_ld(unsigned* p)              { return __hip_atomic_load(p, __ATOMIC_RELAXED, __HIP_MEMORY_SCOPE_AGENT); }
__device__ __forceinline__ unsigned xb_add(unsigned* p, unsigned v) { return __hip_atomic_fetch_add(p, v, __ATOMIC_RELAXED, __HIP_MEMORY_SCOPE_AGENT); }
__device__ __forceinline__ unsigned xb_xcc_id() { return (unsigned)__builtin_amdgcn_s_getreg((3 << 11) | 20) & 0xFu; }
#define XB_SPIN(cond, bar) do { unsigned _sp = 0; while (cond) { __builtin_amdgcn_s_sleep(1); \
    if ((++_sp & 255u) == 0u) { if (xb_ld(&(bar)[XB_TMO])) break; if (_sp > XB_SPIN_CAP) { atomicAdd(&(bar)[XB_TMO], 1u); break; } } } } while (0)

struct XcdBarrier {
    unsigned* bar; unsigned x;
    volatile LAS unsigned* st;
};

__device__ __forceinline__ XcdBarrier xcd_barrier_post(unsigned* bar, volatile LAS unsigned* st) {
    XcdBarrier b; b.bar = bar; b.x = xb_xcc_id(); b.st = st;
    if (threadIdx.x == 0) (void)xb_add(&bar[XB_XCNT(b.x)], 1u);
    return b;
}
__device__ __forceinline__ void xcd_barrier_complete(unsigned* bar, unsigned x, unsigned& nloc, unsigned& nx) {
    const unsigned G = gridDim.x * gridDim.y * gridDim.z;
    unsigned sum, cnt, mine, sp = 0u;
    for (;;) {
        sum = 0u; cnt = 0u; mine = 0u;
#pragma unroll
        for (unsigned j = 0; j < 16; ++j) { const unsigned c = xb_ld(&bar[XB_XCNT(j)]); sum += c; cnt += (c > 0u) ? 1u : 0u; mine = (j == x) ? c : mine; }
        if (sum == G) break;
        __builtin_amdgcn_s_sleep(1);
        if ((++sp & 255u) == 0u) { if (xb_ld(&bar[XB_TMO])) break; if (sp > XB_SPIN_CAP) { atomicAdd(&bar[XB_TMO], 1u); break; } }
    }
    nloc = mine > 0u ? mine : 1u; nx = cnt > 0u ? cnt : 1u;
}

__device__ __forceinline__ void xcd_barrier(const XcdBarrier& b) {
    asm volatile("s_waitcnt vmcnt(0)" ::: "memory");
    __syncthreads();
    if (threadIdx.x == 0) {
        unsigned* bar = b.bar;
        __builtin_amdgcn_s_waitcnt(0);
        unsigned nloc = b.st[0], nx = b.st[1];
        if (nloc == 0u) { xcd_barrier_complete(bar, b.x, nloc, nx); b.st[0] = nloc; b.st[1] = nx; }
        const unsigned old = xb_add(&bar[XB_XSUB(b.x)], 1u);
        const unsigned gen = old / nloc;
        if (old + 1u == (gen + 1u) * nloc) {
            __builtin_amdgcn_fence(__ATOMIC_RELEASE, "agent");
            asm volatile("s_waitcnt vmcnt(0)" ::: "memory");
            const unsigned og = xb_add(&bar[XB_TOP], 1u);
            const unsigned tg = og / nx;
            if (og + 1u == (tg + 1u) * nx) xb_add(&bar[XB_TOPGEN], 1u);
            else XB_SPIN(xb_ld(&bar[XB_TOPGEN]) == tg, bar);
            __builtin_amdgcn_fence(__ATOMIC_ACQUIRE, "agent");
            xb_add(&bar[XB_XGEN(b.x)], 1u);
            asm volatile("s_waitcnt vmcnt(0)" ::: "memory");
        } else {
            XB_SPIN(xb_ld(&bar[XB_XGEN(b.x)]) == gen, bar);
            __builtin_amdgcn_fence(__ATOMIC_ACQUIRE, "agent");
            asm volatile("s_waitcnt vmcnt(0)" ::: "memory");
        }
    }
    __syncthreads();
}
struct Frame {
    LAS unsigned char* lds;
    volatile LAS unsigned* MISC;
    gu32* ctl;
    int tid, lane, wave;
    int vcu, G;
};
__device__ __forceinline__ float wave_sum(float v) {
#pragma unroll
    for (int o = 1; o < 64; o <<= 1) v += __shfl_xor(v, o);
    return v;
}
__device__ __forceinline__ void tr_item(const float* W, int ldw, int k0, int n0, bf16* dst, int dpitch, float scale, LAS float* scr, int lane) {
#pragma unroll 8
    for (int i = 0; i < 32; ++i) { const int kk = 2 * i + (lane >> 5); scr[kk * 33 + (lane & 31)] = W[(size_t)(k0 + kk) * ldw + n0 + (lane & 31)]; }
    LDS_WAIT(); asm volatile("" ::: "memory");
    const int c = lane & 7;
#pragma unroll
    for (int j = 0; j < 4; ++j) { const int n = (lane >> 3) + 8 * j; const LAS float* s = scr + (8 * c) * 33 + n;
        v4u o; o.x = pk2(s[0 * 33] * scale, s[1 * 33] * scale); o.y = pk2(s[2 * 33] * scale, s[3 * 33] * scale); o.z = pk2(s[4 * 33] * scale, s[5 * 33] * scale); o.w = pk2(s[6 * 33] * scale, s[7 * 33] * scale);
        *(GAS v4u*)(dst + (size_t)n * dpitch + 8 * c) = o; }
    LDS_WAIT(); asm volatile("" ::: "memory");
}
__device__ __forceinline__ void rms_row_to_bf16(const float* xrow, const float* g, bf16* orow, int lane) {
    const GAS f32x4* xr = (const GAS f32x4*)xrow + lane;
    f32x4 v[8]; float s = 0.f;
#pragma unroll
    for (int j = 0; j < 8; ++j) { v[j] = xr[64 * j]; s += (v[j].x * v[j].x + v[j].y * v[j].y) + (v[j].z * v[j].z + v[j].w * v[j].w); }
    const float rstd = rsqrtf(wave_sum(s) * (1.f / DM) + EPS);
    GAS v2u* o8 = (GAS v2u*)orow + lane;
#pragma unroll
    for (int j = 0; j < 8; ++j) { const f32x4 gg = *((const GAS f32x4*)g + lane + 64 * j); v2u w; w.x = pk2(v[j].x * rstd * gg.x, v[j].y * rstd * gg.y); w.y = pk2(v[j].z * rstd * gg.z, v[j].w * rstd * gg.w); o8[64 * j] = w; }
}

__device__ __forceinline__ void unpack8(const v4u w, float (&f)[8]) {
#pragma unroll
    for (int q = 0; q < 4; ++q) { f[2 * q] = pg8::bf_lo(w[q]); f[2 * q + 1] = pg8::bf_hi(w[q]); }
}
struct Args { const float* in[21]; float* out; unsigned char* ws; int ph_lo, ph_hi; };


#define x_ (args.in[0])
#define p_in (args.in[1])
#define g_attn (args.in[2])
#define w_in (args.in[3])
#define g_sb (args.in[4])
#define g_diff (args.in[5])
#define lam_q1 (args.in[6])
#define lam_k1 (args.in[7])
#define lam_q2 (args.in[8])
#define lam_k2 (args.in[9])
#define w_out (args.in[10])
#define g_moe (args.in[11])
#define w_rg (args.in[12])
#define w_re (args.in[13])
#define w_gate (args.in[14])
#define w_up (args.in[15])
#define w_down (args.in[16])
#define g_ple (args.in[17])
#define w_ple (args.in[18])
#define w_pg (args.in[19])
#define g_final (args.in[20])
#define rope ((float*)(ws + WS_ROPE))
#define wrt ((float*)(ws + WS_WRT))
#define WIN ((bf16*)(ws + WS_WIN))
#define WOUT ((bf16*)(ws + WS_WOUT))
#define WPG ((bf16*)(ws + WS_WPG))
#define WPLE ((bf16*)(ws + WS_WPLE))
#define WGU ((bf16*)(ws + WS_WGU))
#define WD ((bf16*)(ws + WS_WD))
#define LSLOT ((int*)(ws + WS_LSLOT))
#define LGATE ((float*)(ws + WS_LGATE))
#define PB ((bf16*)(ws + WS_PB))
#define A1 ((bf16*)(ws + WS_A1))
#define QKV ((bf16*)(ws + WS_QKV))
#define XS ((bf16*)(ws + WS_XS))
#define HB ((bf16*)(ws + WS_H))
#define YB ((bf16*)(ws + WS_Y))
#define UB ((bf16*)out)
#define H1B ((bf16*)(ws + WS_U))
#define ecnt (F.ctl + CW_CNT)
__global__ void __launch_bounds__(NWAVES * 64, 2) mega_fwd(Args args) {
    extern __shared__ __attribute__((aligned(16))) unsigned char lds[];
    Frame F;
    F.lds = (LAS unsigned char*)lds;
    F.MISC = (volatile LAS unsigned*)(F.lds + MISC_OFF);
    F.tid = threadIdx.x; F.lane = F.tid & 63; F.wave = __builtin_amdgcn_readfirstlane(F.tid >> 6);
    F.G = gridDim.x; { const int bx = blockIdx.x; F.vcu = (F.G % 8 == 0) ? (bx % 8) * (F.G / 8) + bx / 8 : bx; }
    unsigned char* ws = args.ws;
    F.ctl = (gu32*)(ws + WS_CTL);
    float* const out = args.out;
    for (int u = F.tid; u < (LDS_BYTES - LDSCTL_OFF) / 4; u += NWAVES * 64) ((LAS unsigned*)(F.lds + LDSCTL_OFF))[u] = 0u;
    __syncthreads();
    XcdBarrier bar = xcd_barrier_post((unsigned*)(F.ctl + CW_BAR), F.MISC + 8);
    const int lo = args.ph_lo, hi = args.ph_hi;
#ifndef PROBE_DBL
#define PROBE_DBL -1
#endif
#define REPS(k) _Pragma("unroll 1") for (int rep_ = 0; rep_ < ((PROBE_DBL == (k)) ? 2 : 1); ++rep_)
#ifndef PH_MASK
#define PH_MASK 0x7ff
#endif
#define IN(k) ((((PH_MASK) >> (k)) & 1) && lo <= (k) && (k) < hi)
#define SEAM(k) do { if (IN(k) && IN((k) + 1)) xcd_barrier(bar); } while (0)
    const int gw = F.vcu * NWAVES + F.wave, NGW = F.G * NWAVES;
    LAS int* tstart = (LAS int*)(F.lds + TST_OFF); LAS int* lcnt = (LAS int*)(F.lds + CNT_OFF);

    if (IN(0)) REPS(0) {
        LAS float* scr = (LAS float*)(F.lds + RING_OFF + F.wave * 16384);
        constexpr int I_IN = 32 * 192, I_OUT = 32 * 64, I_PG = 32 * 64, I_PLE = 4 * 64, I_G = 32 * 32 * 16, I_U = I_G, I_D = 32 * 8 * 64;
        constexpr int NITEMS = I_IN + I_OUT + I_PG + I_PLE + I_G + I_U + I_D;
        for (int it = gw; it < NITEMS; it += NGW) {
            int r = it;
            if (r < I_IN) { const int kb = r / 192, nb = r % 192, n0 = 32 * nb, k0 = 64 * kb; const float sc = (n0 < 1024) ? QSCALE_SB : ((n0 >= 3072 && n0 < 4096) ? QSCALE_DF : 1.f);
                tr_item(w_in, QKVC, k0, n0, WIN + (size_t)n0 * DM + k0, DM, sc, scr, F.lane); continue; } r -= I_IN;
            if (r < I_OUT) { const int kb = r / 64, nb = r % 64; tr_item(w_out, DM, 64 * kb, 32 * nb, WOUT + (size_t)(32 * nb) * DM + 64 * kb, DM, 1.f, scr, F.lane); continue; } r -= I_OUT;
            if (r < I_PG) { const int kb = r / 64, nb = r % 64; tr_item(w_pg, DM, 64 * kb, 32 * nb, WPG + (size_t)(32 * nb) * DM + 64 * kb, DM, 1.f, scr, F.lane); continue; } r -= I_PG;
            if (r < I_PLE) { const int kb = r / 64, nb = r % 64; tr_item(w_ple, DM, 64 * kb, 32 * nb, WPLE + (size_t)(32 * nb) * PLED + 64 * kb, PLED, 1.f, scr, F.lane); continue; } r -= I_PLE;
            if (r < I_G + I_U) { const bool isu = r >= I_G; if (isu) r -= I_G; const int e = r / 512, q = r % 512, kb = q / 16, nb = q % 16, n0 = 32 * nb, k0 = 64 * kb;
                const int drow = e * 1024 + (n0 >> 7) * 256 + (isu ? 128 : 0) + (n0 & 127);
                tr_item((isu ? w_up : w_gate) + (size_t)e * DM * DEXP, DEXP, k0, n0, WGU + (size_t)drow * DM + k0, DM, 1.f, scr, F.lane); continue; } r -= I_G + I_U;
            { const int e = r / 512, q = r % 512, kb = q / 64, nb = q % 64, n0 = 32 * nb, k0 = 64 * kb;
                tr_item(w_down + (size_t)e * DEXP * DM, DM, k0, n0, WD + ((size_t)e * DM + n0) * DEXP + k0, DEXP, 1.f, scr, F.lane); }
        }
        for (int i = gw * 64 + F.lane; i < SEQ * 8; i += NGW * 64) { const int pos = i >> 3, k = i & 7;
            const float inv = exp2f(-(float)k * (18.931568569324174f / 8.f));
            const float ang = (float)pos * inv;
            const double rev = (double)ang * 0.15915494309189535; const float fr = (float)(rev - floor(rev));
            rope[pos * 16 + k] = __builtin_amdgcn_cosf(fr); rope[pos * 16 + 8 + k] = __builtin_amdgcn_sinf(fr); }
        for (int i = gw * 64 + F.lane; i < 36 * DM; i += NGW * 64) { const int c = i / DM, k = i % DM; wrt[i] = (c < 4) ? w_rg[k * 4 + c] : w_re[k * 32 + (c - 4)]; }
        for (size_t i = (size_t)gw * 64 + F.lane; i < (size_t)NTOK * PLED / 4; i += (size_t)NGW * 64) { const f32x4 v = *((const GAS f32x4*)p_in + i); v2u w; w.x = pk2(v.x, v.y); w.y = pk2(v.z, v.w); *((GAS v2u*)PB + i) = w; }
        for (int m = gw; m < NTOK; m += NGW) rms_row_to_bf16(x_ + (size_t)m * DM, g_attn, A1 + (size_t)m * DM, F.lane);
    }
    SEAM(0);
    if (IN(1)) REPS(1) {
        pg8::Gemm g{A1, WIN, NTOK, QKVC, DM}; pg8::StaticOrder S; S.init(NTOK, QKVC, F.G, (int)blockIdx.x);
        pg8::EpiQKV E{QKV, rope};
        pg8::gemm_phase<pg8::EpiQKV, pg8::StaticOrder, true, true>(F.lds + RING_OFF, g, S, E);
    }
    SEAM(1);
    if (IN(2)) {
        float lam;
        { float a = (F.lane < 64) ? lam_q1[F.lane] * lam_k1[F.lane] : 0.f, b2 = lam_q2[F.lane] * lam_k2[F.lane]; a = wave_sum(a); b2 = wave_sum(b2); lam = expf(a) - expf(b2) + 0.2f; }
#ifndef NO_DIFF
        REPS(20) for (int L = F.vcu; L < 1024; L += F.G) { const int bh = L >> 5, pr = L & 31;
#pragma unroll 1
            for (int s2 = 0; s2 < 2; ++s2) att::diff_unit(bh >> 3, bh & 7, s2 ? pr : 63 - pr, QKV, A1, g_diff, lam, 0.8f, (char*)lds + RING_OFF); }
#endif
        __syncthreads();
#ifndef NO_SB
        REPS(21) for (int L = F.vcu; L < 1024; L += F.G) { const int bh = L >> 5, qb = L & 31;
            att::sb_unit(bh >> 3, bh & 7, qb, QKV, A1, g_sb, (char*)lds + RING_OFF); }
#endif
    }
    SEAM(2);
    if (IN(3)) REPS(3) {
#ifndef NO_P3A
        { pg8::Gemm g{A1, WOUT, NTOK, DM, DM}; pg8::StaticOrder S; S.init(NTOK, DM, F.G, (int)blockIdx.x);
          pg8::EpiResBf16 E{x_, H1B};
          pg8::gemm_phase<pg8::EpiResBf16, pg8::StaticOrder, true, true>(F.lds + RING_OFF, g, S, E); }
#endif
#ifndef NO_P3B
        { pg8::Gemm g{PB, WPLE, NTOK, DM, PLED}; pg8::StaticOrder S; S.init(NTOK, DM, F.G, (int)blockIdx.x);
          pg8::EpiBf16 E{UB, DM};
          pg8::gemm_phase<pg8::EpiBf16, pg8::StaticOrder, true, true>(F.lds + RING_OFF, g, S, E); }
#endif
    }
    SEAM(3);
    if (IN(4)) {
        LAS int* sel_e = (LAS int*)(F.lds + RING_OFF); LAS float* sel_g = (LAS float*)(F.lds + RING_OFF + 1024); LAS int* lhist = (LAS int*)(F.lds + RING_OFF + 2048); LAS int* lbase = (LAS int*)(F.lds + RING_OFF + 2176);
        LAS int* lrk = (LAS int*)(F.lds + RING_OFF + 2304);
        for (int chunk = blockIdx.x; chunk < NTOK / 128; chunk += F.G) {
            if (F.tid < 32) lhist[F.tid] = 0;
            for (int g4 = 0; g4 < 4; ++g4) {
                const int row0 = chunk * 128 + F.wave * 16 + g4 * 4;
                float v[4][4][8]; float rstd[4];
#pragma unroll
                for (int r = 0; r < 4; ++r) { const GAS v4u* xr = (const GAS v4u*)(H1B + (size_t)(row0 + r) * DM) + F.lane; float s = 0.f;
#pragma unroll
                    for (int j = 0; j < 4; ++j) { unpack8(xr[64 * j], v[r][j]);
#pragma unroll
                        for (int i = 0; i < 8; ++i) s += v[r][j][i] * v[r][j][i]; }
                    rstd[r] = rsqrtf(wave_sum(s) * (1.f / DM) + EPS); }
#pragma unroll
                for (int j = 0; j < 4; ++j) { const f32x4 g0 = *((const GAS f32x4*)g_moe + 2 * F.lane + 128 * j), g1 = *((const GAS f32x4*)g_moe + 2 * F.lane + 128 * j + 1);
#pragma unroll
                    for (int r = 0; r < 4; ++r) {
#pragma unroll
                        for (int i = 0; i < 4; ++i) { v[r][j][i] *= rstd[r] * g0[i]; v[r][j][4 + i] *= rstd[r] * g1[i]; }
                        v4u w; w.x = pk2(v[r][j][0], v[r][j][1]); w.y = pk2(v[r][j][2], v[r][j][3]); w.z = pk2(v[r][j][4], v[r][j][5]); w.w = pk2(v[r][j][6], v[r][j][7]);
                        *((GAS v4u*)(A1 + (size_t)(row0 + r) * DM) + F.lane + 64 * j) = w; } }
                float lg[4] = {0.f, 0.f, 0.f, 0.f};
#pragma unroll 1
                for (int c = 0; c < 36; ++c) { const GAS f32x4* wc = (const GAS f32x4*)(wrt + (size_t)c * DM) + 2 * F.lane;
                    float pa[4] = {0.f, 0.f, 0.f, 0.f};
#pragma unroll
                    for (int j = 0; j < 4; ++j) { const f32x4 w0 = wc[128 * j], w1 = wc[128 * j + 1];
#pragma unroll
                        for (int r = 0; r < 4; ++r) pa[r] += ((v[r][j][0] * w0.x + v[r][j][1] * w0.y) + (v[r][j][2] * w0.z + v[r][j][3] * w0.w)) + ((v[r][j][4] * w1.x + v[r][j][5] * w1.y) + (v[r][j][6] * w1.z + v[r][j][7] * w1.w)); }
#pragma unroll
                    for (int r = 0; r < 4; ++r) { const float t = wave_sum(pa[r]); lg[r] = (F.lane == c) ? t : lg[r]; } }
#pragma unroll
                for (int r = 0; r < 4; ++r) {
                    const float g0 = __shfl(lg[r], 0), g1 = __shfl(lg[r], 1), g2 = __shfl(lg[r], 2), g3 = __shfl(lg[r], 3);
                    int grp = 0; float gm = g0; if (g1 > gm) { gm = g1; grp = 1; } if (g2 > gm) { gm = g2; grp = 2; } if (g3 > gm) { gm = g3; grp = 3; }
                    const float psel = 1.f / (expf(g0 - gm) + expf(g1 - gm) + expf(g2 - gm) + expf(g3 - gm));
                    float ev[8];
#pragma unroll
                    for (int i = 0; i < 8; ++i) ev[i] = __shfl(lg[r], 4 + grp * 8 + i);
                    int i0 = 0; float v0 = ev[0];
#pragma unroll
                    for (int i = 1; i < 8; ++i) if (ev[i] > v0) { v0 = ev[i]; i0 = i; }
                    int i1 = -1; float v1 = 0.f;
#pragma unroll
                    for (int i = 0; i < 8; ++i) if (i != i0 && (i1 < 0 || ev[i] > v1)) { v1 = ev[i]; i1 = i; }
                    const float ga = 1.f / (1.f + expf(v1 - v0)), gb = 1.f - ga;
                    if (F.lane == 0) { const int rl = F.wave * 16 + g4 * 4 + r; sel_e[rl * 2] = grp * 8 + i0; sel_e[rl * 2 + 1] = grp * 8 + i1; sel_g[rl * 2] = ga * psel; sel_g[rl * 2 + 1] = gb * psel; }
                }
            }
            __syncthreads();
            int my_e = 0, my_rk = 0;
            if (F.tid < 256) { my_e = sel_e[F.tid]; my_rk = atomicAdd((int*)(lhist + my_e), 1); }
            __syncthreads();
            if (F.tid < 32) { const int n = lhist[F.tid]; lbase[F.tid] = n ? (int)__hip_atomic_fetch_add(ecnt + 64 * F.tid, (unsigned)n, RLX_AGENT) : 0; }
            __syncthreads();
            if (F.tid < 256) { const int pos = lbase[my_e] + my_rk; LSLOT[(size_t)my_e * LCAP + pos] = (chunk * 128 + (F.tid >> 1)) * 2 + (F.tid & 1); LGATE[(size_t)my_e * LCAP + pos] = sel_g[F.tid]; }
            __syncthreads();
        }
        (void)lrk;
    }
    SEAM(4);
    if (IN(5) || IN(6) || IN(7)) {
        if (F.tid < 32) lcnt[F.tid] = (int)__hip_atomic_load(ecnt + 64 * F.tid, RLX_AGENT);
        __syncthreads();
        if (F.tid == 0) { int acc = 0; for (int e = 0; e < 32; ++e) { tstart[e] = acc; acc += (lcnt[e] + 255) >> 8; } tstart[32] = acc; }
        __syncthreads();
    }
    const int NTILES = (IN(5) || IN(6) || IN(7)) ? __builtin_amdgcn_readfirstlane(tstart[32]) : 0;
    if (IN(5)) REPS(5) {
        for (int d = gw; d < NTILES * 256; d += NGW) { const int tile = d >> 8; int e = 0;
            for (int k = 1; k < 32; ++k) e += (__builtin_amdgcn_readfirstlane(tstart[k]) <= tile) ? 1 : 0;
            const int rank = d - __builtin_amdgcn_readfirstlane(tstart[e]) * 256; const int n = __builtin_amdgcn_readfirstlane(lcnt[e]);
            GAS v4u* dst = (GAS v4u*)(XS + (size_t)d * DM) + F.lane;
            if (rank < n) { const int tok = LSLOT[(size_t)e * LCAP + rank] >> 1; const GAS v4u* src = (const GAS v4u*)(A1 + (size_t)tok * DM) + F.lane;
#pragma unroll
                for (int j = 0; j < 4; ++j) dst[64 * j] = src[64 * j]; }
            else {
#pragma unroll
                for (int j = 0; j < 4; ++j) dst[64 * j] = (v4u){0u, 0u, 0u, 0u}; } }
    }
    SEAM(5);
    if (IN(6)) REPS(6) {
        pg8::Gemm g{XS, WGU, NTILES * 256, 1024, DM}; pg8::MoeOrder S; S.init(NTILES, 4, F.G, (int)blockIdx.x, tstart, lcnt);
        pg8::EpiSwiglu E{HB};
        pg8::gemm_phase<pg8::EpiSwiglu, pg8::MoeOrder, true, true>(F.lds + RING_OFF, g, S, E);
    }
    SEAM(6);
    if (IN(7)) REPS(7) {
        pg8::Gemm g{HB, WD, NTILES * 256, DM, DEXP}; pg8::MoeOrder S; S.init(NTILES, 8, F.G, (int)blockIdx.x, tstart, lcnt);
        pg8::EpiScatter E{YB, LSLOT, LGATE};
        pg8::gemm_phase<pg8::EpiScatter, pg8::MoeOrder, true, true>(F.lds + RING_OFF, g, S, E);
    }
    SEAM(7);
    if (IN(8)) {
        for (int m = gw; m < NTOK; m += NGW) {
            const GAS v4u* hr = (const GAS v4u*)(H1B + (size_t)m * DM) + F.lane; const GAS v4u* y0 = (const GAS v4u*)(YB + (size_t)(2 * m) * DM) + F.lane; const GAS v4u* y1 = (const GAS v4u*)(YB + (size_t)(2 * m + 1) * DM) + F.lane;
            float v[4][8]; float s = 0.f;
#pragma unroll
            for (int j = 0; j < 4; ++j) { float a[8], b[8]; unpack8(hr[64 * j], v[j]); unpack8(y0[64 * j], a); unpack8(y1[64 * j], b);
#pragma unroll
                for (int i = 0; i < 8; ++i) { v[j][i] += a[i] + b[i]; s += v[j][i] * v[j][i]; } }
            const float rstd = rsqrtf(wave_sum(s) * (1.f / DM) + EPS);
            GAS v4u* o8 = (GAS v4u*)(A1 + (size_t)m * DM) + F.lane;
#pragma unroll
            for (int j = 0; j < 4; ++j) { const f32x4 g0 = *((const GAS f32x4*)g_ple + 2 * F.lane + 128 * j), g1 = *((const GAS f32x4*)g_ple + 2 * F.lane + 128 * j + 1);
                v4u w; w.x = pk2(v[j][0] * rstd * g0.x, v[j][1] * rstd * g0.y); w.y = pk2(v[j][2] * rstd * g0.z, v[j][3] * rstd * g0.w); w.z = pk2(v[j][4] * rstd * g1.x, v[j][5] * rstd * g1.y); w.w = pk2(v[j][6] * rstd * g1.z, v[j][7] * rstd * g1.w);
                o8[64 * j] = w; }
        }
    }
    SEAM(8);
    if (IN(9)) {
        pg8::Gemm g{A1, WPG, NTOK, DM, DM}; pg8::StaticOrder S; S.init(NTOK, DM, F.G, (int)blockIdx.x);
        pg8::EpiPle2 E{H1B, YB, UB};
        pg8::gemm_phase<pg8::EpiPle2, pg8::StaticOrder, true, true>(F.lds + RING_OFF, g, S, E);
    }
    SEAM(9);
    if (IN(10)) {
        for (int m = gw; m < NTOK; m += NGW) {
            const GAS v4u* hr = (const GAS v4u*)(H1B + (size_t)m * DM) + F.lane; float v[4][8]; float s = 0.f;
#pragma unroll
            for (int j = 0; j < 4; ++j) { unpack8(hr[64 * j], v[j]);
#pragma unroll
                for (int i = 0; i < 8; ++i) s += v[j][i] * v[j][i]; }
            const float rstd = rsqrtf(wave_sum(s) * (1.f / DM) + EPS);
            GAS f32x4* orow = (GAS f32x4*)(out + (size_t)m * DM) + 2 * F.lane;
#pragma unroll
            for (int j = 0; j < 4; ++j) { const f32x4 g0 = *((const GAS f32x4*)g_final + 2 * F.lane + 128 * j), g1 = *((const GAS f32x4*)g_final + 2 * F.lane + 128 * j + 1);
                orow[128 * j] = (f32x4){v[j][0] * rstd * g0.x, v[j][1] * rstd * g0.y, v[j][2] * rstd * g0.z, v[j][3] * rstd * g0.w};
                orow[128 * j + 1] = (f32x4){v[j][4] * rstd * g1.x, v[j][5] * rstd * g1.y, v[j][6] * rstd * g1.z, v[j][7] * rstd * g1.w}; }
        }
    }
#undef IN
#undef SEAM
}

#ifndef MK_SPLIT
#define MK_SPLIT 0
#endif
extern "C" void kernel_launch(void* const* d_in, const int* in_sizes, int n_in, void* d_out, int out_size, void* d_ws, size_t ws_size, hipStream_t stream) {
    static int grid = 0;
    if (grid == 0) {
        if (n_in != 21 || in_sizes[0] != NTOK * DM || out_size != NTOK * DM || ws_size < WS_END) { fprintf(stderr, "kernel_launch: shape mismatch (n_in %d in0 %d out %d ws %zu)\n", n_in, n_in > 0 ? in_sizes[0] : -1, out_size, ws_size); grid = -1; return; }
        int dev = 0, cus = 0, per_cu = 0;
        if (hipGetDevice(&dev) != hipSuccess || hipDeviceGetAttribute(&cus, hipDeviceAttributeMultiprocessorCount, dev) != hipSuccess) { grid = -1; return; }
        if (hipFuncSetAttribute((const void*)mega_fwd, hipFuncAttributeMaxDynamicSharedMemorySize, LDS_BYTES) != hipSuccess) { fprintf(stderr, "kernel_launch: hipFuncSetAttribute failed\n"); grid = -1; return; }
        if (hipOccupancyMaxActiveBlocksPerMultiprocessor(&per_cu, (const void*)mega_fwd, NWAVES * 64, LDS_BYTES) != hipSuccess || per_cu < 1) fprintf(stderr, "kernel_launch: occupancy query reports %d\n", per_cu);
        (void)hipGetLastError();
        grid = cus;
    }
    if (grid < 0) return;
    if (hipMemsetAsync((char*)d_ws + WS_CTL, 0, CTL_ZERO_BYTES, stream) != hipSuccess) return;
    Args a{};
    for (int i = 0; i < 21; ++i) a.in[i] = (const float*)d_in[i];
    a.out = (float*)d_out; a.ws = (unsigned char*)d_ws;
#if MK_SPLIT
    for (int ph = 0; ph < 11; ++ph) { a.ph_lo = ph; a.ph_hi = ph + 1; hipLaunchKernelGGL(mega_fwd, dim3(grid), dim3(NWAVES * 64), LDS_BYTES, stream, a); }
#else
    a.ph_lo = 0; a.ph_hi = 11;
    hipLaunchKernelGGL(mega_fwd, dim3(grid), dim3(NWAVES * 64), LDS_BYTES, stream, a);
#endif
    const hipError_t le = hipPeekAtLastError();
    if (le != hipSuccess) fprintf(stderr, "kernel_launch: launch failed: %s\n", hipGetErrorName(le));
}
```

```cpp
#include <hip/hip_runtime.h>
#include <hip/hip_bf16.h>
#include <cstdio>
#include <cstdint>
namespace pg8 {
#define PG8_LAS __attribute__((address_space(3)))
typedef unsigned short bf16_t;
typedef short bf16x8 __attribute__((ext_vector_type(8)));
typedef float f32x4 __attribute__((ext_vector_type(4)));
typedef unsigned u32x4 __attribute__((ext_vector_type(4)));
constexpr int BM = 256, BK = 64, HALF = 128, HTB = HALF * BK * 2  , STAGE_BYTES = 8 * HTB, NXCD = 8, WGM = 8;

__host__ __device__ __forceinline__ int lds_byte(int r, int c) { const int st = (r >> 4) * 2 + (c >> 5), rr = r & 15, cc = c & 31, ob = rr * 64 + cc * 2; return st * 1024 + (ob ^ (((ob >> 9) & 1) << 5)); }
__host__ __device__ __forceinline__ void stage_rc(int b, int& R, int& C) { const int st = b / 1024, sb = b % 1024, swz = sb ^ (((sb >> 9) & 1) << 5); R = (st >> 1) * 16 + swz / 64; C = (st & 1) * 32 + (swz % 64) / 2; }
__host__ __device__ __forceinline__ int perm32(int rho) { const int n = rho >> 4, i = rho & 15; return 8 * (i >> 2) + 4 * n + (i & 3); }

struct Unit { int pm, pn, pb, aux0, aux1; };
struct Gemm { const bf16_t* A; const bf16_t* Bt; int M, N, K; const int* glist; };

struct StaticOrder {
    int nM, nN, nwg, G, c;
    __host__ __device__ void init(int M, int N, int G_, int c_) { nM = M / BM; nN = N / BM; nwg = nM * nN; G = G_; c = c_; }
    __host__ __device__ bool next(int i, Unit& u) const {
        const long L = (long)i * G + c; if (L >= nwg) return false;
        int wgid = (int)L; { const int q = nwg / NXCD, r = nwg % NXCD, xcd = wgid % NXCD, off = wgid / NXCD; wgid = (xcd < r ? xcd * (q + 1) : r * (q + 1) + (xcd - r) * q) + off; }
        const int nig = WGM * nN, gid = wgid / nig, fm = gid * WGM, gsz = (nM - fm) < WGM ? (nM - fm) : WGM;
        u.pm = fm + ((wgid % nig) % gsz); u.pn = (wgid % nig) / gsz; u.pb = u.pn; u.aux0 = 0; u.aux1 = 0; return true;
    }
    __device__ __forceinline__ void a_ready(const Unit&) const {}
    __device__ __forceinline__ void done(const Unit&) const {}
};

__device__ __forceinline__ unsigned cvt_pk_bf16(float lo, float hi) { unsigned r; asm volatile("v_cvt_pk_bf16_f32 %0, %1, %2" : "=v"(r) : "v"(lo), "v"(hi)); return r; }
typedef float f32x2 __attribute__((ext_vector_type(2)));
#define PG8_FRESH_LANE(fr, fq) int l__; asm volatile("v_mbcnt_lo_u32_b32 %0, -1, 0\n\tv_mbcnt_hi_u32_b32 %0, -1, %0" : "=v"(l__)); const int fr = l__ & 15, fq = l__ >> 4; (void)fr_; (void)fq_
typedef unsigned u32x2 __attribute__((ext_vector_type(2)));
__device__ __forceinline__ float bf_lo(unsigned w) { return __uint_as_float(w << 16); }
__device__ __forceinline__ float bf_hi(unsigned w) { return __uint_as_float(w & 0xffff0000u); }

struct EpiQKV {
    static constexpr bool PERM = true, AFTER_DRAIN = false;
    bf16_t* O; const float* rope;
    __device__ __forceinline__ void operator()(const f32x4 (&acc)[2][2][4][2], const Unit& u, int wr, int wc, int fr_, int fq_) const {
        PG8_FRESH_LANE(fr, fq);
        const int row0 = u.pm * BM + wr * 64 + fr, col0 = u.pn * BM + wc * 32 + 8 * fq;
        const bool rot = (u.pn >= 12) && (u.pn < 20) && ((wc & 1) == 0);
#pragma unroll
        for (int ai = 0; ai < 2; ++ai)
#pragma unroll
            for (int m = 0; m < 4; ++m) { const int row = row0 + ai * HALF + m * 16; bf16_t* rowp = O + (size_t)row * 6144 + col0;
                f32x4 c0 = {1.f, 1.f, 1.f, 1.f}, c1 = c0, s0 = {0.f, 0.f, 0.f, 0.f}, s1 = s0;
                if (rot) { const float* t = rope + (size_t)(row & 8191) * 16; c0 = *(const f32x4*)(t); c1 = *(const f32x4*)(t + 4); s0 = *(const f32x4*)(t + 8); s1 = *(const f32x4*)(t + 12);
                    if (fq == 0) { s0 = -s0; s1 = -s1; } else if (fq != 1) { s0 = (f32x4){0.f, 0.f, 0.f, 0.f}; s1 = s0; c0 = (f32x4){1.f, 1.f, 1.f, 1.f}; c1 = c0; } }
#pragma unroll
                for (int bj = 0; bj < 2; ++bj) { f32x4 v0 = acc[ai][bj][m][0], v1 = acc[ai][bj][m][1];
                    if (rot) { f32x4 p0, p1;
#pragma unroll
                        for (int j = 0; j < 4; ++j) { p0[j] = __shfl_xor(v0[j], 16); p1[j] = __shfl_xor(v1[j], 16); }
                        v0 = v0 * c0 + p0 * s0; v1 = v1 * c1 + p1 * s1; }
                    u32x4 w; w.x = cvt_pk_bf16(v0[0], v0[1]); w.y = cvt_pk_bf16(v0[2], v0[3]); w.z = cvt_pk_bf16(v1[0], v1[1]); w.w = cvt_pk_bf16(v1[2], v1[3]);
                    *(u32x4*)(rowp + bj * HALF) = w; } }
    }
};
struct EpiBf16 {
    static constexpr bool PERM = true, AFTER_DRAIN = false;
    bf16_t* O; int ldc;
    __device__ __forceinline__ void operator()(const f32x4 (&acc)[2][2][4][2], const Unit& u, int wr, int wc, int fr_, int fq_) const {
        PG8_FRESH_LANE(fr, fq);
        const int row0 = u.pm * BM + wr * 64 + fr, col0 = u.pn * BM + wc * 32 + 8 * fq;
#pragma unroll
        for (int ai = 0; ai < 2; ++ai)
#pragma unroll
            for (int m = 0; m < 4; ++m) { bf16_t* rowp = O + (size_t)(row0 + ai * HALF + m * 16) * ldc + col0;
#pragma unroll
                for (int bj = 0; bj < 2; ++bj) { const f32x4 v0 = acc[ai][bj][m][0], v1 = acc[ai][bj][m][1];
                    u32x4 w; w.x = cvt_pk_bf16(v0[0], v0[1]); w.y = cvt_pk_bf16(v0[2], v0[3]); w.z = cvt_pk_bf16(v1[0], v1[1]); w.w = cvt_pk_bf16(v1[2], v1[3]);
                    *(u32x4*)(rowp + bj * HALF) = w; } }
    }
};
struct EpiResF32 {
    static constexpr bool PERM = false, AFTER_DRAIN = false;
    const float* base; float* out; int ldc;
    __device__ __forceinline__ void operator()(const f32x4 (&acc)[2][2][4][2], const Unit& u, int wr, int wc, int fr_, int fq_) const {
        PG8_FRESH_LANE(fr, fq);
        const int row0 = u.pm * BM + wr * 64 + fr, col0 = u.pn * BM + wc * 32 + 4 * fq;
#pragma unroll
        for (int ai = 0; ai < 2; ++ai)
#pragma unroll
            for (int m = 0; m < 4; ++m) { const size_t off = (size_t)(row0 + ai * HALF + m * 16) * ldc + col0;
#pragma unroll
                for (int bj = 0; bj < 2; ++bj)
#pragma unroll
                    for (int n = 0; n < 2; ++n) { const f32x4 b = *(const f32x4*)(base + off + bj * HALF + n * 16); *(f32x4*)(out + off + bj * HALF + n * 16) = b + acc[ai][bj][m][n]; }
                asm volatile("" ::: "memory"); }
    }
};
struct EpiPle {
    static constexpr bool PERM = false, AFTER_DRAIN = false;
    float* io; const bf16_t* U; int ldc;
    __device__ __forceinline__ void operator()(const f32x4 (&acc)[2][2][4][2], const Unit& u, int wr, int wc, int fr_, int fq_) const {
        PG8_FRESH_LANE(fr, fq);
        const int row0 = u.pm * BM + wr * 64 + fr, col0 = u.pn * BM + wc * 32 + 4 * fq;
#pragma unroll
        for (int ai = 0; ai < 2; ++ai)
#pragma unroll
            for (int m = 0; m < 4; ++m) { const size_t off = (size_t)(row0 + ai * HALF + m * 16) * ldc + col0;
#pragma unroll
                for (int bj = 0; bj < 2; ++bj)
#pragma unroll
                    for (int n = 0; n < 2; ++n) { const size_t o = off + bj * HALF + n * 16; const f32x4 b = *(const f32x4*)(io + o); const u32x2 uw = *(const u32x2*)(U + o); const f32x4 a = acc[ai][bj][m][n];
                        f32x4 r; r[0] = b[0] + bf_lo(uw.x) * __builtin_amdgcn_rcpf(1.f + __builtin_amdgcn_exp2f(-1.4426950408889634f * a[0]));
                        r[1] = b[1] + bf_hi(uw.x) * __builtin_amdgcn_rcpf(1.f + __builtin_amdgcn_exp2f(-1.4426950408889634f * a[1]));
                        r[2] = b[2] + bf_lo(uw.y) * __builtin_amdgcn_rcpf(1.f + __builtin_amdgcn_exp2f(-1.4426950408889634f * a[2]));
                        r[3] = b[3] + bf_hi(uw.y) * __builtin_amdgcn_rcpf(1.f + __builtin_amdgcn_exp2f(-1.4426950408889634f * a[3]));
                        *(f32x4*)(io + o) = r; }
                asm volatile("" ::: "memory"); }
    }
};
struct EpiResBf16 {
    static constexpr bool PERM = true, AFTER_DRAIN = false;
    const float* base; bf16_t* O;
    __device__ __forceinline__ void operator()(const f32x4 (&acc)[2][2][4][2], const Unit& u, int wr, int wc, int fr_, int fq_) const {
        PG8_FRESH_LANE(fr, fq);
        const int row0 = u.pm * BM + wr * 64 + fr, col0 = u.pn * BM + wc * 32 + 8 * fq;
#pragma unroll
        for (int ai = 0; ai < 2; ++ai)
#pragma unroll
            for (int m = 0; m < 4; ++m) { const size_t off = (size_t)(row0 + ai * HALF + m * 16) * 2048 + col0;
#pragma unroll
                for (int bj = 0; bj < 2; ++bj) { const f32x4 b0 = *(const f32x4*)(base + off + bj * HALF), b1 = *(const f32x4*)(base + off + bj * HALF + 4);
                    const f32x4 v0 = acc[ai][bj][m][0] + b0, v1 = acc[ai][bj][m][1] + b1;
                    u32x4 w; w.x = cvt_pk_bf16(v0[0], v0[1]); w.y = cvt_pk_bf16(v0[2], v0[3]); w.z = cvt_pk_bf16(v1[0], v1[1]); w.w = cvt_pk_bf16(v1[2], v1[3]);
                    *(u32x4*)(O + off + bj * HALF) = w; }
                asm volatile("" ::: "memory"); }
    }
};
struct EpiPle2 {
    static constexpr bool PERM = true, AFTER_DRAIN = false;
    bf16_t* Hs; const bf16_t* Y; const bf16_t* U;
    __device__ __forceinline__ void operator()(const f32x4 (&acc)[2][2][4][2], const Unit& u, int wr, int wc, int fr_, int fq_) const {
        PG8_FRESH_LANE(fr, fq);
        const int row0 = u.pm * BM + wr * 64 + fr, col0 = u.pn * BM + wc * 32 + 8 * fq;
#pragma unroll
        for (int ai = 0; ai < 2; ++ai)
#pragma unroll
            for (int m = 0; m < 4; ++m) { const size_t row = (size_t)(row0 + ai * HALF + m * 16); const size_t off = row * 2048 + col0;
#pragma unroll
                for (int bj = 0; bj < 2; ++bj) { const size_t o = off + bj * HALF;
                    const u32x4 hw = *(const u32x4*)(Hs + o), uw = *(const u32x4*)(U + o), ya = *(const u32x4*)(Y + 2 * row * 2048 + col0 + bj * HALF), yb = *(const u32x4*)(Y + (2 * row + 1) * 2048 + col0 + bj * HALF);
                    float r[8];
#pragma unroll
                    for (int q = 0; q < 4; ++q) { const float a0 = acc[ai][bj][m][q >> 1][(q & 1) * 2], a1 = acc[ai][bj][m][q >> 1][(q & 1) * 2 + 1];
                        const float s0 = __builtin_amdgcn_rcpf(1.f + __builtin_amdgcn_exp2f(-1.4426950408889634f * a0)), s1 = __builtin_amdgcn_rcpf(1.f + __builtin_amdgcn_exp2f(-1.4426950408889634f * a1));
                        r[2 * q] = (bf_lo(hw[q]) + (bf_lo(ya[q]) + bf_lo(yb[q]))) + bf_lo(uw[q]) * s0; r[2 * q + 1] = (bf_hi(hw[q]) + (bf_hi(ya[q]) + bf_hi(yb[q]))) + bf_hi(uw[q]) * s1; }
                    u32x4 w; w.x = cvt_pk_bf16(r[0], r[1]); w.y = cvt_pk_bf16(r[2], r[3]); w.z = cvt_pk_bf16(r[4], r[5]); w.w = cvt_pk_bf16(r[6], r[7]);
                    *(u32x4*)(Hs + o) = w; }
                asm volatile("" ::: "memory"); }
    }
};
struct EpiSwiglu {
    static constexpr bool PERM = true, AFTER_DRAIN = false;
    bf16_t* H;
    __device__ __forceinline__ void operator()(const f32x4 (&acc)[2][2][4][2], const Unit& u, int wr, int wc, int fr_, int fq_) const {
        PG8_FRESH_LANE(fr, fq);
        const int row0 = u.pm * BM + wr * 64 + fr, col0 = u.pn * HALF + wc * 32 + 8 * fq;
#pragma unroll
        for (int ai = 0; ai < 2; ++ai)
#pragma unroll
            for (int m = 0; m < 4; ++m) { bf16_t* rowp = H + (size_t)(row0 + ai * HALF + m * 16) * 512 + col0; float h[8];
#pragma unroll
                for (int n = 0; n < 2; ++n)
#pragma unroll
                    for (int j = 0; j < 4; ++j) { const float g = acc[ai][0][m][n][j], up = acc[ai][1][m][n][j];
                        h[n * 4 + j] = g * up * __builtin_amdgcn_rcpf(1.f + __builtin_amdgcn_exp2f(-1.4426950408889634f * g)); }
                u32x4 w; w.x = cvt_pk_bf16(h[0], h[1]); w.y = cvt_pk_bf16(h[2], h[3]); w.z = cvt_pk_bf16(h[4], h[5]); w.w = cvt_pk_bf16(h[6], h[7]);
                *(u32x4*)rowp = w; asm volatile("" ::: "memory"); }
    }
};
struct EpiScatter {
    static constexpr bool PERM = true, AFTER_DRAIN = false;
    bf16_t* Y; const int* lslot; const float* lgate;
    __device__ __forceinline__ void operator()(const f32x4 (&acc)[2][2][4][2], const Unit& u, int wr, int wc, int fr_, int fq_) const {
        PG8_FRESH_LANE(fr, fq);
        const int r0 = wr * 64 + fr, col0 = u.pn * BM + wc * 32 + 8 * fq;
#pragma unroll
        for (int ai = 0; ai < 2; ++ai)
#pragma unroll
            for (int m = 0; m < 4; ++m) { const int r = r0 + ai * HALF + m * 16;
                if (r < u.aux1) { const int slot = lslot[u.aux0 + r]; const float g = lgate[u.aux0 + r]; bf16_t* rowp = Y + (size_t)slot * 2048 + col0;
#pragma unroll
                    for (int bj = 0; bj < 2; ++bj) { const f32x4 v0 = acc[ai][bj][m][0] * g, v1 = acc[ai][bj][m][1] * g;
                        u32x4 w; w.x = cvt_pk_bf16(v0[0], v0[1]); w.y = cvt_pk_bf16(v0[2], v0[3]); w.z = cvt_pk_bf16(v1[0], v1[1]); w.w = cvt_pk_bf16(v1[2], v1[3]);
                        *(u32x4*)(rowp + bj * HALF) = w; } }
                asm volatile("" ::: "memory"); }
    }
};
struct MoeOrder {
    int nM, nN, nwg, G, c; const PG8_LAS int* tstart; const PG8_LAS int* cnt;
    __device__ void init(int nM_, int nN_, int G_, int c_, const PG8_LAS int* ts, const PG8_LAS int* cn) { nM = nM_; nN = nN_; nwg = nM * nN; G = G_; c = c_; tstart = ts; cnt = cn; }
    __device__ bool next(int i, Unit& u) const {
        const long L = (long)i * G + c; if (L >= nwg) return false;
        int wgid = (int)L; { const int q = nwg / NXCD, r = nwg % NXCD, xcd = wgid % NXCD, off = wgid / NXCD; wgid = (xcd < r ? xcd * (q + 1) : r * (q + 1) + (xcd - r) * q) + off; }
        const int nig = WGM * nN, gid = wgid / nig, fm = gid * WGM, gsz = (nM - fm) < WGM ? (nM - fm) : WGM;
        const int pm = fm + ((wgid % nig) % gsz), pn = (wgid % nig) / gsz;
        int e = 0;
        for (int k = 1; k < 32; ++k) e += (__builtin_amdgcn_readfirstlane(tstart[k]) <= pm) ? 1 : 0;
        const int t = pm - __builtin_amdgcn_readfirstlane(tstart[e]); const int left = __builtin_amdgcn_readfirstlane(cnt[e]) - t * 256;
        u.pm = pm; u.pn = pn; u.pb = e * nN + pn; u.aux0 = e * 65536 + t * 256; u.aux1 = left < 256 ? left : 256; return true;
    }
    __device__ __forceinline__ void a_ready(const Unit&) const {}
    __device__ __forceinline__ void done(const Unit&) const {}
};
template <class Epi, class Sched, bool ALIGN_EPI = false, bool SP2 = false, bool GATHER = false>
__device__ __forceinline__ void gemm_phase(PG8_LAS unsigned char* lds, const Gemm g, const Sched& S, const Epi& E) {
    const int tid = threadIdx.x, wid = __builtin_amdgcn_readfirstlane(tid >> 6), lane = tid & 63, wr = wid >> 2, wc = wid & 3, fr = lane & 15, fq = lane >> 4;
    const int K = g.K, nt = K / BK;
    unsigned voffA[2], voffB[2];
#pragma unroll
    for (int i = 0; i < 2; ++i) { int R, C; stage_rc(tid * 16 + i * 8192, R, C); const int Rb = Epi::PERM ? ((R & ~31) + perm32(R & 31)) : R;
        voffA[i] = (unsigned)(R * K + C) * 2u; voffB[i] = (unsigned)(Rb * K + C) * 2u; }
    const size_t kstep = (size_t)(BK * 2);
    const size_t hstep = (size_t)HALF * K * 2;
    const size_t tstep = 2 * hstep;
    const unsigned ldsw = (unsigned)wid * 1024u;
    const int aoff = lds_byte(wr * 64 + fr, fq * 8), boff = lds_byte(wc * 32 + fr, fq * 8);
#define PG8_SA(b, h) (((b) * 2 + (h)) * HTB)
#define PG8_SB(b, h) ((4 + (b) * 2 + (h)) * HTB)
#define PG8_STAGE(bufoff, gbase, voff) do { _Pragma("unroll") for (int _i = 0; _i < 2; ++_i) \
        __builtin_amdgcn_global_load_lds((const unsigned*)((const char*)(gbase) + (voff)[_i]), (PG8_LAS unsigned*)(lds + (bufoff) + ldsw + _i * 8192), 16, 0, 0); } while (0)
#define PG8_STAGE_A(bufoff, nextsel, half, kb) do { _Pragma("unroll") for (int _i = 0; _i < 2; ++_i) { const char* _p; \
        if constexpr (GATHER) _p = (const char*)g.A + (kb) + ((nextsel) ? nx[half][_i] : cu[half][_i]); else _p = ((nextsel) ? nA : cA) + (kb) + (size_t)(half) * hstep + voffA[_i]; \
        __builtin_amdgcn_global_load_lds((const unsigned*)_p, (PG8_LAS unsigned*)(lds + (bufoff) + ldsw + _i * 8192), 16, 0, 0); } } while (0)
#define PG8_ROWS(u, o) do { _Pragma("unroll") for (int _h = 0; _h < 2; ++_h) _Pragma("unroll") for (int _i = 0; _i < 2; ++_i) { const int _r = _h * HALF + (int)(voffA[_i] / (2u * (unsigned)K)); \
        const int _t = (_r < (u).aux1) ? (g.glist[(u).aux0 + _r] >> 1) : 0; o[_h][_i] = (unsigned)_t * (2u * (unsigned)K) + (voffA[_i] % (2u * (unsigned)K)); } } while (0)
#define PG8_LDA(dst, b, h) do { _Pragma("unroll") for (int m = 0; m < 4; ++m) _Pragma("unroll") for (int k = 0; k < 2; ++k) dst[m][k] = *(const PG8_LAS bf16x8*)(lds + PG8_SA(b, h) + aoff + m * 2048 + k * 1024); } while (0)
#define PG8_LDB(dst, b, h) do { _Pragma("unroll") for (int n = 0; n < 2; ++n) _Pragma("unroll") for (int k = 0; k < 2; ++k) dst[n][k] = *(const PG8_LAS bf16x8*)(lds + PG8_SB(b, h) + boff + n * 2048 + k * 1024); } while (0)
#define PG8_MMA(ai, bj, At, Bt) do { __builtin_amdgcn_s_setprio(1); _Pragma("unroll") for (int m = 0; m < 4; ++m) _Pragma("unroll") for (int n = 0; n < 2; ++n) _Pragma("unroll") for (int k = 0; k < 2; ++k) \
        acc[ai][bj][m][n] = __builtin_amdgcn_mfma_f32_16x16x32_bf16(Bt[n][k], At[m][k], acc[ai][bj][m][n], 0, 0, 0); __builtin_amdgcn_s_setprio(0); } while (0)
#define PG8_WAIT_V(n) asm volatile("s_waitcnt vmcnt(" #n ")" ::: "memory")
#define PG8_WAIT_L(n) asm volatile("s_waitcnt lgkmcnt(" #n ")" ::: "memory")
#define PG8_BAR __builtin_amdgcn_s_barrier()
#define PG8_SCHED __builtin_amdgcn_sched_barrier(0)
    Unit cur, nxt; int ui = 0;
    if (!S.next(0, cur)) return;
    f32x4 acc[2][2][4][2];
#pragma unroll
    for (int a = 0; a < 2; ++a)
#pragma unroll
        for (int b = 0; b < 2; ++b)
#pragma unroll
            for (int m = 0; m < 4; ++m)
#pragma unroll
                for (int n = 0; n < 2; ++n) acc[a][b][m][n] = (f32x4){0.f, 0.f, 0.f, 0.f};
    bf16x8 At[4][2], B0[2][2], B1[2][2];
    const char* cA = (const char*)g.A + (size_t)cur.pm * tstep; const char* cB = (const char*)g.Bt + (size_t)cur.pb * tstep;
    S.a_ready(cur);
    unsigned cu[2][2] = {{0u, 0u}, {0u, 0u}}, nx[2][2] = {{0u, 0u}, {0u, 0u}}; const char* nA = cA;
    if constexpr (GATHER) PG8_ROWS(cur, cu);
    if constexpr (SP2) {
        PG8_STAGE(PG8_SB(0, 0), cB, voffB); PG8_STAGE(PG8_SB(0, 1), cB + hstep, voffB); PG8_STAGE_A(PG8_SA(0, 0), false, 0, 0); PG8_STAGE_A(PG8_SA(0, 1), false, 1, 0);
        if (wr == 1) PG8_BAR;
        PG8_WAIT_V(2); PG8_BAR;
        PG8_STAGE(PG8_SB(1, 0), cB + kstep, voffB); PG8_STAGE_A(PG8_SA(1, 0), false, 0, kstep); PG8_STAGE(PG8_SB(1, 1), cB + hstep + kstep, voffB);
        PG8_WAIT_V(6); PG8_BAR;
    } else { static_assert(SP2, "only the SP2 loop is kept in this file"); }
    for (;;) {
        const bool has_next = S.next(ui + 1, nxt);
        nA = has_next ? (const char*)g.A + (size_t)nxt.pm * tstep : cA;
        if constexpr (GATHER) { if (has_next) PG8_ROWS(nxt, nx); else { nx[0][0] = cu[0][0]; nx[0][1] = cu[0][1]; nx[1][0] = cu[1][0]; nx[1][1] = cu[1][1]; } }
        const char* nB = has_next ? (const char*)g.Bt + (size_t)nxt.pb * tstep : cB;
#pragma unroll 1
        for (int t = 0; t < nt; t += 2) {
            const bool last = (t == nt - 2);
            const size_t kb1 = (size_t)(t + 1) * kstep;
            const size_t kb2 = last ? 0 : (size_t)(t + 2) * kstep; const char* b2 = last ? nB : cB + (size_t)(t + 2) * kstep;
            const size_t kb3 = kb2 + kstep; const char* b3 = b2 + kstep;
            if (last && has_next) S.a_ready(nxt);
            if constexpr (SP2) {
            PG8_LDB(B0, 0, 0); PG8_LDB(B1, 0, 1); PG8_SCHED; PG8_LDA(At, 0, 0); PG8_STAGE_A(PG8_SA(1, 1), false, 1, kb1);
            PG8_WAIT_V(8); PG8_WAIT_L(0); PG8_BAR; PG8_MMA(0, 0, At, B0); PG8_MMA(0, 1, At, B1); PG8_BAR; PG8_SCHED;
            PG8_LDA(At, 0, 1); PG8_STAGE(PG8_SB(0, 0), b2, voffB); PG8_STAGE(PG8_SB(0, 1), b2 + hstep, voffB); PG8_STAGE_A(PG8_SA(0, 0), last, 0, kb2);
            PG8_WAIT_V(8); PG8_WAIT_L(0); PG8_BAR; PG8_MMA(1, 0, At, B0); PG8_MMA(1, 1, At, B1); PG8_BAR; PG8_SCHED;
            PG8_LDB(B0, 1, 0); PG8_LDB(B1, 1, 1); PG8_SCHED; PG8_LDA(At, 1, 0); PG8_STAGE_A(PG8_SA(0, 1), last, 1, kb2);
            PG8_WAIT_V(8); PG8_WAIT_L(0); PG8_BAR; PG8_MMA(0, 0, At, B0); PG8_MMA(0, 1, At, B1); PG8_BAR; PG8_SCHED;
            PG8_LDA(At, 1, 1); PG8_STAGE(PG8_SB(1, 0), b3, voffB); PG8_STAGE(PG8_SB(1, 1), b3 + hstep, voffB); PG8_STAGE_A(PG8_SA(1, 0), last, 0, kb3);
            PG8_WAIT_V(8); PG8_WAIT_L(0); PG8_BAR; PG8_MMA(1, 0, At, B0); PG8_MMA(1, 1, At, B1); PG8_BAR; PG8_SCHED;
            }
        }
        if constexpr (ALIGN_EPI) { if (wr == 0) PG8_BAR; }
        if constexpr (!Epi::AFTER_DRAIN) { E(acc, cur, wr, wc, fr, fq); S.done(cur); }
        if (!has_next) break;
#pragma unroll
        for (int a = 0; a < 2; ++a)
#pragma unroll
            for (int b = 0; b < 2; ++b)
#pragma unroll
                for (int m = 0; m < 4; ++m)
#pragma unroll
                    for (int n = 0; n < 2; ++n) acc[a][b][m][n] = (f32x4){0.f, 0.f, 0.f, 0.f};
        cur = nxt; cA = nA; cB = nB; ++ui;
        if constexpr (GATHER) { cu[0][0] = nx[0][0]; cu[0][1] = nx[0][1]; cu[1][0] = nx[1][0]; cu[1][1] = nx[1][1]; }
        if constexpr (ALIGN_EPI) { if (wr == 1) PG8_BAR; }
    }
    PG8_WAIT_V(0);
    if constexpr (!ALIGN_EPI) { if (wr == 0) PG8_BAR; }
    PG8_BAR;
    if constexpr (Epi::AFTER_DRAIN) { E.fused(acc, cur, wr, wc, fr, fq, lds, wid, lane); S.done(cur); }
#undef PG8_SA
#undef PG8_SB
#undef PG8_STAGE
#undef PG8_STAGE_A
#undef PG8_ROWS
#undef PG8_LDA
#undef PG8_LDB
#undef PG8_MMA
#undef PG8_WAIT_V
#undef PG8_WAIT_L
#undef PG8_BAR
#undef PG8_SCHED
}
}
namespace att {
using bf16 = unsigned short;
using bf16x8 = __attribute__((ext_vector_type(8))) short;
using s16x4  = __attribute__((ext_vector_type(4))) short;
using f32x16 = __attribute__((ext_vector_type(16))) float;
using u32x4  = __attribute__((ext_vector_type(4))) unsigned;
constexpr int LDQKV = 6144;
constexpr int SEQ_ = 8192;
constexpr size_t SHM_V = 64 * 128 * 2, SHM_K = 64 * 128 * 2, SHM_ATTN = 2 * SHM_V + 2 * SHM_K + 8 * 64 * 4 + 64;
#define KSWZ(row, colB) ((row) * 256 + ((colB) ^ (((row) & 7) << 4)))
#define SBAR() __builtin_amdgcn_sched_barrier(0)
__device__ __forceinline__ int crow(int r, int hi) { return (r & 3) + 8 * (r >> 2) + 4 * hi; }
__device__ __forceinline__ unsigned cvtpk(float lo, float hi) { unsigned r; asm volatile("v_cvt_pk_bf16_f32 %0, %1, %2" : "=v"(r) : "v"(lo), "v"(hi)); return r; }
__device__ __forceinline__ int v_st(int k, int c) { const int kk = (k & ~0xC) | ((k & 4) << 1) | ((k & 8) >> 1); return ((kk >> 3) * 4 + (c >> 5)) * 512 + ((kk & 7) * 32 + (c & 31)) * 2; }
__device__ __forceinline__ int v_rd_base(int lane) { return ((lane & 3) << 3) | (((lane >> 2) & 3) << 6) | (((lane >> 4) & 1) << 5) | (((lane >> 5) & 1) << 8); }
constexpr int v_rd_off(int d0, int ks, int half) { return d0 * 512 + ks * 4096 + half * 2048; }
template <int OFF> __device__ __forceinline__ s16x4 tr_read(int vb) { s16x4 r; asm volatile("ds_read_b64_tr_b16 %0, %1 offset:%2" : "=&v"(r) : "v"(vb), "i"(OFF) : "memory"); return r; }
template <int D0> __device__ __forceinline__ void pv_one(f32x16& od, int vb, bf16x8 pa0, bf16x8 pa1, bf16x8 pa2, bf16x8 pa3) {
  const s16x4 l0 = tr_read<v_rd_off(D0, 0, 0)>(vb), h0 = tr_read<v_rd_off(D0, 0, 1)>(vb), l1 = tr_read<v_rd_off(D0, 1, 0)>(vb), h1 = tr_read<v_rd_off(D0, 1, 1)>(vb);
  const s16x4 l2 = tr_read<v_rd_off(D0, 2, 0)>(vb), h2 = tr_read<v_rd_off(D0, 2, 1)>(vb), l3 = tr_read<v_rd_off(D0, 3, 0)>(vb), h3 = tr_read<v_rd_off(D0, 3, 1)>(vb);
  asm volatile("s_waitcnt lgkmcnt(0)" ::: "memory"); SBAR();
#define PK(L, H) (bf16x8){L[0], L[1], L[2], L[3], H[0], H[1], H[2], H[3]}
  od = __builtin_amdgcn_mfma_f32_32x32x16_bf16(pa0, PK(l0, h0), od, 0, 0, 0);
  od = __builtin_amdgcn_mfma_f32_32x32x16_bf16(pa1, PK(l1, h1), od, 0, 0, 0);
  od = __builtin_amdgcn_mfma_f32_32x32x16_bf16(pa2, PK(l2, h2), od, 0, 0, 0);
  od = __builtin_amdgcn_mfma_f32_32x32x16_bf16(pa3, PK(l3, h3), od, 0, 0, 0);
#undef PK
}
__device__ __forceinline__ void pv_d0(f32x16* o, int vb, bf16x8 pa0, bf16x8 pa1, bf16x8 pa2, bf16x8 pa3) {
  pv_one<0>(o[0], vb, pa0, pa1, pa2, pa3); pv_one<1>(o[1], vb, pa0, pa1, pa2, pa3); pv_one<2>(o[2], vb, pa0, pa1, pa2, pa3); pv_one<3>(o[3], vb, pa0, pa1, pa2, pa3);
}
__device__ __forceinline__ void pack_p(const f32x16& p0, const f32x16& p1, bf16x8& pa0, bf16x8& pa1, bf16x8& pa2, bf16x8& pa3) {
#define PK4(P, BASE, OUT) do { unsigned a0 = cvtpk(P[BASE + 0], P[BASE + 1]), a1 = cvtpk(P[BASE + 2], P[BASE + 3]);   \
    unsigned b0 = cvtpk(P[BASE + 4], P[BASE + 5]), b1 = cvtpk(P[BASE + 6], P[BASE + 7]);                              \
    auto r0 = __builtin_amdgcn_permlane32_swap(a0, b0, false, false); auto r1 = __builtin_amdgcn_permlane32_swap(a1, b1, false, false); \
    u32x4 w = {r0[0], r1[0], r0[1], r1[1]}; OUT = *reinterpret_cast<bf16x8*>(&w); } while (0)
  PK4(p0, 0, pa0); PK4(p0, 8, pa1); PK4(p1, 0, pa2); PK4(p1, 8, pa3);
#undef PK4
}
template <int ND> __device__ __forceinline__ void qkt(f32x16& p0, f32x16& p1, const char* Ks, const bf16x8* qr, int cb0, int r32, int hi) {
  p0 = f32x16{}; p1 = f32x16{};
#pragma unroll
  for (int d0 = 0; d0 < ND; ++d0) { const int cb = cb0 + (d0 * 16 + hi * 8) * 2;
    const bf16x8 b0 = *reinterpret_cast<const bf16x8*>(Ks + KSWZ(r32, cb));
    const bf16x8 b1 = *reinterpret_cast<const bf16x8*>(Ks + KSWZ(32 + r32, cb));
    p0 = __builtin_amdgcn_mfma_f32_32x32x16_bf16(b0, qr[d0], p0, 0, 0, 0);
    p1 = __builtin_amdgcn_mfma_f32_32x32x16_bf16(b1, qr[d0], p1, 0, 0, 0); }
}
constexpr float THRL = 11.5f;
__device__ __forceinline__ void partialSM(f32x16& p0, f32x16& p1, float& m_reg, float& mn, float& alpha) {
  float pmax = p0[0];
#pragma unroll
  for (int r = 1; r < 16; ++r) pmax = fmaxf(pmax, p0[r]);
#pragma unroll
  for (int r = 0; r < 16; ++r) pmax = fmaxf(pmax, p1[r]);
  { auto rr = __builtin_amdgcn_permlane32_swap(__float_as_uint(pmax), __float_as_uint(pmax), false, false); pmax = fmaxf(__uint_as_float(rr[0]), __uint_as_float(rr[1])); }
  if (__builtin_expect(__all(pmax - m_reg <= THRL), 1)) { mn = m_reg; alpha = 1.f; }
  else { mn = fmaxf(m_reg, pmax); alpha = __builtin_amdgcn_exp2f(m_reg - mn); m_reg = mn; }
#pragma unroll
  for (int r = 0; r < 16; ++r) p0[r] = p0[r] - mn;
#pragma unroll
  for (int r = 0; r < 16; ++r) p1[r] = p1[r] - mn;
#pragma unroll
  for (int r = 0; r < 16; ++r) p0[r] = __builtin_amdgcn_exp2f(p0[r]);
}
__device__ __forceinline__ void finishSM(f32x16& p0, f32x16& p1, float alpha, float& l_reg, bf16x8& pa0, bf16x8& pa1, bf16x8& pa2, bf16x8& pa3) {
#pragma unroll
  for (int r = 0; r < 16; ++r) p1[r] = __builtin_amdgcn_exp2f(p1[r]);
  float ps = 0;
#pragma unroll
  for (int r = 0; r < 16; ++r) ps += p0[r];
#pragma unroll
  for (int r = 0; r < 16; ++r) ps += p1[r];
  { auto rr = __builtin_amdgcn_permlane32_swap(__float_as_uint(ps), __float_as_uint(ps), false, false); ps = __uint_as_float(rr[0]) + __uint_as_float(rr[1]); }
  l_reg = l_reg * alpha + ps;
  pack_p(p0, p1, pa0, pa1, pa2, pa3);
}
__device__ __forceinline__ float half_sum32(float v) {
#pragma unroll
  for (int o = 1; o < 32; o <<= 1) v += __shfl_xor(v, o);
  return v;
}

__device__ __forceinline__ void diff_unit(int b, int h, int qb, const bf16* __restrict__ QKV, bf16* __restrict__ Oout, const float* __restrict__ gdiff, float lam, float oscale, char* lds) {
  const int tid = threadIdx.x, lane = tid & 63, r32 = lane & 31, hi = lane >> 5; const int wid = __builtin_amdgcn_readfirstlane(tid >> 6);
  const int map = wid >> 2, wq = wid & 3;
  bf16* V_lds = (bf16*)lds; bf16* K_lds = (bf16*)(lds + 2 * SHM_V);
  float* ws = (float*)(lds + 2 * SHM_V + 2 * SHM_K) + wid * 64; float* li_l = ws; float* al_l = ws + 32;
  float m_reg = -1e30f, l_reg = 0; f32x16 o[4] = {}; bf16x8 qr[4];
  const size_t rowb = (size_t)b * SEQ_;
  const bf16* Qw = QKV + (rowb + qb * 128 + wq * 32 + r32) * LDQKV + 3072 + h * 128 + map * 64 + hi * 8;
#pragma unroll
  for (int d0 = 0; d0 < 4; ++d0) qr[d0] = *reinterpret_cast<const bf16x8*>(Qw + d0 * 16);
  const bf16* Kh = QKV + rowb * LDQKV + 4096 + h * 128; const bf16* Vh = QKV + rowb * LDQKV + 5120 + h * 128;
  const int sr = tid >> 4, sc = (tid & 15) * 8, vst0 = v_st(sr, sc), vst1 = v_st(32 + sr, sc);
  const int vb0 = (int)(uintptr_t)V_lds + v_rd_base(lane);
  const int cbm = map * 128;
  struct { bf16x8 vs0, vs1, ks0, ks1; } sr_[1];
  const unsigned toff0 = (unsigned)(sr * LDQKV + sc), toff1 = toff0 + 32u * LDQKV;
#define SLOAD(i, k0) do { const bf16* vt_ = Vh + (size_t)(k0) * LDQKV; const bf16* kt_ = Kh + (size_t)(k0) * LDQKV; \
    sr_[i].vs0 = *reinterpret_cast<const bf16x8*>(vt_ + toff0); sr_[i].vs1 = *reinterpret_cast<const bf16x8*>(vt_ + toff1); \
    sr_[i].ks0 = *reinterpret_cast<const bf16x8*>(kt_ + toff0); sr_[i].ks1 = *reinterpret_cast<const bf16x8*>(kt_ + toff1); } while (0)
#define SWRITE(bb, i) do { *(bf16x8*)((char*)V_lds + (bb) * SHM_V + vst0) = sr_[i].vs0; *(bf16x8*)((char*)V_lds + (bb) * SHM_V + vst1) = sr_[i].vs1; const int kc = sc * 2; \
    *(bf16x8*)((char*)K_lds + (bb) * SHM_K + KSWZ(sr, kc)) = sr_[i].ks0; *(bf16x8*)((char*)K_lds + (bb) * SHM_K + KSWZ(32 + sr, kc)) = sr_[i].ks1; } while (0)
#define SWAIT() asm volatile("s_waitcnt vmcnt(0)" ::: "memory")
#define RESC(a) do { if (__any((a) < 1.f)) { if (hi == 0) al_l[r32] = (a); asm volatile("s_waitcnt lgkmcnt(0)" ::: "memory"); \
    _Pragma("unroll") for (int d = 0; d < 4; ++d) _Pragma("unroll") for (int r = 0; r < 16; ++r) o[d][r] *= al_l[crow(r, hi)]; } } while (0)
  f32x16 pA0, pA1, pB0, pB1; float mnA, mnB, alA, alB; bf16x8 pa0, pa1, pa2, pa3; const int NT = 2 * qb + 2;
  __syncthreads();
  SLOAD(0, 0); asm volatile("s_waitcnt vmcnt(0)" ::: "memory"); SWRITE(0, 0); __syncthreads();
  qkt<4>(pA0, pA1, (const char*)K_lds, qr, cbm, r32, hi); partialSM(pA0, pA1, m_reg, mnA, alA);
  SLOAD(0, 64);
  SWAIT(); SWRITE(1, 0); __syncthreads();
  for (int j = 1; j + 1 < NT; j += 2) {
    SBAR(); qkt<4>(pB0, pB1, (const char*)K_lds + SHM_K, qr, cbm, r32, hi);
    finishSM(pA0, pA1, alA, l_reg, pa0, pa1, pa2, pa3); SBAR();
    SLOAD(0, (j + 1) * 64); SBAR();
    pv_d0(o, vb0, pa0, pa1, pa2, pa3); partialSM(pB0, pB1, m_reg, mnB, alB);
    __syncthreads(); SWAIT(); SWRITE(0, 0);
    RESC(alB); __syncthreads();
    SBAR(); qkt<4>(pA0, pA1, (const char*)K_lds, qr, cbm, r32, hi);
    finishSM(pB0, pB1, alB, l_reg, pa0, pa1, pa2, pa3); SBAR();
    SLOAD(0, (j + 2) * 64); SBAR();
    pv_d0(o, vb0 + (int)SHM_V, pa0, pa1, pa2, pa3); partialSM(pA0, pA1, m_reg, mnA, alA);
    __syncthreads(); SWAIT(); SWRITE(1, 0);
    RESC(alA); __syncthreads();
  }
  SBAR(); qkt<4>(pB0, pB1, (const char*)K_lds + SHM_K, qr, cbm, r32, hi);
  if (wq < 2) {
#pragma unroll
    for (int r = 0; r < 16; ++r) { pB0[r] = -1e30f; pB1[r] = -1e30f; } }
  finishSM(pA0, pA1, alA, l_reg, pa0, pa1, pa2, pa3); SBAR();
  pv_d0(o, vb0, pa0, pa1, pa2, pa3); partialSM(pB0, pB1, m_reg, mnB, alB);
  __syncthreads(); RESC(alB);
  finishSM(pB0, pB1, alB, l_reg, pa0, pa1, pa2, pa3); SBAR();
  pv_d0(o, vb0 + (int)SHM_V, pa0, pa1, pa2, pa3);
  if (hi == 0) li_l[r32] = l_reg; asm volatile("s_waitcnt lgkmcnt(0)" ::: "memory");
  float rli[16];
#pragma unroll
  for (int r = 0; r < 16; ++r) rli[r] = __builtin_amdgcn_rcpf(li_l[crow(r, hi)]);
  __syncthreads();
  float* xch = (float*)lds + (size_t)wq * 4096;
  if (map == 1) {
#pragma unroll
    for (int d0 = 0; d0 < 4; ++d0)
#pragma unroll
      for (int r = 0; r < 16; ++r) xch[(d0 * 16 + r) * 64 + lane] = o[d0][r] * rli[r] * lam;
  }
  __syncthreads();
  if (map == 0) {
    float ss[16];
#pragma unroll
    for (int r = 0; r < 16; ++r) { float s = 0.f;
#pragma unroll
      for (int d0 = 0; d0 < 4; ++d0) { const float v = o[d0][r] * rli[r] - xch[(d0 * 16 + r) * 64 + lane]; o[d0][r] = v; s += v * v; }
      ss[r] = s; }
#pragma unroll
    for (int r = 0; r < 16; ++r) ss[r] = half_sum32(ss[r]);
    bf16* Ow = Oout + (rowb + qb * 128 + wq * 32) * 2048 + 1024 + h * 128;
    float gv[4];
#pragma unroll
    for (int d0 = 0; d0 < 4; ++d0) gv[d0] = gdiff[d0 * 32 + r32] * oscale;
#pragma unroll
    for (int r = 0; r < 16; ++r) { const int orow = crow(r, hi); const float rs = rsqrtf(ss[r] * (1.f / 128.f) + 1e-6f);
#pragma unroll
      for (int d0 = 0; d0 < 4; ++d0) { const float y = o[d0][r] * rs * gv[d0]; const unsigned w = cvtpk(y, y); Ow[(size_t)orow * 2048 + d0 * 32 + r32] = (bf16)(w & 0xffffu); } }
  }
#undef SLOAD
#undef SWRITE
#undef SWAIT
#undef RESC
}
__device__ __forceinline__ void sb_unit(int b, int h, int qb, const bf16* __restrict__ QKV, bf16* __restrict__ Oout, const float* __restrict__ gsb, char* lds) {
  const int tid = threadIdx.x, lane = tid & 63, r32 = lane & 31, hi = lane >> 5; const int wid = __builtin_amdgcn_readfirstlane(tid >> 6);
  bf16* V_lds = (bf16*)lds; bf16* K_lds = (bf16*)(lds + 2 * SHM_V);
  volatile __attribute__((address_space(3))) int* flags = (volatile __attribute__((address_space(3))) int*)(lds + 2 * SHM_V + 2 * SHM_K + 8 * 64 * 4);
  f32x16 o[4] = {}; bf16x8 qr[8];
  const size_t rowb = (size_t)b * SEQ_;
  const int R = qb * 256, Q0 = R + wid * 32, tq = Q0 + r32;
  const bf16* Qw = QKV + (rowb + tq) * LDQKV + h * 128 + hi * 8;
#pragma unroll
  for (int d0 = 0; d0 < 8; ++d0) qr[d0] = *reinterpret_cast<const bf16x8*>(Qw + d0 * 16);
  const bf16* Kh = QKV + rowb * LDQKV + 1024 + h * 128; const bf16* Vh = QKV + rowb * LDQKV + 2048 + h * 128;
  const int sr = tid >> 4, sc = (tid & 15) * 8, vst0 = v_st(sr, sc), vst1 = v_st(32 + sr, sc);
  const int vb0 = (int)(uintptr_t)V_lds + v_rd_base(lane);
  const int jd = Q0 >> 6;
  float carry = 0.f;
  if (tid < 8) flags[tid] = 0;
  for (int j = (R + 255) >> 6; j >= 0; --j) {
    __syncthreads();
    { const int k0 = j * 64;
      const bf16x8 vs0 = *reinterpret_cast<const bf16x8*>(&Vh[(size_t)(k0 + sr) * LDQKV + sc]), vs1 = *reinterpret_cast<const bf16x8*>(&Vh[(size_t)(k0 + 32 + sr) * LDQKV + sc]);
      const bf16x8 ks0 = *reinterpret_cast<const bf16x8*>(&Kh[(size_t)(k0 + sr) * LDQKV + sc]), ks1 = *reinterpret_cast<const bf16x8*>(&Kh[(size_t)(k0 + 32 + sr) * LDQKV + sc]);
      *(bf16x8*)((char*)V_lds + vst0) = vs0; *(bf16x8*)((char*)V_lds + vst1) = vs1; const int kc = sc * 2;
      *(bf16x8*)((char*)K_lds + KSWZ(sr, kc)) = ks0; *(bf16x8*)((char*)K_lds + KSWZ(32 + sr, kc)) = ks1; }
    __syncthreads();
    if (j <= jd) {
      f32x16 p0, p1;
      qkt<8>(p0, p1, (const char*)K_lds, qr, 0, r32, hi);
      const bool diag = (j == jd);
      const int kb = j * 64 + 4 * hi;
      f32x16 q0, q1;
#pragma unroll
      for (int r = 0; r < 16; ++r) {
        const float z0 = __builtin_amdgcn_fmed3f(p0[r], -120.f, 120.f), z1 = __builtin_amdgcn_fmed3f(p1[r], -120.f, 120.f);
        float a0 = -__builtin_amdgcn_logf(1.f + __builtin_amdgcn_exp2f(z0)), a1 = -__builtin_amdgcn_logf(1.f + __builtin_amdgcn_exp2f(z1));
        float b0 = z0 + a0, b1 = z1 + a1;
        if (diag) { const int kv = kb + (r & 3) + 8 * (r >> 2); if (kv >= tq) { a0 = 0.f; b0 = -1e30f; } if (kv + 32 >= tq) { a1 = 0.f; b1 = -1e30f; } }
        q0[r] = a0; q1[r] = a1; p0[r] = b0; p1[r] = b1; }
      float G[8], PG[8], SUF[8];
#pragma unroll
      for (int g = 0; g < 4; ++g) { G[g] = (q0[4 * g] + q0[4 * g + 1]) + (q0[4 * g + 2] + q0[4 * g + 3]); G[4 + g] = (q1[4 * g] + q1[4 * g + 1]) + (q1[4 * g + 2] + q1[4 * g + 3]); }
#pragma unroll
      for (int g = 0; g < 8; ++g) PG[g] = __shfl_xor(G[g], 32);
      float run = carry;
#pragma unroll
      for (int g = 7; g >= 0; --g) { SUF[g] = run; run += G[g] + PG[g]; }
      carry = run;
#pragma unroll
      for (int g = 0; g < 8; ++g) SUF[g] += (hi == 0) ? PG[g] : 0.f;
#pragma unroll
      for (int g = 0; g < 4; ++g) {
        float s = SUF[g];
        p0[4 * g + 3] = __builtin_amdgcn_exp2f(p0[4 * g + 3] + s); s += q0[4 * g + 3];
        p0[4 * g + 2] = __builtin_amdgcn_exp2f(p0[4 * g + 2] + s); s += q0[4 * g + 2];
        p0[4 * g + 1] = __builtin_amdgcn_exp2f(p0[4 * g + 1] + s); s += q0[4 * g + 1];
        p0[4 * g + 0] = __builtin_amdgcn_exp2f(p0[4 * g + 0] + s);
        float s2 = SUF[4 + g];
        p1[4 * g + 3] = __builtin_amdgcn_exp2f(p1[4 * g + 3] + s2); s2 += q1[4 * g + 3];
        p1[4 * g + 2] = __builtin_amdgcn_exp2f(p1[4 * g + 2] + s2); s2 += q1[4 * g + 2];
        p1[4 * g + 1] = __builtin_amdgcn_exp2f(p1[4 * g + 1] + s2); s2 += q1[4 * g + 1];
        p1[4 * g + 0] = __builtin_amdgcn_exp2f(p1[4 * g + 0] + s2);
      }
      bf16x8 pa0, pa1, pa2, pa3;
      pack_p(p0, p1, pa0, pa1, pa2, pa3);
      pv_d0(o, vb0, pa0, pa1, pa2, pa3);
      if (__all(carry < -160.f)) { if (lane == 0) flags[wid] = 1; }
    }
    __syncthreads();
    int alld = 1;
#pragma unroll
    for (int w = 0; w < 8; ++w) alld &= flags[w];
    if (alld) break;
  }
  { float ss[16];
#pragma unroll
    for (int r = 0; r < 16; ++r) { float s = 0.f;
#pragma unroll
      for (int d0 = 0; d0 < 4; ++d0) s += o[d0][r] * o[d0][r];
      ss[r] = half_sum32(s); }
    bf16* Ow = Oout + (rowb + Q0) * 2048 + h * 128;
    float gv[4];
#pragma unroll
    for (int d0 = 0; d0 < 4; ++d0) gv[d0] = gsb[d0 * 32 + r32];
#pragma unroll
    for (int r = 0; r < 16; ++r) { const int orow = crow(r, hi); const float rs = rsqrtf(ss[r] * (1.f / 128.f) + 1e-6f);
#pragma unroll
      for (int d0 = 0; d0 < 4; ++d0) { const float y = o[d0][r] * rs * gv[d0]; const unsigned w = cvtpk(y, y); Ow[(size_t)orow * 2048 + d0 * 32 + r32] = (bf16)(w & 0xffffu); } }
  }
  __syncthreads();
}
#undef KSWZ
#undef SBAR
}
constexpr int NWAVES = 8;
constexpr int BATCH = 4, SEQ = 8192, DM = 2048, NTOK = BATCH * SEQ;
constexpr int QKVC = 6144, NEXP = 32, DEXP = 512, PLED = 256, LCAP = 65536;
constexpr float EPS = 1e-6f;
constexpr float QSCALE_SB = 0.08838834764831845f * 1.4426950408889634f;
constexpr float QSCALE_DF = 0.125f * 1.4426950408889634f;
constexpr size_t MiB = 1u << 20;
constexpr size_t WS_CTL = 0, CTL_ZERO_BYTES = 1 * MiB;
constexpr size_t WS_ROPE = 1 * MiB;
constexpr size_t WS_WRT = 1 * MiB + 512 * 1024;
constexpr size_t WS_WIN = 2 * MiB;
constexpr size_t WS_WOUT = 26 * MiB;
constexpr size_t WS_WPG = 34 * MiB;
constexpr size_t WS_WPLE = 42 * MiB;
constexpr size_t WS_WGU = 44 * MiB;
constexpr size_t WS_WD = 172 * MiB;
constexpr size_t WS_LSLOT = 236 * MiB;
constexpr size_t WS_LGATE = 244 * MiB;
constexpr size_t WS_PB = 252 * MiB;
constexpr size_t WS_A1 = 268 * MiB;
constexpr size_t WS_QKV = 396 * MiB;
constexpr size_t WS_XS = WS_QKV;
constexpr size_t WS_H = WS_QKV + 288 * MiB;
constexpr size_t WS_Y = WS_QKV;
constexpr size_t WS_U = 780 * MiB;
constexpr size_t WS_END = 908 * MiB;
constexpr int CW_TMO = 0, CW_CODE = 1;
constexpr int CW_BAR = 4096;
constexpr int CW_CNT = 16384;
constexpr int RING_OFF = 0, RING_BYTES = 131072;
constexpr int LDSCTL_OFF = RING_BYTES;
constexpr int TST_OFF = LDSCTL_OFF;
constexpr int CNT_OFF = LDSCTL_OFF + 160;
constexpr int MISC_OFF = LDSCTL_OFF + 320;
constexpr int LDS_BYTES = 147456;

#define GAS __attribute__((address_space(1)))
#define LAS __attribute__((address_space(3)))
typedef unsigned short bf16;
typedef unsigned v4u __attribute__((ext_vector_type(4)));
typedef unsigned v2u __attribute__((ext_vector_type(2)));
typedef float f32x4 __attribute__((ext_vector_type(4)));
typedef GAS unsigned gu32;
#define RLX_AGENT __ATOMIC_RELAXED, __HIP_MEMORY_SCOPE_AGENT
#define LDS_WAIT() asm volatile("s_waitcnt lgkmcnt(0)" ::: "memory")
#define VM_WAIT() asm volatile("s_waitcnt vmcnt(0)" ::: "memory")
__device__ __forceinline__ unsigned pk2(float lo, float hi) { return pg8::cvt_pk_bf16(lo, hi); }
#define XB_TMO      128
#define XB_XCNT(j)  (256  + 64 * (j))
#define XB_XSUB(j)  (1280 + 64 * (j))
#define XB_XGEN(j)  (2304 + 64 * (j))
#define XB_TOP      3328
#define XB_TOPGEN   3392
#define XCD_BAR_WORDS 3456
#define XB_SPIN_CAP (1u << 18)

__device__ __forceinline__ unsigned xb_ld(unsigned* p)              { return __hip_atomic_load(p, __ATOMIC_RELAXED, __HIP_MEMORY_SCOPE_AGENT); }
__device__ __forceinline__ unsigned xb_add(unsigned* p, unsigned v) { return __hip_atomic_fetch_add(p, v, __ATOMIC_RELAXED, __HIP_MEMORY_SCOPE_AGENT); }
__device__ __forceinline__ unsigned xb_xcc_id() { return (unsigned)__builtin_amdgcn_s_getreg((3 << 11) | 20) & 0xFu; }
#define XB_SPIN(cond, bar) do { unsigned _sp = 0; while (cond) { __builtin_amdgcn_s_sleep(1); \
    if ((++_sp & 255u) == 0u) { if (xb_ld(&(bar)[XB_TMO])) break; if (_sp > XB_SPIN_CAP) { atomicAdd(&(bar)[XB_TMO], 1u); break; } } } } while (0)

struct XcdBarrier {
    unsigned* bar; unsigned x;
    volatile LAS unsigned* st;
};

__device__ __forceinline__ XcdBarrier xcd_barrier_post(unsigned* bar, volatile LAS unsigned* st) {
    XcdBarrier b; b.bar = bar; b.x = xb_xcc_id(); b.st = st;
    if (threadIdx.x == 0) (void)xb_add(&bar[XB_XCNT(b.x)], 1u);
    return b;
}
__device__ __forceinline__ void xcd_barrier_complete(unsigned* bar, unsigned x, unsigned& nloc, unsigned& nx) {
    const unsigned G = gridDim.x * gridDim.y * gridDim.z;
    unsigned sum, cnt, mine, sp = 0u;
    for (;;) {
        sum = 0u; cnt = 0u; mine = 0u;
#pragma unroll
        for (unsigned j = 0; j < 16; ++j) { const unsigned c = xb_ld(&bar[XB_XCNT(j)]); sum += c; cnt += (c > 0u) ? 1u : 0u; mine = (j == x) ? c : mine; }
        if (sum == G) break;
        __builtin_amdgcn_s_sleep(1);
        if ((++sp & 255u) == 0u) { if (xb_ld(&bar[XB_TMO])) break; if (sp > XB_SPIN_CAP) { atomicAdd(&bar[XB_TMO], 1u); break; } }
    }
    nloc = mine > 0u ? mine : 1u; nx = cnt > 0u ? cnt : 1u;
}

__device__ __forceinline__ void xcd_barrier(const XcdBarrier& b) {
    asm volatile("s_waitcnt vmcnt(0)" ::: "memory");
    __syncthreads();
    if (threadIdx.x == 0) {
        unsigned* bar = b.bar;
        __builtin_amdgcn_s_waitcnt(0);
        unsigned nloc = b.st[0], nx = b.st[1];
        if (nloc == 0u) { xcd_barrier_complete(bar, b.x, nloc, nx); b.st[0] = nloc; b.st[1] = nx; }
        const unsigned old = xb_add(&bar[XB_XSUB(b.x)], 1u);
        const unsigned gen = old / nloc;
        if (old + 1u == (gen + 1u) * nloc) {
            __builtin_amdgcn_fence(__ATOMIC_RELEASE, "agent");
            asm volatile("s_waitcnt vmcnt(0)" ::: "memory");
            const unsigned og = xb_add(&bar[XB_TOP], 1u);
            const unsigned tg = og / nx;
            if (og + 1u == (tg + 1u) * nx) xb_add(&bar[XB_TOPGEN], 1u);
            else XB_SPIN(xb_ld(&bar[XB_TOPGEN]) == tg, bar);
            __builtin_amdgcn_fence(__ATOMIC_ACQUIRE, "agent");
            xb_add(&bar[XB_XGEN(b.x)], 1u);
            asm volatile("s_waitcnt vmcnt(0)" ::: "memory");
        } else {
            XB_SPIN(xb_ld(&bar[XB_XGEN(b.x)]) == gen, bar);
            __builtin_amdgcn_fence(__ATOMIC_ACQUIRE, "agent");
            asm volatile("s_waitcnt vmcnt(0)" ::: "memory");
        }
    }
    __syncthreads();
}
struct Frame {
    LAS unsigned char* lds;
    volatile LAS unsigned* MISC;
    gu32* ctl;
    int tid, lane, wave;
    int vcu, G;
};
__device__ __forceinline__ float wave_sum(float v) {
#pragma unroll
    for (int o = 1; o < 64; o <<= 1) v += __shfl_xor(v, o);
    return v;
}
__device__ __forceinline__ void tr_item(const float* W, int ldw, int k0, int n0, bf16* dst, int dpitch, float scale, LAS float* scr, int lane) {
#pragma unroll 8
    for (int i = 0; i < 32; ++i) { const int kk = 2 * i + (lane >> 5); scr[kk * 33 + (lane & 31)] = W[(size_t)(k0 + kk) * ldw + n0 + (lane & 31)]; }
    LDS_WAIT(); asm volatile("" ::: "memory");
    const int c = lane & 7;
#pragma unroll
    for (int j = 0; j < 4; ++j) { const int n = (lane >> 3) + 8 * j; const LAS float* s = scr + (8 * c) * 33 + n;
        v4u o; o.x = pk2(s[0 * 33] * scale, s[1 * 33] * scale); o.y = pk2(s[2 * 33] * scale, s[3 * 33] * scale); o.z = pk2(s[4 * 33] * scale, s[5 * 33] * scale); o.w = pk2(s[6 * 33] * scale, s[7 * 33] * scale);
        *(GAS v4u*)(dst + (size_t)n * dpitch + 8 * c) = o; }
    LDS_WAIT(); asm volatile("" ::: "memory");
}
__device__ __forceinline__ void rms_row_to_bf16(const float* xrow, const float* g, bf16* orow, int lane) {
    const GAS f32x4* xr = (const GAS f32x4*)xrow + lane;
    f32x4 v[8]; float s = 0.f;
#pragma unroll
    for (int j = 0; j < 8; ++j) { v[j] = xr[64 * j]; s += (v[j].x * v[j].x + v[j].y * v[j].y) + (v[j].z * v[j].z + v[j].w * v[j].w); }
    const float rstd = rsqrtf(wave_sum(s) * (1.f / DM) + EPS);
    GAS v2u* o8 = (GAS v2u*)orow + lane;
#pragma unroll
    for (int j = 0; j < 8; ++j) { const f32x4 gg = *((const GAS f32x4*)g + lane + 64 * j); v2u w; w.x = pk2(v[j].x * rstd * gg.x, v[j].y * rstd * gg.y); w.y = pk2(v[j].z * rstd * gg.z, v[j].w * rstd * gg.w); o8[64 * j] = w; }
}

__device__ __forceinline__ void unpack8(const v4u w, float (&f)[8]) {
#pragma unroll
    for (int q = 0; q < 4; ++q) { f[2 * q] = pg8::bf_lo(w[q]); f[2 * q + 1] = pg8::bf_hi(w[q]); }
}
struct Args { const float* in[21]; float* out; unsigned char* ws; int ph_lo, ph_hi; };


#define x_ (args.in[0])
#define p_in (args.in[1])
#define g_attn (args.in[2])
#define w_in (args.in[3])
#define g_sb (args.in[4])
#define g_diff (args.in[5])
#define lam_q1 (args.in[6])
#define lam_k1 (args.in[7])
#define lam_q2 (args.in[8])
#define lam_k2 (args.in[9])
#define w_out (args.in[10])
#define g_moe (args.in[11])
#define w_rg (args.in[12])
#define w_re (args.in[13])
#define w_gate (args.in[14])
#define w_up (args.in[15])
#define w_down (args.in[16])
#define g_ple (args.in[17])
#define w_ple (args.in[18])
#define w_pg (args.in[19])
#define g_final (args.in[20])
#define rope ((float*)(ws + WS_ROPE))
#define wrt ((float*)(ws + WS_WRT))
#define WIN ((bf16*)(ws + WS_WIN))
#define WOUT ((bf16*)(ws + WS_WOUT))
#define WPG ((bf16*)(ws + WS_WPG))
#define WPLE ((bf16*)(ws + WS_WPLE))
#define WGU ((bf16*)(ws + WS_WGU))
#define WD ((bf16*)(ws + WS_WD))
#define LSLOT ((int*)(ws + WS_LSLOT))
#define LGATE ((float*)(ws + WS_LGATE))
#define PB ((bf16*)(ws + WS_PB))
#define A1 ((bf16*)(ws + WS_A1))
#define QKV ((bf16*)(ws + WS_QKV))
#define XS ((bf16*)(ws + WS_XS))
#define HB ((bf16*)(ws + WS_H))
#define YB ((bf16*)(ws + WS_Y))
#define UB ((bf16*)out)
#define H1B ((bf16*)(ws + WS_U))
#define ecnt (F.ctl + CW_CNT)
__global__ void __launch_bounds__(NWAVES * 64, 2) mega_fwd(Args args) {
    extern __shared__ __attribute__((aligned(16))) unsigned char lds[];
    Frame F;
    F.lds = (LAS unsigned char*)lds;
    F.MISC = (volatile LAS unsigned*)(F.lds + MISC_OFF);
    F.tid = threadIdx.x; F.lane = F.tid & 63; F.wave = __builtin_amdgcn_readfirstlane(F.tid >> 6);
    F.G = gridDim.x; { const int bx = blockIdx.x; F.vcu = (F.G % 8 == 0) ? (bx % 8) * (F.G / 8) + bx / 8 : bx; }
    unsigned char* ws = args.ws;
    F.ctl = (gu32*)(ws + WS_CTL);
    float* const out = args.out;
    for (int u = F.tid; u < (LDS_BYTES - LDSCTL_OFF) / 4; u += NWAVES * 64) ((LAS unsigned*)(F.lds + LDSCTL_OFF))[u] = 0u;
    __syncthreads();
    XcdBarrier bar = xcd_barrier_post((unsigned*)(F.ctl + CW_BAR), F.MISC + 8);
    const int lo = args.ph_lo, hi = args.ph_hi;
#ifndef PROBE_DBL
#define PROBE_DBL -1
#endif
#define REPS(k) _Pragma("unroll 1") for (int rep_ = 0; rep_ < ((PROBE_DBL == (k)) ? 2 : 1); ++rep_)
#ifndef PH_MASK
#define PH_MASK 0x7ff
#endif
#define IN(k) ((((PH_MASK) >> (k)) & 1) && lo <= (k) && (k) < hi)
#define SEAM(k) do { if (IN(k) && IN((k) + 1)) xcd_barrier(bar); } while (0)
    const int gw = F.vcu * NWAVES + F.wave, NGW = F.G * NWAVES;
    LAS int* tstart = (LAS int*)(F.lds + TST_OFF); LAS int* lcnt = (LAS int*)(F.lds + CNT_OFF);

    if (IN(0)) REPS(0) {
        LAS float* scr = (LAS float*)(F.lds + RING_OFF + F.wave * 16384);
        constexpr int I_IN = 32 * 192, I_OUT = 32 * 64, I_PG = 32 * 64, I_PLE = 4 * 64, I_G = 32 * 32 * 16, I_U = I_G, I_D = 32 * 8 * 64;
        constexpr int NITEMS = I_IN + I_OUT + I_PG + I_PLE + I_G + I_U + I_D;
        for (int it = gw; it < NITEMS; it += NGW) {
            int r = it;
            if (r < I_IN) { const int kb = r / 192, nb = r % 192, n0 = 32 * nb, k0 = 64 * kb; const float sc = (n0 < 1024) ? QSCALE_SB : ((n0 >= 3072 && n0 < 4096) ? QSCALE_DF : 1.f);
                tr_item(w_in, QKVC, k0, n0, WIN + (size_t)n0 * DM + k0, DM, sc, scr, F.lane); continue; } r -= I_IN;
            if (r < I_OUT) { const int kb = r / 64, nb = r % 64; tr_item(w_out, DM, 64 * kb, 32 * nb, WOUT + (size_t)(32 * nb) * DM + 64 * kb, DM, 1.f, scr, F.lane); continue; } r -= I_OUT;
            if (r < I_PG) { const int kb = r / 64, nb = r % 64; tr_item(w_pg, DM, 64 * kb, 32 * nb, WPG + (size_t)(32 * nb) * DM + 64 * kb, DM, 1.f, scr, F.lane); continue; } r -= I_PG;
            if (r < I_PLE) { const int kb = r / 64, nb = r % 64; tr_item(w_ple, DM, 64 * kb, 32 * nb, WPLE + (size_t)(32 * nb) * PLED + 64 * kb, PLED, 1.f, scr, F.lane); continue; } r -= I_PLE;
            if (r < I_G + I_U) { const bool isu = r >= I_G; if (isu) r -= I_G; const int e = r / 512, q = r % 512, kb = q / 16, nb = q % 16, n0 = 32 * nb, k0 = 64 * kb;
                const int drow = e * 1024 + (n0 >> 7) * 256 + (isu ? 128 : 0) + (n0 & 127);
                tr_item((isu ? w_up : w_gate) + (size_t)e * DM * DEXP, DEXP, k0, n0, WGU + (size_t)drow * DM + k0, DM, 1.f, scr, F.lane); continue; } r -= I_G + I_U;
            { const int e = r / 512, q = r % 512, kb = q / 64, nb = q % 64, n0 = 32 * nb, k0 = 64 * kb;
                tr_item(w_down + (size_t)e * DEXP * DM, DM, k0, n0, WD + ((size_t)e * DM + n0) * DEXP + k0, DEXP, 1.f, scr, F.lane); }
        }
        for (int i = gw * 64 + F.lane; i < SEQ * 8; i += NGW * 64) { const int pos = i >> 3, k = i & 7;
            const float inv = exp2f(-(float)k * (18.931568569324174f / 8.f));
            const float ang = (float)pos * inv;
            const double rev = (double)ang * 0.15915494309189535; const float fr = (float)(rev - floor(rev));
            rope[pos * 16 + k] = __builtin_amdgcn_cosf(fr); rope[pos * 16 + 8 + k] = __builtin_amdgcn_sinf(fr); }
        for (int i = gw * 64 + F.lane; i < 36 * DM; i += NGW * 64) { const int c = i / DM, k = i % DM; wrt[i] = (c < 4) ? w_rg[k * 4 + c] : w_re[k * 32 + (c - 4)]; }
        for (size_t i = (size_t)gw * 64 + F.lane; i < (size_t)NTOK * PLED / 4; i += (size_t)NGW * 64) { const f32x4 v = *((const GAS f32x4*)p_in + i); v2u w; w.x = pk2(v.x, v.y); w.y = pk2(v.z, v.w); *((GAS v2u*)PB + i) = w; }
        for (int m = gw; m < NTOK; m += NGW) rms_row_to_bf16(x_ + (size_t)m * DM, g_attn, A1 + (size_t)m * DM, F.lane);
    }
    SEAM(0);
    if (IN(1)) REPS(1) {
        pg8::Gemm g{A1, WIN, NTOK, QKVC, DM}; pg8::StaticOrder S; S.init(NTOK, QKVC, F.G, (int)blockIdx.x);
        pg8::EpiQKV E{QKV, rope};
        pg8::gemm_phase<pg8::EpiQKV, pg8::StaticOrder, true, true>(F.lds + RING_OFF, g, S, E);
    }
    SEAM(1);
    if (IN(2)) {
        float lam;
        { float a = (F.lane < 64) ? lam_q1[F.lane] * lam_k1[F.lane] : 0.f, b2 = lam_q2[F.lane] * lam_k2[F.lane]; a = wave_sum(a); b2 = wave_sum(b2); lam = expf(a) - expf(b2) + 0.2f; }
#ifndef NO_DIFF
        REPS(20) for (int L = F.vcu; L < 1024; L += F.G) { const int bh = L >> 5, pr = L & 31;
#pragma unroll 1
            for (int s2 = 0; s2 < 2; ++s2) att::diff_unit(bh >> 3, bh & 7, s2 ? pr : 63 - pr, QKV, A1, g_diff, lam, 0.8f, (char*)lds + RING_OFF); }
#endif
        __syncthreads();
#ifndef NO_SB
        REPS(21) for (int L = F.vcu; L < 1024; L += F.G) { const int bh = L >> 5, qb = L & 31;
            att::sb_unit(bh >> 3, bh & 7, qb, QKV, A1, g_sb, (char*)lds + RING_OFF); }
#endif
    }
    SEAM(2);
    if (IN(3)) REPS(3) {
#ifndef NO_P3A
        { pg8::Gemm g{A1, WOUT, NTOK, DM, DM}; pg8::StaticOrder S; S.init(NTOK, DM, F.G, (int)blockIdx.x);
          pg8::EpiResBf16 E{x_, H1B};
          pg8::gemm_phase<pg8::EpiResBf16, pg8::StaticOrder, true, true>(F.lds + RING_OFF, g, S, E); }
#endif
#ifndef NO_P3B
        { pg8::Gemm g{PB, WPLE, NTOK, DM, PLED}; pg8::StaticOrder S; S.init(NTOK, DM, F.G, (int)blockIdx.x);
          pg8::EpiBf16 E{UB, DM};
          pg8::gemm_phase<pg8::EpiBf16, pg8::StaticOrder, true, true>(F.lds + RING_OFF, g, S, E); }
#endif
    }
    SEAM(3);
    if (IN(4)) {
        LAS int* sel_e = (LAS int*)(F.lds + RING_OFF); LAS float* sel_g = (LAS float*)(F.lds + RING_OFF + 1024); LAS int* lhist = (LAS int*)(F.lds + RING_OFF + 2048); LAS int* lbase = (LAS int*)(F.lds + RING_OFF + 2176);
        LAS int* lrk = (LAS int*)(F.lds + RING_OFF + 2304);
        for (int chunk = blockIdx.x; chunk < NTOK / 128; chunk += F.G) {
            if (F.tid < 32) lhist[F.tid] = 0;
            for (int g4 = 0; g4 < 4; ++g4) {
                const int row0 = chunk * 128 + F.wave * 16 + g4 * 4;
                float v[4][4][8]; float rstd[4];
#pragma unroll
                for (int r = 0; r < 4; ++r) { const GAS v4u* xr = (const GAS v4u*)(H1B + (size_t)(row0 + r) * DM) + F.lane; float s = 0.f;
#pragma unroll
                    for (int j = 0; j < 4; ++j) { unpack8(xr[64 * j], v[r][j]);
#pragma unroll
                        for (int i = 0; i < 8; ++i) s += v[r][j][i] * v[r][j][i]; }
                    rstd[r] = rsqrtf(wave_sum(s) * (1.f / DM) + EPS); }
#pragma unroll
                for (int j = 0; j < 4; ++j) { const f32x4 g0 = *((const GAS f32x4*)g_moe + 2 * F.lane + 128 * j), g1 = *((const GAS f32x4*)g_moe + 2 * F.lane + 128 * j + 1);
#pragma unroll
                    for (int r = 0; r < 4; ++r) {
#pragma unroll
                        for (int i = 0; i < 4; ++i) { v[r][j][i] *= rstd[r] * g0[i]; v[r][j][4 + i] *= rstd[r] * g1[i]; }
                        v4u w; w.x = pk2(v[r][j][0], v[r][j][1]); w.y = pk2(v[r][j][2], v[r][j][3]); w.z = pk2(v[r][j][4], v[r][j][5]); w.w = pk2(v[r][j][6], v[r][j][7]);
                        *((GAS v4u*)(A1 + (size_t)(row0 + r) * DM) + F.lane + 64 * j) = w; } }
                float lg[4] = {0.f, 0.f, 0.f, 0.f};
#pragma unroll 1
                for (int c = 0; c < 36; ++c) { const GAS f32x4* wc = (const GAS f32x4*)(wrt + (size_t)c * DM) + 2 * F.lane;
                    float pa[4] = {0.f, 0.f, 0.f, 0.f};
#pragma unroll
                    for (int j = 0; j < 4; ++j) { const f32x4 w0 = wc[128 * j], w1 = wc[128 * j + 1];
#pragma unroll
                        for (int r = 0; r < 4; ++r) pa[r] += ((v[r][j][0] * w0.x + v[r][j][1] * w0.y) + (v[r][j][2] * w0.z + v[r][j][3] * w0.w)) + ((v[r][j][4] * w1.x + v[r][j][5] * w1.y) + (v[r][j][6] * w1.z + v[r][j][7] * w1.w)); }
#pragma unroll
                    for (int r = 0; r < 4; ++r) { const float t = wave_sum(pa[r]); lg[r] = (F.lane == c) ? t : lg[r]; } }
#pragma unroll
                for (int r = 0; r < 4; ++r) {
                    const float g0 = __shfl(lg[r], 0), g1 = __shfl(lg[r], 1), g2 = __shfl(lg[r], 2), g3 = __shfl(lg[r], 3);
                    int grp = 0; float gm = g0; if (g1 > gm) { gm = g1; grp = 1; } if (g2 > gm) { gm = g2; grp = 2; } if (g3 > gm) { gm = g3; grp = 3; }
                    const float psel = 1.f / (expf(g0 - gm) + expf(g1 - gm) + expf(g2 - gm) + expf(g3 - gm));
                    float ev[8];
#pragma unroll
                    for (int i = 0; i < 8; ++i) ev[i] = __shfl(lg[r], 4 + grp * 8 + i);
                    int i0 = 0; float v0 = ev[0];
#pragma unroll
                    for (int i = 1; i < 8; ++i) if (ev[i] > v0) { v0 = ev[i]; i0 = i; }
                    int i1 = -1; float v1 = 0.f;
#pragma unroll
                    for (int i = 0; i < 8; ++i) if (i != i0 && (i1 < 0 || ev[i] > v1)) { v1 = ev[i]; i1 = i; }
                    const float ga = 1.f / (1.f + expf(v1 - v0)), gb = 1.f - ga;
                    if (F.lane == 0) { const int rl = F.wave * 16 + g4 * 4 + r; sel_e[rl * 2] = grp * 8 + i0; sel_e[rl * 2 + 1] = grp * 8 + i1; sel_g[rl * 2] = ga * psel; sel_g[rl * 2 + 1] = gb * psel; }
                }
            }
            __syncthreads();
            int my_e = 0, my_rk = 0;
            if (F.tid < 256) { my_e = sel_e[F.tid]; my_rk = atomicAdd((int*)(lhist + my_e), 1); }
            __syncthreads();
            if (F.tid < 32) { const int n = lhist[F.tid]; lbase[F.tid] = n ? (int)__hip_atomic_fetch_add(ecnt + 64 * F.tid, (unsigned)n, RLX_AGENT) : 0; }
            __syncthreads();
            if (F.tid < 256) { const int pos = lbase[my_e] + my_rk; LSLOT[(size_t)my_e * LCAP + pos] = (chunk * 128 + (F.tid >> 1)) * 2 + (F.tid & 1); LGATE[(size_t)my_e * LCAP + pos] = sel_g[F.tid]; }
            __syncthreads();
        }
        (void)lrk;
    }
    SEAM(4);
    if (IN(6) || IN(7)) {
        if (F.tid < 32) lcnt[F.tid] = (int)__hip_atomic_load(ecnt + 64 * F.tid, RLX_AGENT);
        __syncthreads();
        if (F.tid == 0) { int acc = 0; for (int e = 0; e < 32; ++e) { tstart[e] = acc; acc += (lcnt[e] + 255) >> 8; } tstart[32] = acc; }
        __syncthreads();
    }
    const int NTILES = (IN(6) || IN(7)) ? __builtin_amdgcn_readfirstlane(tstart[32]) : 0;
    if (IN(6)) REPS(6) {
        pg8::Gemm g{A1, WGU, NTILES * 256, 1024, DM, LSLOT}; pg8::MoeOrder S; S.init(NTILES, 4, F.G, (int)blockIdx.x, tstart, lcnt);
        pg8::EpiSwiglu E{HB};
        pg8::gemm_phase<pg8::EpiSwiglu, pg8::MoeOrder, true, true, true>(F.lds + RING_OFF, g, S, E);
    }
    SEAM(6);
    if (IN(7)) REPS(7) {
        pg8::Gemm g{HB, WD, NTILES * 256, DM, DEXP}; pg8::MoeOrder S; S.init(NTILES, 8, F.G, (int)blockIdx.x, tstart, lcnt);
        pg8::EpiScatter E{YB, LSLOT, LGATE};
        pg8::gemm_phase<pg8::EpiScatter, pg8::MoeOrder, true, true>(F.lds + RING_OFF, g, S, E);
    }
    SEAM(7);
    if (IN(8)) {
        for (int m = gw; m < NTOK; m += NGW) {
            const GAS v4u* hr = (const GAS v4u*)(H1B + (size_t)m * DM) + F.lane; const GAS v4u* y0 = (const GAS v4u*)(YB + (size_t)(2 * m) * DM) + F.lane; const GAS v4u* y1 = (const GAS v4u*)(YB + (size_t)(2 * m + 1) * DM) + F.lane;
            float v[4][8]; float s = 0.f;
#pragma unroll
            for (int j = 0; j < 4; ++j) { float a[8], b[8]; unpack8(hr[64 * j], v[j]); unpack8(y0[64 * j], a); unpack8(y1[64 * j], b);
#pragma unroll
                for (int i = 0; i < 8; ++i) { v[j][i] += a[i] + b[i]; s += v[j][i] * v[j][i]; } }
            const float rstd = rsqrtf(wave_sum(s) * (1.f / DM) + EPS);
            GAS v4u* o8 = (GAS v4u*)(A1 + (size_t)m * DM) + F.lane;
#pragma unroll
            for (int j = 0; j < 4; ++j) { const f32x4 g0 = *((const GAS f32x4*)g_ple + 2 * F.lane + 128 * j), g1 = *((const GAS f32x4*)g_ple + 2 * F.lane + 128 * j + 1);
                v4u w; w.x = pk2(v[j][0] * rstd * g0.x, v[j][1] * rstd * g0.y); w.y = pk2(v[j][2] * rstd * g0.z, v[j][3] * rstd * g0.w); w.z = pk2(v[j][4] * rstd * g1.x, v[j][5] * rstd * g1.y); w.w = pk2(v[j][6] * rstd * g1.z, v[j][7] * rstd * g1.w);
                o8[64 * j] = w; }
        }
    }
    SEAM(8);
    if (IN(9)) {
        pg8::Gemm g{A1, WPG, NTOK, DM, DM}; pg8::StaticOrder S; S.init(NTOK, DM, F.G, (int)blockIdx.x);
        pg8::EpiPle2 E{H1B, YB, UB};
        pg8::gemm_phase<pg8::EpiPle2, pg8::StaticOrder, true, true>(F.lds + RING_OFF, g, S, E);
    }
    SEAM(9);
    if (IN(10)) {
        for (int m = gw; m < NTOK; m += NGW) {
            const GAS v4u* hr = (const GAS v4u*)(H1B + (size_t)m * DM) + F.lane; float v[4][8]; float s = 0.f;
#pragma unroll
            for (int j = 0; j < 4; ++j) { unpack8(hr[64 * j], v[j]);
#pragma unroll
                for (int i = 0; i < 8; ++i) s += v[j][i] * v[j][i]; }
            const float rstd = rsqrtf(wave_sum(s) * (1.f / DM) + EPS);
            GAS f32x4* orow = (GAS f32x4*)(out + (size_t)m * DM) + 2 * F.lane;
#pragma unroll
            for (int j = 0; j < 4; ++j) { const f32x4 g0 = *((const GAS f32x4*)g_final + 2 * F.lane + 128 * j), g1 = *((const GAS f32x4*)g_final + 2 * F.lane + 128 * j + 1);
                orow[128 * j] = (f32x4){v[j][0] * rstd * g0.x, v[j][1] * rstd * g0.y, v[j][2] * rstd * g0.z, v[j][3] * rstd * g0.w};
                orow[128 * j + 1] = (f32x4){v[j][4] * rstd * g1.x, v[j][5] * rstd * g1.y, v[j][6] * rstd * g1.z, v[j][7] * rstd * g1.w}; }
        }
    }
#undef IN
#undef SEAM
}

#ifndef MK_SPLIT
#define MK_SPLIT 0
#endif
extern "C" void kernel_launch(void* const* d_in, const int* in_sizes, int n_in, void* d_out, int out_size, void* d_ws, size_t ws_size, hipStream_t stream) {
    static int grid = 0;
    if (grid == 0) {
        if (n_in != 21 || in_sizes[0] != NTOK * DM || out_size != NTOK * DM || ws_size < WS_END) { fprintf(stderr, "kernel_launch: shape mismatch (n_in %d in0 %d out %d ws %zu)\n", n_in, n_in > 0 ? in_sizes[0] : -1, out_size, ws_size); grid = -1; return; }
        int dev = 0, cus = 0, per_cu = 0;
        if (hipGetDevice(&dev) != hipSuccess || hipDeviceGetAttribute(&cus, hipDeviceAttributeMultiprocessorCount, dev) != hipSuccess) { grid = -1; return; }
        if (hipFuncSetAttribute((const void*)mega_fwd, hipFuncAttributeMaxDynamicSharedMemorySize, LDS_BYTES) != hipSuccess) { fprintf(stderr, "kernel_launch: hipFuncSetAttribute failed\n"); grid = -1; return; }
        if (hipOccupancyMaxActiveBlocksPerMultiprocessor(&per_cu, (const void*)mega_fwd, NWAVES * 64, LDS_BYTES) != hipSuccess || per_cu < 1) fprintf(stderr, "kernel_launch: occupancy query reports %d\n", per_cu);
        (void)hipGetLastError();
        grid = cus;
    }
    if (grid < 0) return;
    if (hipMemsetAsync((char*)d_ws + WS_CTL, 0, CTL_ZERO_BYTES, stream) != hipSuccess) return;
    Args a{};
    for (int i = 0; i < 21; ++i) a.in[i] = (const float*)d_in[i];
    a.out = (float*)d_out; a.ws = (unsigned char*)d_ws;
#if MK_SPLIT
    for (int ph = 0; ph < 11; ++ph) { a.ph_lo = ph; a.ph_hi = ph + 1; hipLaunchKernelGGL(mega_fwd, dim3(grid), dim3(NWAVES * 64), LDS_BYTES, stream, a); }
#else
    a.ph_lo = 0; a.ph_hi = 11;
    hipLaunchKernelGGL(mega_fwd, dim3(grid), dim3(NWAVES * 64), LDS_BYTES, stream, a);
#endif
    const hipError_t le = hipPeekAtLastError();
    if (le != hipSuccess) fprintf(stderr, "kernel_launch: launch failed: %s\n", hipGetErrorName(le));
}
```

```cpp
#include <hip/hip_runtime.h>
#include <hip/hip_bf16.h>
#include <cstdio>
#include <cstdint>
namespace pg8 {
#define PG8_LAS __attribute__((address_space(3)))
typedef unsigned short bf16_t;
typedef short bf16x8 __attribute__((ext_vector_type(8)));
typedef float f32x4 __attribute__((ext_vector_type(4)));
typedef unsigned u32x4 __attribute__((ext_vector_type(4)));
constexpr int BM = 256, BK = 64, HALF = 128, HTB = HALF * BK * 2  , STAGE_BYTES = 8 * HTB, NXCD = 8, WGM = 8;

__host__ __device__ __forceinline__ int lds_byte(int r, int c) { const int st = (r >> 4) * 2 + (c >> 5), rr = r & 15, cc = c & 31, ob = rr * 64 + cc * 2; return st * 1024 + (ob ^ (((ob >> 9) & 1) << 5)); }
__host__ __device__ __forceinline__ void stage_rc(int b, int& R, int& C) { const int st = b / 1024, sb = b % 1024, swz = sb ^ (((sb >> 9) & 1) << 5); R = (st >> 1) * 16 + swz / 64; C = (st & 1) * 32 + (swz % 64) / 2; }
__host__ __device__ __forceinline__ int perm32(int rho) { const int n = rho >> 4, i = rho & 15; return 8 * (i >> 2) + 4 * n + (i & 3); }

struct Unit { int pm, pn, pb, aux0, aux1; };
struct Gemm { const bf16_t* A; const bf16_t* Bt; int M, N, K; const int* glist; };

struct StaticOrder {
    int nM, nN, nwg, G, c;
    __host__ __device__ void init(int M, int N, int G_, int c_) { nM = M / BM; nN = N / BM; nwg = nM * nN; G = G_; c = c_; }
    __host__ __device__ bool next(int i, Unit& u) const {
        const long L = (long)i * G + c; if (L >= nwg) return false;
        int wgid = (int)L; { const int q = nwg / NXCD, r = nwg % NXCD, xcd = wgid % NXCD, off = wgid / NXCD; wgid = (xcd < r ? xcd * (q + 1) : r * (q + 1) + (xcd - r) * q) + off; }
        const int nig = WGM * nN, gid = wgid / nig, fm = gid * WGM, gsz = (nM - fm) < WGM ? (nM - fm) : WGM;
        u.pm = fm + ((wgid % nig) % gsz); u.pn = (wgid % nig) / gsz; u.pb = u.pn; u.aux0 = 0; u.aux1 = 0; return true;
    }
    __device__ __forceinline__ void a_ready(const Unit&) const {}
    __device__ __forceinline__ void done(const Unit&) const {}
};

__device__ __forceinline__ unsigned cvt_pk_bf16(float lo, float hi) { unsigned r; asm volatile("v_cvt_pk_bf16_f32 %0, %1, %2" : "=v"(r) : "v"(lo), "v"(hi)); return r; }
typedef float f32x2 __attribute__((ext_vector_type(2)));
#define PG8_FRESH_LANE(fr, fq) int l__; asm volatile("v_mbcnt_lo_u32_b32 %0, -1, 0\n\tv_mbcnt_hi_u32_b32 %0, -1, %0" : "=v"(l__)); const int fr = l__ & 15, fq = l__ >> 4; (void)fr_; (void)fq_
typedef unsigned u32x2 __attribute__((ext_vector_type(2)));
__device__ __forceinline__ float bf_lo(unsigned w) { return __uint_as_float(w << 16); }
__device__ __forceinline__ float bf_hi(unsigned w) { return __uint_as_float(w & 0xffff0000u); }

struct EpiQKV {
    static constexpr bool PERM = true, AFTER_DRAIN = false;
    bf16_t* O; const float* rope;
    __device__ __forceinline__ void operator()(const f32x4 (&acc)[2][2][4][2], const Unit& u, int wr, int wc, int fr_, int fq_) const {
        PG8_FRESH_LANE(fr, fq);
        const int row0 = u.pm * BM + wr * 64 + fr, col0 = u.pn * BM + wc * 32 + 8 * fq;
        const bool rot = (u.pn >= 12) && (u.pn < 20) && ((wc & 1) == 0);
#pragma unroll
        for (int ai = 0; ai < 2; ++ai)
#pragma unroll
            for (int m = 0; m < 4; ++m) { const int row = row0 + ai * HALF + m * 16; bf16_t* rowp = O + (size_t)row * 6144 + col0;
                f32x4 c0 = {1.f, 1.f, 1.f, 1.f}, c1 = c0, s0 = {0.f, 0.f, 0.f, 0.f}, s1 = s0;
                if (rot) { const float* t = rope + (size_t)(row & 8191) * 16; c0 = *(const f32x4*)(t); c1 = *(const f32x4*)(t + 4); s0 = *(const f32x4*)(t + 8); s1 = *(const f32x4*)(t + 12);
                    if (fq == 0) { s0 = -s0; s1 = -s1; } else if (fq != 1) { s0 = (f32x4){0.f, 0.f, 0.f, 0.f}; s1 = s0; c0 = (f32x4){1.f, 1.f, 1.f, 1.f}; c1 = c0; } }
#pragma unroll
                for (int bj = 0; bj < 2; ++bj) { f32x4 v0 = acc[ai][bj][m][0], v1 = acc[ai][bj][m][1];
                    if (rot) { f32x4 p0, p1;
#pragma unroll
                        for (int j = 0; j < 4; ++j) { p0[j] = __shfl_xor(v0[j], 16); p1[j] = __shfl_xor(v1[j], 16); }
                        v0 = v0 * c0 + p0 * s0; v1 = v1 * c1 + p1 * s1; }
                    u32x4 w; w.x = cvt_pk_bf16(v0[0], v0[1]); w.y = cvt_pk_bf16(v0[2], v0[3]); w.z = cvt_pk_bf16(v1[0], v1[1]); w.w = cvt_pk_bf16(v1[2], v1[3]);
                    *(u32x4*)(rowp + bj * HALF) = w; } }
    }
};
struct EpiBf16 {
    static constexpr bool PERM = true, AFTER_DRAIN = false;
    bf16_t* O; int ldc;
    __device__ __forceinline__ void operator()(const f32x4 (&acc)[2][2][4][2], const Unit& u, int wr, int wc, int fr_, int fq_) const {
        PG8_FRESH_LANE(fr, fq);
        const int row0 = u.pm * BM + wr * 64 + fr, col0 = u.pn * BM + wc * 32 + 8 * fq;
#pragma unroll
        for (int ai = 0; ai < 2; ++ai)
#pragma unroll
            for (int m = 0; m < 4; ++m) { bf16_t* rowp = O + (size_t)(row0 + ai * HALF + m * 16) * ldc + col0;
#pragma unroll
                for (int bj = 0; bj < 2; ++bj) { const f32x4 v0 = acc[ai][bj][m][0], v1 = acc[ai][bj][m][1];
                    u32x4 w; w.x = cvt_pk_bf16(v0[0], v0[1]); w.y = cvt_pk_bf16(v0[2], v0[3]); w.z = cvt_pk_bf16(v1[0], v1[1]); w.w = cvt_pk_bf16(v1[2], v1[3]);
                    *(u32x4*)(rowp + bj * HALF) = w; } }
    }
};
struct EpiResF32 {
    static constexpr bool PERM = false, AFTER_DRAIN = false;
    const float* base; float* out; int ldc;
    __device__ __forceinline__ void operator()(const f32x4 (&acc)[2][2][4][2], const Unit& u, int wr, int wc, int fr_, int fq_) const {
        PG8_FRESH_LANE(fr, fq);
        const int row0 = u.pm * BM + wr * 64 + fr, col0 = u.pn * BM + wc * 32 + 4 * fq;
#pragma unroll
        for (int ai = 0; ai < 2; ++ai)
#pragma unroll
            for (int m = 0; m < 4; ++m) { const size_t off = (size_t)(row0 + ai * HALF + m * 16) * ldc + col0;
#pragma unroll
                for (int bj = 0; bj < 2; ++bj)
#pragma unroll
                    for (int n = 0; n < 2; ++n) { const f32x4 b = *(const f32x4*)(base + off + bj * HALF + n * 16); *(f32x4*)(out + off + bj * HALF + n * 16) = b + acc[ai][bj][m][n]; }
                asm volatile("" ::: "memory"); }
    }
};
struct EpiPle {
    static constexpr bool PERM = false, AFTER_DRAIN = false;
    float* io; const bf16_t* U; int ldc;
    __device__ __forceinline__ void operator()(const f32x4 (&acc)[2][2][4][2], const Unit& u, int wr, int wc, int fr_, int fq_) const {
        PG8_FRESH_LANE(fr, fq);
        const int row0 = u.pm * BM + wr * 64 + fr, col0 = u.pn * BM + wc * 32 + 4 * fq;
#pragma unroll
        for (int ai = 0; ai < 2; ++ai)
#pragma unroll
            for (int m = 0; m < 4; ++m) { const size_t off = (size_t)(row0 + ai * HALF + m * 16) * ldc + col0;
#pragma unroll
                for (int bj = 0; bj < 2; ++bj)
#pragma unroll
                    for (int n = 0; n < 2; ++n) { const size_t o = off + bj * HALF + n * 16; const f32x4 b = *(const f32x4*)(io + o); const u32x2 uw = *(const u32x2*)(U + o); const f32x4 a = acc[ai][bj][m][n];
                        f32x4 r; r[0] = b[0] + bf_lo(uw.x) * __builtin_amdgcn_rcpf(1.f + __builtin_amdgcn_exp2f(-1.4426950408889634f * a[0]));
                        r[1] = b[1] + bf_hi(uw.x) * __builtin_amdgcn_rcpf(1.f + __builtin_amdgcn_exp2f(-1.4426950408889634f * a[1]));
                        r[2] = b[2] + bf_lo(uw.y) * __builtin_amdgcn_rcpf(1.f + __builtin_amdgcn_exp2f(-1.4426950408889634f * a[2]));
                        r[3] = b[3] + bf_hi(uw.y) * __builtin_amdgcn_rcpf(1.f + __builtin_amdgcn_exp2f(-1.4426950408889634f * a[3]));
                        *(f32x4*)(io + o) = r; }
                asm volatile("" ::: "memory"); }
    }
};
struct EpiResBf16 {
    static constexpr bool PERM = true, AFTER_DRAIN = false;
    const float* base; bf16_t* O;
    __device__ __forceinline__ void operator()(const f32x4 (&acc)[2][2][4][2], const Unit& u, int wr, int wc, int fr_, int fq_) const {
        PG8_FRESH_LANE(fr, fq);
        const int row0 = u.pm * BM + wr * 64 + fr, col0 = u.pn * BM + wc * 32 + 8 * fq;
#pragma unroll
        for (int ai = 0; ai < 2; ++ai)
#pragma unroll
            for (int m = 0; m < 4; ++m) { const size_t off = (size_t)(row0 + ai * HALF + m * 16) * 2048 + col0;
#pragma unroll
                for (int bj = 0; bj < 2; ++bj) { const f32x4 b0 = *(const f32x4*)(base + off + bj * HALF), b1 = *(const f32x4*)(base + off + bj * HALF + 4);
                    const f32x4 v0 = acc[ai][bj][m][0] + b0, v1 = acc[ai][bj][m][1] + b1;
                    u32x4 w; w.x = cvt_pk_bf16(v0[0], v0[1]); w.y = cvt_pk_bf16(v0[2], v0[3]); w.z = cvt_pk_bf16(v1[0], v1[1]); w.w = cvt_pk_bf16(v1[2], v1[3]);
                    *(u32x4*)(O + off + bj * HALF) = w; }
                asm volatile("" ::: "memory"); }
    }
};
struct EpiPle2 {
    static constexpr bool PERM = true, AFTER_DRAIN = false;
    bf16_t* Hs; const bf16_t* Y; const bf16_t* U;
    __device__ __forceinline__ void operator()(const f32x4 (&acc)[2][2][4][2], const Unit& u, int wr, int wc, int fr_, int fq_) const {
        PG8_FRESH_LANE(fr, fq);
        const int row0 = u.pm * BM + wr * 64 + fr, col0 = u.pn * BM + wc * 32 + 8 * fq;
#pragma unroll
        for (int ai = 0; ai < 2; ++ai)
#pragma unroll
            for (int m = 0; m < 4; ++m) { const size_t row = (size_t)(row0 + ai * HALF + m * 16); const size_t off = row * 2048 + col0;
#pragma unroll
                for (int bj = 0; bj < 2; ++bj) { const size_t o = off + bj * HALF;
                    const u32x4 hw = *(const u32x4*)(Hs + o), uw = *(const u32x4*)(U + o), ya = *(const u32x4*)(Y + 2 * row * 2048 + col0 + bj * HALF), yb = *(const u32x4*)(Y + (2 * row + 1) * 2048 + col0 + bj * HALF);
                    float r[8];
#pragma unroll
                    for (int q = 0; q < 4; ++q) { const float a0 = acc[ai][bj][m][q >> 1][(q & 1) * 2], a1 = acc[ai][bj][m][q >> 1][(q & 1) * 2 + 1];
                        const float s0 = __builtin_amdgcn_rcpf(1.f + __builtin_amdgcn_exp2f(-1.4426950408889634f * a0)), s1 = __builtin_amdgcn_rcpf(1.f + __builtin_amdgcn_exp2f(-1.4426950408889634f * a1));
                        r[2 * q] = (bf_lo(hw[q]) + (bf_lo(ya[q]) + bf_lo(yb[q]))) + bf_lo(uw[q]) * s0; r[2 * q + 1] = (bf_hi(hw[q]) + (bf_hi(ya[q]) + bf_hi(yb[q]))) + bf_hi(uw[q]) * s1; }
                    u32x4 w; w.x = cvt_pk_bf16(r[0], r[1]); w.y = cvt_pk_bf16(r[2], r[3]); w.z = cvt_pk_bf16(r[4], r[5]); w.w = cvt_pk_bf16(r[6], r[7]);
                    *(u32x4*)(Hs + o) = w; }
                asm volatile("" ::: "memory"); }
    }
};
struct EpiSwiglu {
    static constexpr bool PERM = true, AFTER_DRAIN = false;
    bf16_t* H;
    __device__ __forceinline__ void operator()(const f32x4 (&acc)[2][2][4][2], const Unit& u, int wr, int wc, int fr_, int fq_) const {
        PG8_FRESH_LANE(fr, fq);
        const int row0 = u.pm * BM + wr * 64 + fr, col0 = u.pn * HALF + wc * 32 + 8 * fq;
#pragma unroll
        for (int ai = 0; ai < 2; ++ai)
#pragma unroll
            for (int m = 0; m < 4; ++m) { bf16_t* rowp = H + (size_t)(row0 + ai * HALF + m * 16) * 512 + col0; float h[8];
#pragma unroll
                for (int n = 0; n < 2; ++n)
#pragma unroll
                    for (int j = 0; j < 4; ++j) { const float g = acc[ai][0][m][n][j], up = acc[ai][1][m][n][j];
                        h[n * 4 + j] = g * up * __builtin_amdgcn_rcpf(1.f + __builtin_amdgcn_exp2f(-1.4426950408889634f * g)); }
                u32x4 w; w.x = cvt_pk_bf16(h[0], h[1]); w.y = cvt_pk_bf16(h[2], h[3]); w.z = cvt_pk_bf16(h[4], h[5]); w.w = cvt_pk_bf16(h[6], h[7]);
                *(u32x4*)rowp = w; asm volatile("" ::: "memory"); }
    }
};
struct EpiScatter {
    static constexpr bool PERM = true, AFTER_DRAIN = false;
    bf16_t* Y; const int* lslot; const float* lgate;
    __device__ __forceinline__ void operator()(const f32x4 (&acc)[2][2][4][2], const Unit& u, int wr, int wc, int fr_, int fq_) const {
        PG8_FRESH_LANE(fr, fq);
        const int r0 = wr * 64 + fr, col0 = u.pn * BM + wc * 32 + 8 * fq;
#pragma unroll
        for (int ai = 0; ai < 2; ++ai)
#pragma unroll
            for (int m = 0; m < 4; ++m) { const int r = r0 + ai * HALF + m * 16;
                if (r < u.aux1) { const int slot = lslot[u.aux0 + r]; const float g = lgate[u.aux0 + r]; bf16_t* rowp = Y + (size_t)slot * 2048 + col0;
#pragma unroll
                    for (int bj = 0; bj < 2; ++bj) { const f32x4 v0 = acc[ai][bj][m][0] * g, v1 = acc[ai][bj][m][1] * g;
                        u32x4 w; w.x = cvt_pk_bf16(v0[0], v0[1]); w.y = cvt_pk_bf16(v0[2], v0[3]); w.z = cvt_pk_bf16(v1[0], v1[1]); w.w = cvt_pk_bf16(v1[2], v1[3]);
                        *(u32x4*)(rowp + bj * HALF) = w; } }
                asm volatile("" ::: "memory"); }
    }
};
struct MoeOrder {
    int nM, nN, nwg, G, c; const PG8_LAS int* tstart; const PG8_LAS int* cnt;
    __device__ void init(int nM_, int nN_, int G_, int c_, const PG8_LAS int* ts, const PG8_LAS int* cn) { nM = nM_; nN = nN_; nwg = nM * nN; G = G_; c = c_; tstart = ts; cnt = cn; }
    __device__ bool next(int i, Unit& u) const {
        const long L = (long)i * G + c; if (L >= nwg) return false;
        int wgid = (int)L; { const int q = nwg / NXCD, r = nwg % NXCD, xcd = wgid % NXCD, off = wgid / NXCD; wgid = (xcd < r ? xcd * (q + 1) : r * (q + 1) + (xcd - r) * q) + off; }
        const int nig = WGM * nN, gid = wgid / nig, fm = gid * WGM, gsz = (nM - fm) < WGM ? (nM - fm) : WGM;
        const int pm = fm + ((wgid % nig) % gsz), pn = (wgid % nig) / gsz;
        int e = 0;
        for (int k = 1; k < 32; ++k) e += (__builtin_amdgcn_readfirstlane(tstart[k]) <= pm) ? 1 : 0;
        const int t = pm - __builtin_amdgcn_readfirstlane(tstart[e]); const int left = __builtin_amdgcn_readfirstlane(cnt[e]) - t * 256;
        u.pm = pm; u.pn = pn; u.pb = e * nN + pn; u.aux0 = e * 65536 + t * 256; u.aux1 = left < 256 ? left : 256; return true;
    }
    __device__ __forceinline__ void a_ready(const Unit&) const {}
    __device__ __forceinline__ void done(const Unit&) const {}
};
template <class Epi, class Sched, bool ALIGN_EPI = false, bool SP2 = false, bool GATHER = false>
__device__ __forceinline__ void gemm_phase(PG8_LAS unsigned char* lds, const Gemm g, const Sched& S, const Epi& E) {
    const int tid = threadIdx.x, wid = __builtin_amdgcn_readfirstlane(tid >> 6), lane = tid & 63, wr = wid >> 2, wc = wid & 3, fr = lane & 15, fq = lane >> 4;
    const int K = g.K, nt = K / BK;
    unsigned voffA[2], voffB[2];
#pragma unroll
    for (int i = 0; i < 2; ++i) { int R, C; stage_rc(tid * 16 + i * 8192, R, C); const int Rb = Epi::PERM ? ((R & ~31) + perm32(R & 31)) : R;
        voffA[i] = (unsigned)(R * K + C) * 2u; voffB[i] = (unsigned)(Rb * K + C) * 2u; }
    const size_t kstep = (size_t)(BK * 2);
    const size_t hstep = (size_t)HALF * K * 2;
    const size_t tstep = 2 * hstep;
    const unsigned ldsw = (unsigned)wid * 1024u;
    const int aoff = lds_byte(wr * 64 + fr, fq * 8), boff = lds_byte(wc * 32 + fr, fq * 8);
#define PG8_SA(b, h) (((b) * 2 + (h)) * HTB)
#define PG8_SB(b, h) ((4 + (b) * 2 + (h)) * HTB)
#define PG8_STAGE(bufoff, gbase, voff) do { _Pragma("unroll") for (int _i = 0; _i < 2; ++_i) \
        __builtin_amdgcn_global_load_lds((const unsigned*)((const char*)(gbase) + (voff)[_i]), (PG8_LAS unsigned*)(lds + (bufoff) + ldsw + _i * 8192), 16, 0, 0); } while (0)
#define PG8_STAGE_A(bufoff, nextsel, half, kb) do { _Pragma("unroll") for (int _i = 0; _i < 2; ++_i) { const char* _p; \
        if constexpr (GATHER) _p = (const char*)g.A + (kb) + ((nextsel) ? nx[half][_i] : cu[half][_i]); else _p = ((nextsel) ? nA : cA) + (kb) + (size_t)(half) * hstep + voffA[_i]; \
        __builtin_amdgcn_global_load_lds((const unsigned*)_p, (PG8_LAS unsigned*)(lds + (bufoff) + ldsw + _i * 8192), 16, 0, 0); } } while (0)
#define PG8_ROWS(u, o) do { _Pragma("unroll") for (int _h = 0; _h < 2; ++_h) _Pragma("unroll") for (int _i = 0; _i < 2; ++_i) { const int _r = _h * HALF + (int)(voffA[_i] / (2u * (unsigned)K)); \
        const int _t = (_r < (u).aux1) ? (g.glist[(u).aux0 + _r] >> 1) : 0; o[_h][_i] = (unsigned)_t * (2u * (unsigned)K) + (voffA[_i] % (2u * (unsigned)K)); } } while (0)
#define PG8_LDA(dst, b, h) do { _Pragma("unroll") for (int m = 0; m < 4; ++m) _Pragma("unroll") for (int k = 0; k < 2; ++k) dst[m][k] = *(const PG8_LAS bf16x8*)(lds + PG8_SA(b, h) + aoff + m * 2048 + k * 1024); } while (0)
#define PG8_LDB(dst, b, h) do { _Pragma("unroll") for (int n = 0; n < 2; ++n) _Pragma("unroll") for (int k = 0; k < 2; ++k) dst[n][k] = *(const PG8_LAS bf16x8*)(lds + PG8_SB(b, h) + boff + n * 2048 + k * 1024); } while (0)
#define PG8_MMA(ai, bj, At, Bt) do { __builtin_amdgcn_s_setprio(1); _Pragma("unroll") for (int m = 0; m < 4; ++m) _Pragma("unroll") for (int n = 0; n < 2; ++n) _Pragma("unroll") for (int k = 0; k < 2; ++k) \
        acc[ai][bj][m][n] = __builtin_amdgcn_mfma_f32_16x16x32_bf16(Bt[n][k], At[m][k], acc[ai][bj][m][n], 0, 0, 0); __builtin_amdgcn_s_setprio(0); } while (0)
#define PG8_WAIT_V(n) asm volatile("s_waitcnt vmcnt(" #n ")" ::: "memory")
#define PG8_WAIT_L(n) asm volatile("s_waitcnt lgkmcnt(" #n ")" ::: "memory")
#define PG8_BAR __builtin_amdgcn_s_barrier()
#define PG8_SCHED __builtin_amdgcn_sched_barrier(0)
    Unit cur, nxt; int ui = 0;
    if (!S.next(0, cur)) return;
    f32x4 acc[2][2][4][2];
#pragma unroll
    for (int a = 0; a < 2; ++a)
#pragma unroll
        for (int b = 0; b < 2; ++b)
#pragma unroll
            for (int m = 0; m < 4; ++m)
#pragma unroll
                for (int n = 0; n < 2; ++n) acc[a][b][m][n] = (f32x4){0.f, 0.f, 0.f, 0.f};
    bf16x8 At[4][2], B0[2][2], B1[2][2];
    const char* cA = (const char*)g.A + (size_t)cur.pm * tstep; const char* cB = (const char*)g.Bt + (size_t)cur.pb * tstep;
    S.a_ready(cur);
    unsigned cu[2][2] = {{0u, 0u}, {0u, 0u}}, nx[2][2] = {{0u, 0u}, {0u, 0u}}; const char* nA = cA;
    if constexpr (GATHER) PG8_ROWS(cur, cu);
    if constexpr (SP2) {
        PG8_STAGE(PG8_SB(0, 0), cB, voffB); PG8_STAGE(PG8_SB(0, 1), cB + hstep, voffB); PG8_STAGE_A(PG8_SA(0, 0), false, 0, 0); PG8_STAGE_A(PG8_SA(0, 1), false, 1, 0);
        if (wr == 1) PG8_BAR;
        PG8_WAIT_V(2); PG8_BAR;
        PG8_STAGE(PG8_SB(1, 0), cB + kstep, voffB); PG8_STAGE_A(PG8_SA(1, 0), false, 0, kstep); PG8_STAGE(PG8_SB(1, 1), cB + hstep + kstep, voffB);
        PG8_WAIT_V(6); PG8_BAR;
    } else { static_assert(SP2, "only the SP2 loop is kept in this file"); }
    for (;;) {
        const bool has_next = S.next(ui + 1, nxt);
        nA = has_next ? (const char*)g.A + (size_t)nxt.pm * tstep : cA;
        if constexpr (GATHER) { if (has_next) PG8_ROWS(nxt, nx); else { nx[0][0] = cu[0][0]; nx[0][1] = cu[0][1]; nx[1][0] = cu[1][0]; nx[1][1] = cu[1][1]; } }
        const char* nB = has_next ? (const char*)g.Bt + (size_t)nxt.pb * tstep : cB;
#pragma unroll 1
        for (int t = 0; t < nt; t += 2) {
            const bool last = (t == nt - 2);
            const size_t kb1 = (size_t)(t + 1) * kstep;
            const size_t kb2 = last ? 0 : (size_t)(t + 2) * kstep; const char* b2 = last ? nB : cB + (size_t)(t + 2) * kstep;
            const size_t kb3 = kb2 + kstep; const char* b3 = b2 + kstep;
            if (last && has_next) S.a_ready(nxt);
            if constexpr (SP2) {
            PG8_LDB(B0, 0, 0); PG8_LDB(B1, 0, 1); PG8_SCHED; PG8_LDA(At, 0, 0); PG8_STAGE_A(PG8_SA(1, 1), false, 1, kb1);
            PG8_WAIT_V(8); PG8_WAIT_L(0); PG8_BAR; PG8_MMA(0, 0, At, B0); PG8_MMA(0, 1, At, B1); PG8_BAR; PG8_SCHED;
            PG8_LDA(At, 0, 1); PG8_STAGE(PG8_SB(0, 0), b2, voffB); PG8_STAGE(PG8_SB(0, 1), b2 + hstep, voffB); PG8_STAGE_A(PG8_SA(0, 0), last, 0, kb2);
            PG8_WAIT_V(8); PG8_WAIT_L(0); PG8_BAR; PG8_MMA(1, 0, At, B0); PG8_MMA(1, 1, At, B1); PG8_BAR; PG8_SCHED;
            PG8_LDB(B0, 1, 0); PG8_LDB(B1, 1, 1); PG8_SCHED; PG8_LDA(At, 1, 0); PG8_STAGE_A(PG8_SA(0, 1), last, 1, kb2);
            PG8_WAIT_V(8); PG8_WAIT_L(0); PG8_BAR; PG8_MMA(0, 0, At, B0); PG8_MMA(0, 1, At, B1); PG8_BAR; PG8_SCHED;
            PG8_LDA(At, 1, 1); PG8_STAGE(PG8_SB(1, 0), b3, voffB); PG8_STAGE(PG8_SB(1, 1), b3 + hstep, voffB); PG8_STAGE_A(PG8_SA(1, 0), last, 0, kb3);
            PG8_WAIT_V(8); PG8_WAIT_L(0); PG8_BAR; PG8_MMA(1, 0, At, B0); PG8_MMA(1, 1, At, B1); PG8_BAR; PG8_SCHED;
            }
        }
        if constexpr (ALIGN_EPI) { if (wr == 0) PG8_BAR; }
        if constexpr (!Epi::AFTER_DRAIN) { E(acc, cur, wr, wc, fr, fq); S.done(cur); }
        if (!has_next) break;
#pragma unroll
        for (int a = 0; a < 2; ++a)
#pragma unroll
            for (int b = 0; b < 2; ++b)
#pragma unroll
                for (int m = 0; m < 4; ++m)
#pragma unroll
                    for (int n = 0; n < 2; ++n) acc[a][b][m][n] = (f32x4){0.f, 0.f, 0.f, 0.f};
        cur = nxt; cA = nA; cB = nB; ++ui;
        if constexpr (GATHER) { cu[0][0] = nx[0][0]; cu[0][1] = nx[0][1]; cu[1][0] = nx[1][0]; cu[1][1] = nx[1][1]; }
        if constexpr (ALIGN_EPI) { if (wr == 1) PG8_BAR; }
    }
    PG8_WAIT_V(0);
    if constexpr (!ALIGN_EPI) { if (wr == 0) PG8_BAR; }
    PG8_BAR;
    if constexpr (Epi::AFTER_DRAIN) { E.fused(acc, cur, wr, wc, fr, fq, lds, wid, lane); S.done(cur); }
#undef PG8_SA
#undef PG8_SB
#undef PG8_STAGE
#undef PG8_STAGE_A
#undef PG8_ROWS
#undef PG8_LDA
#undef PG8_LDB
#undef PG8_MMA
#undef PG8_WAIT_V
#undef PG8_WAIT_L
#undef PG8_BAR
#undef PG8_SCHED
}
}
namespace att {
using bf16 = unsigned short;
using bf16x8 = __attribute__((ext_vector_type(8))) short;
using s16x4  = __attribute__((ext_vector_type(4))) short;
using f32x16 = __attribute__((ext_vector_type(16))) float;
using u32x4  = __attribute__((ext_vector_type(4))) unsigned;
constexpr int LDQKV = 6144;
constexpr int SEQ_ = 8192;
constexpr size_t SHM_V = 64 * 128 * 2, SHM_K = 64 * 128 * 2, SHM_ATTN = 2 * SHM_V + 2 * SHM_K + 8 * 64 * 4 + 64;
#define KSWZ(row, colB) ((row) * 256 + ((colB) ^ (((row) & 7) << 4)))
#define SBAR() __builtin_amdgcn_sched_barrier(0)
__device__ __forceinline__ int crow(int r, int hi) { return (r & 3) + 8 * (r >> 2) + 4 * hi; }
__device__ __forceinline__ unsigned cvtpk(float lo, float hi) { unsigned r; asm volatile("v_cvt_pk_bf16_f32 %0, %1, %2" : "=v"(r) : "v"(lo), "v"(hi)); return r; }
__device__ __forceinline__ int v_st(int k, int c) { const int kk = (k & ~0xC) | ((k & 4) << 1) | ((k & 8) >> 1); return ((kk >> 3) * 4 + (c >> 5)) * 512 + ((kk & 7) * 32 + (c & 31)) * 2; }
__device__ __forceinline__ int v_rd_base(int lane) { return ((lane & 3) << 3) | (((lane >> 2) & 3) << 6) | (((lane >> 4) & 1) << 5) | (((lane >> 5) & 1) << 8); }
constexpr int v_rd_off(int d0, int ks, int half) { return d0 * 512 + ks * 4096 + half * 2048; }
template <int OFF> __device__ __forceinline__ s16x4 tr_read(int vb) { s16x4 r; asm volatile("ds_read_b64_tr_b16 %0, %1 offset:%2" : "=&v"(r) : "v"(vb), "i"(OFF) : "memory"); return r; }
template <int D0> __device__ __forceinline__ void pv_one(f32x16& od, int vb, bf16x8 pa0, bf16x8 pa1, bf16x8 pa2, bf16x8 pa3) {
  const s16x4 l0 = tr_read<v_rd_off(D0, 0, 0)>(vb), h0 = tr_read<v_rd_off(D0, 0, 1)>(vb), l1 = tr_read<v_rd_off(D0, 1, 0)>(vb), h1 = tr_read<v_rd_off(D0, 1, 1)>(vb);
  const s16x4 l2 = tr_read<v_rd_off(D0, 2, 0)>(vb), h2 = tr_read<v_rd_off(D0, 2, 1)>(vb), l3 = tr_read<v_rd_off(D0, 3, 0)>(vb), h3 = tr_read<v_rd_off(D0, 3, 1)>(vb);
  asm volatile("s_waitcnt lgkmcnt(0)" ::: "memory"); SBAR();
#define PK(L, H) (bf16x8){L[0], L[1], L[2], L[3], H[0], H[1], H[2], H[3]}
  od = __builtin_amdgcn_mfma_f32_32x32x16_bf16(pa0, PK(l0, h0), od, 0, 0, 0);
  od = __builtin_amdgcn_mfma_f32_32x32x16_bf16(pa1, PK(l1, h1), od, 0, 0, 0);
  od = __builtin_amdgcn_mfma_f32_32x32x16_bf16(pa2, PK(l2, h2), od, 0, 0, 0);
  od = __builtin_amdgcn_mfma_f32_32x32x16_bf16(pa3, PK(l3, h3), od, 0, 0, 0);
#undef PK
}
__device__ __forceinline__ void pv_d0(f32x16* o, int vb, bf16x8 pa0, bf16x8 pa1, bf16x8 pa2, bf16x8 pa3) {
  pv_one<0>(o[0], vb, pa0, pa1, pa2, pa3); pv_one<1>(o[1], vb, pa0, pa1, pa2, pa3); pv_one<2>(o[2], vb, pa0, pa1, pa2, pa3); pv_one<3>(o[3], vb, pa0, pa1, pa2, pa3);
}
__device__ __forceinline__ void pack_p(const f32x16& p0, const f32x16& p1, bf16x8& pa0, bf16x8& pa1, bf16x8& pa2, bf16x8& pa3) {
#define PK4(P, BASE, OUT) do { unsigned a0 = cvtpk(P[BASE + 0], P[BASE + 1]), a1 = cvtpk(P[BASE + 2], P[BASE + 3]);   \
    unsigned b0 = cvtpk(P[BASE + 4], P[BASE + 5]), b1 = cvtpk(P[BASE + 6], P[BASE + 7]);                              \
    auto r0 = __builtin_amdgcn_permlane32_swap(a0, b0, false, false); auto r1 = __builtin_amdgcn_permlane32_swap(a1, b1, false, false); \
    u32x4 w = {r0[0], r1[0], r0[1], r1[1]}; OUT = *reinterpret_cast<bf16x8*>(&w); } while (0)
  PK4(p0, 0, pa0); PK4(p0, 8, pa1); PK4(p1, 0, pa2); PK4(p1, 8, pa3);
#undef PK4
}
template <int ND> __device__ __forceinline__ void qkt(f32x16& p0, f32x16& p1, const char* Ks, const bf16x8* qr, int cb0, int r32, int hi) {
  p0 = f32x16{}; p1 = f32x16{};
#pragma unroll
  for (int d0 = 0; d0 < ND; ++d0) { const int cb = cb0 + (d0 * 16 + hi * 8) * 2;
    const bf16x8 b0 = *reinterpret_cast<const bf16x8*>(Ks + KSWZ(r32, cb));
    const bf16x8 b1 = *reinterpret_cast<const bf16x8*>(Ks + KSWZ(32 + r32, cb));
    p0 = __builtin_amdgcn_mfma_f32_32x32x16_bf16(b0, qr[d0], p0, 0, 0, 0);
    p1 = __builtin_amdgcn_mfma_f32_32x32x16_bf16(b1, qr[d0], p1, 0, 0, 0); }
}
constexpr float THRL = 11.5f;
__device__ __forceinline__ void partialSM(f32x16& p0, f32x16& p1, float& m_reg, float& mn, float& alpha) {
  float pmax = p0[0];
#pragma unroll
  for (int r = 1; r < 16; ++r) pmax = fmaxf(pmax, p0[r]);
#pragma unroll
  for (int r = 0; r < 16; ++r) pmax = fmaxf(pmax, p1[r]);
  { auto rr = __builtin_amdgcn_permlane32_swap(__float_as_uint(pmax), __float_as_uint(pmax), false, false); pmax = fmaxf(__uint_as_float(rr[0]), __uint_as_float(rr[1])); }
  if (__builtin_expect(__all(pmax - m_reg <= THRL), 1)) { mn = m_reg; alpha = 1.f; }
  else { mn = fmaxf(m_reg, pmax); alpha = __builtin_amdgcn_exp2f(m_reg - mn); m_reg = mn; }
#pragma unroll
  for (int r = 0; r < 16; ++r) p0[r] = p0[r] - mn;
#pragma unroll
  for (int r = 0; r < 16; ++r) p1[r] = p1[r] - mn;
#pragma unroll
  for (int r = 0; r < 16; ++r) p0[r] = __builtin_amdgcn_exp2f(p0[r]);
}
__device__ __forceinline__ void finishSM(f32x16& p0, f32x16& p1, float alpha, float& l_reg, bf16x8& pa0, bf16x8& pa1, bf16x8& pa2, bf16x8& pa3) {
#pragma unroll
  for (int r = 0; r < 16; ++r) p1[r] = __builtin_amdgcn_exp2f(p1[r]);
  float ps = 0;
#pragma unroll
  for (int r = 0; r < 16; ++r) ps += p0[r];
#pragma unroll
  for (int r = 0; r < 16; ++r) ps += p1[r];
  { auto rr = __builtin_amdgcn_permlane32_swap(__float_as_uint(ps), __float_as_uint(ps), false, false); ps = __uint_as_float(rr[0]) + __uint_as_float(rr[1]); }
  l_reg = l_reg * alpha + ps;
  pack_p(p0, p1, pa0, pa1, pa2, pa3);
}
__device__ __forceinline__ float half_sum32(float v) {
#pragma unroll
  for (int o = 1; o < 32; o <<= 1) v += __shfl_xor(v, o);
  return v;
}

__device__ __forceinline__ void diff_unit(int b, int h, int qb, const bf16* __restrict__ QKV, bf16* __restrict__ Oout, const float* __restrict__ gdiff, float lam, float oscale, char* lds) {
  const int tid = threadIdx.x, lane = tid & 63, r32 = lane & 31, hi = lane >> 5; const int wid = __builtin_amdgcn_readfirstlane(tid >> 6);
  const int map = wid >> 2, wq = wid & 3;
  bf16* V_lds = (bf16*)lds; bf16* K_lds = (bf16*)(lds + 2 * SHM_V);
  float* ws = (float*)(lds + 2 * SHM_V + 2 * SHM_K) + wid * 64; float* li_l = ws; float* al_l = ws + 32;
  float m_reg = -1e30f, l_reg = 0; f32x16 o[4] = {}; bf16x8 qr[4];
  const size_t rowb = (size_t)b * SEQ_;
  const bf16* Qw = QKV + (rowb + qb * 128 + wq * 32 + r32) * LDQKV + 3072 + h * 128 + map * 64 + hi * 8;
#pragma unroll
  for (int d0 = 0; d0 < 4; ++d0) qr[d0] = *reinterpret_cast<const bf16x8*>(Qw + d0 * 16);
  const bf16* Kh = QKV + rowb * LDQKV + 4096 + h * 128; const bf16* Vh = QKV + rowb * LDQKV + 5120 + h * 128;
  const int sr = tid >> 4, sc = (tid & 15) * 8, vst0 = v_st(sr, sc), vst1 = v_st(32 + sr, sc);
  const int vb0 = (int)(uintptr_t)V_lds + v_rd_base(lane);
  const int cbm = map * 128;
  struct { bf16x8 vs0, vs1, ks0, ks1; } sr_[1];
  const unsigned toff0 = (unsigned)(sr * LDQKV + sc), toff1 = toff0 + 32u * LDQKV;
#define SLOAD(i, k0) do { const bf16* vt_ = Vh + (size_t)(k0) * LDQKV; const bf16* kt_ = Kh + (size_t)(k0) * LDQKV; \
    sr_[i].vs0 = *reinterpret_cast<const bf16x8*>(vt_ + toff0); sr_[i].vs1 = *reinterpret_cast<const bf16x8*>(vt_ + toff1); \
    sr_[i].ks0 = *reinterpret_cast<const bf16x8*>(kt_ + toff0); sr_[i].ks1 = *reinterpret_cast<const bf16x8*>(kt_ + toff1); } while (0)
#define SWRITE(bb, i) do { *(bf16x8*)((char*)V_lds + (bb) * SHM_V + vst0) = sr_[i].vs0; *(bf16x8*)((char*)V_lds + (bb) * SHM_V + vst1) = sr_[i].vs1; const int kc = sc * 2; \
    *(bf16x8*)((char*)K_lds + (bb) * SHM_K + KSWZ(sr, kc)) = sr_[i].ks0; *(bf16x8*)((char*)K_lds + (bb) * SHM_K + KSWZ(32 + sr, kc)) = sr_[i].ks1; } while (0)
#define SWAIT() asm volatile("s_waitcnt vmcnt(0)" ::: "memory")
#define RESC(a) do { if (__any((a) < 1.f)) { if (hi == 0) al_l[r32] = (a); asm volatile("s_waitcnt lgkmcnt(0)" ::: "memory"); \
    _Pragma("unroll") for (int d = 0; d < 4; ++d) _Pragma("unroll") for (int r = 0; r < 16; ++r) o[d][r] *= al_l[crow(r, hi)]; } } while (0)
  f32x16 pA0, pA1, pB0, pB1; float mnA, mnB, alA, alB; bf16x8 pa0, pa1, pa2, pa3; const int NT = 2 * qb + 2;
  __syncthreads();
  SLOAD(0, 0); asm volatile("s_waitcnt vmcnt(0)" ::: "memory"); SWRITE(0, 0); __syncthreads();
  qkt<4>(pA0, pA1, (const char*)K_lds, qr, cbm, r32, hi); partialSM(pA0, pA1, m_reg, mnA, alA);
  SLOAD(0, 64);
  SWAIT(); SWRITE(1, 0); __syncthreads();
  for (int j = 1; j + 1 < NT; j += 2) {
    SBAR(); qkt<4>(pB0, pB1, (const char*)K_lds + SHM_K, qr, cbm, r32, hi);
    finishSM(pA0, pA1, alA, l_reg, pa0, pa1, pa2, pa3); SBAR();
    SLOAD(0, (j + 1) * 64); SBAR();
    pv_d0(o, vb0, pa0, pa1, pa2, pa3); partialSM(pB0, pB1, m_reg, mnB, alB);
    __syncthreads(); SWAIT(); SWRITE(0, 0);
    RESC(alB); __syncthreads();
    SBAR(); qkt<4>(pA0, pA1, (const char*)K_lds, qr, cbm, r32, hi);
    finishSM(pB0, pB1, alB, l_reg, pa0, pa1, pa2, pa3); SBAR();
    SLOAD(0, (j + 2) * 64); SBAR();
    pv_d0(o, vb0 + (int)SHM_V, pa0, pa1, pa2, pa3); partialSM(pA0, pA1, m_reg, mnA, alA);
    __syncthreads(); SWAIT(); SWRITE(1, 0);
    RESC(alA); __syncthreads();
  }
  SBAR(); qkt<4>(pB0, pB1, (const char*)K_lds + SHM_K, qr, cbm, r32, hi);
  if (wq < 2) {
#pragma unroll
    for (int r = 0; r < 16; ++r) { pB0[r] = -1e30f; pB1[r] = -1e30f; } }
  finishSM(pA0, pA1, alA, l_reg, pa0, pa1, pa2, pa3); SBAR();
  pv_d0(o, vb0, pa0, pa1, pa2, pa3); partialSM(pB0, pB1, m_reg, mnB, alB);
  __syncthreads(); RESC(alB);
  finishSM(pB0, pB1, alB, l_reg, pa0, pa1, pa2, pa3); SBAR();
  pv_d0(o, vb0 + (int)SHM_V, pa0, pa1, pa2, pa3);
  if (hi == 0) li_l[r32] = l_reg; asm volatile("s_waitcnt lgkmcnt(0)" ::: "memory");
  float rli[16];
#pragma unroll
  for (int r = 0; r < 16; ++r) rli[r] = __builtin_amdgcn_rcpf(li_l[crow(r, hi)]);
  __syncthreads();
  float* xch = (float*)lds + (size_t)wq * 4096;
  if (map == 1) {
#pragma unroll
    for (int d0 = 0; d0 < 4; ++d0)
#pragma unroll
      for (int r = 0; r < 16; ++r) xch[(d0 * 16 + r) * 64 + lane] = o[d0][r] * rli[r] * lam;
  }
  __syncthreads();
  if (map == 0) {
    float ss[16];
#pragma unroll
    for (int r = 0; r < 16; ++r) { float s = 0.f;
#pragma unroll
      for (int d0 = 0; d0 < 4; ++d0) { const float v = o[d0][r] * rli[r] - xch[(d0 * 16 + r) * 64 + lane]; o[d0][r] = v; s += v * v; }
      ss[r] = s; }
#pragma unroll
    for (int r = 0; r < 16; ++r) ss[r] = half_sum32(ss[r]);
    bf16* Ow = Oout + (rowb + qb * 128 + wq * 32) * 2048 + 1024 + h * 128;
    float gv[4];
#pragma unroll
    for (int d0 = 0; d0 < 4; ++d0) gv[d0] = gdiff[d0 * 32 + r32] * oscale;
#pragma unroll
    for (int r = 0; r < 16; ++r) { const int orow = crow(r, hi); const float rs = rsqrtf(ss[r] * (1.f / 128.f) + 1e-6f);
#pragma unroll
      for (int d0 = 0; d0 < 4; ++d0) { const float y = o[d0][r] * rs * gv[d0]; const unsigned w = cvtpk(y, y); Ow[(size_t)orow * 2048 + d0 * 32 + r32] = (bf16)(w & 0xffffu); } }
  }
#undef SLOAD
#undef SWRITE
#undef SWAIT
#undef RESC
}
__device__ __forceinline__ void sb_wave_unit(int b, int h, int wq, const bf16* __restrict__ QKV, bf16* __restrict__ Oout, const float* __restrict__ gsb, char* ldsw, int lane) {
  const int r32 = lane & 31, hi = lane >> 5;
  char* V_lds = ldsw; char* K_lds = ldsw + 8192;
  f32x16 o[4] = {}; bf16x8 qr[8];
  const size_t rowb = (size_t)b * SEQ_;
  const int Q0 = wq * 32, tq = Q0 + r32;
  const bf16* Qw = QKV + (rowb + tq) * LDQKV + h * 128 + hi * 8;
#pragma unroll
  for (int d0 = 0; d0 < 8; ++d0) qr[d0] = *reinterpret_cast<const bf16x8*>(Qw + d0 * 16);
  const bf16* Kh = QKV + rowb * LDQKV + 1024 + h * 128; const bf16* Vh = QKV + rowb * LDQKV + 2048 + h * 128;
  const int skey = lane >> 4, scol = (lane & 15) * 8;
  const unsigned toff = (unsigned)(skey * LDQKV + scol);
  const unsigned koff0 = (unsigned)(skey * LDQKV + (((lane & 15) ^ skey) * 8)), koff1 = (unsigned)(skey * LDQKV + (((lane & 15) ^ (4 + skey)) * 8));
  typedef __attribute__((address_space(3))) unsigned lds_u32;
  lds_u32* kl = (lds_u32*)(K_lds);
  const int vb0 = (int)(uintptr_t)V_lds + v_rd_base(lane);
  bf16x8 vs[8];
#define SB_LOADV(j) do { const bf16* vt_ = Vh + (size_t)(j) * 32 * LDQKV; \
    _Pragma("unroll") for (int i_ = 0; i_ < 8; ++i_) vs[i_] = *reinterpret_cast<const bf16x8*>(vt_ + toff + (unsigned)(4 * i_) * LDQKV); } while (0)
#define SB_DMAK(j) do { const bf16* kt_ = Kh + (size_t)(j) * 32 * LDQKV; \
    _Pragma("unroll") for (int p_ = 0; p_ < 8; ++p_) __builtin_amdgcn_global_load_lds((const unsigned*)(kt_ + (unsigned)(4 * p_) * LDQKV + ((p_ & 1) ? koff1 : koff0)), kl + p_ * 256, 16, 0, 0); } while (0)
  float carry = 0.f;
  SB_DMAK(wq); SB_LOADV(wq);
  for (int j = wq; j >= 0; --j) {
    asm volatile("s_waitcnt vmcnt(0)" ::: "memory");
#pragma unroll
    for (int i = 0; i < 8; ++i) { const int key = 4 * i + skey; *(bf16x8*)(V_lds + v_st(key, scol)) = vs[i]; }
    asm volatile("s_waitcnt lgkmcnt(0)" ::: "memory");
    if (j > 0) SB_LOADV(j - 1);
    f32x16 p0 = f32x16{};
#pragma unroll
    for (int d0 = 0; d0 < 8; ++d0) { const int cb = (d0 * 16 + hi * 8) * 2;
      const bf16x8 b0 = *reinterpret_cast<const bf16x8*>(K_lds + KSWZ(r32, cb));
      p0 = __builtin_amdgcn_mfma_f32_32x32x16_bf16(b0, qr[d0], p0, 0, 0, 0); }
    asm volatile("s_waitcnt lgkmcnt(0)" ::: "memory");
    if (j > 0) SB_DMAK(j - 1);
    const bool diag = (j == wq);
    const int kb = j * 32 + 4 * hi;
    f32x16 q0;
#pragma unroll
    for (int r = 0; r < 16; ++r) {
      const float z0 = __builtin_amdgcn_fmed3f(p0[r], -120.f, 120.f);
      float a0 = -__builtin_amdgcn_logf(1.f + __builtin_amdgcn_exp2f(z0));
      float b0 = z0 + a0;
      if (diag) { const int kv = kb + (r & 3) + 8 * (r >> 2); if (kv >= tq) { a0 = 0.f; b0 = -1e30f; } }
      q0[r] = a0; p0[r] = b0; }
    float G[4], PG[4], SUF[4];
#pragma unroll
    for (int g = 0; g < 4; ++g) G[g] = (q0[4 * g] + q0[4 * g + 1]) + (q0[4 * g + 2] + q0[4 * g + 3]);
#pragma unroll
    for (int g = 0; g < 4; ++g) PG[g] = __shfl_xor(G[g], 32);
    float run = carry;
#pragma unroll
    for (int g = 3; g >= 0; --g) { SUF[g] = run; run += G[g] + PG[g]; }
    carry = run;
#pragma unroll
    for (int g = 0; g < 4; ++g) SUF[g] += (hi == 0) ? PG[g] : 0.f;
#pragma unroll
    for (int g = 0; g < 4; ++g) {
      float s = SUF[g];
      p0[4 * g + 3] = __builtin_amdgcn_exp2f(p0[4 * g + 3] + s); s += q0[4 * g + 3];
      p0[4 * g + 2] = __builtin_amdgcn_exp2f(p0[4 * g + 2] + s); s += q0[4 * g + 2];
      p0[4 * g + 1] = __builtin_amdgcn_exp2f(p0[4 * g + 1] + s); s += q0[4 * g + 1];
      p0[4 * g + 0] = __builtin_amdgcn_exp2f(p0[4 * g + 0] + s);
    }
    bf16x8 pa0, pa1;
#define PK4(P, BASE, OUT) do { unsigned a0 = cvtpk(P[BASE + 0], P[BASE + 1]), a1 = cvtpk(P[BASE + 2], P[BASE + 3]);   \
    unsigned b0 = cvtpk(P[BASE + 4], P[BASE + 5]), b1 = cvtpk(P[BASE + 6], P[BASE + 7]);                              \
    auto r0 = __builtin_amdgcn_permlane32_swap(a0, b0, false, false); auto r1 = __builtin_amdgcn_permlane32_swap(a1, b1, false, false); \
    u32x4 w = {r0[0], r1[0], r0[1], r1[1]}; OUT = *reinterpret_cast<bf16x8*>(&w); } while (0)
    PK4(p0, 0, pa0); PK4(p0, 8, pa1);
#undef PK4
#define SB_PV(D0) do { const s16x4 l0 = tr_read<v_rd_off(D0, 0, 0)>(vb0), h0 = tr_read<v_rd_off(D0, 0, 1)>(vb0), l1 = tr_read<v_rd_off(D0, 1, 0)>(vb0), h1 = tr_read<v_rd_off(D0, 1, 1)>(vb0); \
    asm volatile("s_waitcnt lgkmcnt(0)" ::: "memory"); SBAR(); \
    o[D0] = __builtin_amdgcn_mfma_f32_32x32x16_bf16(pa0, (bf16x8){l0[0], l0[1], l0[2], l0[3], h0[0], h0[1], h0[2], h0[3]}, o[D0], 0, 0, 0); \
    o[D0] = __builtin_amdgcn_mfma_f32_32x32x16_bf16(pa1, (bf16x8){l1[0], l1[1], l1[2], l1[3], h1[0], h1[1], h1[2], h1[3]}, o[D0], 0, 0, 0); } while (0)
    SB_PV(0); SB_PV(1); SB_PV(2); SB_PV(3);
#undef SB_PV
    if (__all(carry < -160.f)) break;
  }
#undef SB_LOADV
#undef SB_DMAK
  { float ss[16];
#pragma unroll
    for (int r = 0; r < 16; ++r) { float s = 0.f;
#pragma unroll
      for (int d0 = 0; d0 < 4; ++d0) s += o[d0][r] * o[d0][r];
      ss[r] = half_sum32(s); }
    bf16* Ow = Oout + (rowb + Q0) * 2048 + h * 128;
    float gv[4];
#pragma unroll
    for (int d0 = 0; d0 < 4; ++d0) gv[d0] = gsb[d0 * 32 + r32];
#pragma unroll
    for (int r = 0; r < 16; ++r) { const int orow = crow(r, hi); const float rs = rsqrtf(ss[r] * (1.f / 128.f) + 1e-6f);
#pragma unroll
      for (int d0 = 0; d0 < 4; ++d0) { const float y = o[d0][r] * rs * gv[d0]; const unsigned w = cvtpk(y, y); Ow[(size_t)orow * 2048 + d0 * 32 + r32] = (bf16)(w & 0xffffu); } }
  }
  asm volatile("s_waitcnt vmcnt(0)" ::: "memory");
}
#undef KSWZ
#undef SBAR
}
constexpr int NWAVES = 8;
constexpr int BATCH = 4, SEQ = 8192, DM = 2048, NTOK = BATCH * SEQ;
constexpr int QKVC = 6144, NEXP = 32, DEXP = 512, PLED = 256, LCAP = 65536;
constexpr float EPS = 1e-6f;
constexpr float QSCALE_SB = 0.08838834764831845f * 1.4426950408889634f;
constexpr float QSCALE_DF = 0.125f * 1.4426950408889634f;
constexpr size_t MiB = 1u << 20;
constexpr size_t WS_CTL = 0, CTL_ZERO_BYTES = 1 * MiB;
constexpr size_t WS_ROPE = 1 * MiB;
constexpr size_t WS_WRT = 1 * MiB + 512 * 1024;
constexpr size_t WS_WIN = 2 * MiB;
constexpr size_t WS_WOUT = 26 * MiB;
constexpr size_t WS_WPG = 34 * MiB;
constexpr size_t WS_WPLE = 42 * MiB;
constexpr size_t WS_WGU = 44 * MiB;
constexpr size_t WS_WD = 172 * MiB;
constexpr size_t WS_LSLOT = 236 * MiB;
constexpr size_t WS_LGATE = 244 * MiB;
constexpr size_t WS_PB = 252 * MiB;
constexpr size_t WS_A1 = 268 * MiB;
constexpr size_t WS_QKV = 396 * MiB;
constexpr size_t WS_XS = WS_QKV;
constexpr size_t WS_H = WS_QKV + 288 * MiB;
constexpr size_t WS_Y = WS_QKV;
constexpr size_t WS_U = 780 * MiB;
constexpr size_t WS_END = 908 * MiB;
constexpr int CW_TMO = 0, CW_CODE = 1;
constexpr int CW_BAR = 4096;
constexpr int CW_CNT = 16384;
constexpr int RING_OFF = 0, RING_BYTES = 131072;
constexpr int LDSCTL_OFF = RING_BYTES;
constexpr int TST_OFF = LDSCTL_OFF;
constexpr int CNT_OFF = LDSCTL_OFF + 160;
constexpr int MISC_OFF = LDSCTL_OFF + 320;
constexpr int LDS_BYTES = 147456;

#define GAS __attribute__((address_space(1)))
#define LAS __attribute__((address_space(3)))
typedef unsigned short bf16;
typedef unsigned v4u __attribute__((ext_vector_type(4)));
typedef unsigned v2u __attribute__((ext_vector_type(2)));
typedef float f32x4 __attribute__((ext_vector_type(4)));
typedef GAS unsigned gu32;
#define RLX_AGENT __ATOMIC_RELAXED, __HIP_MEMORY_SCOPE_AGENT
#define LDS_WAIT() asm volatile("s_waitcnt lgkmcnt(0)" ::: "memory")
#define VM_WAIT() asm volatile("s_waitcnt vmcnt(0)" ::: "memory")
__device__ __forceinline__ unsigned pk2(float lo, float hi) { return pg8::cvt_pk_bf16(lo, hi); }
#define XB_TMO      128
#define XB_XCNT(j)  (256  + 64 * (j))
#define XB_XSUB(j)  (1280 + 64 * (j))
#define XB_XGEN(j)  (2304 + 64 * (j))
#define XB_TOP      3328
#define XB_TOPGEN   3392
#define XCD_BAR_WORDS 3456
#define XB_SPIN_CAP (1u << 18)

__device__ __forceinline__ unsigned xb_ld(unsigned* p)              { return __hip_atomic_load(p, __ATOMIC_RELAXED, __HIP_MEMORY_SCOPE_AGENT); }
__device__ __forceinline__ unsigned xb_add(unsigned* p, unsigned v) { return __hip_atomic_fetch_add(p, v, __ATOMIC_RELAXED, __HIP_MEMORY_SCOPE_AGENT); }
__device__ __forceinline__ unsigned xb_xcc_id() { return (unsigned)__builtin_amdgcn_s_getreg((3 << 11) | 20) & 0xFu; }
#define XB_SPIN(cond, bar) do { unsigned _sp = 0; while (cond) { __builtin_amdgcn_s_sleep(1); \
    if ((++_sp & 255u) == 0u) { if (xb_ld(&(bar)[XB_TMO])) break; if (_sp > XB_SPIN_CAP) { atomicAdd(&(bar)[XB_TMO], 1u); break; } } } } while (0)

struct XcdBarrier {
    unsigned* bar; unsigned x;
    volatile LAS unsigned* st;
};

__device__ __forceinline__ XcdBarrier xcd_barrier_post(unsigned* bar, volatile LAS unsigned* st) {
    XcdBarrier b; b.bar = bar; b.x = xb_xcc_id(); b.st = st;
    if (threadIdx.x == 0) (void)xb_add(&bar[XB_XCNT(b.x)], 1u);
    return b;
}
__device__ __forceinline__ void xcd_barrier_complete(unsigned* bar, unsigned x, unsigned& nloc, unsigned& nx) {
    const unsigned G = gridDim.x * gridDim.y * gridDim.z;
    unsigned sum, cnt, mine, sp = 0u;
    for (;;) {
        sum = 0u; cnt = 0u; mine = 0u;
#pragma unroll
        for (unsigned j = 0; j < 16; ++j) { const unsigned c = xb_ld(&bar[XB_XCNT(j)]); sum += c; cnt += (c > 0u) ? 1u : 0u; mine = (j == x) ? c : mine; }
        if (sum == G) break;
        __builtin_amdgcn_s_sleep(1);
        if ((++sp & 255u) == 0u) { if (xb_ld(&bar[XB_TMO])) break; if (sp > XB_SPIN_CAP) { atomicAdd(&bar[XB_TMO], 1u); break; } }
    }
    nloc = mine > 0u ? mine : 1u; nx = cnt > 0u ? cnt : 1u;
}

__device__ __forceinline__ void xcd_barrier(const XcdBarrier& b) {
    asm volatile("s_waitcnt vmcnt(0)" ::: "memory");
    __syncthreads();
    if (threadIdx.x == 0) {
        unsigned* bar = b.bar;
        __builtin_amdgcn_s_waitcnt(0);
        unsigned nloc = b.st[0], nx = b.st[1];
        if (nloc == 0u) { xcd_barrier_complete(bar, b.x, nloc, nx); b.st[0] = nloc; b.st[1] = nx; }
        const unsigned old = xb_add(&bar[XB_XSUB(b.x)], 1u);
        const unsigned gen = old / nloc;
        if (old + 1u == (gen + 1u) * nloc) {
            __builtin_amdgcn_fence(__ATOMIC_RELEASE, "agent");
            asm volatile("s_waitcnt vmcnt(0)" ::: "memory");
            const unsigned og = xb_add(&bar[XB_TOP], 1u);
            const unsigned tg = og / nx;
            if (og + 1u == (tg + 1u) * nx) xb_add(&bar[XB_TOPGEN], 1u);
            else XB_SPIN(xb_ld(&bar[XB_TOPGEN]) == tg, bar);
            __builtin_amdgcn_fence(__ATOMIC_ACQUIRE, "agent");
            xb_add(&bar[XB_XGEN(b.x)], 1u);
            asm volatile("s_waitcnt vmcnt(0)" ::: "memory");
        } else {
            XB_SPIN(xb_ld(&bar[XB_XGEN(b.x)]) == gen, bar);
            __builtin_amdgcn_fence(__ATOMIC_ACQUIRE, "agent");
            asm volatile("s_waitcnt vmcnt(0)" ::: "memory");
        }
    }
    __syncthreads();
}
struct Frame {
    LAS unsigned char* lds;
    volatile LAS unsigned* MISC;
    gu32* ctl;
    int tid, lane, wave;
    int vcu, G;
};
__device__ __forceinline__ float wave_sum(float v) {
#pragma unroll
    for (int o = 1; o < 64; o <<= 1) v += __shfl_xor(v, o);
    return v;
}
__device__ __forceinline__ void tr_item(const float* W, int ldw, int k0, int n0, bf16* dst, int dpitch, float scale, LAS float* scr, int lane) {
#pragma unroll 8
    for (int i = 0; i < 32; ++i) { const int kk = 2 * i + (lane >> 5); scr[kk * 33 + (lane & 31)] = W[(size_t)(k0 + kk) * ldw + n0 + (lane & 31)]; }
    LDS_WAIT(); asm volatile("" ::: "memory");
    const int c = lane & 7;
#pragma unroll
    for (int j = 0; j < 4; ++j) { const int n = (lane >> 3) + 8 * j; const LAS float* s = scr + (8 * c) * 33 + n;
        v4u o; o.x = pk2(s[0 * 33] * scale, s[1 * 33] * scale); o.y = pk2(s[2 * 33] * scale, s[3 * 33] * scale); o.z = pk2(s[4 * 33] * scale, s[5 * 33] * scale); o.w = pk2(s[6 * 33] * scale, s[7 * 33] * scale);
        *(GAS v4u*)(dst + (size_t)n * dpitch + 8 * c) = o; }
    LDS_WAIT(); asm volatile("" ::: "memory");
}
__device__ __forceinline__ void rms_row_to_bf16(const float* xrow, const float* g, bf16* orow, int lane) {
    const GAS f32x4* xr = (const GAS f32x4*)xrow + lane;
    f32x4 v[8]; float s = 0.f;
#pragma unroll
    for (int j = 0; j < 8; ++j) { v[j] = xr[64 * j]; s += (v[j].x * v[j].x + v[j].y * v[j].y) + (v[j].z * v[j].z + v[j].w * v[j].w); }
    const float rstd = rsqrtf(wave_sum(s) * (1.f / DM) + EPS);
    GAS v2u* o8 = (GAS v2u*)orow + lane;
#pragma unroll
    for (int j = 0; j < 8; ++j) { const f32x4 gg = *((const GAS f32x4*)g + lane + 64 * j); v2u w; w.x = pk2(v[j].x * rstd * gg.x, v[j].y * rstd * gg.y); w.y = pk2(v[j].z * rstd * gg.z, v[j].w * rstd * gg.w); o8[64 * j] = w; }
}

__device__ __forceinline__ void unpack8(const v4u w, float (&f)[8]) {
#pragma unroll
    for (int q = 0; q < 4; ++q) { f[2 * q] = pg8::bf_lo(w[q]); f[2 * q + 1] = pg8::bf_hi(w[q]); }
}
struct Args { const float* in[21]; float* out; unsigned char* ws; int ph_lo, ph_hi; };


#define x_ (args.in[0])
#define p_in (args.in[1])
#define g_attn (args.in[2])
#define w_in (args.in[3])
#define g_sb (args.in[4])
#define g_diff (args.in[5])
#define lam_q1 (args.in[6])
#define lam_k1 (args.in[7])
#define lam_q2 (args.in[8])
#define lam_k2 (args.in[9])
#define w_out (args.in[10])
#define g_moe (args.in[11])
#define w_rg (args.in[12])
#define w_re (args.in[13])
#define w_gate (args.in[14])
#define w_up (args.in[15])
#define w_down (args.in[16])
#define g_ple (args.in[17])
#define w_ple (args.in[18])
#define w_pg (args.in[19])
#define g_final (args.in[20])
#define rope ((float*)(ws + WS_ROPE))
#define wrt ((float*)(ws + WS_WRT))
#define WIN ((bf16*)(ws + WS_WIN))
#define WOUT ((bf16*)(ws + WS_WOUT))
#define WPG ((bf16*)(ws + WS_WPG))
#define WPLE ((bf16*)(ws + WS_WPLE))
#define WGU ((bf16*)(ws + WS_WGU))
#define WD ((bf16*)(ws + WS_WD))
#define LSLOT ((int*)(ws + WS_LSLOT))
#define LGATE ((float*)(ws + WS_LGATE))
#define PB ((bf16*)(ws + WS_PB))
#define A1 ((bf16*)(ws + WS_A1))
#define QKV ((bf16*)(ws + WS_QKV))
#define XS ((bf16*)(ws + WS_XS))
#define HB ((bf16*)(ws + WS_H))
#define YB ((bf16*)(ws + WS_Y))
#define UB ((bf16*)out)
#define H1B ((bf16*)(ws + WS_U))
#define ecnt (F.ctl + CW_CNT)
__global__ void __launch_bounds__(NWAVES * 64, 2) mega_fwd(Args args) {
    extern __shared__ __attribute__((aligned(16))) unsigned char lds[];
    Frame F;
    F.lds = (LAS unsigned char*)lds;
    F.MISC = (volatile LAS unsigned*)(F.lds + MISC_OFF);
    F.tid = threadIdx.x; F.lane = F.tid & 63; F.wave = __builtin_amdgcn_readfirstlane(F.tid >> 6);
    F.G = gridDim.x; { const int bx = blockIdx.x; F.vcu = (F.G % 8 == 0) ? (bx % 8) * (F.G / 8) + bx / 8 : bx; }
    unsigned char* ws = args.ws;
    F.ctl = (gu32*)(ws + WS_CTL);
    float* const out = args.out;
    for (int u = F.tid; u < (LDS_BYTES - LDSCTL_OFF) / 4; u += NWAVES * 64) ((LAS unsigned*)(F.lds + LDSCTL_OFF))[u] = 0u;
    __syncthreads();
    XcdBarrier bar = xcd_barrier_post((unsigned*)(F.ctl + CW_BAR), F.MISC + 8);
    const int lo = args.ph_lo, hi = args.ph_hi;
#ifndef PROBE_DBL
#define PROBE_DBL -1
#endif
#define REPS(k) _Pragma("unroll 1") for (int rep_ = 0; rep_ < ((PROBE_DBL == (k)) ? 2 : 1); ++rep_)
#ifndef PH_MASK
#define PH_MASK 0x7ff
#endif
#define IN(k) ((((PH_MASK) >> (k)) & 1) && lo <= (k) && (k) < hi)
#define SEAM(k) do { if (IN(k) && IN((k) + 1)) xcd_barrier(bar); } while (0)
    const int gw = F.vcu * NWAVES + F.wave, NGW = F.G * NWAVES;
    LAS int* tstart = (LAS int*)(F.lds + TST_OFF); LAS int* lcnt = (LAS int*)(F.lds + CNT_OFF);

    if (IN(0)) REPS(0) {
        LAS float* scr = (LAS float*)(F.lds + RING_OFF + F.wave * 16384);
        constexpr int I_IN = 32 * 192, I_OUT = 32 * 64, I_PG = 32 * 64, I_PLE = 4 * 64, I_G = 32 * 32 * 16, I_U = I_G, I_D = 32 * 8 * 64;
        constexpr int NITEMS = I_IN + I_OUT + I_PG + I_PLE + I_G + I_U + I_D;
        for (int it = gw; it < NITEMS; it += NGW) {
            int r = it;
            if (r < I_IN) { const int kb = r / 192, nb = r % 192, n0 = 32 * nb, k0 = 64 * kb; const float sc = (n0 < 1024) ? QSCALE_SB : ((n0 >= 3072 && n0 < 4096) ? QSCALE_DF : 1.f);
                tr_item(w_in, QKVC, k0, n0, WIN + (size_t)n0 * DM + k0, DM, sc, scr, F.lane); continue; } r -= I_IN;
            if (r < I_OUT) { const int kb = r / 64, nb = r % 64; tr_item(w_out, DM, 64 * kb, 32 * nb, WOUT + (size_t)(32 * nb) * DM + 64 * kb, DM, 1.f, scr, F.lane); continue; } r -= I_OUT;
            if (r < I_PG) { const int kb = r / 64, nb = r % 64; tr_item(w_pg, DM, 64 * kb, 32 * nb, WPG + (size_t)(32 * nb) * DM + 64 * kb, DM, 1.f, scr, F.lane); continue; } r -= I_PG;
            if (r < I_PLE) { const int kb = r / 64, nb = r % 64; tr_item(w_ple, DM, 64 * kb, 32 * nb, WPLE + (size_t)(32 * nb) * PLED + 64 * kb, PLED, 1.f, scr, F.lane); continue; } r -= I_PLE;
            if (r < I_G + I_U) { const bool isu = r >= I_G; if (isu) r -= I_G; const int e = r / 512, q = r % 512, kb = q / 16, nb = q % 16, n0 = 32 * nb, k0 = 64 * kb;
                const int drow = e * 1024 + (n0 >> 7) * 256 + (isu ? 128 : 0) + (n0 & 127);
                tr_item((isu ? w_up : w_gate) + (size_t)e * DM * DEXP, DEXP, k0, n0, WGU + (size_t)drow * DM + k0, DM, 1.f, scr, F.lane); continue; } r -= I_G + I_U;
            { const int e = r / 512, q = r % 512, kb = q / 64, nb = q % 64, n0 = 32 * nb, k0 = 64 * kb;
                tr_item(w_down + (size_t)e * DEXP * DM, DM, k0, n0, WD + ((size_t)e * DM + n0) * DEXP + k0, DEXP, 1.f, scr, F.lane); }
        }
        for (int i = gw * 64 + F.lane; i < SEQ * 8; i += NGW * 64) { const int pos = i >> 3, k = i & 7;
            const float inv = exp2f(-(float)k * (18.931568569324174f / 8.f));
            const float ang = (float)pos * inv;
            const double rev = (double)ang * 0.15915494309189535; const float fr = (float)(rev - floor(rev));
            rope[pos * 16 + k] = __builtin_amdgcn_cosf(fr); rope[pos * 16 + 8 + k] = __builtin_amdgcn_sinf(fr); }
        for (int i = gw * 64 + F.lane; i < 36 * DM; i += NGW * 64) { const int c = i / DM, k = i % DM; wrt[i] = (c < 4) ? w_rg[k * 4 + c] : w_re[k * 32 + (c - 4)]; }
        for (size_t i = (size_t)gw * 64 + F.lane; i < (size_t)NTOK * PLED / 4; i += (size_t)NGW * 64) { const f32x4 v = *((const GAS f32x4*)p_in + i); v2u w; w.x = pk2(v.x, v.y); w.y = pk2(v.z, v.w); *((GAS v2u*)PB + i) = w; }
        for (int m = gw; m < NTOK; m += NGW) rms_row_to_bf16(x_ + (size_t)m * DM, g_attn, A1 + (size_t)m * DM, F.lane);
    }
    SEAM(0);
    if (IN(1)) REPS(1) {
        pg8::Gemm g{A1, WIN, NTOK, QKVC, DM}; pg8::StaticOrder S; S.init(NTOK, QKVC, F.G, (int)blockIdx.x);
        pg8::EpiQKV E{QKV, rope};
        pg8::gemm_phase<pg8::EpiQKV, pg8::StaticOrder, true, true>(F.lds + RING_OFF, g, S, E);
    }
    SEAM(1);
    if (IN(2)) {
        float lam;
        { float a = (F.lane < 64) ? lam_q1[F.lane] * lam_k1[F.lane] : 0.f, b2 = lam_q2[F.lane] * lam_k2[F.lane]; a = wave_sum(a); b2 = wave_sum(b2); lam = expf(a) - expf(b2) + 0.2f; }
#ifndef NO_DIFF
        REPS(20) for (int L = F.vcu; L < 1024; L += F.G) { const int bh = L >> 5, pr = L & 31;
#pragma unroll 1
            for (int s2 = 0; s2 < 2; ++s2) att::diff_unit(bh >> 3, bh & 7, s2 ? pr : 63 - pr, QKV, A1, g_diff, lam, 0.8f, (char*)lds + RING_OFF); }
#endif
        __syncthreads();
#ifndef NO_SB
        REPS(21) for (int uid = gw; uid < 8192; uid += NGW) { const int bh = uid >> 8, wq = uid & 255;
            att::sb_wave_unit(bh >> 3, bh & 7, wq, QKV, A1, g_sb, (char*)lds + RING_OFF + F.wave * 16384, F.lane); }
#endif
    }
    SEAM(2);
    if (IN(3)) REPS(3) {
#ifndef NO_P3A
        { pg8::Gemm g{A1, WOUT, NTOK, DM, DM}; pg8::StaticOrder S; S.init(NTOK, DM, F.G, (int)blockIdx.x);
          pg8::EpiResBf16 E{x_, H1B};
          pg8::gemm_phase<pg8::EpiResBf16, pg8::StaticOrder, true, true>(F.lds + RING_OFF, g, S, E); }
#endif
#ifndef NO_P3B
        { pg8::Gemm g{PB, WPLE, NTOK, DM, PLED}; pg8::StaticOrder S; S.init(NTOK, DM, F.G, (int)blockIdx.x);
          pg8::EpiBf16 E{UB, DM};
          pg8::gemm_phase<pg8::EpiBf16, pg8::StaticOrder, true, true>(F.lds + RING_OFF, g, S, E); }
#endif
    }
    SEAM(3);
    if (IN(4)) {
        LAS int* sel_e = (LAS int*)(F.lds + RING_OFF); LAS float* sel_g = (LAS float*)(F.lds + RING_OFF + 1024); LAS int* lhist = (LAS int*)(F.lds + RING_OFF + 2048); LAS int* lbase = (LAS int*)(F.lds + RING_OFF + 2176);
        LAS int* lrk = (LAS int*)(F.lds + RING_OFF + 2304);
        for (int chunk = blockIdx.x; chunk < NTOK / 128; chunk += F.G) {
            if (F.tid < 32) lhist[F.tid] = 0;
            for (int g4 = 0; g4 < 4; ++g4) {
                const int row0 = chunk * 128 + F.wave * 16 + g4 * 4;
                float v[4][4][8]; float rstd[4];
#pragma unroll
                for (int r = 0; r < 4; ++r) { const GAS v4u* xr = (const GAS v4u*)(H1B + (size_t)(row0 + r) * DM) + F.lane; float s = 0.f;
#pragma unroll
                    for (int j = 0; j < 4; ++j) { unpack8(xr[64 * j], v[r][j]);
#pragma unroll
                        for (int i = 0; i < 8; ++i) s += v[r][j][i] * v[r][j][i]; }
                    rstd[r] = rsqrtf(wave_sum(s) * (1.f / DM) + EPS); }
#pragma unroll
                for (int j = 0; j < 4; ++j) { const f32x4 g0 = *((const GAS f32x4*)g_moe + 2 * F.lane + 128 * j), g1 = *((const GAS f32x4*)g_moe + 2 * F.lane + 128 * j + 1);
#pragma unroll
                    for (int r = 0; r < 4; ++r) {
#pragma unroll
                        for (int i = 0; i < 4; ++i) { v[r][j][i] *= rstd[r] * g0[i]; v[r][j][4 + i] *= rstd[r] * g1[i]; }
                        v4u w; w.x = pk2(v[r][j][0], v[r][j][1]); w.y = pk2(v[r][j][2], v[r][j][3]); w.z = pk2(v[r][j][4], v[r][j][5]); w.w = pk2(v[r][j][6], v[r][j][7]);
                        *((GAS v4u*)(A1 + (size_t)(row0 + r) * DM) + F.lane + 64 * j) = w; } }
                float lg[4] = {0.f, 0.f, 0.f, 0.f};
#pragma unroll 1
                for (int c = 0; c < 36; ++c) { const GAS f32x4* wc = (const GAS f32x4*)(wrt + (size_t)c * DM) + 2 * F.lane;
                    float pa[4] = {0.f, 0.f, 0.f, 0.f};
#pragma unroll
                    for (int j = 0; j < 4; ++j) { const f32x4 w0 = wc[128 * j], w1 = wc[128 * j + 1];
#pragma unroll
                        for (int r = 0; r < 4; ++r) pa[r] += ((v[r][j][0] * w0.x + v[r][j][1] * w0.y) + (v[r][j][2] * w0.z + v[r][j][3] * w0.w)) + ((v[r][j][4] * w1.x + v[r][j][5] * w1.y) + (v[r][j][6] * w1.z + v[r][j][7] * w1.w)); }
#pragma unroll
                    for (int r = 0; r < 4; ++r) { const float t = wave_sum(pa[r]); lg[r] = (F.lane == c) ? t : lg[r]; } }
#pragma unroll
                for (int r = 0; r < 4; ++r) {
                    const float g0 = __shfl(lg[r], 0), g1 = __shfl(lg[r], 1), g2 = __shfl(lg[r], 2), g3 = __shfl(lg[r], 3);
                    int grp = 0; float gm = g0; if (g1 > gm) { gm = g1; grp = 1; } if (g2 > gm) { gm = g2; grp = 2; } if (g3 > gm) { gm = g3; grp = 3; }
                    const float psel = 1.f / (expf(g0 - gm) + expf(g1 - gm) + expf(g2 - gm) + expf(g3 - gm));
                    float ev[8];
#pragma unroll
                    for (int i = 0; i < 8; ++i) ev[i] = __shfl(lg[r], 4 + grp * 8 + i);
                    int i0 = 0; float v0 = ev[0];
#pragma unroll
                    for (int i = 1; i < 8; ++i) if (ev[i] > v0) { v0 = ev[i]; i0 = i; }
                    int i1 = -1; float v1 = 0.f;
#pragma unroll
                    for (int i = 0; i < 8; ++i) if (i != i0 && (i1 < 0 || ev[i] > v1)) { v1 = ev[i]; i1 = i; }
                    const float ga = 1.f / (1.f + expf(v1 - v0)), gb = 1.f - ga;
                    if (F.lane == 0) { const int rl = F.wave * 16 + g4 * 4 + r; sel_e[rl * 2] = grp * 8 + i0; sel_e[rl * 2 + 1] = grp * 8 + i1; sel_g[rl * 2] = ga * psel; sel_g[rl * 2 + 1] = gb * psel; }
                }
            }
            __syncthreads();
            int my_e = 0, my_rk = 0;
            if (F.tid < 256) { my_e = sel_e[F.tid]; my_rk = atomicAdd((int*)(lhist + my_e), 1); }
            __syncthreads();
            if (F.tid < 32) { const int n = lhist[F.tid]; lbase[F.tid] = n ? (int)__hip_atomic_fetch_add(ecnt + 64 * F.tid, (unsigned)n, RLX_AGENT) : 0; }
            __syncthreads();
            if (F.tid < 256) { const int pos = lbase[my_e] + my_rk; LSLOT[(size_t)my_e * LCAP + pos] = (chunk * 128 + (F.tid >> 1)) * 2 + (F.tid & 1); LGATE[(size_t)my_e * LCAP + pos] = sel_g[F.tid]; }
            __syncthreads();
        }
        (void)lrk;
    }
    SEAM(4);
    if (IN(6) || IN(7)) {
        if (F.tid < 32) lcnt[F.tid] = (int)__hip_atomic_load(ecnt + 64 * F.tid, RLX_AGENT);
        __syncthreads();
        if (F.tid == 0) { int acc = 0; for (int e = 0; e < 32; ++e) { tstart[e] = acc; acc += (lcnt[e] + 255) >> 8; } tstart[32] = acc; }
        __syncthreads();
    }
    const int NTILES = (IN(6) || IN(7)) ? __builtin_amdgcn_readfirstlane(tstart[32]) : 0;
    if (IN(6)) REPS(6) {
        pg8::Gemm g{A1, WGU, NTILES * 256, 1024, DM, LSLOT}; pg8::MoeOrder S; S.init(NTILES, 4, F.G, (int)blockIdx.x, tstart, lcnt);
        pg8::EpiSwiglu E{HB};
        pg8::gemm_phase<pg8::EpiSwiglu, pg8::MoeOrder, true, true, true>(F.lds + RING_OFF, g, S, E);
    }
    SEAM(6);
    if (IN(7)) REPS(7) {
        pg8::Gemm g{HB, WD, NTILES * 256, DM, DEXP}; pg8::MoeOrder S; S.init(NTILES, 8, F.G, (int)blockIdx.x, tstart, lcnt);
        pg8::EpiScatter E{YB, LSLOT, LGATE};
        pg8::gemm_phase<pg8::EpiScatter, pg8::MoeOrder, true, true>(F.lds + RING_OFF, g, S, E);
    }
    SEAM(7);
    if (IN(8)) {
        for (int m = gw; m < NTOK; m += NGW) {
            const GAS v4u* hr = (const GAS v4u*)(H1B + (size_t)m * DM) + F.lane; const GAS v4u* y0 = (const GAS v4u*)(YB + (size_t)(2 * m) * DM) + F.lane; const GAS v4u* y1 = (const GAS v4u*)(YB + (size_t)(2 * m + 1) * DM) + F.lane;
            float v[4][8]; float s = 0.f;
#pragma unroll
            for (int j = 0; j < 4; ++j) { float a[8], b[8]; unpack8(hr[64 * j], v[j]); unpack8(y0[64 * j], a); unpack8(y1[64 * j], b);
#pragma unroll
                for (int i = 0; i < 8; ++i) { v[j][i] += a[i] + b[i]; s += v[j][i] * v[j][i]; } }
            const float rstd = rsqrtf(wave_sum(s) * (1.f / DM) + EPS);
            GAS v4u* o8 = (GAS v4u*)(A1 + (size_t)m * DM) + F.lane;
#pragma unroll
            for (int j = 0; j < 4; ++j) { const f32x4 g0 = *((const GAS f32x4*)g_ple + 2 * F.lane + 128 * j), g1 = *((const GAS f32x4*)g_ple + 2 * F.lane + 128 * j + 1);
                v4u w; w.x = pk2(v[j][0] * rstd * g0.x, v[j][1] * rstd * g0.y); w.y = pk2(v[j][2] * rstd * g0.z, v[j][3] * rstd * g0.w); w.z = pk2(v[j][4] * rstd * g1.x, v[j][5] * rstd * g1.y); w.w = pk2(v[j][6] * rstd * g1.z, v[j][7] * rstd * g1.w);
                o8[64 * j] = w; }
        }
    }
    SEAM(8);
    if (IN(9)) {
        pg8::Gemm g{A1, WPG, NTOK, DM, DM}; pg8::StaticOrder S; S.init(NTOK, DM, F.G, (int)blockIdx.x);
        pg8::EpiPle2 E{H1B, YB, UB};
        pg8::gemm_phase<pg8::EpiPle2, pg8::StaticOrder, true, true>(F.lds + RING_OFF, g, S, E);
    }
    SEAM(9);
    if (IN(10)) {
        for (int m = gw; m < NTOK; m += NGW) {
            const GAS v4u* hr = (const GAS v4u*)(H1B + (size_t)m * DM) + F.lane; float v[4][8]; float s = 0.f;
#pragma unroll
            for (int j = 0; j < 4; ++j) { unpack8(hr[64 * j], v[j]);
#pragma unroll
                for (int i = 0; i < 8; ++i) s += v[j][i] * v[j][i]; }
            const float rstd = rsqrtf(wave_sum(s) * (1.f / DM) + EPS);
            GAS f32x4* orow = (GAS f32x4*)(out + (size_t)m * DM) + 2 * F.lane;
#pragma unroll
            for (int j = 0; j < 4; ++j) { const f32x4 g0 = *((const GAS f32x4*)g_final + 2 * F.lane + 128 * j), g1 = *((const GAS f32x4*)g_final + 2 * F.lane + 128 * j + 1);
                orow[128 * j] = (f32x4){v[j][0] * rstd * g0.x, v[j][1] * rstd * g0.y, v[j][2] * rstd * g0.z, v[j][3] * rstd * g0.w};
                orow[128 * j + 1] = (f32x4){v[j][4] * rstd * g1.x, v[j][5] * rstd * g1.y, v[j][6] * rstd * g1.z, v[j][7] * rstd * g1.w}; }
        }
    }
#undef IN
#undef SEAM
}

#ifndef MK_SPLIT
#define MK_SPLIT 0
#endif
extern "C" void kernel_launch(void* const* d_in, const int* in_sizes, int n_in, void* d_out, int out_size, void* d_ws, size_t ws_size, hipStream_t stream) {
    static int grid = 0;
    if (grid == 0) {
        if (n_in != 21 || in_sizes[0] != NTOK * DM || out_size != NTOK * DM || ws_size < WS_END) { fprintf(stderr, "kernel_launch: shape mismatch (n_in %d in0 %d out %d ws %zu)\n", n_in, n_in > 0 ? in_sizes[0] : -1, out_size, ws_size); grid = -1; return; }
        int dev = 0, cus = 0, per_cu = 0;
        if (hipGetDevice(&dev) != hipSuccess || hipDeviceGetAttribute(&cus, hipDeviceAttributeMultiprocessorCount, dev) != hipSuccess) { grid = -1; return; }
        if (hipFuncSetAttribute((const void*)mega_fwd, hipFuncAttributeMaxDynamicSharedMemorySize, LDS_BYTES) != hipSuccess) { fprintf(stderr, "kernel_launch: hipFuncSetAttribute failed\n"); grid = -1; return; }
        if (hipOccupancyMaxActiveBlocksPerMultiprocessor(&per_cu, (const void*)mega_fwd, NWAVES * 64, LDS_BYTES) != hipSuccess || per_cu < 1) fprintf(stderr, "kernel_launch: occupancy query reports %d\n", per_cu);
        (void)hipGetLastError();
        grid = cus;
    }
    if (grid < 0) return;
    if (hipMemsetAsync((char*)d_ws + WS_CTL, 0, CTL_ZERO_BYTES, stream) != hipSuccess) return;
    Args a{};
    for (int i = 0; i < 21; ++i) a.in[i] = (const float*)d_in[i];
    a.out = (float*)d_out; a.ws = (unsigned char*)d_ws;
#if MK_SPLIT
    for (int ph = 0; ph < 11; ++ph) { a.ph_lo = ph; a.ph_hi = ph + 1; hipLaunchKernelGGL(mega_fwd, dim3(grid), dim3(NWAVES * 64), LDS_BYTES, stream, a); }
#else
    a.ph_lo = 0; a.ph_hi = 11;
    hipLaunchKernelGGL(mega_fwd, dim3(grid), dim3(NWAVES * 64), LDS_BYTES, stream, a);
#endif
    const hipError_t le = hipPeekAtLastError();
    if (le != hipSuccess) fprintf(stderr, "kernel_launch: launch failed: %s\n", hipGetErrorName(le));
}
```

```cpp
#include <hip/hip_runtime.h>
#include <hip/hip_bf16.h>
#include <cstdio>
#include <cstdint>
#define FRESH_LANE(v) int v; asm volatile("v_mbcnt_lo_u32_b32 %0, -1, 0\n\tv_mbcnt_hi_u32_b32 %0, -1, %0" : "=v"(v))
template <int M> __device__ __forceinline__ float swz_xor(float v) { return __int_as_float(__builtin_amdgcn_ds_swizzle(__float_as_int(v), 0x1f | (M << 10))); }
__device__ __forceinline__ float half_sum32_(float v) { v += swz_xor<1>(v); v += swz_xor<2>(v); v += swz_xor<4>(v); v += swz_xor<8>(v); v += swz_xor<16>(v); return v; }
__device__ __forceinline__ float wave_sum_(float v) { v = half_sum32_(v); auto rr = __builtin_amdgcn_permlane32_swap(__float_as_uint(v), __float_as_uint(v), false, false); return __uint_as_float(rr[0]) + __uint_as_float(rr[1]); }
namespace pg8 {
#define PG8_LAS __attribute__((address_space(3)))
typedef unsigned short bf16_t;
typedef short bf16x8 __attribute__((ext_vector_type(8)));
typedef float f32x4 __attribute__((ext_vector_type(4)));
typedef unsigned u32x4 __attribute__((ext_vector_type(4)));
constexpr int BM = 256, BK = 64, HALF = 128, HTB = HALF * BK * 2  , STAGE_BYTES = 8 * HTB, NXCD = 8, WGM = 8;

__host__ __device__ __forceinline__ int lds_byte(int r, int c) { const int st = (r >> 4) * 2 + (c >> 5), rr = r & 15, cc = c & 31, ob = rr * 64 + cc * 2; return st * 1024 + (ob ^ (((ob >> 9) & 1) << 5)); }
__host__ __device__ __forceinline__ void stage_rc(int b, int& R, int& C) { const int st = b / 1024, sb = b % 1024, swz = sb ^ (((sb >> 9) & 1) << 5); R = (st >> 1) * 16 + swz / 64; C = (st & 1) * 32 + (swz % 64) / 2; }
__host__ __device__ __forceinline__ int perm32(int rho) { const int n = rho >> 4, i = rho & 15; return 8 * (i >> 2) + 4 * n + (i & 3); }

struct Unit { int pm, pn, pb, aux0, aux1; };
struct Gemm { const bf16_t* A; const bf16_t* Bt; int M, N, K; const int* glist; };

struct StaticOrder {
    int nM, nN, nwg, G, c;
    __host__ __device__ void init(int M, int N, int G_, int c_) { nM = M / BM; nN = N / BM; nwg = nM * nN; G = G_; c = c_; }
    __host__ __device__ bool next(int i, Unit& u) const {
        const long L = (long)i * G + c; if (L >= nwg) return false;
        int wgid = (int)L; { const int q = nwg / NXCD, r = nwg % NXCD, xcd = wgid % NXCD, off = wgid / NXCD; wgid = (xcd < r ? xcd * (q + 1) : r * (q + 1) + (xcd - r) * q) + off; }
        const int nig = WGM * nN, gid = wgid / nig, fm = gid * WGM, gsz = (nM - fm) < WGM ? (nM - fm) : WGM;
        u.pm = fm + ((wgid % nig) % gsz); u.pn = (wgid % nig) / gsz; u.pb = u.pn; u.aux0 = 0; u.aux1 = 0; return true;
    }
    __device__ __forceinline__ void a_ready(const Unit&) const {}
    __device__ __forceinline__ void done(const Unit&) const {}
};

__device__ __forceinline__ unsigned cvt_pk_bf16(float lo, float hi) { unsigned r; asm volatile("v_cvt_pk_bf16_f32 %0, %1, %2" : "=v"(r) : "v"(lo), "v"(hi)); return r; }
typedef float f32x2 __attribute__((ext_vector_type(2)));
#define PG8_FRESH_LANE(fr, fq) int l__; asm volatile("v_mbcnt_lo_u32_b32 %0, -1, 0\n\tv_mbcnt_hi_u32_b32 %0, -1, %0" : "=v"(l__)); const int fr = l__ & 15, fq = l__ >> 4; (void)fr_; (void)fq_
typedef unsigned u32x2 __attribute__((ext_vector_type(2)));
__device__ __forceinline__ float bf_lo(unsigned w) { return __uint_as_float(w << 16); }
__device__ __forceinline__ float bf_hi(unsigned w) { return __uint_as_float(w & 0xffff0000u); }

struct EpiQKV {
    static constexpr bool PERM = true, AFTER_DRAIN = false;
    bf16_t* O; const float* rope;
    __device__ __forceinline__ void operator()(const f32x4 (&acc)[2][2][4][2], const Unit& u, int wr, int wc, int fr_, int fq_) const {
        PG8_FRESH_LANE(fr, fq);
        const int row0 = u.pm * BM + wr * 64 + fr, col0 = u.pn * BM + wc * 32 + 8 * fq;
        const bool rot = (u.pn >= 12) && (u.pn < 20) && ((wc & 1) == 0);
#pragma unroll
        for (int ai = 0; ai < 2; ++ai)
#pragma unroll
            for (int m = 0; m < 4; ++m) { const int row = row0 + ai * HALF + m * 16; bf16_t* rowp = O + (size_t)row * 6144 + col0;
                f32x4 c0 = {1.f, 1.f, 1.f, 1.f}, c1 = c0, s0 = {0.f, 0.f, 0.f, 0.f}, s1 = s0;
                if (rot) { const float* t = rope + (size_t)(row & 8191) * 16; c0 = *(const f32x4*)(t); c1 = *(const f32x4*)(t + 4); s0 = *(const f32x4*)(t + 8); s1 = *(const f32x4*)(t + 12);
                    if (fq == 0) { s0 = -s0; s1 = -s1; } else if (fq != 1) { s0 = (f32x4){0.f, 0.f, 0.f, 0.f}; s1 = s0; c0 = (f32x4){1.f, 1.f, 1.f, 1.f}; c1 = c0; } }
#pragma unroll
                for (int bj = 0; bj < 2; ++bj) { f32x4 v0 = acc[ai][bj][m][0], v1 = acc[ai][bj][m][1];
                    if (rot) { f32x4 p0, p1;
#pragma unroll
                        for (int j = 0; j < 4; ++j) { p0[j] = swz_xor<16>(v0[j]); p1[j] = swz_xor<16>(v1[j]); }
                        v0 = v0 * c0 + p0 * s0; v1 = v1 * c1 + p1 * s1; }
                    u32x4 w; w.x = cvt_pk_bf16(v0[0], v0[1]); w.y = cvt_pk_bf16(v0[2], v0[3]); w.z = cvt_pk_bf16(v1[0], v1[1]); w.w = cvt_pk_bf16(v1[2], v1[3]);
                    *(u32x4*)(rowp + bj * HALF) = w; } }
    }
};
struct EpiBf16 {
    static constexpr bool PERM = true, AFTER_DRAIN = false;
    bf16_t* O; int ldc;
    __device__ __forceinline__ void operator()(const f32x4 (&acc)[2][2][4][2], const Unit& u, int wr, int wc, int fr_, int fq_) const {
        PG8_FRESH_LANE(fr, fq);
        const int row0 = u.pm * BM + wr * 64 + fr, col0 = u.pn * BM + wc * 32 + 8 * fq;
#pragma unroll
        for (int ai = 0; ai < 2; ++ai)
#pragma unroll
            for (int m = 0; m < 4; ++m) { bf16_t* rowp = O + (size_t)(row0 + ai * HALF + m * 16) * ldc + col0;
#pragma unroll
                for (int bj = 0; bj < 2; ++bj) { const f32x4 v0 = acc[ai][bj][m][0], v1 = acc[ai][bj][m][1];
                    u32x4 w; w.x = cvt_pk_bf16(v0[0], v0[1]); w.y = cvt_pk_bf16(v0[2], v0[3]); w.z = cvt_pk_bf16(v1[0], v1[1]); w.w = cvt_pk_bf16(v1[2], v1[3]);
                    *(u32x4*)(rowp + bj * HALF) = w; } }
    }
};
struct EpiResF32 {
    static constexpr bool PERM = false, AFTER_DRAIN = false;
    const float* base; float* out; int ldc;
    __device__ __forceinline__ void operator()(const f32x4 (&acc)[2][2][4][2], const Unit& u, int wr, int wc, int fr_, int fq_) const {
        PG8_FRESH_LANE(fr, fq);
        const int row0 = u.pm * BM + wr * 64 + fr, col0 = u.pn * BM + wc * 32 + 4 * fq;
#pragma unroll
        for (int ai = 0; ai < 2; ++ai)
#pragma unroll
            for (int m = 0; m < 4; ++m) { const size_t off = (size_t)(row0 + ai * HALF + m * 16) * ldc + col0;
#pragma unroll
                for (int bj = 0; bj < 2; ++bj)
#pragma unroll
                    for (int n = 0; n < 2; ++n) { const f32x4 b = *(const f32x4*)(base + off + bj * HALF + n * 16); *(f32x4*)(out + off + bj * HALF + n * 16) = b + acc[ai][bj][m][n]; }
                asm volatile("" ::: "memory"); }
    }
};
struct EpiPle {
    static constexpr bool PERM = false, AFTER_DRAIN = false;
    float* io; const bf16_t* U; int ldc;
    __device__ __forceinline__ void operator()(const f32x4 (&acc)[2][2][4][2], const Unit& u, int wr, int wc, int fr_, int fq_) const {
        PG8_FRESH_LANE(fr, fq);
        const int row0 = u.pm * BM + wr * 64 + fr, col0 = u.pn * BM + wc * 32 + 4 * fq;
#pragma unroll
        for (int ai = 0; ai < 2; ++ai)
#pragma unroll
            for (int m = 0; m < 4; ++m) { const size_t off = (size_t)(row0 + ai * HALF + m * 16) * ldc + col0;
#pragma unroll
                for (int bj = 0; bj < 2; ++bj)
#pragma unroll
                    for (int n = 0; n < 2; ++n) { const size_t o = off + bj * HALF + n * 16; const f32x4 b = *(const f32x4*)(io + o); const u32x2 uw = *(const u32x2*)(U + o); const f32x4 a = acc[ai][bj][m][n];
                        f32x4 r; r[0] = b[0] + bf_lo(uw.x) * __builtin_amdgcn_rcpf(1.f + __builtin_amdgcn_exp2f(-1.4426950408889634f * a[0]));
                        r[1] = b[1] + bf_hi(uw.x) * __builtin_amdgcn_rcpf(1.f + __builtin_amdgcn_exp2f(-1.4426950408889634f * a[1]));
                        r[2] = b[2] + bf_lo(uw.y) * __builtin_amdgcn_rcpf(1.f + __builtin_amdgcn_exp2f(-1.4426950408889634f * a[2]));
                        r[3] = b[3] + bf_hi(uw.y) * __builtin_amdgcn_rcpf(1.f + __builtin_amdgcn_exp2f(-1.4426950408889634f * a[3]));
                        *(f32x4*)(io + o) = r; }
                asm volatile("" ::: "memory"); }
    }
};
struct EpiResBf16 {
    static constexpr bool PERM = true, AFTER_DRAIN = false;
    const float* base; bf16_t* O;
    __device__ __forceinline__ void operator()(const f32x4 (&acc)[2][2][4][2], const Unit& u, int wr, int wc, int fr_, int fq_) const {
        PG8_FRESH_LANE(fr, fq);
        const int row0 = u.pm * BM + wr * 64 + fr, col0 = u.pn * BM + wc * 32 + 8 * fq;
#pragma unroll
        for (int ai = 0; ai < 2; ++ai)
#pragma unroll
            for (int m = 0; m < 4; ++m) { const size_t off = (size_t)(row0 + ai * HALF + m * 16) * 2048 + col0;
#pragma unroll
                for (int bj = 0; bj < 2; ++bj) { const f32x4 b0 = *(const f32x4*)(base + off + bj * HALF), b1 = *(const f32x4*)(base + off + bj * HALF + 4);
                    const f32x4 v0 = acc[ai][bj][m][0] + b0, v1 = acc[ai][bj][m][1] + b1;
                    u32x4 w; w.x = cvt_pk_bf16(v0[0], v0[1]); w.y = cvt_pk_bf16(v0[2], v0[3]); w.z = cvt_pk_bf16(v1[0], v1[1]); w.w = cvt_pk_bf16(v1[2], v1[3]);
                    *(u32x4*)(O + off + bj * HALF) = w; }
                asm volatile("" ::: "memory"); }
    }
};
struct EpiPle2 {
    static constexpr bool PERM = true, AFTER_DRAIN = false;
    bf16_t* Hs; const bf16_t* Y; const bf16_t* U;
    __device__ __forceinline__ void operator()(const f32x4 (&acc)[2][2][4][2], const Unit& u, int wr, int wc, int fr_, int fq_) const {
        PG8_FRESH_LANE(fr, fq);
        const int row0 = u.pm * BM + wr * 64 + fr, col0 = u.pn * BM + wc * 32 + 8 * fq;
#pragma unroll
        for (int ai = 0; ai < 2; ++ai)
#pragma unroll
            for (int m = 0; m < 4; ++m) { const size_t row = (size_t)(row0 + ai * HALF + m * 16); const size_t off = row * 2048 + col0;
#pragma unroll
                for (int bj = 0; bj < 2; ++bj) { const size_t o = off + bj * HALF;
                    const u32x4 hw = *(const u32x4*)(Hs + o), uw = *(const u32x4*)(U + o), ya = *(const u32x4*)(Y + 2 * row * 2048 + col0 + bj * HALF), yb = *(const u32x4*)(Y + (2 * row + 1) * 2048 + col0 + bj * HALF);
                    float r[8];
#pragma unroll
                    for (int q = 0; q < 4; ++q) { const float a0 = acc[ai][bj][m][q >> 1][(q & 1) * 2], a1 = acc[ai][bj][m][q >> 1][(q & 1) * 2 + 1];
                        const float s0 = __builtin_amdgcn_rcpf(1.f + __builtin_amdgcn_exp2f(-1.4426950408889634f * a0)), s1 = __builtin_amdgcn_rcpf(1.f + __builtin_amdgcn_exp2f(-1.4426950408889634f * a1));
                        r[2 * q] = (bf_lo(hw[q]) + (bf_lo(ya[q]) + bf_lo(yb[q]))) + bf_lo(uw[q]) * s0; r[2 * q + 1] = (bf_hi(hw[q]) + (bf_hi(ya[q]) + bf_hi(yb[q]))) + bf_hi(uw[q]) * s1; }
                    u32x4 w; w.x = cvt_pk_bf16(r[0], r[1]); w.y = cvt_pk_bf16(r[2], r[3]); w.z = cvt_pk_bf16(r[4], r[5]); w.w = cvt_pk_bf16(r[6], r[7]);
                    *(u32x4*)(Hs + o) = w; }
                asm volatile("" ::: "memory"); }
    }
};
struct EpiSwiglu {
    static constexpr bool PERM = true, AFTER_DRAIN = false;
    bf16_t* H;
    __device__ __forceinline__ void operator()(const f32x4 (&acc)[2][2][4][2], const Unit& u, int wr, int wc, int fr_, int fq_) const {
        PG8_FRESH_LANE(fr, fq);
        const int row0 = u.pm * BM + wr * 64 + fr, col0 = u.pn * HALF + wc * 32 + 8 * fq;
#pragma unroll
        for (int ai = 0; ai < 2; ++ai)
#pragma unroll
            for (int m = 0; m < 4; ++m) { bf16_t* rowp = H + (size_t)(row0 + ai * HALF + m * 16) * 512 + col0; float h[8];
#pragma unroll
                for (int n = 0; n < 2; ++n)
#pragma unroll
                    for (int j = 0; j < 4; ++j) { const float g = acc[ai][0][m][n][j], up = acc[ai][1][m][n][j];
                        h[n * 4 + j] = g * up * __builtin_amdgcn_rcpf(1.f + __builtin_amdgcn_exp2f(-1.4426950408889634f * g)); }
                u32x4 w; w.x = cvt_pk_bf16(h[0], h[1]); w.y = cvt_pk_bf16(h[2], h[3]); w.z = cvt_pk_bf16(h[4], h[5]); w.w = cvt_pk_bf16(h[6], h[7]);
                *(u32x4*)rowp = w; asm volatile("" ::: "memory"); }
    }
};
struct EpiScatter {
    static constexpr bool PERM = true, AFTER_DRAIN = false;
    bf16_t* Y; const int* lslot; const float* lgate;
    __device__ __forceinline__ void operator()(const f32x4 (&acc)[2][2][4][2], const Unit& u, int wr, int wc, int fr_, int fq_) const {
        PG8_FRESH_LANE(fr, fq);
        const int r0 = wr * 64 + fr, col0 = u.pn * BM + wc * 32 + 8 * fq;
#pragma unroll
        for (int ai = 0; ai < 2; ++ai)
#pragma unroll
            for (int m = 0; m < 4; ++m) { const int r = r0 + ai * HALF + m * 16;
                if (r < u.aux1) { const int slot = lslot[u.aux0 + r]; const float g = lgate[u.aux0 + r]; bf16_t* rowp = Y + (size_t)slot * 2048 + col0;
#pragma unroll
                    for (int bj = 0; bj < 2; ++bj) { const f32x4 v0 = acc[ai][bj][m][0] * g, v1 = acc[ai][bj][m][1] * g;
                        u32x4 w; w.x = cvt_pk_bf16(v0[0], v0[1]); w.y = cvt_pk_bf16(v0[2], v0[3]); w.z = cvt_pk_bf16(v1[0], v1[1]); w.w = cvt_pk_bf16(v1[2], v1[3]);
                        *(u32x4*)(rowp + bj * HALF) = w; } }
                asm volatile("" ::: "memory"); }
    }
};
struct MoeOrder {
    int nM, nN, nwg, G, c; const PG8_LAS int* tstart; const PG8_LAS int* cnt;
    __device__ void init(int nM_, int nN_, int G_, int c_, const PG8_LAS int* ts, const PG8_LAS int* cn) { nM = nM_; nN = nN_; nwg = nM * nN; G = G_; c = c_; tstart = ts; cnt = cn; }
    __device__ bool next(int i, Unit& u) const {
        const long L = (long)i * G + c; if (L >= nwg) return false;
        int wgid = (int)L; { const int q = nwg / NXCD, r = nwg % NXCD, xcd = wgid % NXCD, off = wgid / NXCD; wgid = (xcd < r ? xcd * (q + 1) : r * (q + 1) + (xcd - r) * q) + off; }
        const int nig = WGM * nN, gid = wgid / nig, fm = gid * WGM, gsz = (nM - fm) < WGM ? (nM - fm) : WGM;
        const int pm = fm + ((wgid % nig) % gsz), pn = (wgid % nig) / gsz;
        int e = 0;
        for (int k = 1; k < 32; ++k) e += (__builtin_amdgcn_readfirstlane(tstart[k]) <= pm) ? 1 : 0;
        const int t = pm - __builtin_amdgcn_readfirstlane(tstart[e]); const int left = __builtin_amdgcn_readfirstlane(cnt[e]) - t * 256;
        u.pm = pm; u.pn = pn; u.pb = e * nN + pn; u.aux0 = e * 65536 + t * 256; u.aux1 = left < 256 ? left : 256; return true;
    }
    __device__ __forceinline__ void a_ready(const Unit&) const {}
    __device__ __forceinline__ void done(const Unit&) const {}
};
template <class Epi, class Sched, bool ALIGN_EPI = false, bool SP2 = false, bool GATHER = false>
__device__ __forceinline__ void gemm_phase(PG8_LAS unsigned char* lds, const Gemm g, const Sched& S, const Epi& E, const int wid) {
    FRESH_LANE(lane); const int tid = wid * 64 + lane, wr = wid >> 2, wc = wid & 3, fr = lane & 15, fq = lane >> 4;
    const int K = g.K, nt = K / BK;
    unsigned voffA[2], voffB[2];
#pragma unroll
    for (int i = 0; i < 2; ++i) { int R, C; stage_rc(tid * 16 + i * 8192, R, C); const int Rb = Epi::PERM ? ((R & ~31) + perm32(R & 31)) : R;
        voffA[i] = (unsigned)(R * K + C) * 2u; voffB[i] = (unsigned)(Rb * K + C) * 2u; }
    const size_t kstep = (size_t)(BK * 2);
    const size_t hstep = (size_t)HALF * K * 2;
    const size_t tstep = 2 * hstep;
    const unsigned ldsw = (unsigned)wid * 1024u;
    const int aoff = lds_byte(wr * 64 + fr, fq * 8), boff = lds_byte(wc * 32 + fr, fq * 8);
#define PG8_SA(b, h) (((b) * 2 + (h)) * HTB)
#define PG8_SB(b, h) ((4 + (b) * 2 + (h)) * HTB)
#define PG8_STAGE(bufoff, gbase, voff) do { _Pragma("unroll") for (int _i = 0; _i < 2; ++_i) \
        __builtin_amdgcn_global_load_lds((const unsigned*)((const char*)(gbase) + (voff)[_i]), (PG8_LAS unsigned*)(lds + (bufoff) + ldsw + _i * 8192), 16, 0, 0); } while (0)
#define PG8_STAGE_A(bufoff, nextsel, half, kb) do { _Pragma("unroll") for (int _i = 0; _i < 2; ++_i) { const char* _p; \
        if constexpr (GATHER) _p = (const char*)g.A + (kb) + ((nextsel) ? nx[half][_i] : cu[half][_i]); else _p = ((nextsel) ? nA : cA) + (kb) + (size_t)(half) * hstep + voffA[_i]; \
        __builtin_amdgcn_global_load_lds((const unsigned*)_p, (PG8_LAS unsigned*)(lds + (bufoff) + ldsw + _i * 8192), 16, 0, 0); } } while (0)
#define PG8_ROWS(u, o) do { _Pragma("unroll") for (int _h = 0; _h < 2; ++_h) _Pragma("unroll") for (int _i = 0; _i < 2; ++_i) { const int _r = _h * HALF + (int)(voffA[_i] / (2u * (unsigned)K)); \
        const int _t = (_r < (u).aux1) ? (g.glist[(u).aux0 + _r] >> 1) : 0; o[_h][_i] = (unsigned)_t * (2u * (unsigned)K) + (voffA[_i] % (2u * (unsigned)K)); } } while (0)
#define PG8_LDA(dst, b, h) do { _Pragma("unroll") for (int m = 0; m < 4; ++m) _Pragma("unroll") for (int k = 0; k < 2; ++k) dst[m][k] = *(const PG8_LAS bf16x8*)(lds + PG8_SA(b, h) + aoff + m * 2048 + k * 1024); } while (0)
#define PG8_LDB(dst, b, h) do { _Pragma("unroll") for (int n = 0; n < 2; ++n) _Pragma("unroll") for (int k = 0; k < 2; ++k) dst[n][k] = *(const PG8_LAS bf16x8*)(lds + PG8_SB(b, h) + boff + n * 2048 + k * 1024); } while (0)
#define PG8_MMA(ai, bj, At, Bt) do { __builtin_amdgcn_s_setprio(1); _Pragma("unroll") for (int m = 0; m < 4; ++m) _Pragma("unroll") for (int n = 0; n < 2; ++n) _Pragma("unroll") for (int k = 0; k < 2; ++k) \
        acc[ai][bj][m][n] = __builtin_amdgcn_mfma_f32_16x16x32_bf16(Bt[n][k], At[m][k], acc[ai][bj][m][n], 0, 0, 0); __builtin_amdgcn_s_setprio(0); } while (0)
#define PG8_WAIT_V(n) asm volatile("s_waitcnt vmcnt(" #n ")" ::: "memory")
#define PG8_WAIT_L(n) asm volatile("s_waitcnt lgkmcnt(" #n ")" ::: "memory")
#define PG8_BAR __builtin_amdgcn_s_barrier()
#define PG8_SCHED __builtin_amdgcn_sched_barrier(0)
    Unit cur, nxt; int ui = 0;
    if (!S.next(0, cur)) return;
    f32x4 acc[2][2][4][2];
#pragma unroll
    for (int a = 0; a < 2; ++a)
#pragma unroll
        for (int b = 0; b < 2; ++b)
#pragma unroll
            for (int m = 0; m < 4; ++m)
#pragma unroll
                for (int n = 0; n < 2; ++n) acc[a][b][m][n] = (f32x4){0.f, 0.f, 0.f, 0.f};
    bf16x8 At[4][2], B0[2][2], B1[2][2];
    const char* cA = (const char*)g.A + (size_t)cur.pm * tstep; const char* cB = (const char*)g.Bt + (size_t)cur.pb * tstep;
    S.a_ready(cur);
    unsigned cu[2][2] = {{0u, 0u}, {0u, 0u}}, nx[2][2] = {{0u, 0u}, {0u, 0u}}; const char* nA = cA;
    if constexpr (GATHER) PG8_ROWS(cur, cu);
    if constexpr (SP2) {
        PG8_STAGE(PG8_SB(0, 0), cB, voffB); PG8_STAGE(PG8_SB(0, 1), cB + hstep, voffB); PG8_STAGE_A(PG8_SA(0, 0), false, 0, 0); PG8_STAGE_A(PG8_SA(0, 1), false, 1, 0);
        if (wr == 1) PG8_BAR;
        PG8_WAIT_V(2); PG8_BAR;
        PG8_STAGE(PG8_SB(1, 0), cB + kstep, voffB); PG8_STAGE_A(PG8_SA(1, 0), false, 0, kstep); PG8_STAGE(PG8_SB(1, 1), cB + hstep + kstep, voffB);
        PG8_WAIT_V(6); PG8_BAR;
    } else { static_assert(SP2, "only the SP2 loop is kept in this file"); }
    for (;;) {
        const bool has_next = S.next(ui + 1, nxt);
        nA = has_next ? (const char*)g.A + (size_t)nxt.pm * tstep : cA;
        if constexpr (GATHER) { if (has_next) PG8_ROWS(nxt, nx); else { nx[0][0] = cu[0][0]; nx[0][1] = cu[0][1]; nx[1][0] = cu[1][0]; nx[1][1] = cu[1][1]; } }
        const char* nB = has_next ? (const char*)g.Bt + (size_t)nxt.pb * tstep : cB;
#pragma unroll 1
        for (int t = 0; t < nt; t += 2) {
            const bool last = (t == nt - 2);
            const size_t kb1 = (size_t)(t + 1) * kstep;
            const size_t kb2 = last ? 0 : (size_t)(t + 2) * kstep; const char* b2 = last ? nB : cB + (size_t)(t + 2) * kstep;
            const size_t kb3 = kb2 + kstep; const char* b3 = b2 + kstep;
            if (last && has_next) S.a_ready(nxt);
            if constexpr (SP2) {
            PG8_LDB(B0, 0, 0); PG8_LDB(B1, 0, 1); PG8_SCHED; PG8_LDA(At, 0, 0); PG8_STAGE_A(PG8_SA(1, 1), false, 1, kb1);
            PG8_WAIT_V(8); PG8_WAIT_L(0); PG8_BAR; PG8_MMA(0, 0, At, B0); PG8_MMA(0, 1, At, B1); PG8_BAR; PG8_SCHED;
            PG8_LDA(At, 0, 1); PG8_STAGE(PG8_SB(0, 0), b2, voffB); PG8_STAGE(PG8_SB(0, 1), b2 + hstep, voffB); PG8_STAGE_A(PG8_SA(0, 0), last, 0, kb2);
            PG8_WAIT_V(8); PG8_WAIT_L(0); PG8_BAR; PG8_MMA(1, 0, At, B0); PG8_MMA(1, 1, At, B1); PG8_BAR; PG8_SCHED;
            PG8_LDB(B0, 1, 0); PG8_LDB(B1, 1, 1); PG8_SCHED; PG8_LDA(At, 1, 0); PG8_STAGE_A(PG8_SA(0, 1), last, 1, kb2);
            PG8_WAIT_V(8); PG8_WAIT_L(0); PG8_BAR; PG8_MMA(0, 0, At, B0); PG8_MMA(0, 1, At, B1); PG8_BAR; PG8_SCHED;
            PG8_LDA(At, 1, 1); PG8_STAGE(PG8_SB(1, 0), b3, voffB); PG8_STAGE(PG8_SB(1, 1), b3 + hstep, voffB); PG8_STAGE_A(PG8_SA(1, 0), last, 0, kb3);
            PG8_WAIT_V(8); PG8_WAIT_L(0); PG8_BAR; PG8_MMA(1, 0, At, B0); PG8_MMA(1, 1, At, B1); PG8_BAR; PG8_SCHED;
            }
        }
        if constexpr (ALIGN_EPI) { if (wr == 0) PG8_BAR; }
        if constexpr (!Epi::AFTER_DRAIN) { E(acc, cur, wr, wc, fr, fq); S.done(cur); }
        if (!has_next) break;
#pragma unroll
        for (int a = 0; a < 2; ++a)
#pragma unroll
            for (int b = 0; b < 2; ++b)
#pragma unroll
                for (int m = 0; m < 4; ++m)
#pragma unroll
                    for (int n = 0; n < 2; ++n) acc[a][b][m][n] = (f32x4){0.f, 0.f, 0.f, 0.f};
        cur = nxt; cA = nA; cB = nB; ++ui;
        if constexpr (GATHER) { cu[0][0] = nx[0][0]; cu[0][1] = nx[0][1]; cu[1][0] = nx[1][0]; cu[1][1] = nx[1][1]; }
        if constexpr (ALIGN_EPI) { if (wr == 1) PG8_BAR; }
    }
    PG8_WAIT_V(0);
    if constexpr (!ALIGN_EPI) { if (wr == 0) PG8_BAR; }
    PG8_BAR;
    if constexpr (Epi::AFTER_DRAIN) { E.fused(acc, cur, wr, wc, fr, fq, lds, wid, lane); S.done(cur); }
#undef PG8_SA
#undef PG8_SB
#undef PG8_STAGE
#undef PG8_STAGE_A
#undef PG8_ROWS
#undef PG8_LDA
#undef PG8_LDB
#undef PG8_MMA
#undef PG8_WAIT_V
#undef PG8_WAIT_L
#undef PG8_BAR
#undef PG8_SCHED
}
}
namespace att {
using bf16 = unsigned short;
using bf16x8 = __attribute__((ext_vector_type(8))) short;
using s16x4  = __attribute__((ext_vector_type(4))) short;
using f32x16 = __attribute__((ext_vector_type(16))) float;
using u32x4  = __attribute__((ext_vector_type(4))) unsigned;
constexpr int LDQKV = 6144;
constexpr int SEQ_ = 8192;
constexpr size_t SHM_V = 64 * 128 * 2, SHM_K = 64 * 128 * 2, SHM_ATTN = 2 * SHM_V + 2 * SHM_K + 8 * 64 * 4 + 64;
#define KSWZ(row, colB) ((row) * 256 + ((colB) ^ (((row) & 7) << 4)))
#define SBAR() __builtin_amdgcn_sched_barrier(0)
__device__ __forceinline__ int crow(int r, int hi) { return (r & 3) + 8 * (r >> 2) + 4 * hi; }
__device__ __forceinline__ unsigned cvtpk(float lo, float hi) { unsigned r; asm volatile("v_cvt_pk_bf16_f32 %0, %1, %2" : "=v"(r) : "v"(lo), "v"(hi)); return r; }
__device__ __forceinline__ int v_st(int k, int c) { const int kk = (k & ~0xC) | ((k & 4) << 1) | ((k & 8) >> 1); return ((kk >> 3) * 4 + (c >> 5)) * 512 + ((kk & 7) * 32 + (c & 31)) * 2; }
__device__ __forceinline__ int v_rd_base(int lane) { return ((lane & 3) << 3) | (((lane >> 2) & 3) << 6) | (((lane >> 4) & 1) << 5) | (((lane >> 5) & 1) << 8); }
constexpr int v_rd_off(int d0, int ks, int half) { return d0 * 512 + ks * 4096 + half * 2048; }
template <int OFF> __device__ __forceinline__ s16x4 tr_read(int vb) { s16x4 r; asm volatile("ds_read_b64_tr_b16 %0, %1 offset:%2" : "=&v"(r) : "v"(vb), "i"(OFF) : "memory"); return r; }
template <int D0> __device__ __forceinline__ void pv_one(f32x16& od, int vb, bf16x8 pa0, bf16x8 pa1, bf16x8 pa2, bf16x8 pa3) {
  const s16x4 l0 = tr_read<v_rd_off(D0, 0, 0)>(vb), h0 = tr_read<v_rd_off(D0, 0, 1)>(vb), l1 = tr_read<v_rd_off(D0, 1, 0)>(vb), h1 = tr_read<v_rd_off(D0, 1, 1)>(vb);
  const s16x4 l2 = tr_read<v_rd_off(D0, 2, 0)>(vb), h2 = tr_read<v_rd_off(D0, 2, 1)>(vb), l3 = tr_read<v_rd_off(D0, 3, 0)>(vb), h3 = tr_read<v_rd_off(D0, 3, 1)>(vb);
  asm volatile("s_waitcnt lgkmcnt(0)" ::: "memory"); SBAR();
#define PK(L, H) (bf16x8){L[0], L[1], L[2], L[3], H[0], H[1], H[2], H[3]}
  od = __builtin_amdgcn_mfma_f32_32x32x16_bf16(pa0, PK(l0, h0), od, 0, 0, 0);
  od = __builtin_amdgcn_mfma_f32_32x32x16_bf16(pa1, PK(l1, h1), od, 0, 0, 0);
  od = __builtin_amdgcn_mfma_f32_32x32x16_bf16(pa2, PK(l2, h2), od, 0, 0, 0);
  od = __builtin_amdgcn_mfma_f32_32x32x16_bf16(pa3, PK(l3, h3), od, 0, 0, 0);
#undef PK
}
__device__ __forceinline__ void pv_d0(f32x16* o, int vb, bf16x8 pa0, bf16x8 pa1, bf16x8 pa2, bf16x8 pa3) {
  pv_one<0>(o[0], vb, pa0, pa1, pa2, pa3); pv_one<1>(o[1], vb, pa0, pa1, pa2, pa3); pv_one<2>(o[2], vb, pa0, pa1, pa2, pa3); pv_one<3>(o[3], vb, pa0, pa1, pa2, pa3);
}
__device__ __forceinline__ void pack_p(const f32x16& p0, const f32x16& p1, bf16x8& pa0, bf16x8& pa1, bf16x8& pa2, bf16x8& pa3) {
#define PK4(P, BASE, OUT) do { unsigned a0 = cvtpk(P[BASE + 0], P[BASE + 1]), a1 = cvtpk(P[BASE + 2], P[BASE + 3]);   \
    unsigned b0 = cvtpk(P[BASE + 4], P[BASE + 5]), b1 = cvtpk(P[BASE + 6], P[BASE + 7]);                              \
    auto r0 = __builtin_amdgcn_permlane32_swap(a0, b0, false, false); auto r1 = __builtin_amdgcn_permlane32_swap(a1, b1, false, false); \
    u32x4 w = {r0[0], r1[0], r0[1], r1[1]}; OUT = *reinterpret_cast<bf16x8*>(&w); } while (0)
  PK4(p0, 0, pa0); PK4(p0, 8, pa1); PK4(p1, 0, pa2); PK4(p1, 8, pa3);
#undef PK4
}
template <int ND> __device__ __forceinline__ void qkt(f32x16& p0, f32x16& p1, const char* Ks, const bf16x8* qr, int cb0, int r32, int hi) {
  p0 = f32x16{}; p1 = f32x16{};
#pragma unroll
  for (int d0 = 0; d0 < ND; ++d0) { const int cb = cb0 + (d0 * 16 + hi * 8) * 2;
    const bf16x8 b0 = *reinterpret_cast<const bf16x8*>(Ks + KSWZ(r32, cb));
    const bf16x8 b1 = *reinterpret_cast<const bf16x8*>(Ks + KSWZ(32 + r32, cb));
    p0 = __builtin_amdgcn_mfma_f32_32x32x16_bf16(b0, qr[d0], p0, 0, 0, 0);
    p1 = __builtin_amdgcn_mfma_f32_32x32x16_bf16(b1, qr[d0], p1, 0, 0, 0); }
}
constexpr float THRL = 11.5f;
__device__ __forceinline__ void partialSM(f32x16& p0, f32x16& p1, float& m_reg, float& mn, float& alpha) {
  float pmax = p0[0];
#pragma unroll
  for (int r = 1; r < 16; ++r) pmax = fmaxf(pmax, p0[r]);
#pragma unroll
  for (int r = 0; r < 16; ++r) pmax = fmaxf(pmax, p1[r]);
  { auto rr = __builtin_amdgcn_permlane32_swap(__float_as_uint(pmax), __float_as_uint(pmax), false, false); pmax = fmaxf(__uint_as_float(rr[0]), __uint_as_float(rr[1])); }
  if (__builtin_expect(__all(pmax - m_reg <= THRL), 1)) { mn = m_reg; alpha = 1.f; }
  else { mn = fmaxf(m_reg, pmax); alpha = __builtin_amdgcn_exp2f(m_reg - mn); m_reg = mn; }
#pragma unroll
  for (int r = 0; r < 16; ++r) p0[r] = p0[r] - mn;
#pragma unroll
  for (int r = 0; r < 16; ++r) p1[r] = p1[r] - mn;
#pragma unroll
  for (int r = 0; r < 16; ++r) p0[r] = __builtin_amdgcn_exp2f(p0[r]);
}
__device__ __forceinline__ void finishSM(f32x16& p0, f32x16& p1, float alpha, float& l_reg, bf16x8& pa0, bf16x8& pa1, bf16x8& pa2, bf16x8& pa3) {
#pragma unroll
  for (int r = 0; r < 16; ++r) p1[r] = __builtin_amdgcn_exp2f(p1[r]);
  float ps = 0;
#pragma unroll
  for (int r = 0; r < 16; ++r) ps += p0[r];
#pragma unroll
  for (int r = 0; r < 16; ++r) ps += p1[r];
  { auto rr = __builtin_amdgcn_permlane32_swap(__float_as_uint(ps), __float_as_uint(ps), false, false); ps = __uint_as_float(rr[0]) + __uint_as_float(rr[1]); }
  l_reg = l_reg * alpha + ps;
  pack_p(p0, p1, pa0, pa1, pa2, pa3);
}
__device__ __forceinline__ float half_sum32(float v) { return half_sum32_(v); }

__device__ __forceinline__ void diff_unit(int b, int h, int qb, const bf16* __restrict__ QKV, bf16* __restrict__ Oout, const float* __restrict__ gdiff, float lam, float oscale, char* lds) {
  const int tid = threadIdx.x, lane = tid & 63, r32 = lane & 31, hi = lane >> 5; const int wid = __builtin_amdgcn_readfirstlane(tid >> 6);
  const int map = wid >> 2, wq = wid & 3;
  bf16* V_lds = (bf16*)lds; bf16* K_lds = (bf16*)(lds + 2 * SHM_V);
  float* ws = (float*)(lds + 2 * SHM_V + 2 * SHM_K) + wid * 64; float* li_l = ws; float* al_l = ws + 32;
  float m_reg = -1e30f, l_reg = 0; f32x16 o[4] = {}; bf16x8 qr[4];
  const size_t rowb = (size_t)b * SEQ_;
  const bf16* Qw = QKV + (rowb + qb * 128 + wq * 32 + r32) * LDQKV + 3072 + h * 128 + map * 64 + hi * 8;
#pragma unroll
  for (int d0 = 0; d0 < 4; ++d0) qr[d0] = *reinterpret_cast<const bf16x8*>(Qw + d0 * 16);
  const bf16* Kh = QKV + rowb * LDQKV + 4096 + h * 128; const bf16* Vh = QKV + rowb * LDQKV + 5120 + h * 128;
  const int sr = tid >> 4, sc = (tid & 15) * 8, vst0 = v_st(sr, sc), vst1 = v_st(32 + sr, sc);
  const int vb0 = (int)(uintptr_t)V_lds + v_rd_base(lane);
  const int cbm = map * 128;
  struct { bf16x8 vs0, vs1, ks0, ks1; } sr_[1];
  const unsigned toff0 = (unsigned)(sr * LDQKV + sc), toff1 = toff0 + 32u * LDQKV;
#define SLOAD(i, k0) do { const bf16* vt_ = Vh + (size_t)(k0) * LDQKV; const bf16* kt_ = Kh + (size_t)(k0) * LDQKV; \
    sr_[i].vs0 = *reinterpret_cast<const bf16x8*>(vt_ + toff0); sr_[i].vs1 = *reinterpret_cast<const bf16x8*>(vt_ + toff1); \
    sr_[i].ks0 = *reinterpret_cast<const bf16x8*>(kt_ + toff0); sr_[i].ks1 = *reinterpret_cast<const bf16x8*>(kt_ + toff1); } while (0)
#define SWRITE(bb, i) do { *(bf16x8*)((char*)V_lds + (bb) * SHM_V + vst0) = sr_[i].vs0; *(bf16x8*)((char*)V_lds + (bb) * SHM_V + vst1) = sr_[i].vs1; const int kc = sc * 2; \
    *(bf16x8*)((char*)K_lds + (bb) * SHM_K + KSWZ(sr, kc)) = sr_[i].ks0; *(bf16x8*)((char*)K_lds + (bb) * SHM_K + KSWZ(32 + sr, kc)) = sr_[i].ks1; } while (0)
#define SWAIT() asm volatile("s_waitcnt vmcnt(0)" ::: "memory")
#define RESC(a) do { if (__any((a) < 1.f)) { if (hi == 0) al_l[r32] = (a); asm volatile("s_waitcnt lgkmcnt(0)" ::: "memory"); \
    _Pragma("unroll") for (int d = 0; d < 4; ++d) _Pragma("unroll") for (int r = 0; r < 16; ++r) o[d][r] *= al_l[crow(r, hi)]; } } while (0)
  f32x16 pA0, pA1, pB0, pB1; float mnA, mnB, alA, alB; bf16x8 pa0, pa1, pa2, pa3; const int NT = 2 * qb + 2;
  __syncthreads();
  SLOAD(0, 0); asm volatile("s_waitcnt vmcnt(0)" ::: "memory"); SWRITE(0, 0); __syncthreads();
  qkt<4>(pA0, pA1, (const char*)K_lds, qr, cbm, r32, hi); partialSM(pA0, pA1, m_reg, mnA, alA);
  SLOAD(0, 64);
  SWAIT(); SWRITE(1, 0); __syncthreads();
  for (int j = 1; j + 1 < NT; j += 2) {
    SBAR(); qkt<4>(pB0, pB1, (const char*)K_lds + SHM_K, qr, cbm, r32, hi);
    finishSM(pA0, pA1, alA, l_reg, pa0, pa1, pa2, pa3); SBAR();
    SLOAD(0, (j + 1) * 64); SBAR();
    pv_d0(o, vb0, pa0, pa1, pa2, pa3); partialSM(pB0, pB1, m_reg, mnB, alB);
    __syncthreads(); SWAIT(); SWRITE(0, 0);
    RESC(alB); __syncthreads();
    SBAR(); qkt<4>(pA0, pA1, (const char*)K_lds, qr, cbm, r32, hi);
    finishSM(pB0, pB1, alB, l_reg, pa0, pa1, pa2, pa3); SBAR();
    SLOAD(0, (j + 2) * 64); SBAR();
    pv_d0(o, vb0 + (int)SHM_V, pa0, pa1, pa2, pa3); partialSM(pA0, pA1, m_reg, mnA, alA);
    __syncthreads(); SWAIT(); SWRITE(1, 0);
    RESC(alA); __syncthreads();
  }
  SBAR(); qkt<4>(pB0, pB1, (const char*)K_lds + SHM_K, qr, cbm, r32, hi);
  if (wq < 2) {
#pragma unroll
    for (int r = 0; r < 16; ++r) { pB0[r] = -1e30f; pB1[r] = -1e30f; } }
  finishSM(pA0, pA1, alA, l_reg, pa0, pa1, pa2, pa3); SBAR();
  pv_d0(o, vb0, pa0, pa1, pa2, pa3); partialSM(pB0, pB1, m_reg, mnB, alB);
  __syncthreads(); RESC(alB);
  finishSM(pB0, pB1, alB, l_reg, pa0, pa1, pa2, pa3); SBAR();
  pv_d0(o, vb0 + (int)SHM_V, pa0, pa1, pa2, pa3);
  if (hi == 0) li_l[r32] = l_reg; asm volatile("s_waitcnt lgkmcnt(0)" ::: "memory");
  float rli[16];
#pragma unroll
  for (int r = 0; r < 16; ++r) rli[r] = __builtin_amdgcn_rcpf(li_l[crow(r, hi)]);
  __syncthreads();
  float* xch = (float*)lds + (size_t)wq * 4096;
  if (map == 1) {
#pragma unroll
    for (int d0 = 0; d0 < 4; ++d0)
#pragma unroll
      for (int r = 0; r < 16; ++r) xch[(d0 * 16 + r) * 64 + lane] = o[d0][r] * rli[r] * lam;
  }
  __syncthreads();
  if (map == 0) {
    float ss[16];
#pragma unroll
    for (int r = 0; r < 16; ++r) { float s = 0.f;
#pragma unroll
      for (int d0 = 0; d0 < 4; ++d0) { const float v = o[d0][r] * rli[r] - xch[(d0 * 16 + r) * 64 + lane]; o[d0][r] = v; s += v * v; }
      ss[r] = s; }
#pragma unroll
    for (int r = 0; r < 16; ++r) ss[r] = half_sum32(ss[r]);
    bf16* Ow = Oout + (rowb + qb * 128 + wq * 32) * 2048 + 1024 + h * 128;
    float gv[4];
#pragma unroll
    for (int d0 = 0; d0 < 4; ++d0) gv[d0] = gdiff[d0 * 32 + r32] * oscale;
#pragma unroll
    for (int r = 0; r < 16; ++r) { const int orow = crow(r, hi); const float rs = rsqrtf(ss[r] * (1.f / 128.f) + 1e-6f);
#pragma unroll
      for (int d0 = 0; d0 < 4; ++d0) { const float y = o[d0][r] * rs * gv[d0]; const unsigned w = cvtpk(y, y); Ow[(size_t)orow * 2048 + d0 * 32 + r32] = (bf16)(w & 0xffffu); } }
  }
#undef SLOAD
#undef SWRITE
#undef SWAIT
#undef RESC
}
__device__ __forceinline__ void sb_wave_unit(int b, int h, int wq, const bf16* __restrict__ QKV, bf16* __restrict__ Oout, const float* __restrict__ gsb, char* ldsw) {
  FRESH_LANE(lane);
  const int r32 = lane & 31, hi = lane >> 5;
  char* V_lds = ldsw; char* K_lds = ldsw + 8192;
  f32x16 o[4] = {}; bf16x8 qr[8];
  const size_t rowb = (size_t)b * SEQ_;
  const int Q0 = wq * 32, tq = Q0 + r32;
  const bf16* Qw = QKV + (rowb + tq) * LDQKV + h * 128 + hi * 8;
#pragma unroll
  for (int d0 = 0; d0 < 8; ++d0) qr[d0] = *reinterpret_cast<const bf16x8*>(Qw + d0 * 16);
  const bf16* Kh = QKV + rowb * LDQKV + 1024 + h * 128; const bf16* Vh = QKV + rowb * LDQKV + 2048 + h * 128;
  const int skey = lane >> 4, scol = (lane & 15) * 8;
  const unsigned toff = (unsigned)(skey * LDQKV + scol);
  const unsigned koff0 = (unsigned)(skey * LDQKV + (((lane & 15) ^ skey) * 8)), koff1 = (unsigned)(skey * LDQKV + (((lane & 15) ^ (4 + skey)) * 8));
  typedef __attribute__((address_space(3))) unsigned lds_u32;
  lds_u32* kl = (lds_u32*)(K_lds);
  const int vb0 = (int)(uintptr_t)V_lds + v_rd_base(lane);
  bf16x8 vs[8];
#define SB_LOADV(j) do { const bf16* vt_ = Vh + (size_t)(j) * 32 * LDQKV; \
    _Pragma("unroll") for (int i_ = 0; i_ < 8; ++i_) vs[i_] = *reinterpret_cast<const bf16x8*>(vt_ + toff + (unsigned)(4 * i_) * LDQKV); } while (0)
#define SB_DMAK(j) do { const bf16* kt_ = Kh + (size_t)(j) * 32 * LDQKV; \
    _Pragma("unroll") for (int p_ = 0; p_ < 8; ++p_) __builtin_amdgcn_global_load_lds((const unsigned*)(kt_ + (unsigned)(4 * p_) * LDQKV + ((p_ & 1) ? koff1 : koff0)), kl + p_ * 256, 16, 0, 0); } while (0)
  float carry = 0.f;
  SB_DMAK(wq); SB_LOADV(wq);
  for (int j = wq; j >= 0; --j) {
    asm volatile("s_waitcnt vmcnt(0)" ::: "memory");
#pragma unroll
    for (int i = 0; i < 8; ++i) { const int key = 4 * i + skey; *(bf16x8*)(V_lds + v_st(key, scol)) = vs[i]; }
    asm volatile("s_waitcnt lgkmcnt(0)" ::: "memory");
    if (j > 0) SB_LOADV(j - 1);
    f32x16 p0 = f32x16{};
#pragma unroll
    for (int d0 = 0; d0 < 8; ++d0) { const int cb = (d0 * 16 + hi * 8) * 2;
      const bf16x8 b0 = *reinterpret_cast<const bf16x8*>(K_lds + KSWZ(r32, cb));
      p0 = __builtin_amdgcn_mfma_f32_32x32x16_bf16(b0, qr[d0], p0, 0, 0, 0); }
    asm volatile("s_waitcnt lgkmcnt(0)" ::: "memory");
    if (j > 0) SB_DMAK(j - 1);
    const bool diag = (j == wq);
    const int kb = j * 32 + 4 * hi;
    f32x16 q0;
#pragma unroll
    for (int r = 0; r < 16; ++r) {
      const float z0 = __builtin_amdgcn_fmed3f(p0[r], -120.f, 120.f);
      float a0 = -__builtin_amdgcn_logf(1.f + __builtin_amdgcn_exp2f(z0));
      float b0 = z0 + a0;
      if (diag) { const int kv = kb + (r & 3) + 8 * (r >> 2); if (kv >= tq) { a0 = 0.f; b0 = -1e30f; } }
      q0[r] = a0; p0[r] = b0; }
    float G[4], PG[4], SUF[4];
#pragma unroll
    for (int g = 0; g < 4; ++g) G[g] = (q0[4 * g] + q0[4 * g + 1]) + (q0[4 * g + 2] + q0[4 * g + 3]);
    float CS[4];
#pragma unroll
    for (int g = 0; g < 4; ++g) { auto rr = __builtin_amdgcn_permlane32_swap(__float_as_uint(G[g]), __float_as_uint(G[g]), false, false);
      CS[g] = __uint_as_float(rr[0]) + __uint_as_float(rr[1]); PG[g] = __uint_as_float(rr[1]); }
    float run = carry;
#pragma unroll
    for (int g = 3; g >= 0; --g) { SUF[g] = run; run += CS[g]; }
    carry = run;
#pragma unroll
    for (int g = 0; g < 4; ++g) SUF[g] += (hi == 0) ? PG[g] : 0.f;
#pragma unroll
    for (int g = 0; g < 4; ++g) {
      float s = SUF[g];
      p0[4 * g + 3] = __builtin_amdgcn_exp2f(p0[4 * g + 3] + s); s += q0[4 * g + 3];
      p0[4 * g + 2] = __builtin_amdgcn_exp2f(p0[4 * g + 2] + s); s += q0[4 * g + 2];
      p0[4 * g + 1] = __builtin_amdgcn_exp2f(p0[4 * g + 1] + s); s += q0[4 * g + 1];
      p0[4 * g + 0] = __builtin_amdgcn_exp2f(p0[4 * g + 0] + s);
    }
    bf16x8 pa0, pa1;
#define PK4(P, BASE, OUT) do { unsigned a0 = cvtpk(P[BASE + 0], P[BASE + 1]), a1 = cvtpk(P[BASE + 2], P[BASE + 3]);   \
    unsigned b0 = cvtpk(P[BASE + 4], P[BASE + 5]), b1 = cvtpk(P[BASE + 6], P[BASE + 7]);                              \
    auto r0 = __builtin_amdgcn_permlane32_swap(a0, b0, false, false); auto r1 = __builtin_amdgcn_permlane32_swap(a1, b1, false, false); \
    u32x4 w = {r0[0], r1[0], r0[1], r1[1]}; OUT = *reinterpret_cast<bf16x8*>(&w); } while (0)
    PK4(p0, 0, pa0); PK4(p0, 8, pa1);
#undef PK4
#define SB_PV(D0) do { const s16x4 l0 = tr_read<v_rd_off(D0, 0, 0)>(vb0), h0 = tr_read<v_rd_off(D0, 0, 1)>(vb0), l1 = tr_read<v_rd_off(D0, 1, 0)>(vb0), h1 = tr_read<v_rd_off(D0, 1, 1)>(vb0); \
    asm volatile("s_waitcnt lgkmcnt(0)" ::: "memory"); SBAR(); \
    o[D0] = __builtin_amdgcn_mfma_f32_32x32x16_bf16(pa0, (bf16x8){l0[0], l0[1], l0[2], l0[3], h0[0], h0[1], h0[2], h0[3]}, o[D0], 0, 0, 0); \
    o[D0] = __builtin_amdgcn_mfma_f32_32x32x16_bf16(pa1, (bf16x8){l1[0], l1[1], l1[2], l1[3], h1[0], h1[1], h1[2], h1[3]}, o[D0], 0, 0, 0); } while (0)
    SB_PV(0); SB_PV(1); SB_PV(2); SB_PV(3);
#undef SB_PV
    if (__all(carry < -160.f)) break;
  }
#undef SB_LOADV
#undef SB_DMAK
  { FRESH_LANE(le_); const int r32e = le_ & 31, hie = le_ >> 5; float ss[16];
#pragma unroll
    for (int r = 0; r < 16; ++r) { float s = 0.f;
#pragma unroll
      for (int d0 = 0; d0 < 4; ++d0) s += o[d0][r] * o[d0][r];
      ss[r] = half_sum32(s); }
    bf16* Ow = Oout + (rowb + Q0) * 2048 + h * 128;
    float gv[4];
#pragma unroll
    for (int d0 = 0; d0 < 4; ++d0) gv[d0] = gsb[d0 * 32 + r32e];
#pragma unroll
    for (int r = 0; r < 16; ++r) { const int orow = crow(r, hie); const float rs = rsqrtf(ss[r] * (1.f / 128.f) + 1e-6f);
#pragma unroll
      for (int d0 = 0; d0 < 4; ++d0) { const float y = o[d0][r] * rs * gv[d0]; const unsigned w = cvtpk(y, y); Ow[(size_t)orow * 2048 + d0 * 32 + r32e] = (bf16)(w & 0xffffu); } }
  }
  asm volatile("s_waitcnt vmcnt(0)" ::: "memory");
}
#undef KSWZ
#undef SBAR
}
namespace att {
typedef __attribute__((address_space(3))) const char* lds_cptr;
typedef short v4i16_t __attribute__((ext_vector_type(4)));
constexpr int D2_K = 0, D2_V = 49152, D2_WS = 98304, D2_SLOT = 16384;
constexpr float THR2 = 8.f;
__device__ __forceinline__ void glds16(const void* gsrc, unsigned lds_dst) { unsigned keep;
  asm volatile("s_mov_b32 %0, m0\n\ts_mov_b32 m0, %2\n\ts_nop 0\n\tglobal_load_lds_dwordx4 %1, off\n\ts_mov_b32 m0, %0" : "=&s"(keep) : "v"(gsrc), "s"(lds_dst) : "memory"); }
__device__ __forceinline__ s16x4 vtr(lds_cptr p) { return __builtin_bit_cast(s16x4, __builtin_amdgcn_ds_read_tr16_b64_v4i16((__attribute__((address_space(3))) v4i16_t*)p)); }
__device__ __forceinline__ float max3f(float a, float b, float c) { return __builtin_fmaxf(__builtin_fmaxf(a, b), c); }
__device__ __forceinline__ float rowmax2(const f32x16& p0, const f32x16& p1) {
  float a = max3f(p0[0], p0[1], p1[0]), b = max3f(p0[2], p0[3], p1[1]); a = max3f(a, p1[2], p1[3]);
#pragma unroll
  for (int r = 4; r < 16; r += 4) { a = max3f(a, p0[r], p0[r + 1]); b = max3f(b, p0[r + 2], p0[r + 3]); a = max3f(a, p1[r], p1[r + 1]); b = max3f(b, p1[r + 2], p1[r + 3]); }
  const float m = __builtin_fmaxf(a, b);
  auto rr = __builtin_amdgcn_permlane32_swap(__float_as_uint(m), __float_as_uint(m), false, false);
  return __builtin_fmaxf(__uint_as_float(rr[0]), __uint_as_float(rr[1]));
}
#define SBAR2() __builtin_amdgcn_sched_barrier(0)
#define WAIT_BAR2(N) asm volatile("s_waitcnt vmcnt(" #N ") lgkmcnt(0)\n\ts_barrier" ::: "memory")
__device__ __forceinline__ void diff_unit2(int b, int h, int qb, const bf16* __restrict__ QKV, bf16* __restrict__ Oout, const float* __restrict__ gdiff, float lam, float oscale, char* shm, int wid) {
  int lane; asm volatile("v_mbcnt_lo_u32_b32 %0, -1, 0\n\tv_mbcnt_hi_u32_b32 %0, -1, %0" : "=v"(lane));
  const int r32 = lane & 31, hi = lane >> 5;
  const int map = wid >> 2, wq = wid & 3;
  const size_t rowb = (size_t)b * SEQ_;
  const bf16* Kh = QKV + rowb * LDQKV + 4096 + h * 128; const bf16* Vh = QKV + rowb * LDQKV + 5120 + h * 128;
  const unsigned lds0 = (unsigned)(uintptr_t)shm;
  float* wsf = (float*)(shm + D2_WS) + wid * 64;
  const bf16* ksrc = Kh + (size_t)lane * LDQKV + wid * 8;
  const bf16* vsrc = Vh + (size_t)(16 * (wid & 3) + (lane >> 2)) * LDQKV + (wid >> 2) * 32 + (lane & 3) * 8;
  const unsigned kdst = lds0 + D2_K + wid * 1024, vdst = lds0 + D2_V + wid * 1024;
#define DMA_K(t, slot) do { const bf16* s_ = ksrc + (size_t)(t) * 64 * LDQKV; const unsigned d_ = (unsigned)__builtin_amdgcn_readfirstlane(kdst + (slot)); glds16(s_, d_); glds16(s_ + 64, d_ + 8192); } while (0)
#define DMA_V(t, slot) do { const bf16* s_ = vsrc + (size_t)(t) * 64 * LDQKV; const unsigned d_ = (unsigned)__builtin_amdgcn_readfirstlane(vdst + (slot)); glds16(s_, d_); glds16(s_ + 64, d_ + 8192); } while (0)
  const lds_cptr shm3 = (lds_cptr)shm;
  const lds_cptr kp0 = shm3 + D2_K + (map * 8 + hi) * 1024 + r32 * 16;
  const lds_cptr vp0 = shm3 + D2_V + ((lane >> 4) & 1) * 32 + (lane & 3) * 8 + (4 * hi + ((lane & 15) >> 2)) * 64;
  const int NT = 2 * qb + 2;
  __syncthreads();
  DMA_K(0, 0); DMA_V(0, 0); DMA_K(1, D2_SLOT);
  bf16x8 qr[4];
  { const bf16* Qw = QKV + (rowb + qb * 128 + wq * 32 + r32) * LDQKV + 3072 + h * 128 + map * 64 + hi * 8;
#pragma unroll
    for (int d0 = 0; d0 < 4; ++d0) qr[d0] = *reinterpret_cast<const bf16x8*>(Qw + d0 * 16); }
  float mhat = 0.f, l_reg = 0.f; f32x16 o[4];
  { float z_ = 0.f; asm volatile("" : "+v"(z_));
#pragma unroll
    for (int d_ = 0; d_ < 4; ++d_)
#pragma unroll
      for (int r = 0; r < 16; ++r) o[d_][r] = z_; }
  bool resc = false;
  f32x16 pA0, pA1, pB0, pB1;
  int sl_prev = 0, sl_cur = 0, sl_next = D2_SLOT;
#define ROT() do { sl_prev = sl_cur; sl_cur = sl_next; sl_next = (sl_next == 2 * D2_SLOT) ? 0 : sl_next + D2_SLOT; } while (0)
#define KF(kp, d0, half) (*(const __attribute__((address_space(3))) bf16x8*)((kp) + (d0) * 2048 + (half) * 512))
#define RESC2() do { if (resc) { asm volatile("s_waitcnt lgkmcnt(0)" ::: "memory"); \
      _Pragma("unroll") for (int d_ = 0; d_ < 4; ++d_) _Pragma("unroll") for (int r = 0; r < 16; ++r) o[d_][r] *= wsf[crow(r, hi)]; } } while (0)
  WAIT_BAR2(0);
  { const lds_cptr kp_ = kp0;
    pA0 = __builtin_amdgcn_mfma_f32_32x32x16_bf16(KF(kp_, 0, 0), qr[0], f32x16{}, 0, 0, 0); pA1 = __builtin_amdgcn_mfma_f32_32x32x16_bf16(KF(kp_, 0, 1), qr[0], f32x16{}, 0, 0, 0);
#pragma unroll
    for (int d0 = 1; d0 < 4; ++d0) { pA0 = __builtin_amdgcn_mfma_f32_32x32x16_bf16(KF(kp_, d0, 0), qr[d0], pA0, 0, 0, 0); pA1 = __builtin_amdgcn_mfma_f32_32x32x16_bf16(KF(kp_, d0, 1), qr[d0], pA1, 0, 0, 0); }
    const float rm = rowmax2(pA0, pA1); mhat = rm;
#pragma unroll
    for (int r = 0; r < 16; ++r) { pA0[r] = __builtin_amdgcn_exp2f(pA0[r] - rm); pA1[r] = __builtin_amdgcn_exp2f(pA1[r] - rm); }
    if (2 < NT) DMA_K(2, 2 * D2_SLOT);
    DMA_V(1, D2_SLOT);
    asm volatile("s_waitcnt lgkmcnt(0)\n\ts_barrier" ::: "memory");
    ROT(); }
  u32x4 pw0, pw1, pw2, pw3;
#define PKW(P, B) cvtpk(P[B], P[B + 1])
#define PAF(k) __builtin_bit_cast(bf16x8, pw##k)
#define MFQ(C, d0, half, first) C = __builtin_amdgcn_mfma_f32_32x32x16_bf16(KF(kp_, d0, half), qr[d0], (first) ? f32x16{} : C, 0, 0, 0)
#define VRD(i) do { vl[(i) & 3] = vtr(vp_ + ((i) & 3) * 4096 + ((i) >> 2) * 1024); vh[(i) & 3] = vtr(vp_ + ((i) & 3) * 4096 + ((i) >> 2) * 1024 + 512); } while (0)
#define VFR(i) (bf16x8){vl[(i) & 3][0], vl[(i) & 3][1], vl[(i) & 3][2], vl[(i) & 3][3], vh[(i) & 3][0], vh[(i) & 3][1], vh[(i) & 3][2], vh[(i) & 3][3]}
#define EX2(C, B) do { C[B] = __builtin_amdgcn_exp2f(C[B]); C[(B) + 1] = __builtin_amdgcn_exp2f(C[(B) + 1]); asm volatile("" : "+v"(C)); } while (0)
#define KRD(i) kfr[(i) % 3] = KF(kp_, (i) >> 1, (i) & 1)
#define MFK(C, i, first) C = __builtin_amdgcn_mfma_f32_32x32x16_bf16(kfr[(i) % 3], qr[(i) >> 1], (first) ? f32x16{} : C, 0, 0, 0)
#define STEP2(C0, C1, P0, P1, t, GK, GV, MASKED) do { SBAR2(); \
    const lds_cptr kp_ = kp0 + sl_cur; const lds_cptr vp_ = vp0 + sl_prev; s16x4 vl[4], vh[4]; bf16x8 kfr[3]; \
    KRD(0); KRD(1); SBAR2(); \
    float sacc = P0[0] + P0[1]; \
    KRD(2); MFK(C0, 0, true);  sacc += P0[2]; sacc += P0[3]; sacc += P0[4]; sacc += P0[5]; asm volatile("" : "+v"(sacc));     pw0[0] = PKW(P0, 0); pw0[1] = PKW(P0, 2); SBAR2(); \
    KRD(3); MFK(C1, 1, true);  sacc += P0[6]; sacc += P0[7]; sacc += P0[8]; sacc += P0[9]; asm volatile("" : "+v"(sacc));     pw0[2] = PKW(P0, 4); pw0[3] = PKW(P0, 6); SBAR2(); \
    KRD(4); MFK(C0, 2, false); sacc += P0[10]; sacc += P0[11]; sacc += P0[12]; sacc += P0[13]; asm volatile("" : "+v"(sacc)); pw1[0] = PKW(P0, 8); pw1[1] = PKW(P0, 10); SBAR2(); \
    KRD(5); MFK(C1, 3, false); sacc += P0[14]; sacc += P0[15]; sacc += P1[0]; sacc += P1[1]; asm volatile("" : "+v"(sacc));   pw1[2] = PKW(P0, 12); pw1[3] = PKW(P0, 14); SBAR2(); \
    KRD(6); MFK(C0, 4, false); sacc += P1[2]; sacc += P1[3]; sacc += P1[4]; sacc += P1[5]; asm volatile("" : "+v"(sacc));     pw2[0] = PKW(P1, 0); pw2[1] = PKW(P1, 2); SBAR2(); \
    KRD(7); MFK(C1, 5, false); sacc += P1[6]; sacc += P1[7]; sacc += P1[8]; sacc += P1[9]; asm volatile("" : "+v"(sacc));     pw2[2] = PKW(P1, 4); pw2[3] = PKW(P1, 6); SBAR2(); \
    VRD(0); MFK(C0, 6, false); sacc += P1[10]; sacc += P1[11]; sacc += P1[12]; sacc += P1[13]; asm volatile("" : "+v"(sacc)); pw3[0] = PKW(P1, 8); pw3[1] = PKW(P1, 10); SBAR2(); \
    VRD(1); MFK(C1, 7, false); sacc += P1[14]; sacc += P1[15]; asm volatile("" : "+v"(sacc));                                 pw3[2] = PKW(P1, 12); pw3[3] = PKW(P1, 14); SBAR2(); \
    VRD(2); \
    l_reg += sacc; \
    if (GK) { DMA_K((t) + 2, sl_prev); } if (GV) { DMA_V((t) + 1, sl_next); } \
    if (MASKED) { _Pragma("unroll") for (int r = 0; r < 16; ++r) { C0[r] = -1e30f; C1[r] = -1e30f; } } \
    { const float rm = rowmax2(C0, C1) - mhat; resc = false; \
      if (__builtin_expect(__any(rm > THR2), 0)) { const float dl = __builtin_fmaxf(rm, 0.f); mhat += dl; \
        const float f = __builtin_amdgcn_exp2f(-dl); l_reg *= f; if (hi == 0) wsf[r32] = f; resc = true; } \
      _Pragma("unroll") for (int r = 0; r < 16; ++r) { C0[r] -= mhat; C1[r] -= mhat; } } \
    SBAR2(); \
    VRD(3);  o[0] = __builtin_amdgcn_mfma_f32_32x32x16_bf16(PAF(0), VFR(0),  o[0], 0, 0, 0); EX2(C0, 0);  SBAR2(); \
    VRD(4);  o[1] = __builtin_amdgcn_mfma_f32_32x32x16_bf16(PAF(0), VFR(1),  o[1], 0, 0, 0); EX2(C0, 2);  SBAR2(); \
    VRD(5);  o[2] = __builtin_amdgcn_mfma_f32_32x32x16_bf16(PAF(0), VFR(2),  o[2], 0, 0, 0); EX2(C0, 4);  SBAR2(); \
    VRD(6);  o[3] = __builtin_amdgcn_mfma_f32_32x32x16_bf16(PAF(0), VFR(3),  o[3], 0, 0, 0); EX2(C0, 6);  SBAR2(); \
    VRD(7);  o[0] = __builtin_amdgcn_mfma_f32_32x32x16_bf16(PAF(1), VFR(4),  o[0], 0, 0, 0); EX2(C0, 8);  SBAR2(); \
    VRD(8);  o[1] = __builtin_amdgcn_mfma_f32_32x32x16_bf16(PAF(1), VFR(5),  o[1], 0, 0, 0); EX2(C0, 10); SBAR2(); \
    VRD(9);  o[2] = __builtin_amdgcn_mfma_f32_32x32x16_bf16(PAF(1), VFR(6),  o[2], 0, 0, 0); EX2(C0, 12); SBAR2(); \
    VRD(10); o[3] = __builtin_amdgcn_mfma_f32_32x32x16_bf16(PAF(1), VFR(7),  o[3], 0, 0, 0); EX2(C0, 14); SBAR2(); \
    VRD(11); o[0] = __builtin_amdgcn_mfma_f32_32x32x16_bf16(PAF(2), VFR(8),  o[0], 0, 0, 0); EX2(C1, 0);  SBAR2(); \
    VRD(12); o[1] = __builtin_amdgcn_mfma_f32_32x32x16_bf16(PAF(2), VFR(9),  o[1], 0, 0, 0); EX2(C1, 2);  SBAR2(); \
    VRD(13); o[2] = __builtin_amdgcn_mfma_f32_32x32x16_bf16(PAF(2), VFR(10), o[2], 0, 0, 0); EX2(C1, 4);  SBAR2(); \
    VRD(14); o[3] = __builtin_amdgcn_mfma_f32_32x32x16_bf16(PAF(2), VFR(11), o[3], 0, 0, 0); EX2(C1, 6);  SBAR2(); \
    VRD(15); o[0] = __builtin_amdgcn_mfma_f32_32x32x16_bf16(PAF(3), VFR(12), o[0], 0, 0, 0); EX2(C1, 8);  SBAR2(); \
             o[1] = __builtin_amdgcn_mfma_f32_32x32x16_bf16(PAF(3), VFR(13), o[1], 0, 0, 0); EX2(C1, 10); SBAR2(); \
             o[2] = __builtin_amdgcn_mfma_f32_32x32x16_bf16(PAF(3), VFR(14), o[2], 0, 0, 0); EX2(C1, 12); SBAR2(); \
             o[3] = __builtin_amdgcn_mfma_f32_32x32x16_bf16(PAF(3), VFR(15), o[3], 0, 0, 0); EX2(C1, 14); SBAR2(); \
  } while (0)
  int t = 1;
  for (; t + 3 < NT; t += 2) {
    STEP2(pB0, pB1, pA0, pA1, t, true, true, false);     WAIT_BAR2(4); RESC2(); ROT();
    STEP2(pA0, pA1, pB0, pB1, t + 1, true, true, false); WAIT_BAR2(4); RESC2(); ROT();
  }
  if (NT >= 4) {
    STEP2(pB0, pB1, pA0, pA1, t, true, true, false);      WAIT_BAR2(4); RESC2(); ROT();
    STEP2(pA0, pA1, pB0, pB1, t + 1, false, true, false); WAIT_BAR2(2); RESC2(); ROT();
    t += 2;
  }
  if (wq < 2) { STEP2(pB0, pB1, pA0, pA1, t, false, false, true); } else { STEP2(pB0, pB1, pA0, pA1, t, false, false, false); }
  WAIT_BAR2(0); RESC2(); ROT();
  { float sacc = pB0[0] + pB0[1];
#pragma unroll
    for (int r = 2; r < 16; ++r) sacc += pB0[r];
#pragma unroll
    for (int r = 0; r < 16; ++r) sacc += pB1[r];
    l_reg += sacc;
    pw0 = (u32x4){PKW(pB0, 0), PKW(pB0, 2), PKW(pB0, 4), PKW(pB0, 6)}; pw1 = (u32x4){PKW(pB0, 8), PKW(pB0, 10), PKW(pB0, 12), PKW(pB0, 14)};
    pw2 = (u32x4){PKW(pB1, 0), PKW(pB1, 2), PKW(pB1, 4), PKW(pB1, 6)}; pw3 = (u32x4){PKW(pB1, 8), PKW(pB1, 10), PKW(pB1, 12), PKW(pB1, 14)};
    const lds_cptr vp_ = vp0 + sl_prev; s16x4 vl[4], vh[4];
#pragma unroll
    for (int ks = 0; ks < 4; ++ks) {
#pragma unroll
      for (int d0 = 0; d0 < 4; ++d0) { vl[d0] = vtr(vp_ + d0 * 4096 + ks * 1024); vh[d0] = vtr(vp_ + d0 * 4096 + ks * 1024 + 512); }
      const bf16x8 pa = (ks == 0) ? PAF(0) : (ks == 1) ? PAF(1) : (ks == 2) ? PAF(2) : PAF(3);
#pragma unroll
      for (int d0 = 0; d0 < 4; ++d0) o[d0] = __builtin_amdgcn_mfma_f32_32x32x16_bf16(pa, (bf16x8){vl[d0][0], vl[d0][1], vl[d0][2], vl[d0][3], vh[d0][0], vh[d0][1], vh[d0][2], vh[d0][3]}, o[d0], 0, 0, 0); }
  }
  int lane_e; asm volatile("v_mbcnt_lo_u32_b32 %0, -1, 0\n\tv_mbcnt_hi_u32_b32 %0, -1, %0" : "=v"(lane_e));
  const int r32e = lane_e & 31, hie = lane_e >> 5;
  { auto rr = __builtin_amdgcn_permlane32_swap(__float_as_uint(l_reg), __float_as_uint(l_reg), false, false); l_reg = __uint_as_float(rr[0]) + __uint_as_float(rr[1]); }
  if (hie == 0) wsf[32 + r32e] = l_reg; asm volatile("s_waitcnt lgkmcnt(0)" ::: "memory");
  float rli[16];
#pragma unroll
  for (int r = 0; r < 16; ++r) rli[r] = __builtin_amdgcn_rcpf(wsf[32 + crow(r, hie)]);
  __syncthreads();
  float* xch = (float*)shm + (size_t)wq * 4096;
  if (map == 1) {
#pragma unroll
    for (int d0 = 0; d0 < 4; ++d0)
#pragma unroll
      for (int r = 0; r < 16; ++r) xch[(d0 * 16 + r) * 64 + lane_e] = o[d0][r] * rli[r] * lam;
  }
  __syncthreads();
  if (map == 0) {
    float ss[16];
#pragma unroll
    for (int r = 0; r < 16; ++r) { float s = 0.f;
#pragma unroll
      for (int d0 = 0; d0 < 4; ++d0) { const float v = o[d0][r] * rli[r] - xch[(d0 * 16 + r) * 64 + lane_e]; o[d0][r] = v; s += v * v; }
      ss[r] = s; }
#pragma unroll
    for (int r = 0; r < 16; ++r) ss[r] = half_sum32(ss[r]);
    bf16* Ow = Oout + (rowb + qb * 128 + wq * 32) * 2048 + 1024 + h * 128;
    float gv[4];
#pragma unroll
    for (int d0 = 0; d0 < 4; ++d0) gv[d0] = gdiff[d0 * 32 + r32e] * oscale;
#pragma unroll
    for (int r = 0; r < 16; ++r) { const int orow = crow(r, hie); const float rs = rsqrtf(ss[r] * (1.f / 128.f) + 1e-6f);
#pragma unroll
      for (int d0 = 0; d0 < 4; ++d0) { const float y = o[d0][r] * rs * gv[d0]; const unsigned w = cvtpk(y, y); Ow[(size_t)orow * 2048 + d0 * 32 + r32e] = (bf16)(w & 0xffffu); } }
  }
#undef DMA_K
#undef DMA_V
#undef ROT
#undef KF
#undef RESC2
#undef PKW
#undef PAF
#undef MFQ
#undef KRD
#undef MFK
#undef VRD
#undef VFR
#undef EX2
#undef STEP2
}
#undef SBAR2
#undef WAIT_BAR2
}
constexpr int NWAVES = 8;
constexpr int BATCH = 4, SEQ = 8192, DM = 2048, NTOK = BATCH * SEQ;
constexpr int QKVC = 6144, NEXP = 32, DEXP = 512, PLED = 256, LCAP = 65536;
constexpr float EPS = 1e-6f;
constexpr float QSCALE_SB = 0.08838834764831845f * 1.4426950408889634f;
constexpr float QSCALE_DF = 0.125f * 1.4426950408889634f;
constexpr size_t MiB = 1u << 20;
constexpr size_t WS_CTL = 0, CTL_ZERO_BYTES = 1 * MiB;
constexpr size_t WS_ROPE = 1 * MiB;
constexpr size_t WS_WRT = 1 * MiB + 512 * 1024;
constexpr size_t WS_WIN = 2 * MiB;
constexpr size_t WS_WOUT = 26 * MiB;
constexpr size_t WS_WPG = 34 * MiB;
constexpr size_t WS_WPLE = 42 * MiB;
constexpr size_t WS_WGU = 44 * MiB;
constexpr size_t WS_WD = 172 * MiB;
constexpr size_t WS_LSLOT = 236 * MiB;
constexpr size_t WS_LGATE = 244 * MiB;
constexpr size_t WS_PB = 252 * MiB;
constexpr size_t WS_A1 = 268 * MiB;
constexpr size_t WS_QKV = 396 * MiB;
constexpr size_t WS_XS = WS_QKV;
constexpr size_t WS_H = WS_QKV + 288 * MiB;
constexpr size_t WS_Y = WS_QKV;
constexpr size_t WS_U = 780 * MiB;
constexpr size_t WS_END = 908 * MiB;
constexpr int CW_TMO = 0, CW_CODE = 1;
constexpr int CW_BAR = 4096;
constexpr int CW_CNT = 16384;
constexpr int RING_OFF = 0, RING_BYTES = 131072;
constexpr int LDSCTL_OFF = RING_BYTES;
constexpr int TST_OFF = LDSCTL_OFF;
constexpr int CNT_OFF = LDSCTL_OFF + 160;
constexpr int MISC_OFF = LDSCTL_OFF + 320;
constexpr int LDS_BYTES = 147456;

#define GAS __attribute__((address_space(1)))
#define LAS __attribute__((address_space(3)))
typedef unsigned short bf16;
typedef unsigned v4u __attribute__((ext_vector_type(4)));
typedef unsigned v2u __attribute__((ext_vector_type(2)));
typedef float f32x4 __attribute__((ext_vector_type(4)));
typedef GAS unsigned gu32;
#define RLX_AGENT __ATOMIC_RELAXED, __HIP_MEMORY_SCOPE_AGENT
#define LDS_WAIT() asm volatile("s_waitcnt lgkmcnt(0)" ::: "memory")
#define VM_WAIT() asm volatile("s_waitcnt vmcnt(0)" ::: "memory")
__device__ __forceinline__ unsigned pk2(float lo, float hi) { return pg8::cvt_pk_bf16(lo, hi); }
#define XB_TMO      128
#define XB_XCNT(j)  (256  + 64 * (j))
#define XB_XSUB(j)  (1280 + 64 * (j))
#define XB_XGEN(j)  (2304 + 64 * (j))
#define XB_TOP      3328
#define XB_TOPGEN   3392
#define XCD_BAR_WORDS 3456
#define XB_SPIN_CAP (1u << 18)

__device__ __forceinline__ unsigned xb_ld(unsigned* p)              { return __hip_atomic_load(p, __ATOMIC_RELAXED, __HIP_MEMORY_SCOPE_AGENT); }
__device__ __forceinline__ unsigned xb_add(unsigned* p, unsigned v) { return __hip_atomic_fetch_add(p, v, __ATOMIC_RELAXED, __HIP_MEMORY_SCOPE_AGENT); }
__device__ __forceinline__ unsigned xb_xcc_id() { return (unsigned)__builtin_amdgcn_s_getreg((3 << 11) | 20) & 0xFu; }
#define XB_SPIN(cond, bar) do { unsigned _sp = 0; while (cond) { __builtin_amdgcn_s_sleep(1); \
    if ((++_sp & 255u) == 0u) { if (xb_ld(&(bar)[XB_TMO])) break; if (_sp > XB_SPIN_CAP) { atomicAdd(&(bar)[XB_TMO], 1u); break; } } } } while (0)

struct XcdBarrier {
    unsigned* bar; unsigned x;
    volatile LAS unsigned* st;
};

__device__ __forceinline__ XcdBarrier xcd_barrier_post(unsigned* bar, volatile LAS unsigned* st, bool leader) {
    XcdBarrier b; b.bar = bar; b.x = xb_xcc_id(); b.st = st;
    if (leader) (void)xb_add(&bar[XB_XCNT(b.x)], 1u);
    return b;
}
__device__ __forceinline__ void xcd_barrier_complete(unsigned* bar, unsigned x, unsigned& nloc, unsigned& nx) {
    const unsigned G = gridDim.x * gridDim.y * gridDim.z;
    unsigned sum, cnt, mine, sp = 0u;
    for (;;) {
        sum = 0u; cnt = 0u; mine = 0u;
#pragma unroll
        for (unsigned j = 0; j < 16; ++j) { const unsigned c = xb_ld(&bar[XB_XCNT(j)]); sum += c; cnt += (c > 0u) ? 1u : 0u; mine = (j == x) ? c : mine; }
        if (sum == G) break;
        __builtin_amdgcn_s_sleep(1);
        if ((++sp & 255u) == 0u) { if (xb_ld(&bar[XB_TMO])) break; if (sp > XB_SPIN_CAP) { atomicAdd(&bar[XB_TMO], 1u); break; } }
    }
    nloc = mine > 0u ? mine : 1u; nx = cnt > 0u ? cnt : 1u;
}

__device__ __forceinline__ void xcd_barrier(const XcdBarrier& b, int wave) {
    FRESH_LANE(xl_); const bool leader = (wave == 0) && (xl_ == 0);
    asm volatile("s_waitcnt vmcnt(0)" ::: "memory");
    __syncthreads();
    if (leader) {
        unsigned* bar = b.bar;
        __builtin_amdgcn_s_waitcnt(0);
        unsigned nloc = b.st[0], nx = b.st[1];
        if (nloc == 0u) { xcd_barrier_complete(bar, b.x, nloc, nx); b.st[0] = nloc; b.st[1] = nx; }
        const unsigned old = xb_add(&bar[XB_XSUB(b.x)], 1u);
        const unsigned gen = old / nloc;
        if (old + 1u == (gen + 1u) * nloc) {
            __builtin_amdgcn_fence(__ATOMIC_RELEASE, "agent");
            asm volatile("s_waitcnt vmcnt(0)" ::: "memory");
            const unsigned og = xb_add(&bar[XB_TOP], 1u);
            const unsigned tg = og / nx;
            if (og + 1u == (tg + 1u) * nx) xb_add(&bar[XB_TOPGEN], 1u);
            else XB_SPIN(xb_ld(&bar[XB_TOPGEN]) == tg, bar);
            __builtin_amdgcn_fence(__ATOMIC_ACQUIRE, "agent");
            xb_add(&bar[XB_XGEN(b.x)], 1u);
            asm volatile("s_waitcnt vmcnt(0)" ::: "memory");
        } else {
            XB_SPIN(xb_ld(&bar[XB_XGEN(b.x)]) == gen, bar);
            __builtin_amdgcn_fence(__ATOMIC_ACQUIRE, "agent");
            asm volatile("s_waitcnt vmcnt(0)" ::: "memory");
        }
    }
    __syncthreads();
}
struct Frame {
    LAS unsigned char* lds;
    volatile LAS unsigned* MISC;
    gu32* ctl;
    int tid, lane, wave;
    int vcu, G;
};
__device__ __forceinline__ float wave_sum(float v) { return wave_sum_(v); }
__device__ __forceinline__ void tr_item(const float* W, int ldw, int k0, int n0, bf16* dst, int dpitch, float scale, LAS float* scr, int lane) {
#pragma unroll 8
    for (int i = 0; i < 32; ++i) { const int kk = 2 * i + (lane >> 5); scr[kk * 33 + (lane & 31)] = W[(size_t)(k0 + kk) * ldw + n0 + (lane & 31)]; }
    LDS_WAIT(); asm volatile("" ::: "memory");
    const int c = lane & 7;
#pragma unroll
    for (int j = 0; j < 4; ++j) { const int n = (lane >> 3) + 8 * j; const LAS float* s = scr + (8 * c) * 33 + n;
        v4u o; o.x = pk2(s[0 * 33] * scale, s[1 * 33] * scale); o.y = pk2(s[2 * 33] * scale, s[3 * 33] * scale); o.z = pk2(s[4 * 33] * scale, s[5 * 33] * scale); o.w = pk2(s[6 * 33] * scale, s[7 * 33] * scale);
        *(GAS v4u*)(dst + (size_t)n * dpitch + 8 * c) = o; }
    LDS_WAIT(); asm volatile("" ::: "memory");
}
__device__ __forceinline__ void rms_row_to_bf16(const float* xrow, const float* g, bf16* orow, int lane) {
    const GAS f32x4* xr = (const GAS f32x4*)xrow + lane;
    f32x4 v[8]; float s = 0.f;
#pragma unroll
    for (int j = 0; j < 8; ++j) { v[j] = xr[64 * j]; s += (v[j].x * v[j].x + v[j].y * v[j].y) + (v[j].z * v[j].z + v[j].w * v[j].w); }
    const float rstd = rsqrtf(wave_sum(s) * (1.f / DM) + EPS);
    GAS v2u* o8 = (GAS v2u*)orow + lane;
#pragma unroll
    for (int j = 0; j < 8; ++j) { const f32x4 gg = *((const GAS f32x4*)g + lane + 64 * j); v2u w; w.x = pk2(v[j].x * rstd * gg.x, v[j].y * rstd * gg.y); w.y = pk2(v[j].z * rstd * gg.z, v[j].w * rstd * gg.w); o8[64 * j] = w; }
}

__device__ __forceinline__ void unpack8(const v4u w, float (&f)[8]) {
#pragma unroll
    for (int q = 0; q < 4; ++q) { f[2 * q] = pg8::bf_lo(w[q]); f[2 * q + 1] = pg8::bf_hi(w[q]); }
}
struct Args { const float* in[21]; float* out; unsigned char* ws; int ph_lo, ph_hi; };


#define x_ (args.in[0])
#define p_in (args.in[1])
#define g_attn (args.in[2])
#define w_in (args.in[3])
#define g_sb (args.in[4])
#define g_diff (args.in[5])
#define lam_q1 (args.in[6])
#define lam_k1 (args.in[7])
#define lam_q2 (args.in[8])
#define lam_k2 (args.in[9])
#define w_out (args.in[10])
#define g_moe (args.in[11])
#define w_rg (args.in[12])
#define w_re (args.in[13])
#define w_gate (args.in[14])
#define w_up (args.in[15])
#define w_down (args.in[16])
#define g_ple (args.in[17])
#define w_ple (args.in[18])
#define w_pg (args.in[19])
#define g_final (args.in[20])
#define rope ((float*)(ws + WS_ROPE))
#define wrt ((float*)(ws + WS_WRT))
#define WIN ((bf16*)(ws + WS_WIN))
#define WOUT ((bf16*)(ws + WS_WOUT))
#define WPG ((bf16*)(ws + WS_WPG))
#define WPLE ((bf16*)(ws + WS_WPLE))
#define WGU ((bf16*)(ws + WS_WGU))
#define WD ((bf16*)(ws + WS_WD))
#define LSLOT ((int*)(ws + WS_LSLOT))
#define LGATE ((float*)(ws + WS_LGATE))
#define PB ((bf16*)(ws + WS_PB))
#define A1 ((bf16*)(ws + WS_A1))
#define QKV ((bf16*)(ws + WS_QKV))
#define XS ((bf16*)(ws + WS_XS))
#define HB ((bf16*)(ws + WS_H))
#define YB ((bf16*)(ws + WS_Y))
#define UB ((bf16*)out)
#define H1B ((bf16*)(ws + WS_U))
#define ecnt (F.ctl + CW_CNT)
__global__ void __launch_bounds__(NWAVES * 64, 2) mega_fwd(Args args) {
    extern __shared__ __attribute__((aligned(16))) unsigned char lds[];
    Frame F;
    F.lds = (LAS unsigned char*)lds;
    F.MISC = (volatile LAS unsigned*)(F.lds + MISC_OFF);
    F.tid = threadIdx.x; F.lane = F.tid & 63; F.wave = __builtin_amdgcn_readfirstlane(F.tid >> 6);
    F.G = gridDim.x; { const int bx = blockIdx.x; F.vcu = (F.G % 8 == 0) ? (bx % 8) * (F.G / 8) + bx / 8 : bx; }
    unsigned char* ws = args.ws;
    F.ctl = (gu32*)(ws + WS_CTL);
    float* const out = args.out;
    for (int u = F.tid; u < (LDS_BYTES - LDSCTL_OFF) / 4; u += NWAVES * 64) ((LAS unsigned*)(F.lds + LDSCTL_OFF))[u] = 0u;
    __syncthreads();
    XcdBarrier bar = xcd_barrier_post((unsigned*)(F.ctl + CW_BAR), F.MISC + 8, F.tid == 0);
    const int lo = args.ph_lo, hi = args.ph_hi;
#ifndef PROBE_DBL
#define PROBE_DBL -1
#endif
#define REPS(k) _Pragma("unroll 1") for (int rep_ = 0; rep_ < ((PROBE_DBL == (k)) ? 2 : 1); ++rep_)
#ifndef PH_MASK
#define PH_MASK 0x7ff
#endif
#define IN(k) ((((PH_MASK) >> (k)) & 1) && lo <= (k) && (k) < hi)
#define SEAM(k) do { if (IN(k) && IN((k) + 1)) xcd_barrier(bar, F.wave); } while (0)
#define PHASE_LANE() do { FRESH_LANE(pl_); F.lane = pl_; F.tid = F.wave * 64 + pl_; } while (0)
    const int gw = F.vcu * NWAVES + F.wave, NGW = F.G * NWAVES;
    LAS int* tstart = (LAS int*)(F.lds + TST_OFF); LAS int* lcnt = (LAS int*)(F.lds + CNT_OFF);

    if (IN(0)) REPS(0) {
        PHASE_LANE();
        LAS float* scr = (LAS float*)(F.lds + RING_OFF + F.wave * 16384);
        constexpr int I_IN = 32 * 192, I_OUT = 32 * 64, I_PG = 32 * 64, I_PLE = 4 * 64, I_G = 32 * 32 * 16, I_U = I_G, I_D = 32 * 8 * 64;
        constexpr int NITEMS = I_IN + I_OUT + I_PG + I_PLE + I_G + I_U + I_D;
        for (int it = gw; it < NITEMS; it += NGW) {
            int r = it;
            if (r < I_IN) { const int kb = r / 192, nb = r % 192, n0 = 32 * nb, k0 = 64 * kb; const float sc = (n0 < 1024) ? QSCALE_SB : ((n0 >= 3072 && n0 < 4096) ? QSCALE_DF : 1.f);
                tr_item(w_in, QKVC, k0, n0, WIN + (size_t)n0 * DM + k0, DM, sc, scr, F.lane); continue; } r -= I_IN;
            if (r < I_OUT) { const int kb = r / 64, nb = r % 64; tr_item(w_out, DM, 64 * kb, 32 * nb, WOUT + (size_t)(32 * nb) * DM + 64 * kb, DM, 1.f, scr, F.lane); continue; } r -= I_OUT;
            if (r < I_PG) { const int kb = r / 64, nb = r % 64; tr_item(w_pg, DM, 64 * kb, 32 * nb, WPG + (size_t)(32 * nb) * DM + 64 * kb, DM, 1.f, scr, F.lane); continue; } r -= I_PG;
            if (r < I_PLE) { const int kb = r / 64, nb = r % 64; tr_item(w_ple, DM, 64 * kb, 32 * nb, WPLE + (size_t)(32 * nb) * PLED + 64 * kb, PLED, 1.f, scr, F.lane); continue; } r -= I_PLE;
            if (r < I_G + I_U) { const bool isu = r >= I_G; if (isu) r -= I_G; const int e = r / 512, q = r % 512, kb = q / 16, nb = q % 16, n0 = 32 * nb, k0 = 64 * kb;
                const int drow = e * 1024 + (n0 >> 7) * 256 + (isu ? 128 : 0) + (n0 & 127);
                tr_item((isu ? w_up : w_gate) + (size_t)e * DM * DEXP, DEXP, k0, n0, WGU + (size_t)drow * DM + k0, DM, 1.f, scr, F.lane); continue; } r -= I_G + I_U;
            { const int e = r / 512, q = r % 512, kb = q / 64, nb = q % 64, n0 = 32 * nb, k0 = 64 * kb;
                tr_item(w_down + (size_t)e * DEXP * DM, DM, k0, n0, WD + ((size_t)e * DM + n0) * DEXP + k0, DEXP, 1.f, scr, F.lane); }
        }
        for (int i = gw * 64 + F.lane; i < SEQ * 8; i += NGW * 64) { const int pos = i >> 3, k = i & 7;
            const float inv = exp2f(-(float)k * (18.931568569324174f / 8.f));
            const float ang = (float)pos * inv;
            const double rev = (double)ang * 0.15915494309189535; const float fr = (float)(rev - floor(rev));
            rope[pos * 16 + k] = __builtin_amdgcn_cosf(fr); rope[pos * 16 + 8 + k] = __builtin_amdgcn_sinf(fr); }
        for (int i = gw * 64 + F.lane; i < 36 * DM; i += NGW * 64) { const int c = i / DM, k = i % DM; wrt[i] = (c < 4) ? w_rg[k * 4 + c] : w_re[k * 32 + (c - 4)]; }
        for (size_t i = (size_t)gw * 64 + F.lane; i < (size_t)NTOK * PLED / 4; i += (size_t)NGW * 64) { const f32x4 v = *((const GAS f32x4*)p_in + i); v2u w; w.x = pk2(v.x, v.y); w.y = pk2(v.z, v.w); *((GAS v2u*)PB + i) = w; }
        for (int m = gw; m < NTOK; m += NGW) rms_row_to_bf16(x_ + (size_t)m * DM, g_attn, A1 + (size_t)m * DM, F.lane);
    }
    SEAM(0);
    if (IN(1)) REPS(1) {
        pg8::Gemm g{A1, WIN, NTOK, QKVC, DM}; pg8::StaticOrder S; S.init(NTOK, QKVC, F.G, (int)blockIdx.x);
        pg8::EpiQKV E{QKV, rope};
        pg8::gemm_phase<pg8::EpiQKV, pg8::StaticOrder, true, true>(F.lds + RING_OFF, g, S, E, F.wave);
    }
    SEAM(1);
    if (IN(2)) {
        PHASE_LANE();
        float lam;
        { float a = (F.lane < 64) ? lam_q1[F.lane] * lam_k1[F.lane] : 0.f, b2 = lam_q2[F.lane] * lam_k2[F.lane]; a = wave_sum(a); b2 = wave_sum(b2); lam = expf(a) - expf(b2) + 0.2f; }
#ifndef NO_DIFF
        REPS(20) for (int L = F.vcu; L < 1024; L += F.G) { const int bh = L >> 5, pr = L & 31;
#pragma unroll 1
            for (int s2 = 0; s2 < 2; ++s2) att::diff_unit2(bh >> 3, bh & 7, s2 ? pr : 63 - pr, QKV, A1, g_diff, lam, 0.8f, (char*)lds + RING_OFF, F.wave); }
#endif
        __syncthreads();
#ifndef NO_SB
        REPS(21) for (int uid = gw; uid < 8192; uid += NGW) { const int bh = uid >> 8, wq = uid & 255;
            att::sb_wave_unit(bh >> 3, bh & 7, wq, QKV, A1, g_sb, (char*)lds + RING_OFF + F.wave * 16384); }
#endif
    }
    SEAM(2);
    if (IN(3)) REPS(3) {
#ifndef NO_P3A
        { pg8::Gemm g{A1, WOUT, NTOK, DM, DM}; pg8::StaticOrder S; S.init(NTOK, DM, F.G, (int)blockIdx.x);
          pg8::EpiResBf16 E{x_, H1B};
          pg8::gemm_phase<pg8::EpiResBf16, pg8::StaticOrder, true, true>(F.lds + RING_OFF, g, S, E, F.wave); }
#endif
#ifndef NO_P3B
        { pg8::Gemm g{PB, WPLE, NTOK, DM, PLED}; pg8::StaticOrder S; S.init(NTOK, DM, F.G, (int)blockIdx.x);
          pg8::EpiBf16 E{UB, DM};
          pg8::gemm_phase<pg8::EpiBf16, pg8::StaticOrder, true, true>(F.lds + RING_OFF, g, S, E, F.wave); }
#endif
    }
    SEAM(3);
    if (IN(4)) {
        PHASE_LANE();
        LAS int* sel_e = (LAS int*)(F.lds + RING_OFF); LAS float* sel_g = (LAS float*)(F.lds + RING_OFF + 1024); LAS int* lhist = (LAS int*)(F.lds + RING_OFF + 2048); LAS int* lbase = (LAS int*)(F.lds + RING_OFF + 2176);
        LAS int* lrk = (LAS int*)(F.lds + RING_OFF + 2304);
        for (int chunk = blockIdx.x; chunk < NTOK / 128; chunk += F.G) {
            if (F.tid < 32) lhist[F.tid] = 0;
            for (int g4 = 0; g4 < 4; ++g4) {
                const int row0 = chunk * 128 + F.wave * 16 + g4 * 4;
                float v[4][4][8]; float rstd[4];
#pragma unroll
                for (int r = 0; r < 4; ++r) { const GAS v4u* xr = (const GAS v4u*)(H1B + (size_t)(row0 + r) * DM) + F.lane; float s = 0.f;
#pragma unroll
                    for (int j = 0; j < 4; ++j) { unpack8(xr[64 * j], v[r][j]);
#pragma unroll
                        for (int i = 0; i < 8; ++i) s += v[r][j][i] * v[r][j][i]; }
                    rstd[r] = rsqrtf(wave_sum(s) * (1.f / DM) + EPS); }
#pragma unroll
                for (int j = 0; j < 4; ++j) { const f32x4 g0 = *((const GAS f32x4*)g_moe + 2 * F.lane + 128 * j), g1 = *((const GAS f32x4*)g_moe + 2 * F.lane + 128 * j + 1);
#pragma unroll
                    for (int r = 0; r < 4; ++r) {
#pragma unroll
                        for (int i = 0; i < 4; ++i) { v[r][j][i] *= rstd[r] * g0[i]; v[r][j][4 + i] *= rstd[r] * g1[i]; }
                        v4u w; w.x = pk2(v[r][j][0], v[r][j][1]); w.y = pk2(v[r][j][2], v[r][j][3]); w.z = pk2(v[r][j][4], v[r][j][5]); w.w = pk2(v[r][j][6], v[r][j][7]);
                        *((GAS v4u*)(A1 + (size_t)(row0 + r) * DM) + F.lane + 64 * j) = w; } }
                float lg[4] = {0.f, 0.f, 0.f, 0.f};
#pragma unroll 1
                for (int c = 0; c < 36; ++c) { const GAS f32x4* wc = (const GAS f32x4*)(wrt + (size_t)c * DM) + 2 * F.lane;
                    float pa[4] = {0.f, 0.f, 0.f, 0.f};
#pragma unroll
                    for (int j = 0; j < 4; ++j) { const f32x4 w0 = wc[128 * j], w1 = wc[128 * j + 1];
#pragma unroll
                        for (int r = 0; r < 4; ++r) pa[r] += ((v[r][j][0] * w0.x + v[r][j][1] * w0.y) + (v[r][j][2] * w0.z + v[r][j][3] * w0.w)) + ((v[r][j][4] * w1.x + v[r][j][5] * w1.y) + (v[r][j][6] * w1.z + v[r][j][7] * w1.w)); }
#pragma unroll
                    for (int r = 0; r < 4; ++r) { const float t = wave_sum(pa[r]); lg[r] = (F.lane == c) ? t : lg[r]; } }
#pragma unroll
                for (int r = 0; r < 4; ++r) {
                    const float g0 = __shfl(lg[r], 0), g1 = __shfl(lg[r], 1), g2 = __shfl(lg[r], 2), g3 = __shfl(lg[r], 3);
                    int grp = 0; float gm = g0; if (g1 > gm) { gm = g1; grp = 1; } if (g2 > gm) { gm = g2; grp = 2; } if (g3 > gm) { gm = g3; grp = 3; }
                    const float psel = 1.f / (expf(g0 - gm) + expf(g1 - gm) + expf(g2 - gm) + expf(g3 - gm));
                    float ev[8];
#pragma unroll
                    for (int i = 0; i < 8; ++i) ev[i] = __shfl(lg[r], 4 + grp * 8 + i);
                    int i0 = 0; float v0 = ev[0];
#pragma unroll
                    for (int i = 1; i < 8; ++i) if (ev[i] > v0) { v0 = ev[i]; i0 = i; }
                    int i1 = -1; float v1 = 0.f;
#pragma unroll
                    for (int i = 0; i < 8; ++i) if (i != i0 && (i1 < 0 || ev[i] > v1)) { v1 = ev[i]; i1 = i; }
                    const float ga = 1.f / (1.f + expf(v1 - v0)), gb = 1.f - ga;
                    if (F.lane == 0) { const int rl = F.wave * 16 + g4 * 4 + r; sel_e[rl * 2] = grp * 8 + i0; sel_e[rl * 2 + 1] = grp * 8 + i1; sel_g[rl * 2] = ga * psel; sel_g[rl * 2 + 1] = gb * psel; }
                }
            }
            __syncthreads();
            FRESH_LANE(l4_); const int t4 = F.wave * 64 + l4_;
            int my_e = 0, my_rk = 0;
            if (t4 < 256) { my_e = sel_e[t4]; my_rk = atomicAdd((int*)(lhist + my_e), 1); }
            __syncthreads();
            if (t4 < 32) { const int n = lhist[t4]; lbase[t4] = n ? (int)__hip_atomic_fetch_add(ecnt + 64 * t4, (unsigned)n, RLX_AGENT) : 0; }
            __syncthreads();
            if (t4 < 256) { const int pos = lbase[my_e] + my_rk; LSLOT[(size_t)my_e * LCAP + pos] = (chunk * 128 + (t4 >> 1)) * 2 + (t4 & 1); LGATE[(size_t)my_e * LCAP + pos] = sel_g[t4]; }
            __syncthreads();
        }
        (void)lrk;
    }
    SEAM(4);
    if (IN(6) || IN(7)) {
        PHASE_LANE();
        if (F.tid < 32) lcnt[F.tid] = (int)__hip_atomic_load(ecnt + 64 * F.tid, RLX_AGENT);
        __syncthreads();
        if (F.tid == 0) { int acc = 0; for (int e = 0; e < 32; ++e) { tstart[e] = acc; acc += (lcnt[e] + 255) >> 8; } tstart[32] = acc; }
        __syncthreads();
    }
    const int NTILES = (IN(6) || IN(7)) ? __builtin_amdgcn_readfirstlane(tstart[32]) : 0;
    if (IN(6)) REPS(6) {
        pg8::Gemm g{A1, WGU, NTILES * 256, 1024, DM, LSLOT}; pg8::MoeOrder S; S.init(NTILES, 4, F.G, (int)blockIdx.x, tstart, lcnt);
        pg8::EpiSwiglu E{HB};
        pg8::gemm_phase<pg8::EpiSwiglu, pg8::MoeOrder, true, true, true>(F.lds + RING_OFF, g, S, E, F.wave);
    }
    SEAM(6);
    if (IN(7)) REPS(7) {
        pg8::Gemm g{HB, WD, NTILES * 256, DM, DEXP}; pg8::MoeOrder S; S.init(NTILES, 8, F.G, (int)blockIdx.x, tstart, lcnt);
        pg8::EpiScatter E{YB, LSLOT, LGATE};
        pg8::gemm_phase<pg8::EpiScatter, pg8::MoeOrder, true, true>(F.lds + RING_OFF, g, S, E, F.wave);
    }
    SEAM(7);
    if (IN(8)) {
        PHASE_LANE();
        for (int m = gw; m < NTOK; m += NGW) {
            const GAS v4u* hr = (const GAS v4u*)(H1B + (size_t)m * DM) + F.lane; const GAS v4u* y0 = (const GAS v4u*)(YB + (size_t)(2 * m) * DM) + F.lane; const GAS v4u* y1 = (const GAS v4u*)(YB + (size_t)(2 * m + 1) * DM) + F.lane;
            float v[4][8]; float s = 0.f;
#pragma unroll
            for (int j = 0; j < 4; ++j) { float a[8], b[8]; unpack8(hr[64 * j], v[j]); unpack8(y0[64 * j], a); unpack8(y1[64 * j], b);
#pragma unroll
                for (int i = 0; i < 8; ++i) { v[j][i] += a[i] + b[i]; s += v[j][i] * v[j][i]; } }
            const float rstd = rsqrtf(wave_sum(s) * (1.f / DM) + EPS);
            GAS v4u* o8 = (GAS v4u*)(A1 + (size_t)m * DM) + F.lane;
#pragma unroll
            for (int j = 0; j < 4; ++j) { const f32x4 g0 = *((const GAS f32x4*)g_ple + 2 * F.lane + 128 * j), g1 = *((const GAS f32x4*)g_ple + 2 * F.lane + 128 * j + 1);
                v4u w; w.x = pk2(v[j][0] * rstd * g0.x, v[j][1] * rstd * g0.y); w.y = pk2(v[j][2] * rstd * g0.z, v[j][3] * rstd * g0.w); w.z = pk2(v[j][4] * rstd * g1.x, v[j][5] * rstd * g1.y); w.w = pk2(v[j][6] * rstd * g1.z, v[j][7] * rstd * g1.w);
                o8[64 * j] = w; }
        }
    }
    SEAM(8);
    if (IN(9)) {
        pg8::Gemm g{A1, WPG, NTOK, DM, DM}; pg8::StaticOrder S; S.init(NTOK, DM, F.G, (int)blockIdx.x);
        pg8::EpiPle2 E{H1B, YB, UB};
        pg8::gemm_phase<pg8::EpiPle2, pg8::StaticOrder, true, true>(F.lds + RING_OFF, g, S, E, F.wave);
    }
    SEAM(9);
    if (IN(10)) {
        PHASE_LANE();
        for (int m = gw; m < NTOK; m += NGW) {
            const GAS v4u* hr = (const GAS v4u*)(H1B + (size_t)m * DM) + F.lane; float v[4][8]; float s = 0.f;
#pragma unroll
            for (int j = 0; j < 4; ++j) { unpack8(hr[64 * j], v[j]);
#pragma unroll
                for (int i = 0; i < 8; ++i) s += v[j][i] * v[j][i]; }
            const float rstd = rsqrtf(wave_sum(s) * (1.f / DM) + EPS);
            GAS f32x4* orow = (GAS f32x4*)(out + (size_t)m * DM) + 2 * F.lane;
#pragma unroll
            for (int j = 0; j < 4; ++j) { const f32x4 g0 = *((const GAS f32x4*)g_final + 2 * F.lane + 128 * j), g1 = *((const GAS f32x4*)g_final + 2 * F.lane + 128 * j + 1);
                orow[128 * j] = (f32x4){v[j][0] * rstd * g0.x, v[j][1] * rstd * g0.y, v[j][2] * rstd * g0.z, v[j][3] * rstd * g0.w};
                orow[128 * j + 1] = (f32x4){v[j][4] * rstd * g1.x, v[j][5] * rstd * g1.y, v[j][6] * rstd * g1.z, v[j][7] * rstd * g1.w}; }
        }
    }
#undef IN
#undef SEAM
}

#ifndef MK_SPLIT
#define MK_SPLIT 0
#endif
extern "C" void kernel_launch(void* const* d_in, const int* in_sizes, int n_in, void* d_out, int out_size, void* d_ws, size_t ws_size, hipStream_t stream) {
    static int grid = 0;
    if (grid == 0) {
        if (n_in != 21 || in_sizes[0] != NTOK * DM || out_size != NTOK * DM || ws_size < WS_END) { fprintf(stderr, "kernel_launch: shape mismatch (n_in %d in0 %d out %d ws %zu)\n", n_in, n_in > 0 ? in_sizes[0] : -1, out_size, ws_size); grid = -1; return; }
        int dev = 0, cus = 0, per_cu = 0;
        if (hipGetDevice(&dev) != hipSuccess || hipDeviceGetAttribute(&cus, hipDeviceAttributeMultiprocessorCount, dev) != hipSuccess) { grid = -1; return; }
        if (hipFuncSetAttribute((const void*)mega_fwd, hipFuncAttributeMaxDynamicSharedMemorySize, LDS_BYTES) != hipSuccess) { fprintf(stderr, "kernel_launch: hipFuncSetAttribute failed\n"); grid = -1; return; }
        if (hipOccupancyMaxActiveBlocksPerMultiprocessor(&per_cu, (const void*)mega_fwd, NWAVES * 64, LDS_BYTES) != hipSuccess || per_cu < 1) fprintf(stderr, "kernel_launch: occupancy query reports %d\n", per_cu);
        (void)hipGetLastError();
        grid = cus;
    }
    if (grid < 0) return;
    if (hipMemsetAsync((char*)d_ws + WS_CTL, 0, CTL_ZERO_BYTES, stream) != hipSuccess) return;
    Args a{};
    for (int i = 0; i < 21; ++i) a.in[i] = (const float*)d_in[i];
    a.out = (float*)d_out; a.ws = (unsigned char*)d_ws;
#if MK_SPLIT
    for (int ph = 0; ph < 11; ++ph) { a.ph_lo = ph; a.ph_hi = ph + 1; hipLaunchKernelGGL(mega_fwd, dim3(grid), dim3(NWAVES * 64), LDS_BYTES, stream, a); }
#else
    a.ph_lo = 0; a.ph_hi = 11;
    hipLaunchKernelGGL(mega_fwd, dim3(grid), dim3(NWAVES * 64), LDS_BYTES, stream, a);
#endif
    const hipError_t le = hipPeekAtLastError();
    if (le != hipSuccess) fprintf(stderr, "kernel_launch: launch failed: %s\n", hipGetErrorName(le));
}
```

```cpp
#include <hip/hip_runtime.h>
#include <hip/hip_bf16.h>
#include <cstdio>
#include <cstdint>
#define FRESH_LANE(v) int v; asm volatile("v_mbcnt_lo_u32_b32 %0, -1, 0\n\tv_mbcnt_hi_u32_b32 %0, -1, %0" : "=v"(v))
template <int M> __device__ __forceinline__ float swz_xor(float v) { return __int_as_float(__builtin_amdgcn_ds_swizzle(__float_as_int(v), 0x1f | (M << 10))); }
__device__ __forceinline__ float half_sum32_(float v) { v += swz_xor<1>(v); v += swz_xor<2>(v); v += swz_xor<4>(v); v += swz_xor<8>(v); v += swz_xor<16>(v); return v; }
__device__ __forceinline__ float wave_sum_(float v) { v = half_sum32_(v); auto rr = __builtin_amdgcn_permlane32_swap(__float_as_uint(v), __float_as_uint(v), false, false); return __uint_as_float(rr[0]) + __uint_as_float(rr[1]); }
namespace pg8 {
#define PG8_LAS __attribute__((address_space(3)))
typedef unsigned short bf16_t;
typedef short bf16x8 __attribute__((ext_vector_type(8)));
typedef float f32x4 __attribute__((ext_vector_type(4)));
typedef unsigned u32x4 __attribute__((ext_vector_type(4)));
constexpr int BM = 256, BK = 64, HALF = 128, HTB = HALF * BK * 2  , STAGE_BYTES = 8 * HTB, NXCD = 8, WGM = 8;

__host__ __device__ __forceinline__ int lds_byte(int r, int c) { const int st = (r >> 4) * 2 + (c >> 5), rr = r & 15, cc = c & 31, ob = rr * 64 + cc * 2; return st * 1024 + (ob ^ (((ob >> 9) & 1) << 5)); }
__host__ __device__ __forceinline__ void stage_rc(int b, int& R, int& C) { const int st = b / 1024, sb = b % 1024, swz = sb ^ (((sb >> 9) & 1) << 5); R = (st >> 1) * 16 + swz / 64; C = (st & 1) * 32 + (swz % 64) / 2; }
__host__ __device__ __forceinline__ int perm32(int rho) { const int n = rho >> 4, i = rho & 15; return 8 * (i >> 2) + 4 * n + (i & 3); }

struct Unit { int pm, pn, pb, aux0, aux1; };
struct Gemm { const bf16_t* A; const bf16_t* Bt; int M, N, K; const int* glist; int lda, ldb; };

struct StaticOrder {
    int nM, nN, nwg, G, c, fixed;
    __host__ __device__ void init(int M, int N, int G_, int c_) { nM = M / BM; nN = N / BM; nwg = nM * nN; G = G_; c = c_; fixed = 0; }
    __host__ __device__ bool next(int i, Unit& u) const {
        const long L = (long)i * G + c; if (L >= nwg) return false;
        int wgid = (int)L; { const int q = nwg / NXCD, r = nwg % NXCD, xcd = wgid % NXCD, off = wgid / NXCD; wgid = (xcd < r ? xcd * (q + 1) : r * (q + 1) + (xcd - r) * q) + off; }
        const int nig = WGM * nN, gid = wgid / nig, fm = gid * WGM, gsz = (nM - fm) < WGM ? (nM - fm) : WGM;
        u.pm = fm + ((wgid % nig) % gsz); u.pn = (wgid % nig) / gsz; if (fixed) { u.pm = 0; u.pn = 0; } u.pb = u.pn; u.aux0 = 0; u.aux1 = 0; return true;
    }
    __device__ __forceinline__ void a_ready(const Unit&) const {}
    __device__ __forceinline__ void done(const Unit&) const {}
};

__device__ __forceinline__ unsigned cvt_pk_bf16(float lo, float hi) { unsigned r; asm volatile("v_cvt_pk_bf16_f32 %0, %1, %2" : "=v"(r) : "v"(lo), "v"(hi)); return r; }
typedef float f32x2 __attribute__((ext_vector_type(2)));
#define PG8_FRESH_LANE(fr, fq) int l__; asm volatile("v_mbcnt_lo_u32_b32 %0, -1, 0\n\tv_mbcnt_hi_u32_b32 %0, -1, %0" : "=v"(l__)); const int fr = l__ & 15, fq = l__ >> 4; (void)fr_; (void)fq_
typedef unsigned u32x2 __attribute__((ext_vector_type(2)));
__device__ __forceinline__ float bf_lo(unsigned w) { return __uint_as_float(w << 16); }
__device__ __forceinline__ float bf_hi(unsigned w) { return __uint_as_float(w & 0xffff0000u); }

struct EpiQKV {
    static constexpr bool PERM = true, AFTER_DRAIN = false;
    bf16_t* O; const float* rope;
    __device__ __forceinline__ void operator()(const f32x4 (&acc)[2][2][4][2], const Unit& u, int wr, int wc, int fr_, int fq_) const {
        PG8_FRESH_LANE(fr, fq);
        const int row0 = u.pm * BM + wr * 64 + fr, col0 = u.pn * BM + wc * 32 + 8 * fq;
        const bool rot = (u.pn >= 12) && (u.pn < 20) && ((wc & 1) == 0);
#pragma unroll
        for (int ai = 0; ai < 2; ++ai)
#pragma unroll
            for (int m = 0; m < 4; ++m) { const int row = row0 + ai * HALF + m * 16; bf16_t* rowp = O + (size_t)row * 6208 + col0;
                f32x4 c0 = {1.f, 1.f, 1.f, 1.f}, c1 = c0, s0 = {0.f, 0.f, 0.f, 0.f}, s1 = s0;
                if (rot) { const float* t = rope + (size_t)(row & 8191) * 16; c0 = *(const f32x4*)(t); c1 = *(const f32x4*)(t + 4); s0 = *(const f32x4*)(t + 8); s1 = *(const f32x4*)(t + 12);
                    if (fq == 0) { s0 = -s0; s1 = -s1; } else if (fq != 1) { s0 = (f32x4){0.f, 0.f, 0.f, 0.f}; s1 = s0; c0 = (f32x4){1.f, 1.f, 1.f, 1.f}; c1 = c0; } }
#pragma unroll
                for (int bj = 0; bj < 2; ++bj) { f32x4 v0 = acc[ai][bj][m][0], v1 = acc[ai][bj][m][1];
                    if (rot) { f32x4 p0, p1;
#pragma unroll
                        for (int j = 0; j < 4; ++j) { p0[j] = swz_xor<16>(v0[j]); p1[j] = swz_xor<16>(v1[j]); }
                        v0 = v0 * c0 + p0 * s0; v1 = v1 * c1 + p1 * s1; }
                    u32x4 w; w.x = cvt_pk_bf16(v0[0], v0[1]); w.y = cvt_pk_bf16(v0[2], v0[3]); w.z = cvt_pk_bf16(v1[0], v1[1]); w.w = cvt_pk_bf16(v1[2], v1[3]);
                    *(u32x4*)(rowp + bj * HALF) = w; } }
    }
};
struct EpiBf16 {
    static constexpr bool PERM = true, AFTER_DRAIN = false;
    bf16_t* O; int ldc;
    __device__ __forceinline__ void operator()(const f32x4 (&acc)[2][2][4][2], const Unit& u, int wr, int wc, int fr_, int fq_) const {
        PG8_FRESH_LANE(fr, fq);
        const int row0 = u.pm * BM + wr * 64 + fr, col0 = u.pn * BM + wc * 32 + 8 * fq;
#pragma unroll
        for (int ai = 0; ai < 2; ++ai)
#pragma unroll
            for (int m = 0; m < 4; ++m) { bf16_t* rowp = O + (size_t)(row0 + ai * HALF + m * 16) * ldc + col0;
#pragma unroll
                for (int bj = 0; bj < 2; ++bj) { const f32x4 v0 = acc[ai][bj][m][0], v1 = acc[ai][bj][m][1];
                    u32x4 w; w.x = cvt_pk_bf16(v0[0], v0[1]); w.y = cvt_pk_bf16(v0[2], v0[3]); w.z = cvt_pk_bf16(v1[0], v1[1]); w.w = cvt_pk_bf16(v1[2], v1[3]);
                    *(u32x4*)(rowp + bj * HALF) = w; } }
    }
};
struct EpiResF32 {
    static constexpr bool PERM = false, AFTER_DRAIN = false;
    const float* base; float* out; int ldc;
    __device__ __forceinline__ void operator()(const f32x4 (&acc)[2][2][4][2], const Unit& u, int wr, int wc, int fr_, int fq_) const {
        PG8_FRESH_LANE(fr, fq);
        const int row0 = u.pm * BM + wr * 64 + fr, col0 = u.pn * BM + wc * 32 + 4 * fq;
#pragma unroll
        for (int ai = 0; ai < 2; ++ai)
#pragma unroll
            for (int m = 0; m < 4; ++m) { const size_t off = (size_t)(row0 + ai * HALF + m * 16) * ldc + col0;
#pragma unroll
                for (int bj = 0; bj < 2; ++bj)
#pragma unroll
                    for (int n = 0; n < 2; ++n) { const f32x4 b = *(const f32x4*)(base + off + bj * HALF + n * 16); *(f32x4*)(out + off + bj * HALF + n * 16) = b + acc[ai][bj][m][n]; }
                asm volatile("" ::: "memory"); }
    }
};
struct EpiPle {
    static constexpr bool PERM = false, AFTER_DRAIN = false;
    float* io; const bf16_t* U; int ldc;
    __device__ __forceinline__ void operator()(const f32x4 (&acc)[2][2][4][2], const Unit& u, int wr, int wc, int fr_, int fq_) const {
        PG8_FRESH_LANE(fr, fq);
        const int row0 = u.pm * BM + wr * 64 + fr, col0 = u.pn * BM + wc * 32 + 4 * fq;
#pragma unroll
        for (int ai = 0; ai < 2; ++ai)
#pragma unroll
            for (int m = 0; m < 4; ++m) { const size_t off = (size_t)(row0 + ai * HALF + m * 16) * ldc + col0;
#pragma unroll
                for (int bj = 0; bj < 2; ++bj)
#pragma unroll
                    for (int n = 0; n < 2; ++n) { const size_t o = off + bj * HALF + n * 16; const f32x4 b = *(const f32x4*)(io + o); const u32x2 uw = *(const u32x2*)(U + o); const f32x4 a = acc[ai][bj][m][n];
                        f32x4 r; r[0] = b[0] + bf_lo(uw.x) * __builtin_amdgcn_rcpf(1.f + __builtin_amdgcn_exp2f(-1.4426950408889634f * a[0]));
                        r[1] = b[1] + bf_hi(uw.x) * __builtin_amdgcn_rcpf(1.f + __builtin_amdgcn_exp2f(-1.4426950408889634f * a[1]));
                        r[2] = b[2] + bf_lo(uw.y) * __builtin_amdgcn_rcpf(1.f + __builtin_amdgcn_exp2f(-1.4426950408889634f * a[2]));
                        r[3] = b[3] + bf_hi(uw.y) * __builtin_amdgcn_rcpf(1.f + __builtin_amdgcn_exp2f(-1.4426950408889634f * a[3]));
                        *(f32x4*)(io + o) = r; }
                asm volatile("" ::: "memory"); }
    }
};
struct EpiResBf16 {
    static constexpr bool PERM = true, AFTER_DRAIN = false;
    const float* base; bf16_t* O;
    __device__ __forceinline__ void operator()(const f32x4 (&acc)[2][2][4][2], const Unit& u, int wr, int wc, int fr_, int fq_) const {
        PG8_FRESH_LANE(fr, fq);
        const int row0 = u.pm * BM + wr * 64 + fr, col0 = u.pn * BM + wc * 32 + 8 * fq;
#pragma unroll
        for (int ai = 0; ai < 2; ++ai)
#pragma unroll
            for (int m = 0; m < 4; ++m) { const size_t off = (size_t)(row0 + ai * HALF + m * 16) * 2048 + col0;
#pragma unroll
                for (int bj = 0; bj < 2; ++bj) { const f32x4 b0 = *(const f32x4*)(base + off + bj * HALF), b1 = *(const f32x4*)(base + off + bj * HALF + 4);
                    const f32x4 v0 = acc[ai][bj][m][0] + b0, v1 = acc[ai][bj][m][1] + b1;
                    u32x4 w; w.x = cvt_pk_bf16(v0[0], v0[1]); w.y = cvt_pk_bf16(v0[2], v0[3]); w.z = cvt_pk_bf16(v1[0], v1[1]); w.w = cvt_pk_bf16(v1[2], v1[3]);
                    *(u32x4*)(O + off + bj * HALF) = w; }
                asm volatile("" ::: "memory"); }
    }
};
struct EpiPle2 {
    static constexpr bool PERM = true, AFTER_DRAIN = false;
    bf16_t* Hs; const bf16_t* Y; const bf16_t* U;
    __device__ __forceinline__ void operator()(const f32x4 (&acc)[2][2][4][2], const Unit& u, int wr, int wc, int fr_, int fq_) const {
        PG8_FRESH_LANE(fr, fq);
        const int row0 = u.pm * BM + wr * 64 + fr, col0 = u.pn * BM + wc * 32 + 8 * fq;
#pragma unroll
        for (int ai = 0; ai < 2; ++ai)
#pragma unroll
            for (int m = 0; m < 4; ++m) { const size_t row = (size_t)(row0 + ai * HALF + m * 16); const size_t off = row * 2048 + col0;
#pragma unroll
                for (int bj = 0; bj < 2; ++bj) { const size_t o = off + bj * HALF;
                    const u32x4 hw = *(const u32x4*)(Hs + o), uw = *(const u32x4*)(U + o), ya = *(const u32x4*)(Y + 2 * row * 2048 + col0 + bj * HALF), yb = *(const u32x4*)(Y + (2 * row + 1) * 2048 + col0 + bj * HALF);
                    float r[8];
#pragma unroll
                    for (int q = 0; q < 4; ++q) { const float a0 = acc[ai][bj][m][q >> 1][(q & 1) * 2], a1 = acc[ai][bj][m][q >> 1][(q & 1) * 2 + 1];
                        const float s0 = __builtin_amdgcn_rcpf(1.f + __builtin_amdgcn_exp2f(-1.4426950408889634f * a0)), s1 = __builtin_amdgcn_rcpf(1.f + __builtin_amdgcn_exp2f(-1.4426950408889634f * a1));
                        r[2 * q] = (bf_lo(hw[q]) + (bf_lo(ya[q]) + bf_lo(yb[q]))) + bf_lo(uw[q]) * s0; r[2 * q + 1] = (bf_hi(hw[q]) + (bf_hi(ya[q]) + bf_hi(yb[q]))) + bf_hi(uw[q]) * s1; }
                    u32x4 w; w.x = cvt_pk_bf16(r[0], r[1]); w.y = cvt_pk_bf16(r[2], r[3]); w.z = cvt_pk_bf16(r[4], r[5]); w.w = cvt_pk_bf16(r[6], r[7]);
                    *(u32x4*)(Hs + o) = w; }
                asm volatile("" ::: "memory"); }
    }
};
struct EpiSwiglu {
    static constexpr bool PERM = true, AFTER_DRAIN = false;
    bf16_t* H;
    __device__ __forceinline__ void operator()(const f32x4 (&acc)[2][2][4][2], const Unit& u, int wr, int wc, int fr_, int fq_) const {
        PG8_FRESH_LANE(fr, fq);
        const int row0 = u.pm * BM + wr * 64 + fr, col0 = u.pn * HALF + wc * 32 + 8 * fq;
#pragma unroll
        for (int ai = 0; ai < 2; ++ai)
#pragma unroll
            for (int m = 0; m < 4; ++m) { bf16_t* rowp = H + (size_t)(row0 + ai * HALF + m * 16) * 576 + col0; float h[8];
#pragma unroll
                for (int n = 0; n < 2; ++n)
#pragma unroll
                    for (int j = 0; j < 4; ++j) { const float g = acc[ai][0][m][n][j], up = acc[ai][1][m][n][j];
                        h[n * 4 + j] = g * up * __builtin_amdgcn_rcpf(1.f + __builtin_amdgcn_exp2f(-1.4426950408889634f * g)); }
                u32x4 w; w.x = cvt_pk_bf16(h[0], h[1]); w.y = cvt_pk_bf16(h[2], h[3]); w.z = cvt_pk_bf16(h[4], h[5]); w.w = cvt_pk_bf16(h[6], h[7]);
                *(u32x4*)rowp = w; asm volatile("" ::: "memory"); }
    }
};
struct EpiScatter {
    static constexpr bool PERM = true, AFTER_DRAIN = false;
    bf16_t* Y; const int* lslot; const float* lgate;
    __device__ __forceinline__ void operator()(const f32x4 (&acc)[2][2][4][2], const Unit& u, int wr, int wc, int fr_, int fq_) const {
        PG8_FRESH_LANE(fr, fq);
        const int r0 = wr * 64 + fr, col0 = u.pn * BM + wc * 32 + 8 * fq;
#pragma unroll
        for (int ai = 0; ai < 2; ++ai)
#pragma unroll
            for (int m = 0; m < 4; ++m) { const int r = r0 + ai * HALF + m * 16;
                if (r < u.aux1) { const int slot = lslot[u.aux0 + r]; const float g = lgate[u.aux0 + r]; bf16_t* rowp = Y + (size_t)slot * 2048 + col0;
#pragma unroll
                    for (int bj = 0; bj < 2; ++bj) { const f32x4 v0 = acc[ai][bj][m][0] * g, v1 = acc[ai][bj][m][1] * g;
                        u32x4 w; w.x = cvt_pk_bf16(v0[0], v0[1]); w.y = cvt_pk_bf16(v0[2], v0[3]); w.z = cvt_pk_bf16(v1[0], v1[1]); w.w = cvt_pk_bf16(v1[2], v1[3]);
                        *(u32x4*)(rowp + bj * HALF) = w; } }
                asm volatile("" ::: "memory"); }
    }
};
struct MoeOrder {
    int nM, nN, nwg, G, c; const PG8_LAS int* tstart; const PG8_LAS int* cnt;
    __device__ void init(int nM_, int nN_, int G_, int c_, const PG8_LAS int* ts, const PG8_LAS int* cn) { nM = nM_; nN = nN_; nwg = nM * nN; G = G_; c = c_; tstart = ts; cnt = cn; }
    __device__ bool next(int i, Unit& u) const {
        const long L = (long)i * G + c; if (L >= nwg) return false;
        int wgid = (int)L; { const int q = nwg / NXCD, r = nwg % NXCD, xcd = wgid % NXCD, off = wgid / NXCD; wgid = (xcd < r ? xcd * (q + 1) : r * (q + 1) + (xcd - r) * q) + off; }
        const int nig = WGM * nN, gid = wgid / nig, fm = gid * WGM, gsz = (nM - fm) < WGM ? (nM - fm) : WGM;
        const int pm = fm + ((wgid % nig) % gsz), pn = (wgid % nig) / gsz;
        int e = 0;
        for (int k = 1; k < 32; ++k) e += (__builtin_amdgcn_readfirstlane(tstart[k]) <= pm) ? 1 : 0;
        const int t = pm - __builtin_amdgcn_readfirstlane(tstart[e]); const int left = __builtin_amdgcn_readfirstlane(cnt[e]) - t * 256;
        u.pm = pm; u.pn = pn; u.pb = e * nN + pn; u.aux0 = e * 65536 + t * 256; u.aux1 = left < 256 ? left : 256; return true;
    }
    __device__ __forceinline__ void a_ready(const Unit&) const {}
    __device__ __forceinline__ void done(const Unit&) const {}
};
template <class Epi, class Sched, bool ALIGN_EPI = false, bool SP2 = false, bool GATHER = false>
__device__ __forceinline__ void gemm_phase(PG8_LAS unsigned char* lds, const Gemm g, const Sched& S, const Epi& E, const int wid) {
    FRESH_LANE(lane); const int tid = wid * 64 + lane, wr = wid >> 2, wc = wid & 3, fr = lane & 15, fq = lane >> 4;
    const int K = g.K, nt = K / BK;
    unsigned voffA[2], voffB[2];
#pragma unroll
    for (int i = 0; i < 2; ++i) { int R, C; stage_rc(tid * 16 + i * 8192, R, C); const int Rb = Epi::PERM ? ((R & ~31) + perm32(R & 31)) : R;
        voffA[i] = (unsigned)(R * g.lda + C) * 2u; voffB[i] = (unsigned)(Rb * g.ldb + C) * 2u; }
    const size_t kstep = (size_t)(BK * 2);
    const size_t hstepA = (size_t)HALF * g.lda * 2, hstep = (size_t)HALF * g.ldb * 2;
    const size_t tstepA = 2 * hstepA, tstep = 2 * hstep;
    const unsigned ldsw = (unsigned)wid * 1024u;
    const int aoff = lds_byte(wr * 64 + fr, fq * 8), boff = lds_byte(wc * 32 + fr, fq * 8);
#define PG8_SA(b, h) (((b) * 2 + (h)) * HTB)
#define PG8_SB(b, h) ((4 + (b) * 2 + (h)) * HTB)
#define PG8_STAGE(bufoff, gbase, voff) do { _Pragma("unroll") for (int _i = 0; _i < 2; ++_i) \
        __builtin_amdgcn_global_load_lds((const unsigned*)((const char*)(gbase) + (voff)[_i]), (PG8_LAS unsigned*)(lds + (bufoff) + ldsw + _i * 8192), 16, 0, 0); } while (0)
#define PG8_STAGE_A(bufoff, nextsel, half, kb) do { _Pragma("unroll") for (int _i = 0; _i < 2; ++_i) { const char* _p; \
        if constexpr (GATHER) _p = (const char*)g.A + (kb) + ((nextsel) ? nx[half][_i] : cu[half][_i]); else _p = ((nextsel) ? nA : cA) + (kb) + (size_t)(half) * hstepA + voffA[_i]; \
        __builtin_amdgcn_global_load_lds((const unsigned*)_p, (PG8_LAS unsigned*)(lds + (bufoff) + ldsw + _i * 8192), 16, 0, 0); } } while (0)
#define PG8_ROWS(u, o) do { _Pragma("unroll") for (int _h = 0; _h < 2; ++_h) _Pragma("unroll") for (int _i = 0; _i < 2; ++_i) { int _R, _C; stage_rc(tid * 16 + _i * 8192, _R, _C); const int _r = _h * HALF + _R; \
        const int _t = (_r < (u).aux1) ? (g.glist[(u).aux0 + _r] >> 1) : 0; o[_h][_i] = ((unsigned)_t * (unsigned)g.lda + (unsigned)_C) * 2u; } } while (0)
#define PG8_LDA(dst, b, h) do { _Pragma("unroll") for (int m = 0; m < 4; ++m) _Pragma("unroll") for (int k = 0; k < 2; ++k) dst[m][k] = *(const PG8_LAS bf16x8*)(lds + PG8_SA(b, h) + aoff + m * 2048 + k * 1024); } while (0)
#define PG8_LDB(dst, b, h) do { _Pragma("unroll") for (int n = 0; n < 2; ++n) _Pragma("unroll") for (int k = 0; k < 2; ++k) dst[n][k] = *(const PG8_LAS bf16x8*)(lds + PG8_SB(b, h) + boff + n * 2048 + k * 1024); } while (0)
#define PG8_MMA(ai, bj, At, Bt) do { __builtin_amdgcn_s_setprio(1); _Pragma("unroll") for (int m = 0; m < 4; ++m) _Pragma("unroll") for (int n = 0; n < 2; ++n) _Pragma("unroll") for (int k = 0; k < 2; ++k) \
        acc[ai][bj][m][n] = __builtin_amdgcn_mfma_f32_16x16x32_bf16(Bt[n][k], At[m][k], acc[ai][bj][m][n], 0, 0, 0); __builtin_amdgcn_s_setprio(0); } while (0)
#define PG8_WAIT_V(n) asm volatile("s_waitcnt vmcnt(" #n ")" ::: "memory")
#define PG8_WAIT_L(n) asm volatile("s_waitcnt lgkmcnt(" #n ")" ::: "memory")
#define PG8_BAR __builtin_amdgcn_s_barrier()
#define PG8_SCHED __builtin_amdgcn_sched_barrier(0)
    Unit cur, nxt; int ui = 0;
    if (!S.next(0, cur)) return;
    f32x4 acc[2][2][4][2];
#pragma unroll
    for (int a = 0; a < 2; ++a)
#pragma unroll
        for (int b = 0; b < 2; ++b)
#pragma unroll
            for (int m = 0; m < 4; ++m)
#pragma unroll
                for (int n = 0; n < 2; ++n) acc[a][b][m][n] = (f32x4){0.f, 0.f, 0.f, 0.f};
    bf16x8 At[4][2], B0[2][2], B1[2][2];
    const char* cA = (const char*)g.A + (size_t)cur.pm * tstepA; const char* cB = (const char*)g.Bt + (size_t)cur.pb * tstep;
    S.a_ready(cur);
    unsigned cu[2][2] = {{0u, 0u}, {0u, 0u}}, nx[2][2] = {{0u, 0u}, {0u, 0u}}; const char* nA = cA;
    if constexpr (GATHER) PG8_ROWS(cur, cu);
    if constexpr (SP2) {
        PG8_STAGE(PG8_SB(0, 0), cB, voffB); PG8_STAGE(PG8_SB(0, 1), cB + hstep, voffB); PG8_STAGE_A(PG8_SA(0, 0), false, 0, 0); PG8_STAGE_A(PG8_SA(0, 1), false, 1, 0);
        if (wr == 1) PG8_BAR;
        PG8_WAIT_V(2); PG8_BAR;
        PG8_STAGE(PG8_SB(1, 0), cB + kstep, voffB); PG8_STAGE_A(PG8_SA(1, 0), false, 0, kstep); PG8_STAGE(PG8_SB(1, 1), cB + hstep + kstep, voffB);
        PG8_WAIT_V(6); PG8_BAR;
    } else { static_assert(SP2, "only the SP2 loop is kept in this file"); }
    for (;;) {
        const bool has_next = S.next(ui + 1, nxt);
        nA = has_next ? (const char*)g.A + (size_t)nxt.pm * tstepA : cA;
        if constexpr (GATHER) { if (has_next) PG8_ROWS(nxt, nx); else { nx[0][0] = cu[0][0]; nx[0][1] = cu[0][1]; nx[1][0] = cu[1][0]; nx[1][1] = cu[1][1]; } }
        const char* nB = has_next ? (const char*)g.Bt + (size_t)nxt.pb * tstep : cB;
#pragma unroll 1
        for (int t = 0; t < nt; t += 2) {
            const bool last = (t == nt - 2);
            const size_t kb1 = (size_t)(t + 1) * kstep;
            const size_t kb2 = last ? 0 : (size_t)(t + 2) * kstep; const char* b2 = last ? nB : cB + (size_t)(t + 2) * kstep;
            const size_t kb3 = kb2 + kstep; const char* b3 = b2 + kstep;
            if (last && has_next) S.a_ready(nxt);
            if constexpr (SP2) {
            PG8_LDB(B0, 0, 0); PG8_LDB(B1, 0, 1); PG8_SCHED; PG8_LDA(At, 0, 0); PG8_STAGE_A(PG8_SA(1, 1), false, 1, kb1);
            PG8_WAIT_V(8); PG8_WAIT_L(0); PG8_BAR; PG8_MMA(0, 0, At, B0); PG8_MMA(0, 1, At, B1); PG8_BAR; PG8_SCHED;
            PG8_LDA(At, 0, 1); PG8_STAGE(PG8_SB(0, 0), b2, voffB); PG8_STAGE(PG8_SB(0, 1), b2 + hstep, voffB); PG8_STAGE_A(PG8_SA(0, 0), last, 0, kb2);
            PG8_WAIT_V(8); PG8_WAIT_L(0); PG8_BAR; PG8_MMA(1, 0, At, B0); PG8_MMA(1, 1, At, B1); PG8_BAR; PG8_SCHED;
            PG8_LDB(B0, 1, 0); PG8_LDB(B1, 1, 1); PG8_SCHED; PG8_LDA(At, 1, 0); PG8_STAGE_A(PG8_SA(0, 1), last, 1, kb2);
            PG8_WAIT_V(8); PG8_WAIT_L(0); PG8_BAR; PG8_MMA(0, 0, At, B0); PG8_MMA(0, 1, At, B1); PG8_BAR; PG8_SCHED;
            PG8_LDA(At, 1, 1); PG8_STAGE(PG8_SB(1, 0), b3, voffB); PG8_STAGE(PG8_SB(1, 1), b3 + hstep, voffB); PG8_STAGE_A(PG8_SA(1, 0), last, 0, kb3);
            PG8_WAIT_V(8); PG8_WAIT_L(0); PG8_BAR; PG8_MMA(1, 0, At, B0); PG8_MMA(1, 1, At, B1); PG8_BAR; PG8_SCHED;
            }
        }
        if constexpr (ALIGN_EPI) { if (wr == 0) PG8_BAR; }
        if constexpr (!Epi::AFTER_DRAIN) { E(acc, cur, wr, wc, fr, fq); S.done(cur); }
        if (!has_next) break;
#pragma unroll
        for (int a = 0; a < 2; ++a)
#pragma unroll
            for (int b = 0; b < 2; ++b)
#pragma unroll
                for (int m = 0; m < 4; ++m)
#pragma unroll
                    for (int n = 0; n < 2; ++n) acc[a][b][m][n] = (f32x4){0.f, 0.f, 0.f, 0.f};
        cur = nxt; cA = nA; cB = nB; ++ui;
        if constexpr (GATHER) { cu[0][0] = nx[0][0]; cu[0][1] = nx[0][1]; cu[1][0] = nx[1][0]; cu[1][1] = nx[1][1]; }
        if constexpr (ALIGN_EPI) { if (wr == 1) PG8_BAR; }
    }
    PG8_WAIT_V(0);
    if constexpr (!ALIGN_EPI) { if (wr == 0) PG8_BAR; }
    PG8_BAR;
    if constexpr (Epi::AFTER_DRAIN) { E.fused(acc, cur, wr, wc, fr, fq, lds, wid, lane); S.done(cur); }
#undef PG8_SA
#undef PG8_SB
#undef PG8_STAGE
#undef PG8_STAGE_A
#undef PG8_ROWS
#undef PG8_LDA
#undef PG8_LDB
#undef PG8_MMA
#undef PG8_WAIT_V
#undef PG8_WAIT_L
#undef PG8_BAR
#undef PG8_SCHED
}
}
namespace att {
using bf16 = unsigned short;
using bf16x8 = __attribute__((ext_vector_type(8))) short;
using s16x4  = __attribute__((ext_vector_type(4))) short;
using f32x16 = __attribute__((ext_vector_type(16))) float;
using u32x4  = __attribute__((ext_vector_type(4))) unsigned;
constexpr int LDQKV = 6208, LDO = 2112;
constexpr int SEQ_ = 8192;
constexpr size_t SHM_V = 64 * 128 * 2, SHM_K = 64 * 128 * 2, SHM_ATTN = 2 * SHM_V + 2 * SHM_K + 8 * 64 * 4 + 64;
#define KSWZ(row, colB) ((row) * 256 + ((colB) ^ (((row) & 7) << 4)))
#define SBAR() __builtin_amdgcn_sched_barrier(0)
__device__ __forceinline__ int crow(int r, int hi) { return (r & 3) + 8 * (r >> 2) + 4 * hi; }
__device__ __forceinline__ unsigned cvtpk(float lo, float hi) { unsigned r; asm volatile("v_cvt_pk_bf16_f32 %0, %1, %2" : "=v"(r) : "v"(lo), "v"(hi)); return r; }
__device__ __forceinline__ int v_st(int k, int c) { const int kk = (k & ~0xC) | ((k & 4) << 1) | ((k & 8) >> 1); return ((kk >> 3) * 4 + (c >> 5)) * 512 + ((kk & 7) * 32 + (c & 31)) * 2; }
__device__ __forceinline__ int v_rd_base(int lane) { return ((lane & 3) << 3) | (((lane >> 2) & 3) << 6) | (((lane >> 4) & 1) << 5) | (((lane >> 5) & 1) << 8); }
constexpr int v_rd_off(int d0, int ks, int half) { return d0 * 512 + ks * 4096 + half * 2048; }
template <int OFF> __device__ __forceinline__ s16x4 tr_read(int vb) { s16x4 r; asm volatile("ds_read_b64_tr_b16 %0, %1 offset:%2" : "=&v"(r) : "v"(vb), "i"(OFF) : "memory"); return r; }
template <int D0> __device__ __forceinline__ void pv_one(f32x16& od, int vb, bf16x8 pa0, bf16x8 pa1, bf16x8 pa2, bf16x8 pa3) {
  const s16x4 l0 = tr_read<v_rd_off(D0, 0, 0)>(vb), h0 = tr_read<v_rd_off(D0, 0, 1)>(vb), l1 = tr_read<v_rd_off(D0, 1, 0)>(vb), h1 = tr_read<v_rd_off(D0, 1, 1)>(vb);
  const s16x4 l2 = tr_read<v_rd_off(D0, 2, 0)>(vb), h2 = tr_read<v_rd_off(D0, 2, 1)>(vb), l3 = tr_read<v_rd_off(D0, 3, 0)>(vb), h3 = tr_read<v_rd_off(D0, 3, 1)>(vb);
  asm volatile("s_waitcnt lgkmcnt(0)" ::: "memory"); SBAR();
#define PK(L, H) (bf16x8){L[0], L[1], L[2], L[3], H[0], H[1], H[2], H[3]}
  od = __builtin_amdgcn_mfma_f32_32x32x16_bf16(pa0, PK(l0, h0), od, 0, 0, 0);
  od = __builtin_amdgcn_mfma_f32_32x32x16_bf16(pa1, PK(l1, h1), od, 0, 0, 0);
  od = __builtin_amdgcn_mfma_f32_32x32x16_bf16(pa2, PK(l2, h2), od, 0, 0, 0);
  od = __builtin_amdgcn_mfma_f32_32x32x16_bf16(pa3, PK(l3, h3), od, 0, 0, 0);
#undef PK
}
__device__ __forceinline__ void pv_d0(f32x16* o, int vb, bf16x8 pa0, bf16x8 pa1, bf16x8 pa2, bf16x8 pa3) {
  pv_one<0>(o[0], vb, pa0, pa1, pa2, pa3); pv_one<1>(o[1], vb, pa0, pa1, pa2, pa3); pv_one<2>(o[2], vb, pa0, pa1, pa2, pa3); pv_one<3>(o[3], vb, pa0, pa1, pa2, pa3);
}
__device__ __forceinline__ void pack_p(const f32x16& p0, const f32x16& p1, bf16x8& pa0, bf16x8& pa1, bf16x8& pa2, bf16x8& pa3) {
#define PK4(P, BASE, OUT) do { unsigned a0 = cvtpk(P[BASE + 0], P[BASE + 1]), a1 = cvtpk(P[BASE + 2], P[BASE + 3]);   \
    unsigned b0 = cvtpk(P[BASE + 4], P[BASE + 5]), b1 = cvtpk(P[BASE + 6], P[BASE + 7]);                              \
    auto r0 = __builtin_amdgcn_permlane32_swap(a0, b0, false, false); auto r1 = __builtin_amdgcn_permlane32_swap(a1, b1, false, false); \
    u32x4 w = {r0[0], r1[0], r0[1], r1[1]}; OUT = *reinterpret_cast<bf16x8*>(&w); } while (0)
  PK4(p0, 0, pa0); PK4(p0, 8, pa1); PK4(p1, 0, pa2); PK4(p1, 8, pa3);
#undef PK4
}
template <int ND> __device__ __forceinline__ void qkt(f32x16& p0, f32x16& p1, const char* Ks, const bf16x8* qr, int cb0, int r32, int hi) {
  p0 = f32x16{}; p1 = f32x16{};
#pragma unroll
  for (int d0 = 0; d0 < ND; ++d0) { const int cb = cb0 + (d0 * 16 + hi * 8) * 2;
    const bf16x8 b0 = *reinterpret_cast<const bf16x8*>(Ks + KSWZ(r32, cb));
    const bf16x8 b1 = *reinterpret_cast<const bf16x8*>(Ks + KSWZ(32 + r32, cb));
    p0 = __builtin_amdgcn_mfma_f32_32x32x16_bf16(b0, qr[d0], p0, 0, 0, 0);
    p1 = __builtin_amdgcn_mfma_f32_32x32x16_bf16(b1, qr[d0], p1, 0, 0, 0); }
}
constexpr float THRL = 11.5f;
__device__ __forceinline__ void partialSM(f32x16& p0, f32x16& p1, float& m_reg, float& mn, float& alpha) {
  float pmax = p0[0];
#pragma unroll
  for (int r = 1; r < 16; ++r) pmax = fmaxf(pmax, p0[r]);
#pragma unroll
  for (int r = 0; r < 16; ++r) pmax = fmaxf(pmax, p1[r]);
  { auto rr = __builtin_amdgcn_permlane32_swap(__float_as_uint(pmax), __float_as_uint(pmax), false, false); pmax = fmaxf(__uint_as_float(rr[0]), __uint_as_float(rr[1])); }
  if (__builtin_expect(__all(pmax - m_reg <= THRL), 1)) { mn = m_reg; alpha = 1.f; }
  else { mn = fmaxf(m_reg, pmax); alpha = __builtin_amdgcn_exp2f(m_reg - mn); m_reg = mn; }
#pragma unroll
  for (int r = 0; r < 16; ++r) p0[r] = p0[r] - mn;
#pragma unroll
  for (int r = 0; r < 16; ++r) p1[r] = p1[r] - mn;
#pragma unroll
  for (int r = 0; r < 16; ++r) p0[r] = __builtin_amdgcn_exp2f(p0[r]);
}
__device__ __forceinline__ void finishSM(f32x16& p0, f32x16& p1, float alpha, float& l_reg, bf16x8& pa0, bf16x8& pa1, bf16x8& pa2, bf16x8& pa3) {
#pragma unroll
  for (int r = 0; r < 16; ++r) p1[r] = __builtin_amdgcn_exp2f(p1[r]);
  float ps = 0;
#pragma unroll
  for (int r = 0; r < 16; ++r) ps += p0[r];
#pragma unroll
  for (int r = 0; r < 16; ++r) ps += p1[r];
  { auto rr = __builtin_amdgcn_permlane32_swap(__float_as_uint(ps), __float_as_uint(ps), false, false); ps = __uint_as_float(rr[0]) + __uint_as_float(rr[1]); }
  l_reg = l_reg * alpha + ps;
  pack_p(p0, p1, pa0, pa1, pa2, pa3);
}
__device__ __forceinline__ float half_sum32(float v) { return half_sum32_(v); }

__device__ __forceinline__ void diff_unit(int b, int h, int qb, const bf16* __restrict__ QKV, bf16* __restrict__ Oout, const float* __restrict__ gdiff, float lam, float oscale, char* lds) {
  const int tid = threadIdx.x, lane = tid & 63, r32 = lane & 31, hi = lane >> 5; const int wid = __builtin_amdgcn_readfirstlane(tid >> 6);
  const int map = wid >> 2, wq = wid & 3;
  bf16* V_lds = (bf16*)lds; bf16* K_lds = (bf16*)(lds + 2 * SHM_V);
  float* ws = (float*)(lds + 2 * SHM_V + 2 * SHM_K) + wid * 64; float* li_l = ws; float* al_l = ws + 32;
  float m_reg = -1e30f, l_reg = 0; f32x16 o[4] = {}; bf16x8 qr[4];
  const size_t rowb = (size_t)b * SEQ_;
  const bf16* Qw = QKV + (rowb + qb * 128 + wq * 32 + r32) * LDQKV + 3072 + h * 128 + map * 64 + hi * 8;
#pragma unroll
  for (int d0 = 0; d0 < 4; ++d0) qr[d0] = *reinterpret_cast<const bf16x8*>(Qw + d0 * 16);
  const bf16* Kh = QKV + rowb * LDQKV + 4096 + h * 128; const bf16* Vh = QKV + rowb * LDQKV + 5120 + h * 128;
  const int sr = tid >> 4, sc = (tid & 15) * 8, vst0 = v_st(sr, sc), vst1 = v_st(32 + sr, sc);
  const int vb0 = (int)(uintptr_t)V_lds + v_rd_base(lane);
  const int cbm = map * 128;
  struct { bf16x8 vs0, vs1, ks0, ks1; } sr_[1];
  const unsigned toff0 = (unsigned)(sr * LDQKV + sc), toff1 = toff0 + 32u * LDQKV;
#define SLOAD(i, k0) do { const bf16* vt_ = Vh + (size_t)(k0) * LDQKV; const bf16* kt_ = Kh + (size_t)(k0) * LDQKV; \
    sr_[i].vs0 = *reinterpret_cast<const bf16x8*>(vt_ + toff0); sr_[i].vs1 = *reinterpret_cast<const bf16x8*>(vt_ + toff1); \
    sr_[i].ks0 = *reinterpret_cast<const bf16x8*>(kt_ + toff0); sr_[i].ks1 = *reinterpret_cast<const bf16x8*>(kt_ + toff1); } while (0)
#define SWRITE(bb, i) do { *(bf16x8*)((char*)V_lds + (bb) * SHM_V + vst0) = sr_[i].vs0; *(bf16x8*)((char*)V_lds + (bb) * SHM_V + vst1) = sr_[i].vs1; const int kc = sc * 2; \
    *(bf16x8*)((char*)K_lds + (bb) * SHM_K + KSWZ(sr, kc)) = sr_[i].ks0; *(bf16x8*)((char*)K_lds + (bb) * SHM_K + KSWZ(32 + sr, kc)) = sr_[i].ks1; } while (0)
#define SWAIT() asm volatile("s_waitcnt vmcnt(0)" ::: "memory")
#define RESC(a) do { if (__any((a) < 1.f)) { if (hi == 0) al_l[r32] = (a); asm volatile("s_waitcnt lgkmcnt(0)" ::: "memory"); \
    _Pragma("unroll") for (int d = 0; d < 4; ++d) _Pragma("unroll") for (int r = 0; r < 16; ++r) o[d][r] *= al_l[crow(r, hi)]; } } while (0)
  f32x16 pA0, pA1, pB0, pB1; float mnA, mnB, alA, alB; bf16x8 pa0, pa1, pa2, pa3; const int NT = 2 * qb + 2;
  __syncthreads();
  SLOAD(0, 0); asm volatile("s_waitcnt vmcnt(0)" ::: "memory"); SWRITE(0, 0); __syncthreads();
  qkt<4>(pA0, pA1, (const char*)K_lds, qr, cbm, r32, hi); partialSM(pA0, pA1, m_reg, mnA, alA);
  SLOAD(0, 64);
  SWAIT(); SWRITE(1, 0); __syncthreads();
  for (int j = 1; j + 1 < NT; j += 2) {
    SBAR(); qkt<4>(pB0, pB1, (const char*)K_lds + SHM_K, qr, cbm, r32, hi);
    finishSM(pA0, pA1, alA, l_reg, pa0, pa1, pa2, pa3); SBAR();
    SLOAD(0, (j + 1) * 64); SBAR();
    pv_d0(o, vb0, pa0, pa1, pa2, pa3); partialSM(pB0, pB1, m_reg, mnB, alB);
    __syncthreads(); SWAIT(); SWRITE(0, 0);
    RESC(alB); __syncthreads();
    SBAR(); qkt<4>(pA0, pA1, (const char*)K_lds, qr, cbm, r32, hi);
    finishSM(pB0, pB1, alB, l_reg, pa0, pa1, pa2, pa3); SBAR();
    SLOAD(0, (j + 2) * 64); SBAR();
    pv_d0(o, vb0 + (int)SHM_V, pa0, pa1, pa2, pa3); partialSM(pA0, pA1, m_reg, mnA, alA);
    __syncthreads(); SWAIT(); SWRITE(1, 0);
    RESC(alA); __syncthreads();
  }
  SBAR(); qkt<4>(pB0, pB1, (const char*)K_lds + SHM_K, qr, cbm, r32, hi);
  if (wq < 2) {
#pragma unroll
    for (int r = 0; r < 16; ++r) { pB0[r] = -1e30f; pB1[r] = -1e30f; } }
  finishSM(pA0, pA1, alA, l_reg, pa0, pa1, pa2, pa3); SBAR();
  pv_d0(o, vb0, pa0, pa1, pa2, pa3); partialSM(pB0, pB1, m_reg, mnB, alB);
  __syncthreads(); RESC(alB);
  finishSM(pB0, pB1, alB, l_reg, pa0, pa1, pa2, pa3); SBAR();
  pv_d0(o, vb0 + (int)SHM_V, pa0, pa1, pa2, pa3);
  if (hi == 0) li_l[r32] = l_reg; asm volatile("s_waitcnt lgkmcnt(0)" ::: "memory");
  float rli[16];
#pragma unroll
  for (int r = 0; r < 16; ++r) rli[r] = __builtin_amdgcn_rcpf(li_l[crow(r, hi)]);
  __syncthreads();
  float* xch = (float*)lds + (size_t)wq * 4096;
  if (map == 1) {
#pragma unroll
    for (int d0 = 0; d0 < 4; ++d0)
#pragma unroll
      for (int r = 0; r < 16; ++r) xch[(d0 * 16 + r) * 64 + lane] = o[d0][r] * rli[r] * lam;
  }
  __syncthreads();
  if (map == 0) {
    float ss[16];
#pragma unroll
    for (int r = 0; r < 16; ++r) { float s = 0.f;
#pragma unroll
      for (int d0 = 0; d0 < 4; ++d0) { const float v = o[d0][r] * rli[r] - xch[(d0 * 16 + r) * 64 + lane]; o[d0][r] = v; s += v * v; }
      ss[r] = s; }
#pragma unroll
    for (int r = 0; r < 16; ++r) ss[r] = half_sum32(ss[r]);
    bf16* Ow = Oout + (rowb + qb * 128 + wq * 32) * LDO + 1024 + h * 128;
    float gv[4];
#pragma unroll
    for (int d0 = 0; d0 < 4; ++d0) gv[d0] = gdiff[d0 * 32 + r32] * oscale;
#pragma unroll
    for (int r = 0; r < 16; ++r) { const int orow = crow(r, hi); const float rs = rsqrtf(ss[r] * (1.f / 128.f) + 1e-6f);
#pragma unroll
      for (int d0 = 0; d0 < 4; ++d0) { const float y = o[d0][r] * rs * gv[d0]; const unsigned w = cvtpk(y, y); Ow[(size_t)orow * LDO + d0 * 32 + r32] = (bf16)(w & 0xffffu); } }
  }
#undef SLOAD
#undef SWRITE
#undef SWAIT
#undef RESC
}
__device__ __forceinline__ void sb_wave_unit(int b, int h, int wq, const bf16* __restrict__ QKV, bf16* __restrict__ Oout, const float* __restrict__ gsb, char* ldsw) {
  FRESH_LANE(lane);
  const int r32 = lane & 31, hi = lane >> 5;
  char* V_lds = ldsw; char* K_lds = ldsw + 8192;
  f32x16 o[4] = {}; bf16x8 qr[8];
  const size_t rowb = (size_t)b * SEQ_;
  const int Q0 = wq * 32, tq = Q0 + r32;
  const bf16* Qw = QKV + (rowb + tq) * LDQKV + h * 128 + hi * 8;
#pragma unroll
  for (int d0 = 0; d0 < 8; ++d0) qr[d0] = *reinterpret_cast<const bf16x8*>(Qw + d0 * 16);
  const bf16* Kh = QKV + rowb * LDQKV + 1024 + h * 128; const bf16* Vh = QKV + rowb * LDQKV + 2048 + h * 128;
  const int skey = lane >> 4, scol = (lane & 15) * 8;
  const unsigned toff = (unsigned)(skey * LDQKV + scol);
  const unsigned koff0 = (unsigned)(skey * LDQKV + (((lane & 15) ^ skey) * 8)), koff1 = (unsigned)(skey * LDQKV + (((lane & 15) ^ (4 + skey)) * 8));
  typedef __attribute__((address_space(3))) unsigned lds_u32;
  lds_u32* kl = (lds_u32*)(K_lds);
  const int vb0 = (int)(uintptr_t)V_lds + v_rd_base(lane);
  bf16x8 vs[8];
#define SB_LOADV(j) do { const bf16* vt_ = Vh + (size_t)(j) * 32 * LDQKV; \
    _Pragma("unroll") for (int i_ = 0; i_ < 8; ++i_) vs[i_] = *reinterpret_cast<const bf16x8*>(vt_ + toff + (unsigned)(4 * i_) * LDQKV); } while (0)
#define SB_DMAK(j) do { const bf16* kt_ = Kh + (size_t)(j) * 32 * LDQKV; \
    _Pragma("unroll") for (int p_ = 0; p_ < 8; ++p_) __builtin_amdgcn_global_load_lds((const unsigned*)(kt_ + (unsigned)(4 * p_) * LDQKV + ((p_ & 1) ? koff1 : koff0)), kl + p_ * 256, 16, 0, 0); } while (0)
  float carry = 0.f;
  SB_DMAK(wq); SB_LOADV(wq);
  for (int j = wq; j >= 0; --j) {
    asm volatile("s_waitcnt vmcnt(0)" ::: "memory");
#pragma unroll
    for (int i = 0; i < 8; ++i) { const int key = 4 * i + skey; *(bf16x8*)(V_lds + v_st(key, scol)) = vs[i]; }
    asm volatile("s_waitcnt lgkmcnt(0)" ::: "memory");
    if (j > 0) SB_LOADV(j - 1);
    f32x16 p0 = f32x16{};
#pragma unroll
    for (int d0 = 0; d0 < 8; ++d0) { const int cb = (d0 * 16 + hi * 8) * 2;
      const bf16x8 b0 = *reinterpret_cast<const bf16x8*>(K_lds + KSWZ(r32, cb));
      p0 = __builtin_amdgcn_mfma_f32_32x32x16_bf16(b0, qr[d0], p0, 0, 0, 0); }
    asm volatile("s_waitcnt lgkmcnt(0)" ::: "memory");
    if (j > 0) SB_DMAK(j - 1);
    const bool diag = (j == wq);
    const int kb = j * 32 + 4 * hi;
    f32x16 q0;
#pragma unroll
    for (int r = 0; r < 16; ++r) {
      const float z0 = __builtin_amdgcn_fmed3f(p0[r], -120.f, 120.f);
      float a0 = -__builtin_amdgcn_logf(1.f + __builtin_amdgcn_exp2f(z0));
      float b0 = z0 + a0;
      if (diag) { const int kv = kb + (r & 3) + 8 * (r >> 2); if (kv >= tq) { a0 = 0.f; b0 = -1e30f; } }
      q0[r] = a0; p0[r] = b0; }
    float G[4], PG[4], SUF[4];
#pragma unroll
    for (int g = 0; g < 4; ++g) G[g] = (q0[4 * g] + q0[4 * g + 1]) + (q0[4 * g + 2] + q0[4 * g + 3]);
    float CS[4];
#pragma unroll
    for (int g = 0; g < 4; ++g) { auto rr = __builtin_amdgcn_permlane32_swap(__float_as_uint(G[g]), __float_as_uint(G[g]), false, false);
      CS[g] = __uint_as_float(rr[0]) + __uint_as_float(rr[1]); PG[g] = __uint_as_float(rr[1]); }
    float run = carry;
#pragma unroll
    for (int g = 3; g >= 0; --g) { SUF[g] = run; run += CS[g]; }
    carry = run;
#pragma unroll
    for (int g = 0; g < 4; ++g) SUF[g] += (hi == 0) ? PG[g] : 0.f;
#pragma unroll
    for (int g = 0; g < 4; ++g) {
      float s = SUF[g];
      p0[4 * g + 3] = __builtin_amdgcn_exp2f(p0[4 * g + 3] + s); s += q0[4 * g + 3];
      p0[4 * g + 2] = __builtin_amdgcn_exp2f(p0[4 * g + 2] + s); s += q0[4 * g + 2];
      p0[4 * g + 1] = __builtin_amdgcn_exp2f(p0[4 * g + 1] + s); s += q0[4 * g + 1];
      p0[4 * g + 0] = __builtin_amdgcn_exp2f(p0[4 * g + 0] + s);
    }
    bf16x8 pa0, pa1;
#define PK4(P, BASE, OUT) do { unsigned a0 = cvtpk(P[BASE + 0], P[BASE + 1]), a1 = cvtpk(P[BASE + 2], P[BASE + 3]);   \
    unsigned b0 = cvtpk(P[BASE + 4], P[BASE + 5]), b1 = cvtpk(P[BASE + 6], P[BASE + 7]);                              \
    auto r0 = __builtin_amdgcn_permlane32_swap(a0, b0, false, false); auto r1 = __builtin_amdgcn_permlane32_swap(a1, b1, false, false); \
    u32x4 w = {r0[0], r1[0], r0[1], r1[1]}; OUT = *reinterpret_cast<bf16x8*>(&w); } while (0)
    PK4(p0, 0, pa0); PK4(p0, 8, pa1);
#undef PK4
#define SB_PV(D0) do { const s16x4 l0 = tr_read<v_rd_off(D0, 0, 0)>(vb0), h0 = tr_read<v_rd_off(D0, 0, 1)>(vb0), l1 = tr_read<v_rd_off(D0, 1, 0)>(vb0), h1 = tr_read<v_rd_off(D0, 1, 1)>(vb0); \
    asm volatile("s_waitcnt lgkmcnt(0)" ::: "memory"); SBAR(); \
    o[D0] = __builtin_amdgcn_mfma_f32_32x32x16_bf16(pa0, (bf16x8){l0[0], l0[1], l0[2], l0[3], h0[0], h0[1], h0[2], h0[3]}, o[D0], 0, 0, 0); \
    o[D0] = __builtin_amdgcn_mfma_f32_32x32x16_bf16(pa1, (bf16x8){l1[0], l1[1], l1[2], l1[3], h1[0], h1[1], h1[2], h1[3]}, o[D0], 0, 0, 0); } while (0)
    SB_PV(0); SB_PV(1); SB_PV(2); SB_PV(3);
#undef SB_PV
    if (__all(carry < -160.f)) break;
  }
#undef SB_LOADV
#undef SB_DMAK
  { FRESH_LANE(le_); const int r32e = le_ & 31, hie = le_ >> 5; float ss[16];
#pragma unroll
    for (int r = 0; r < 16; ++r) { float s = 0.f;
#pragma unroll
      for (int d0 = 0; d0 < 4; ++d0) s += o[d0][r] * o[d0][r];
      ss[r] = half_sum32(s); }
    bf16* Ow = Oout + (rowb + Q0) * LDO + h * 128;
    float gv[4];
#pragma unroll
    for (int d0 = 0; d0 < 4; ++d0) gv[d0] = gsb[d0 * 32 + r32e];
#pragma unroll
    for (int r = 0; r < 16; ++r) { const int orow = crow(r, hie); const float rs = rsqrtf(ss[r] * (1.f / 128.f) + 1e-6f);
#pragma unroll
      for (int d0 = 0; d0 < 4; ++d0) { const float y = o[d0][r] * rs * gv[d0]; const unsigned w = cvtpk(y, y); Ow[(size_t)orow * LDO + d0 * 32 + r32e] = (bf16)(w & 0xffffu); } }
  }
  asm volatile("s_waitcnt vmcnt(0)" ::: "memory");
}
#undef KSWZ
#undef SBAR
}
namespace att {
typedef __attribute__((address_space(3))) const char* lds_cptr;
typedef short v4i16_t __attribute__((ext_vector_type(4)));
constexpr int D2_K = 0, D2_V = 49152, D2_WS = 98304, D2_SLOT = 16384;
constexpr float THR2 = 8.f;
__device__ __forceinline__ void glds16(const void* gsrc, unsigned lds_dst) { unsigned keep;
  asm volatile("s_mov_b32 %0, m0\n\ts_mov_b32 m0, %2\n\ts_nop 0\n\tglobal_load_lds_dwordx4 %1, off\n\ts_mov_b32 m0, %0" : "=&s"(keep) : "v"(gsrc), "s"(lds_dst) : "memory"); }
__device__ __forceinline__ s16x4 vtr(lds_cptr p) { return __builtin_bit_cast(s16x4, __builtin_amdgcn_ds_read_tr16_b64_v4i16((__attribute__((address_space(3))) v4i16_t*)p)); }
__device__ __forceinline__ float max3f(float a, float b, float c) { return __builtin_fmaxf(__builtin_fmaxf(a, b), c); }
__device__ __forceinline__ float rowmax2(const f32x16& p0, const f32x16& p1) {
  float a = max3f(p0[0], p0[1], p1[0]), b = max3f(p0[2], p0[3], p1[1]); a = max3f(a, p1[2], p1[3]);
#pragma unroll
  for (int r = 4; r < 16; r += 4) { a = max3f(a, p0[r], p0[r + 1]); b = max3f(b, p0[r + 2], p0[r + 3]); a = max3f(a, p1[r], p1[r + 1]); b = max3f(b, p1[r + 2], p1[r + 3]); }
  const float m = __builtin_fmaxf(a, b);
  auto rr = __builtin_amdgcn_permlane32_swap(__float_as_uint(m), __float_as_uint(m), false, false);
  return __builtin_fmaxf(__uint_as_float(rr[0]), __uint_as_float(rr[1]));
}
#define SBAR2() __builtin_amdgcn_sched_barrier(0)
#define WAIT_BAR2(N) asm volatile("s_waitcnt vmcnt(" #N ") lgkmcnt(0)\n\ts_barrier" ::: "memory")
__device__ __forceinline__ void diff_unit2(int b, int h, int qb, const bf16* __restrict__ QKV, bf16* __restrict__ Oout, const float* __restrict__ gdiff, float lam, float oscale, char* shm, int wid) {
  int lane; asm volatile("v_mbcnt_lo_u32_b32 %0, -1, 0\n\tv_mbcnt_hi_u32_b32 %0, -1, %0" : "=v"(lane));
  const int r32 = lane & 31, hi = lane >> 5;
  const int map = wid >> 2, wq = wid & 3;
  const size_t rowb = (size_t)b * SEQ_;
  const bf16* Kh = QKV + rowb * LDQKV + 4096 + h * 128; const bf16* Vh = QKV + rowb * LDQKV + 5120 + h * 128;
  const unsigned lds0 = (unsigned)(uintptr_t)shm;
  float* wsf = (float*)(shm + D2_WS) + wid * 64;
  const bf16* ksrc = Kh + (size_t)lane * LDQKV + wid * 8;
  const bf16* vsrc = Vh + (size_t)(16 * (wid & 3) + (lane >> 2)) * LDQKV + (wid >> 2) * 32 + (lane & 3) * 8;
  const unsigned kdst = lds0 + D2_K + wid * 1024, vdst = lds0 + D2_V + wid * 1024;
#define DMA_K(t, slot) do { const bf16* s_ = ksrc + (size_t)(t) * 64 * LDQKV; const unsigned d_ = (unsigned)__builtin_amdgcn_readfirstlane(kdst + (slot)); glds16(s_, d_); glds16(s_ + 64, d_ + 8192); } while (0)
#define DMA_V(t, slot) do { const bf16* s_ = vsrc + (size_t)(t) * 64 * LDQKV; const unsigned d_ = (unsigned)__builtin_amdgcn_readfirstlane(vdst + (slot)); glds16(s_, d_); glds16(s_ + 64, d_ + 8192); } while (0)
  const lds_cptr shm3 = (lds_cptr)shm;
  const lds_cptr kp0 = shm3 + D2_K + (map * 8 + hi) * 1024 + r32 * 16;
  const lds_cptr vp0 = shm3 + D2_V + ((lane >> 4) & 1) * 32 + (lane & 3) * 8 + (4 * hi + ((lane & 15) >> 2)) * 64;
  const int NT = 2 * qb + 2;
  __syncthreads();
  DMA_K(0, 0); DMA_V(0, 0); DMA_K(1, D2_SLOT);
  bf16x8 qr[4];
  { const bf16* Qw = QKV + (rowb + qb * 128 + wq * 32 + r32) * LDQKV + 3072 + h * 128 + map * 64 + hi * 8;
#pragma unroll
    for (int d0 = 0; d0 < 4; ++d0) qr[d0] = *reinterpret_cast<const bf16x8*>(Qw + d0 * 16); }
  float mhat = 0.f, l_reg = 0.f; f32x16 o[4];
  { float z_ = 0.f; asm volatile("" : "+v"(z_));
#pragma unroll
    for (int d_ = 0; d_ < 4; ++d_)
#pragma unroll
      for (int r = 0; r < 16; ++r) o[d_][r] = z_; }
  bool resc = false;
  f32x16 pA0, pA1, pB0, pB1;
  int sl_prev = 0, sl_cur = 0, sl_next = D2_SLOT;
#define ROT() do { sl_prev = sl_cur; sl_cur = sl_next; sl_next = (sl_next == 2 * D2_SLOT) ? 0 : sl_next + D2_SLOT; } while (0)
#define KF(kp, d0, half) (*(const __attribute__((address_space(3))) bf16x8*)((kp) + (d0) * 2048 + (half) * 512))
#define RESC2() do { if (resc) { asm volatile("s_waitcnt lgkmcnt(0)" ::: "memory"); \
      _Pragma("unroll") for (int d_ = 0; d_ < 4; ++d_) _Pragma("unroll") for (int r = 0; r < 16; ++r) o[d_][r] *= wsf[crow(r, hi)]; } } while (0)
  WAIT_BAR2(0);
  { const lds_cptr kp_ = kp0;
    pA0 = __builtin_amdgcn_mfma_f32_32x32x16_bf16(KF(kp_, 0, 0), qr[0], f32x16{}, 0, 0, 0); pA1 = __builtin_amdgcn_mfma_f32_32x32x16_bf16(KF(kp_, 0, 1), qr[0], f32x16{}, 0, 0, 0);
#pragma unroll
    for (int d0 = 1; d0 < 4; ++d0) { pA0 = __builtin_amdgcn_mfma_f32_32x32x16_bf16(KF(kp_, d0, 0), qr[d0], pA0, 0, 0, 0); pA1 = __builtin_amdgcn_mfma_f32_32x32x16_bf16(KF(kp_, d0, 1), qr[d0], pA1, 0, 0, 0); }
    const float rm = rowmax2(pA0, pA1); mhat = rm;
#pragma unroll
    for (int r = 0; r < 16; ++r) { pA0[r] = __builtin_amdgcn_exp2f(pA0[r] - rm); pA1[r] = __builtin_amdgcn_exp2f(pA1[r] - rm); }
    if (2 < NT) DMA_K(2, 2 * D2_SLOT);
    DMA_V(1, D2_SLOT);
    asm volatile("s_waitcnt lgkmcnt(0)\n\ts_barrier" ::: "memory");
    ROT(); }
  u32x4 pw0, pw1, pw2, pw3;
#define PKW(P, B) cvtpk(P[B], P[B + 1])
#define PAF(k) __builtin_bit_cast(bf16x8, pw##k)
#define MFQ(C, d0, half, first) C = __builtin_amdgcn_mfma_f32_32x32x16_bf16(KF(kp_, d0, half), qr[d0], (first) ? f32x16{} : C, 0, 0, 0)
#define VRD(i) do { vl[(i) & 3] = vtr(vp_ + ((i) & 3) * 4096 + ((i) >> 2) * 1024); vh[(i) & 3] = vtr(vp_ + ((i) & 3) * 4096 + ((i) >> 2) * 1024 + 512); } while (0)
#define VFR(i) (bf16x8){vl[(i) & 3][0], vl[(i) & 3][1], vl[(i) & 3][2], vl[(i) & 3][3], vh[(i) & 3][0], vh[(i) & 3][1], vh[(i) & 3][2], vh[(i) & 3][3]}
#define EX2(C, B) do { C[B] = __builtin_amdgcn_exp2f(C[B]); C[(B) + 1] = __builtin_amdgcn_exp2f(C[(B) + 1]); asm volatile("" : "+v"(C)); } while (0)
#define KRD(i) kfr[(i) % 3] = KF(kp_, (i) >> 1, (i) & 1)
#define MFK(C, i, first) C = __builtin_amdgcn_mfma_f32_32x32x16_bf16(kfr[(i) % 3], qr[(i) >> 1], (first) ? f32x16{} : C, 0, 0, 0)
#define STEP2(C0, C1, P0, P1, t, GK, GV, MASKED) do { SBAR2(); \
    const lds_cptr kp_ = kp0 + sl_cur; const lds_cptr vp_ = vp0 + sl_prev; s16x4 vl[4], vh[4]; bf16x8 kfr[3]; \
    KRD(0); KRD(1); SBAR2(); \
    float sacc = P0[0] + P0[1]; \
    KRD(2); MFK(C0, 0, true);  sacc += P0[2]; sacc += P0[3]; sacc += P0[4]; sacc += P0[5]; asm volatile("" : "+v"(sacc));     pw0[0] = PKW(P0, 0); pw0[1] = PKW(P0, 2); SBAR2(); \
    KRD(3); MFK(C1, 1, true);  sacc += P0[6]; sacc += P0[7]; sacc += P0[8]; sacc += P0[9]; asm volatile("" : "+v"(sacc));     pw0[2] = PKW(P0, 4); pw0[3] = PKW(P0, 6); SBAR2(); \
    KRD(4); MFK(C0, 2, false); sacc += P0[10]; sacc += P0[11]; sacc += P0[12]; sacc += P0[13]; asm volatile("" : "+v"(sacc)); pw1[0] = PKW(P0, 8); pw1[1] = PKW(P0, 10); SBAR2(); \
    KRD(5); MFK(C1, 3, false); sacc += P0[14]; sacc += P0[15]; sacc += P1[0]; sacc += P1[1]; asm volatile("" : "+v"(sacc));   pw1[2] = PKW(P0, 12); pw1[3] = PKW(P0, 14); SBAR2(); \
    KRD(6); MFK(C0, 4, false); sacc += P1[2]; sacc += P1[3]; sacc += P1[4]; sacc += P1[5]; asm volatile("" : "+v"(sacc));     pw2[0] = PKW(P1, 0); pw2[1] = PKW(P1, 2); SBAR2(); \
    KRD(7); MFK(C1, 5, false); sacc += P1[6]; sacc += P1[7]; sacc += P1[8]; sacc += P1[9]; asm volatile("" : "+v"(sacc));     pw2[2] = PKW(P1, 4); pw2[3] = PKW(P1, 6); SBAR2(); \
    VRD(0); MFK(C0, 6, false); sacc += P1[10]; sacc += P1[11]; sacc += P1[12]; sacc += P1[13]; asm volatile("" : "+v"(sacc)); pw3[0] = PKW(P1, 8); pw3[1] = PKW(P1, 10); SBAR2(); \
    VRD(1); MFK(C1, 7, false); sacc += P1[14]; sacc += P1[15]; asm volatile("" : "+v"(sacc));                                 pw3[2] = PKW(P1, 12); pw3[3] = PKW(P1, 14); SBAR2(); \
    VRD(2); \
    l_reg += sacc; \
    if (GK) { DMA_K((t) + 2, sl_prev); } if (GV) { DMA_V((t) + 1, sl_next); } \
    if (MASKED) { _Pragma("unroll") for (int r = 0; r < 16; ++r) { C0[r] = -1e30f; C1[r] = -1e30f; } } \
    { const float rm = rowmax2(C0, C1) - mhat; resc = false; \
      if (__builtin_expect(__any(rm > THR2), 0)) { const float dl = __builtin_fmaxf(rm, 0.f); mhat += dl; \
        const float f = __builtin_amdgcn_exp2f(-dl); l_reg *= f; if (hi == 0) wsf[r32] = f; resc = true; } \
      _Pragma("unroll") for (int r = 0; r < 16; ++r) { C0[r] -= mhat; C1[r] -= mhat; } } \
    SBAR2(); \
    VRD(3);  o[0] = __builtin_amdgcn_mfma_f32_32x32x16_bf16(PAF(0), VFR(0),  o[0], 0, 0, 0); EX2(C0, 0);  SBAR2(); \
    VRD(4);  o[1] = __builtin_amdgcn_mfma_f32_32x32x16_bf16(PAF(0), VFR(1),  o[1], 0, 0, 0); EX2(C0, 2);  SBAR2(); \
    VRD(5);  o[2] = __builtin_amdgcn_mfma_f32_32x32x16_bf16(PAF(0), VFR(2),  o[2], 0, 0, 0); EX2(C0, 4);  SBAR2(); \
    VRD(6);  o[3] = __builtin_amdgcn_mfma_f32_32x32x16_bf16(PAF(0), VFR(3),  o[3], 0, 0, 0); EX2(C0, 6);  SBAR2(); \
    VRD(7);  o[0] = __builtin_amdgcn_mfma_f32_32x32x16_bf16(PAF(1), VFR(4),  o[0], 0, 0, 0); EX2(C0, 8);  SBAR2(); \
    VRD(8);  o[1] = __builtin_amdgcn_mfma_f32_32x32x16_bf16(PAF(1), VFR(5),  o[1], 0, 0, 0); EX2(C0, 10); SBAR2(); \
    VRD(9);  o[2] = __builtin_amdgcn_mfma_f32_32x32x16_bf16(PAF(1), VFR(6),  o[2], 0, 0, 0); EX2(C0, 12); SBAR2(); \
    VRD(10); o[3] = __builtin_amdgcn_mfma_f32_32x32x16_bf16(PAF(1), VFR(7),  o[3], 0, 0, 0); EX2(C0, 14); SBAR2(); \
    VRD(11); o[0] = __builtin_amdgcn_mfma_f32_32x32x16_bf16(PAF(2), VFR(8),  o[0], 0, 0, 0); EX2(C1, 0);  SBAR2(); \
    VRD(12); o[1] = __builtin_amdgcn_mfma_f32_32x32x16_bf16(PAF(2), VFR(9),  o[1], 0, 0, 0); EX2(C1, 2);  SBAR2(); \
    VRD(13); o[2] = __builtin_amdgcn_mfma_f32_32x32x16_bf16(PAF(2), VFR(10), o[2], 0, 0, 0); EX2(C1, 4);  SBAR2(); \
    VRD(14); o[3] = __builtin_amdgcn_mfma_f32_32x32x16_bf16(PAF(2), VFR(11), o[3], 0, 0, 0); EX2(C1, 6);  SBAR2(); \
    VRD(15); o[0] = __builtin_amdgcn_mfma_f32_32x32x16_bf16(PAF(3), VFR(12), o[0], 0, 0, 0); EX2(C1, 8);  SBAR2(); \
             o[1] = __builtin_amdgcn_mfma_f32_32x32x16_bf16(PAF(3), VFR(13), o[1], 0, 0, 0); EX2(C1, 10); SBAR2(); \
             o[2] = __builtin_amdgcn_mfma_f32_32x32x16_bf16(PAF(3), VFR(14), o[2], 0, 0, 0); EX2(C1, 12); SBAR2(); \
             o[3] = __builtin_amdgcn_mfma_f32_32x32x16_bf16(PAF(3), VFR(15), o[3], 0, 0, 0); EX2(C1, 14); SBAR2(); \
  } while (0)
  int t = 1;
  for (; t + 3 < NT; t += 2) {
    STEP2(pB0, pB1, pA0, pA1, t, true, true, false);     WAIT_BAR2(4); RESC2(); ROT();
    STEP2(pA0, pA1, pB0, pB1, t + 1, true, true, false); WAIT_BAR2(4); RESC2(); ROT();
  }
  if (NT >= 4) {
    STEP2(pB0, pB1, pA0, pA1, t, true, true, false);      WAIT_BAR2(4); RESC2(); ROT();
    STEP2(pA0, pA1, pB0, pB1, t + 1, false, true, false); WAIT_BAR2(2); RESC2(); ROT();
    t += 2;
  }
  if (wq < 2) { STEP2(pB0, pB1, pA0, pA1, t, false, false, true); } else { STEP2(pB0, pB1, pA0, pA1, t, false, false, false); }
  WAIT_BAR2(0); RESC2(); ROT();
  { float sacc = pB0[0] + pB0[1];
#pragma unroll
    for (int r = 2; r < 16; ++r) sacc += pB0[r];
#pragma unroll
    for (int r = 0; r < 16; ++r) sacc += pB1[r];
    l_reg += sacc;
    pw0 = (u32x4){PKW(pB0, 0), PKW(pB0, 2), PKW(pB0, 4), PKW(pB0, 6)}; pw1 = (u32x4){PKW(pB0, 8), PKW(pB0, 10), PKW(pB0, 12), PKW(pB0, 14)};
    pw2 = (u32x4){PKW(pB1, 0), PKW(pB1, 2), PKW(pB1, 4), PKW(pB1, 6)}; pw3 = (u32x4){PKW(pB1, 8), PKW(pB1, 10), PKW(pB1, 12), PKW(pB1, 14)};
    const lds_cptr vp_ = vp0 + sl_prev; s16x4 vl[4], vh[4];
#pragma unroll
    for (int ks = 0; ks < 4; ++ks) {
#pragma unroll
      for (int d0 = 0; d0 < 4; ++d0) { vl[d0] = vtr(vp_ + d0 * 4096 + ks * 1024); vh[d0] = vtr(vp_ + d0 * 4096 + ks * 1024 + 512); }
      const bf16x8 pa = (ks == 0) ? PAF(0) : (ks == 1) ? PAF(1) : (ks == 2) ? PAF(2) : PAF(3);
#pragma unroll
      for (int d0 = 0; d0 < 4; ++d0) o[d0] = __builtin_amdgcn_mfma_f32_32x32x16_bf16(pa, (bf16x8){vl[d0][0], vl[d0][1], vl[d0][2], vl[d0][3], vh[d0][0], vh[d0][1], vh[d0][2], vh[d0][3]}, o[d0], 0, 0, 0); }
  }
  int lane_e; asm volatile("v_mbcnt_lo_u32_b32 %0, -1, 0\n\tv_mbcnt_hi_u32_b32 %0, -1, %0" : "=v"(lane_e));
  const int r32e = lane_e & 31, hie = lane_e >> 5;
  { auto rr = __builtin_amdgcn_permlane32_swap(__float_as_uint(l_reg), __float_as_uint(l_reg), false, false); l_reg = __uint_as_float(rr[0]) + __uint_as_float(rr[1]); }
  if (hie == 0) wsf[32 + r32e] = l_reg; asm volatile("s_waitcnt lgkmcnt(0)" ::: "memory");
  float rli[16];
#pragma unroll
  for (int r = 0; r < 16; ++r) rli[r] = __builtin_amdgcn_rcpf(wsf[32 + crow(r, hie)]);
  __syncthreads();
  float* xch = (float*)shm + (size_t)wq * 4096;
  if (map == 1) {
#pragma unroll
    for (int d0 = 0; d0 < 4; ++d0)
#pragma unroll
      for (int r = 0; r < 16; ++r) xch[(d0 * 16 + r) * 64 + lane_e] = o[d0][r] * rli[r] * lam;
  }
  __syncthreads();
  if (map == 0) {
    float ss[16];
#pragma unroll
    for (int r = 0; r < 16; ++r) { float s = 0.f;
#pragma unroll
      for (int d0 = 0; d0 < 4; ++d0) { const float v = o[d0][r] * rli[r] - xch[(d0 * 16 + r) * 64 + lane_e]; o[d0][r] = v; s += v * v; }
      ss[r] = s; }
#pragma unroll
    for (int r = 0; r < 16; ++r) ss[r] = half_sum32(ss[r]);
    bf16* Ow = Oout + (rowb + qb * 128 + wq * 32) * LDO + 1024 + h * 128;
    float gv[4];
#pragma unroll
    for (int d0 = 0; d0 < 4; ++d0) gv[d0] = gdiff[d0 * 32 + r32e] * oscale;
#pragma unroll
    for (int r = 0; r < 16; ++r) { const int orow = crow(r, hie); const float rs = rsqrtf(ss[r] * (1.f / 128.f) + 1e-6f);
#pragma unroll
      for (int d0 = 0; d0 < 4; ++d0) { const float y = o[d0][r] * rs * gv[d0]; const unsigned w = cvtpk(y, y); Ow[(size_t)orow * LDO + d0 * 32 + r32e] = (bf16)(w & 0xffffu); } }
  }
#undef DMA_K
#undef DMA_V
#undef ROT
#undef KF
#undef RESC2
#undef PKW
#undef PAF
#undef MFQ
#undef KRD
#undef MFK
#undef VRD
#undef VFR
#undef EX2
#undef STEP2
}
#undef SBAR2
#undef WAIT_BAR2
}
constexpr int NWAVES = 8;
constexpr int BATCH = 4, SEQ = 8192, DM = 2048, NTOK = BATCH * SEQ;
constexpr int QKVC = 6144, NEXP = 32, DEXP = 512, PLED = 256, LCAP = 65536;
constexpr float EPS = 1e-6f;
constexpr int LDA1 = DM + 64, LDQ = QKVC + 64, LDW = DM + 64, LDP = PLED + 64, LDH = DEXP + 64;
constexpr float QSCALE_SB = 0.08838834764831845f * 1.4426950408889634f;
constexpr float QSCALE_DF = 0.125f * 1.4426950408889634f;
constexpr size_t MiB = 1u << 20;
constexpr size_t WS_CTL = 0, CTL_ZERO_BYTES = 1 * MiB;
constexpr size_t WS_ROPE = 1 * MiB;
constexpr size_t WS_WRT = 1 * MiB + 512 * 1024;
constexpr size_t WS_WIN = 2 * MiB;
constexpr size_t WS_WOUT = 27 * MiB;
constexpr size_t WS_WPG = 36 * MiB;
constexpr size_t WS_WPLE = 45 * MiB;
constexpr size_t WS_WGU = 47 * MiB;
constexpr size_t WS_WD = 179 * MiB;
constexpr size_t WS_LSLOT = 251 * MiB;
constexpr size_t WS_LGATE = 259 * MiB;
constexpr size_t WS_PB = 267 * MiB;
constexpr size_t WS_A1 = 287 * MiB;
constexpr size_t WS_QKV = 419 * MiB;
constexpr size_t WS_Y = WS_QKV;
constexpr size_t WS_H = WS_QKV + 288 * MiB;
constexpr size_t WS_U = 807 * MiB;
constexpr size_t WS_END = 935 * MiB;
static_assert(WS_WIN + (size_t)QKVC * LDW * 2 <= WS_WOUT && WS_WOUT + (size_t)DM * LDW * 2 <= WS_WPG && WS_WPG + (size_t)DM * LDW * 2 <= WS_WPLE && WS_WPLE + (size_t)DM * LDP * 2 <= WS_WGU, "ws map 1");
static_assert(WS_WGU + (size_t)32 * 1024 * LDW * 2 <= WS_WD && WS_WD + (size_t)32 * DM * LDH * 2 <= WS_LSLOT && WS_PB + (size_t)NTOK * LDP * 2 <= WS_A1 && WS_A1 + (size_t)NTOK * LDA1 * 2 <= WS_QKV, "ws map 2");
static_assert(WS_QKV + (size_t)NTOK * LDQ * 2 <= WS_U && WS_H + (size_t)73728 * LDH * 2 <= WS_U && WS_Y + (size_t)2 * NTOK * DM * 2 <= WS_H, "ws map 3");
constexpr int CW_TMO = 0, CW_CODE = 1;
constexpr int CW_BAR = 4096;
constexpr int CW_CNT = 16384;
constexpr int RING_OFF = 0, RING_BYTES = 131072;
constexpr int LDSCTL_OFF = RING_BYTES;
constexpr int TST_OFF = LDSCTL_OFF;
constexpr int CNT_OFF = LDSCTL_OFF + 160;
constexpr int MISC_OFF = LDSCTL_OFF + 320;
constexpr int LDS_BYTES = 147456;

#define GAS __attribute__((address_space(1)))
#define LAS __attribute__((address_space(3)))
typedef unsigned short bf16;
typedef unsigned v4u __attribute__((ext_vector_type(4)));
typedef unsigned v2u __attribute__((ext_vector_type(2)));
typedef float f32x4 __attribute__((ext_vector_type(4)));
typedef GAS unsigned gu32;
#define RLX_AGENT __ATOMIC_RELAXED, __HIP_MEMORY_SCOPE_AGENT
#define LDS_WAIT() asm volatile("s_waitcnt lgkmcnt(0)" ::: "memory")
#define VM_WAIT() asm volatile("s_waitcnt vmcnt(0)" ::: "memory")
__device__ __forceinline__ unsigned pk2(float lo, float hi) { return pg8::cvt_pk_bf16(lo, hi); }
#define XB_TMO      128
#define XB_XCNT(j)  (256  + 64 * (j))
#define XB_XSUB(j)  (1280 + 64 * (j))
#define XB_XGEN(j)  (2304 + 64 * (j))
#define XB_TOP      3328
#define XB_TOPGEN   3392
#define XCD_BAR_WORDS 3456
#define XB_SPIN_CAP (1u << 18)

__device__ __forceinline__ unsigned xb_ld(unsigned* p)              { return __hip_atomic_load(p, __ATOMIC_RELAXED, __HIP_MEMORY_SCOPE_AGENT); }
__device__ __forceinline__ unsigned xb_add(unsigned* p, unsigned v) { return __hip_atomic_fetch_add(p, v, __ATOMIC_RELAXED, __HIP_MEMORY_SCOPE_AGENT); }
__device__ __forceinline__ unsigned xb_xcc_id() { return (unsigned)__builtin_amdgcn_s_getreg((3 << 11) | 20) & 0xFu; }
#define XB_SPIN(cond, bar) do { unsigned _sp = 0; while (cond) { __builtin_amdgcn_s_sleep(1); \
    if ((++_sp & 255u) == 0u) { if (xb_ld(&(bar)[XB_TMO])) break; if (_sp > XB_SPIN_CAP) { atomicAdd(&(bar)[XB_TMO], 1u); break; } } } } while (0)

struct XcdBarrier {
    unsigned* bar; unsigned x;
    volatile LAS unsigned* st;
};

__device__ __forceinline__ XcdBarrier xcd_barrier_post(unsigned* bar, volatile LAS unsigned* st, bool leader) {
    XcdBarrier b; b.bar = bar; b.x = xb_xcc_id(); b.st = st;
    if (leader) (void)xb_add(&bar[XB_XCNT(b.x)], 1u);
    return b;
}
__device__ __forceinline__ void xcd_barrier_complete(unsigned* bar, unsigned x, unsigned& nloc, unsigned& nx) {
    const unsigned G = gridDim.x * gridDim.y * gridDim.z;
    unsigned sum, cnt, mine, sp = 0u;
    for (;;) {
        sum = 0u; cnt = 0u; mine = 0u;
#pragma unroll
        for (unsigned j = 0; j < 16; ++j) { const unsigned c = xb_ld(&bar[XB_XCNT(j)]); sum += c; cnt += (c > 0u) ? 1u : 0u; mine = (j == x) ? c : mine; }
        if (sum == G) break;
        __builtin_amdgcn_s_sleep(1);
        if ((++sp & 255u) == 0u) { if (xb_ld(&bar[XB_TMO])) break; if (sp > XB_SPIN_CAP) { atomicAdd(&bar[XB_TMO], 1u); break; } }
    }
    nloc = mine > 0u ? mine : 1u; nx = cnt > 0u ? cnt : 1u;
}

__device__ __forceinline__ void xcd_barrier(const XcdBarrier& b, int wave) {
    FRESH_LANE(xl_); const bool leader = (wave == 0) && (xl_ == 0);
    asm volatile("s_waitcnt vmcnt(0)" ::: "memory");
    __syncthreads();
    if (leader) {
        unsigned* bar = b.bar;
        __builtin_amdgcn_s_waitcnt(0);
        unsigned nloc = b.st[0], nx = b.st[1];
        if (nloc == 0u) { xcd_barrier_complete(bar, b.x, nloc, nx); b.st[0] = nloc; b.st[1] = nx; }
        const unsigned old = xb_add(&bar[XB_XSUB(b.x)], 1u);
        const unsigned gen = old / nloc;
        if (old + 1u == (gen + 1u) * nloc) {
            __builtin_amdgcn_fence(__ATOMIC_RELEASE, "agent");
            asm volatile("s_waitcnt vmcnt(0)" ::: "memory");
            const unsigned og = xb_add(&bar[XB_TOP], 1u);
            const unsigned tg = og / nx;
            if (og + 1u == (tg + 1u) * nx) xb_add(&bar[XB_TOPGEN], 1u);
            else XB_SPIN(xb_ld(&bar[XB_TOPGEN]) == tg, bar);
            __builtin_amdgcn_fence(__ATOMIC_ACQUIRE, "agent");
            xb_add(&bar[XB_XGEN(b.x)], 1u);
            asm volatile("s_waitcnt vmcnt(0)" ::: "memory");
        } else {
            XB_SPIN(xb_ld(&bar[XB_XGEN(b.x)]) == gen, bar);
            __builtin_amdgcn_fence(__ATOMIC_ACQUIRE, "agent");
            asm volatile("s_waitcnt vmcnt(0)" ::: "memory");
        }
    }
    __syncthreads();
}
struct Frame {
    LAS unsigned char* lds;
    volatile LAS unsigned* MISC;
    gu32* ctl;
    int tid, lane, wave;
    int vcu, G;
};
__device__ __forceinline__ float wave_sum(float v) { return wave_sum_(v); }
__device__ __forceinline__ void tr_item(const float* W, int ldw, int k0, int n0, bf16* dst, int dpitch, float scale, LAS float* scr, int lane) {
#pragma unroll 8
    for (int i = 0; i < 32; ++i) { const int kk = 2 * i + (lane >> 5); scr[kk * 33 + (lane & 31)] = W[(size_t)(k0 + kk) * ldw + n0 + (lane & 31)]; }
    LDS_WAIT(); asm volatile("" ::: "memory");
    const int c = lane & 7;
#pragma unroll
    for (int j = 0; j < 4; ++j) { const int n = (lane >> 3) + 8 * j; const LAS float* s = scr + (8 * c) * 33 + n;
        v4u o; o.x = pk2(s[0 * 33] * scale, s[1 * 33] * scale); o.y = pk2(s[2 * 33] * scale, s[3 * 33] * scale); o.z = pk2(s[4 * 33] * scale, s[5 * 33] * scale); o.w = pk2(s[6 * 33] * scale, s[7 * 33] * scale);
        *(GAS v4u*)(dst + (size_t)n * dpitch + 8 * c) = o; }
    LDS_WAIT(); asm volatile("" ::: "memory");
}
__device__ __forceinline__ void rms_row_to_bf16(const float* xrow, const float* g, bf16* orow, int lane) {
    const GAS f32x4* xr = (const GAS f32x4*)xrow + lane;
    f32x4 v[8]; float s = 0.f;
#pragma unroll
    for (int j = 0; j < 8; ++j) { v[j] = xr[64 * j]; s += (v[j].x * v[j].x + v[j].y * v[j].y) + (v[j].z * v[j].z + v[j].w * v[j].w); }
    const float rstd = rsqrtf(wave_sum(s) * (1.f / DM) + EPS);
    GAS v2u* o8 = (GAS v2u*)orow + lane;
#pragma unroll
    for (int j = 0; j < 8; ++j) { const f32x4 gg = *((const GAS f32x4*)g + lane + 64 * j); v2u w; w.x = pk2(v[j].x * rstd * gg.x, v[j].y * rstd * gg.y); w.y = pk2(v[j].z * rstd * gg.z, v[j].w * rstd * gg.w); o8[64 * j] = w; }
}

__device__ __forceinline__ void unpack8(const v4u w, float (&f)[8]) {
#pragma unroll
    for (int q = 0; q < 4; ++q) { f[2 * q] = pg8::bf_lo(w[q]); f[2 * q + 1] = pg8::bf_hi(w[q]); }
}
struct Args { const float* in[21]; float* out; unsigned char* ws; int ph_lo, ph_hi; };


#define x_ (args.in[0])
#define p_in (args.in[1])
#define g_attn (args.in[2])
#define w_in (args.in[3])
#define g_sb (args.in[4])
#define g_diff (args.in[5])
#define lam_q1 (args.in[6])
#define lam_k1 (args.in[7])
#define lam_q2 (args.in[8])
#define lam_k2 (args.in[9])
#define w_out (args.in[10])
#define g_moe (args.in[11])
#define w_rg (args.in[12])
#define w_re (args.in[13])
#define w_gate (args.in[14])
#define w_up (args.in[15])
#define w_down (args.in[16])
#define g_ple (args.in[17])
#define w_ple (args.in[18])
#define w_pg (args.in[19])
#define g_final (args.in[20])
#define rope ((float*)(ws + WS_ROPE))
#define wrt ((float*)(ws + WS_WRT))
#define WIN ((bf16*)(ws + WS_WIN))
#define WOUT ((bf16*)(ws + WS_WOUT))
#define WPG ((bf16*)(ws + WS_WPG))
#define WPLE ((bf16*)(ws + WS_WPLE))
#define WGU ((bf16*)(ws + WS_WGU))
#define WD ((bf16*)(ws + WS_WD))
#define LSLOT ((int*)(ws + WS_LSLOT))
#define LGATE ((float*)(ws + WS_LGATE))
#define PB ((bf16*)(ws + WS_PB))
#define A1 ((bf16*)(ws + WS_A1))
#define QKV ((bf16*)(ws + WS_QKV))
#define HB ((bf16*)(ws + WS_H))
#define YB ((bf16*)(ws + WS_Y))
#define UB ((bf16*)out)
#define H1B ((bf16*)(ws + WS_U))
#define ecnt (F.ctl + CW_CNT)
__global__ void __launch_bounds__(NWAVES * 64, 2) mega_fwd(Args args) {
    extern __shared__ __attribute__((aligned(16))) unsigned char lds[];
    Frame F;
    F.lds = (LAS unsigned char*)lds;
    F.MISC = (volatile LAS unsigned*)(F.lds + MISC_OFF);
    F.tid = threadIdx.x; F.lane = F.tid & 63; F.wave = __builtin_amdgcn_readfirstlane(F.tid >> 6);
    F.G = gridDim.x; { const int bx = blockIdx.x; F.vcu = (F.G % 8 == 0) ? (bx % 8) * (F.G / 8) + bx / 8 : bx; }
    unsigned char* ws = args.ws;
    F.ctl = (gu32*)(ws + WS_CTL);
    float* const out = args.out;
    for (int u = F.tid; u < (LDS_BYTES - LDSCTL_OFF) / 4; u += NWAVES * 64) ((LAS unsigned*)(F.lds + LDSCTL_OFF))[u] = 0u;
    __syncthreads();
    XcdBarrier bar = xcd_barrier_post((unsigned*)(F.ctl + CW_BAR), F.MISC + 8, F.tid == 0);
    const int lo = args.ph_lo, hi = args.ph_hi;
#ifndef PROBE_DBL
#define PROBE_DBL -1
#endif
#define REPS(k) _Pragma("unroll 1") for (int rep_ = 0; rep_ < ((PROBE_DBL == (k)) ? 2 : 1); ++rep_)
#ifndef PH_MASK
#define PH_MASK 0x7ff
#endif
#define IN(k) ((((PH_MASK) >> (k)) & 1) && lo <= (k) && (k) < hi)
#define SEAM(k) do { if (IN(k) && IN((k) + 1)) xcd_barrier(bar, F.wave); } while (0)
#define PHASE_LANE() do { FRESH_LANE(pl_); F.lane = pl_; F.tid = F.wave * 64 + pl_; } while (0)
    const int gw = F.vcu * NWAVES + F.wave, NGW = F.G * NWAVES;
    LAS int* tstart = (LAS int*)(F.lds + TST_OFF); LAS int* lcnt = (LAS int*)(F.lds + CNT_OFF);

    if (IN(0)) REPS(0) {
        PHASE_LANE();
        LAS float* scr = (LAS float*)(F.lds + RING_OFF + F.wave * 16384);
        constexpr int I_IN = 32 * 192, I_OUT = 32 * 64, I_PG = 32 * 64, I_PLE = 4 * 64, I_G = 32 * 32 * 16, I_U = I_G, I_D = 32 * 8 * 64;
        constexpr int NITEMS = I_IN + I_OUT + I_PG + I_PLE + I_G + I_U + I_D;
        for (int it = gw; it < NITEMS; it += NGW) {
            int r = it;
            if (r < I_IN) { const int kb = r / 192, nb = r % 192, n0 = 32 * nb, k0 = 64 * kb; const float sc = (n0 < 1024) ? QSCALE_SB : ((n0 >= 3072 && n0 < 4096) ? QSCALE_DF : 1.f);
                tr_item(w_in, QKVC, k0, n0, WIN + (size_t)n0 * LDW + k0, LDW, sc, scr, F.lane); continue; } r -= I_IN;
            if (r < I_OUT) { const int kb = r / 64, nb = r % 64; tr_item(w_out, DM, 64 * kb, 32 * nb, WOUT + (size_t)(32 * nb) * LDW + 64 * kb, LDW, 1.f, scr, F.lane); continue; } r -= I_OUT;
            if (r < I_PG) { const int kb = r / 64, nb = r % 64; tr_item(w_pg, DM, 64 * kb, 32 * nb, WPG + (size_t)(32 * nb) * LDW + 64 * kb, LDW, 1.f, scr, F.lane); continue; } r -= I_PG;
            if (r < I_PLE) { const int kb = r / 64, nb = r % 64; tr_item(w_ple, DM, 64 * kb, 32 * nb, WPLE + (size_t)(32 * nb) * LDP + 64 * kb, LDP, 1.f, scr, F.lane); continue; } r -= I_PLE;
            if (r < I_G + I_U) { const bool isu = r >= I_G; if (isu) r -= I_G; const int e = r / 512, q = r % 512, kb = q / 16, nb = q % 16, n0 = 32 * nb, k0 = 64 * kb;
                const int drow = e * 1024 + (n0 >> 7) * 256 + (isu ? 128 : 0) + (n0 & 127);
                tr_item((isu ? w_up : w_gate) + (size_t)e * DM * DEXP, DEXP, k0, n0, WGU + (size_t)drow * LDW + k0, LDW, 1.f, scr, F.lane); continue; } r -= I_G + I_U;
            { const int e = r / 512, q = r % 512, kb = q / 64, nb = q % 64, n0 = 32 * nb, k0 = 64 * kb;
                tr_item(w_down + (size_t)e * DEXP * DM, DM, k0, n0, WD + ((size_t)e * DM + n0) * LDH + k0, LDH, 1.f, scr, F.lane); }
        }
        for (int i = gw * 64 + F.lane; i < SEQ * 8; i += NGW * 64) { const int pos = i >> 3, k = i & 7;
            const float inv = exp2f(-(float)k * (18.931568569324174f / 8.f));
            const float ang = (float)pos * inv;
            const double rev = (double)ang * 0.15915494309189535; const float fr = (float)(rev - floor(rev));
            rope[pos * 16 + k] = __builtin_amdgcn_cosf(fr); rope[pos * 16 + 8 + k] = __builtin_amdgcn_sinf(fr); }
        for (int i = gw * 64 + F.lane; i < 36 * DM; i += NGW * 64) { const int c = i / DM, k = i % DM; wrt[i] = (c < 4) ? w_rg[k * 4 + c] : w_re[k * 32 + (c - 4)]; }
        for (size_t i = (size_t)gw * 64 + F.lane; i < (size_t)NTOK * PLED / 4; i += (size_t)NGW * 64) { const f32x4 v = *((const GAS f32x4*)p_in + i); v2u w; w.x = pk2(v.x, v.y); w.y = pk2(v.z, v.w);
            const size_t row = i >> 6, c4 = i & 63; *((GAS v2u*)(PB + row * LDP) + c4) = w; }
        for (int m = gw; m < NTOK; m += NGW) rms_row_to_bf16(x_ + (size_t)m * DM, g_attn, A1 + (size_t)m * LDA1, F.lane);
    }
    SEAM(0);
    if (IN(1)) REPS(1) {
        pg8::Gemm g{A1, WIN, NTOK, QKVC, DM, nullptr, LDA1, LDW}; pg8::StaticOrder S; S.init(NTOK, QKVC, F.G, (int)blockIdx.x);
#if PROBE_DBL == 1 && defined(PROBE_FIXED)
        S.fixed = rep_;
#endif
        pg8::EpiQKV E{QKV, rope};
        pg8::gemm_phase<pg8::EpiQKV, pg8::StaticOrder, true, true>(F.lds + RING_OFF, g, S, E, F.wave);
    }
    SEAM(1);
    if (IN(2)) {
        PHASE_LANE();
        float lam;
        { float a = (F.lane < 64) ? lam_q1[F.lane] * lam_k1[F.lane] : 0.f, b2 = lam_q2[F.lane] * lam_k2[F.lane]; a = wave_sum(a); b2 = wave_sum(b2); lam = expf(a) - expf(b2) + 0.2f; }
#ifndef NO_DIFF
        REPS(20) for (int L = F.vcu; L < 1024; L += F.G) { const int bh = L >> 5, pr = L & 31;
#pragma unroll 1
            for (int s2 = 0; s2 < 2; ++s2) att::diff_unit2(bh >> 3, bh & 7, s2 ? pr : 63 - pr, QKV, A1, g_diff, lam, 0.8f, (char*)lds + RING_OFF, F.wave); }
#endif
        __syncthreads();
#ifndef NO_SB
        REPS(21) for (int uid = gw; uid < 8192; uid += NGW) { const int bh = uid >> 8, wq = uid & 255;
            att::sb_wave_unit(bh >> 3, bh & 7, wq, QKV, A1, g_sb, (char*)lds + RING_OFF + F.wave * 16384); }
#endif
    }
    SEAM(2);
    if (IN(3)) REPS(3) {
#ifndef NO_P3A
        { pg8::Gemm g{A1, WOUT, NTOK, DM, DM, nullptr, LDA1, LDW}; pg8::StaticOrder S; S.init(NTOK, DM, F.G, (int)blockIdx.x);
          pg8::EpiResBf16 E{x_, H1B};
          pg8::gemm_phase<pg8::EpiResBf16, pg8::StaticOrder, true, true>(F.lds + RING_OFF, g, S, E, F.wave); }
#endif
#ifndef NO_P3B
        { pg8::Gemm g{PB, WPLE, NTOK, DM, PLED, nullptr, LDP, LDP}; pg8::StaticOrder S; S.init(NTOK, DM, F.G, (int)blockIdx.x);
          pg8::EpiBf16 E{UB, DM};
          pg8::gemm_phase<pg8::EpiBf16, pg8::StaticOrder, true, true>(F.lds + RING_OFF, g, S, E, F.wave); }
#endif
    }
    SEAM(3);
    if (IN(4)) {
        PHASE_LANE();
        LAS int* sel_e = (LAS int*)(F.lds + RING_OFF); LAS float* sel_g = (LAS float*)(F.lds + RING_OFF + 1024); LAS int* lhist = (LAS int*)(F.lds + RING_OFF + 2048); LAS int* lbase = (LAS int*)(F.lds + RING_OFF + 2176);
        LAS int* lrk = (LAS int*)(F.lds + RING_OFF + 2304);
        for (int chunk = blockIdx.x; chunk < NTOK / 128; chunk += F.G) {
            if (F.tid < 32) lhist[F.tid] = 0;
            for (int g4 = 0; g4 < 4; ++g4) {
                const int row0 = chunk * 128 + F.wave * 16 + g4 * 4;
                float v[4][4][8]; float rstd[4];
#pragma unroll
                for (int r = 0; r < 4; ++r) { const GAS v4u* xr = (const GAS v4u*)(H1B + (size_t)(row0 + r) * DM) + F.lane; float s = 0.f;
#pragma unroll
                    for (int j = 0; j < 4; ++j) { unpack8(xr[64 * j], v[r][j]);
#pragma unroll
                        for (int i = 0; i < 8; ++i) s += v[r][j][i] * v[r][j][i]; }
                    rstd[r] = rsqrtf(wave_sum(s) * (1.f / DM) + EPS); }
#pragma unroll
                for (int j = 0; j < 4; ++j) { const f32x4 g0 = *((const GAS f32x4*)g_moe + 2 * F.lane + 128 * j), g1 = *((const GAS f32x4*)g_moe + 2 * F.lane + 128 * j + 1);
#pragma unroll
                    for (int r = 0; r < 4; ++r) {
#pragma unroll
                        for (int i = 0; i < 4; ++i) { v[r][j][i] *= rstd[r] * g0[i]; v[r][j][4 + i] *= rstd[r] * g1[i]; }
                        v4u w; w.x = pk2(v[r][j][0], v[r][j][1]); w.y = pk2(v[r][j][2], v[r][j][3]); w.z = pk2(v[r][j][4], v[r][j][5]); w.w = pk2(v[r][j][6], v[r][j][7]);
                        *((GAS v4u*)(A1 + (size_t)(row0 + r) * LDA1) + F.lane + 64 * j) = w; } }
                float lg[4] = {0.f, 0.f, 0.f, 0.f};
#pragma unroll 1
                for (int c = 0; c < 36; ++c) { const GAS f32x4* wc = (const GAS f32x4*)(wrt + (size_t)c * DM) + 2 * F.lane;
                    float pa[4] = {0.f, 0.f, 0.f, 0.f};
#pragma unroll
                    for (int j = 0; j < 4; ++j) { const f32x4 w0 = wc[128 * j], w1 = wc[128 * j + 1];
#pragma unroll
                        for (int r = 0; r < 4; ++r) pa[r] += ((v[r][j][0] * w0.x + v[r][j][1] * w0.y) + (v[r][j][2] * w0.z + v[r][j][3] * w0.w)) + ((v[r][j][4] * w1.x + v[r][j][5] * w1.y) + (v[r][j][6] * w1.z + v[r][j][7] * w1.w)); }
#pragma unroll
                    for (int r = 0; r < 4; ++r) { const float t = wave_sum(pa[r]); lg[r] = (F.lane == c) ? t : lg[r]; } }
#pragma unroll
                for (int r = 0; r < 4; ++r) {
                    const float g0 = __shfl(lg[r], 0), g1 = __shfl(lg[r], 1), g2 = __shfl(lg[r], 2), g3 = __shfl(lg[r], 3);
                    int grp = 0; float gm = g0; if (g1 > gm) { gm = g1; grp = 1; } if (g2 > gm) { gm = g2; grp = 2; } if (g3 > gm) { gm = g3; grp = 3; }
                    const float psel = 1.f / (expf(g0 - gm) + expf(g1 - gm) + expf(g2 - gm) + expf(g3 - gm));
                    float ev[8];
#pragma unroll
                    for (int i = 0; i < 8; ++i) ev[i] = __shfl(lg[r], 4 + grp * 8 + i);
                    int i0 = 0; float v0 = ev[0];
#pragma unroll
                    for (int i = 1; i < 8; ++i) if (ev[i] > v0) { v0 = ev[i]; i0 = i; }
                    int i1 = -1; float v1 = 0.f;
#pragma unroll
                    for (int i = 0; i < 8; ++i) if (i != i0 && (i1 < 0 || ev[i] > v1)) { v1 = ev[i]; i1 = i; }
                    const float ga = 1.f / (1.f + expf(v1 - v0)), gb = 1.f - ga;
                    if (F.lane == 0) { const int rl = F.wave * 16 + g4 * 4 + r; sel_e[rl * 2] = grp * 8 + i0; sel_e[rl * 2 + 1] = grp * 8 + i1; sel_g[rl * 2] = ga * psel; sel_g[rl * 2 + 1] = gb * psel; }
                }
            }
            __syncthreads();
            FRESH_LANE(l4_); const int t4 = F.wave * 64 + l4_;
            int my_e = 0, my_rk = 0;
            if (t4 < 256) { my_e = sel_e[t4]; my_rk = atomicAdd((int*)(lhist + my_e), 1); }
            __syncthreads();
            if (t4 < 32) { const int n = lhist[t4]; lbase[t4] = n ? (int)__hip_atomic_fetch_add(ecnt + 64 * t4, (unsigned)n, RLX_AGENT) : 0; }
            __syncthreads();
            if (t4 < 256) { const int pos = lbase[my_e] + my_rk; LSLOT[(size_t)my_e * LCAP + pos] = (chunk * 128 + (t4 >> 1)) * 2 + (t4 & 1); LGATE[(size_t)my_e * LCAP + pos] = sel_g[t4]; }
            __syncthreads();
        }
        (void)lrk;
    }
    SEAM(4);
    if (IN(6) || IN(7)) {
        PHASE_LANE();
        if (F.tid < 32) lcnt[F.tid] = (int)__hip_atomic_load(ecnt + 64 * F.tid, RLX_AGENT);
        __syncthreads();
        if (F.tid == 0) { int acc = 0; for (int e = 0; e < 32; ++e) { tstart[e] = acc; acc += (lcnt[e] + 255) >> 8; } tstart[32] = acc; }
        __syncthreads();
    }
    const int NTILES = (IN(6) || IN(7)) ? __builtin_amdgcn_readfirstlane(tstart[32]) : 0;
    if (IN(6)) REPS(6) {
        pg8::Gemm g{A1, WGU, NTILES * 256, 1024, DM, LSLOT, LDA1, LDW}; pg8::MoeOrder S; S.init(NTILES, 4, F.G, (int)blockIdx.x, tstart, lcnt);
        pg8::EpiSwiglu E{HB};
        pg8::gemm_phase<pg8::EpiSwiglu, pg8::MoeOrder, true, true, true>(F.lds + RING_OFF, g, S, E, F.wave);
    }
    SEAM(6);
    if (IN(7)) REPS(7) {
        pg8::Gemm g{HB, WD, NTILES * 256, DM, DEXP, nullptr, LDH, LDH}; pg8::MoeOrder S; S.init(NTILES, 8, F.G, (int)blockIdx.x, tstart, lcnt);
        pg8::EpiScatter E{YB, LSLOT, LGATE};
        pg8::gemm_phase<pg8::EpiScatter, pg8::MoeOrder, true, true>(F.lds + RING_OFF, g, S, E, F.wave);
    }
    SEAM(7);
    if (IN(8)) {
        PHASE_LANE();
        for (int m = gw; m < NTOK; m += NGW) {
            const GAS v4u* hr = (const GAS v4u*)(H1B + (size_t)m * DM) + F.lane; const GAS v4u* y0 = (const GAS v4u*)(YB + (size_t)(2 * m) * DM) + F.lane; const GAS v4u* y1 = (const GAS v4u*)(YB + (size_t)(2 * m + 1) * DM) + F.lane;
            float v[4][8]; float s = 0.f;
#pragma unroll
            for (int j = 0; j < 4; ++j) { float a[8], b[8]; unpack8(hr[64 * j], v[j]); unpack8(y0[64 * j], a); unpack8(y1[64 * j], b);
#pragma unroll
                for (int i = 0; i < 8; ++i) { v[j][i] += a[i] + b[i]; s += v[j][i] * v[j][i]; } }
            const float rstd = rsqrtf(wave_sum(s) * (1.f / DM) + EPS);
            GAS v4u* o8 = (GAS v4u*)(A1 + (size_t)m * LDA1) + F.lane;
#pragma unroll
            for (int j = 0; j < 4; ++j) { const f32x4 g0 = *((const GAS f32x4*)g_ple + 2 * F.lane + 128 * j), g1 = *((const GAS f32x4*)g_ple + 2 * F.lane + 128 * j + 1);
                v4u w; w.x = pk2(v[j][0] * rstd * g0.x, v[j][1] * rstd * g0.y); w.y = pk2(v[j][2] * rstd * g0.z, v[j][3] * rstd * g0.w); w.z = pk2(v[j][4] * rstd * g1.x, v[j][5] * rstd * g1.y); w.w = pk2(v[j][6] * rstd * g1.z, v[j][7] * rstd * g1.w);
                o8[64 * j] = w; }
        }
    }
    SEAM(8);
    if (IN(9)) {
        pg8::Gemm g{A1, WPG, NTOK, DM, DM, nullptr, LDA1, LDW}; pg8::StaticOrder S; S.init(NTOK, DM, F.G, (int)blockIdx.x);
        pg8::EpiPle2 E{H1B, YB, UB};
        pg8::gemm_phase<pg8::EpiPle2, pg8::StaticOrder, true, true>(F.lds + RING_OFF, g, S, E, F.wave);
    }
    SEAM(9);
    if (IN(10)) {
        PHASE_LANE();
        for (int m = gw; m < NTOK; m += NGW) {
            const GAS v4u* hr = (const GAS v4u*)(H1B + (size_t)m * DM) + F.lane; float v[4][8]; float s = 0.f;
#pragma unroll
            for (int j = 0; j < 4; ++j) { unpack8(hr[64 * j], v[j]);
#pragma unroll
                for (int i = 0; i < 8; ++i) s += v[j][i] * v[j][i]; }
            const float rstd = rsqrtf(wave_sum(s) * (1.f / DM) + EPS);
            GAS f32x4* orow = (GAS f32x4*)(out + (size_t)m * DM) + 2 * F.lane;
#pragma unroll
            for (int j = 0; j < 4; ++j) { const f32x4 g0 = *((const GAS f32x4*)g_final + 2 * F.lane + 128 * j), g1 = *((const GAS f32x4*)g_final + 2 * F.lane + 128 * j + 1);
                orow[128 * j] = (f32x4){v[j][0] * rstd * g0.x, v[j][1] * rstd * g0.y, v[j][2] * rstd * g0.z, v[j][3] * rstd * g0.w};
                orow[128 * j + 1] = (f32x4){v[j][4] * rstd * g1.x, v[j][5] * rstd * g1.y, v[j][6] * rstd * g1.z, v[j][7] * rstd * g1.w}; }
        }
    }
#undef IN
#undef SEAM
}

#ifndef MK_SPLIT
#define MK_SPLIT 0
#endif
extern "C" void kernel_launch(void* const* d_in, const int* in_sizes, int n_in, void* d_out, int out_size, void* d_ws, size_t ws_size, hipStream_t stream) {
    static int grid = 0;
    if (grid == 0) {
        if (n_in != 21 || in_sizes[0] != NTOK * DM || out_size != NTOK * DM || ws_size < WS_END) { fprintf(stderr, "kernel_launch: shape mismatch (n_in %d in0 %d out %d ws %zu)\n", n_in, n_in > 0 ? in_sizes[0] : -1, out_size, ws_size); grid = -1; return; }
        int dev = 0, cus = 0, per_cu = 0;
        if (hipGetDevice(&dev) != hipSuccess || hipDeviceGetAttribute(&cus, hipDeviceAttributeMultiprocessorCount, dev) != hipSuccess) { grid = -1; return; }
        if (hipFuncSetAttribute((const void*)mega_fwd, hipFuncAttributeMaxDynamicSharedMemorySize, LDS_BYTES) != hipSuccess) { fprintf(stderr, "kernel_launch: hipFuncSetAttribute failed\n"); grid = -1; return; }
        if (hipOccupancyMaxActiveBlocksPerMultiprocessor(&per_cu, (const void*)mega_fwd, NWAVES * 64, LDS_BYTES) != hipSuccess || per_cu < 1) fprintf(stderr, "kernel_launch: occupancy query reports %d\n", per_cu);
        (void)hipGetLastError();
        grid = cus;
    }
    if (grid < 0) return;
    if (hipMemsetAsync((char*)d_ws + WS_CTL, 0, CTL_ZERO_BYTES, stream) != hipSuccess) return;
    Args a{};
    for (int i = 0; i < 21; ++i) a.in[i] = (const float*)d_in[i];
    a.out = (float*)d_out; a.ws = (unsigned char*)d_ws;
#if MK_SPLIT
    for (int ph = 0; ph < 11; ++ph) { a.ph_lo = ph; a.ph_hi = ph + 1; hipLaunchKernelGGL(mega_fwd, dim3(grid), dim3(NWAVES * 64), LDS_BYTES, stream, a); }
#else
    a.ph_lo = 0; a.ph_hi = 11;
    hipLaunchKernelGGL(mega_fwd, dim3(grid), dim3(NWAVES * 64), LDS_BYTES, stream, a);
#endif
    const hipError_t le = hipPeekAtLastError();
    if (le != hipSuccess) fprintf(stderr, "kernel_launch: launch failed: %s\n", hipGetErrorName(le));
}
```

```cpp
#include <hip/hip_runtime.h>
#include <hip/hip_bf16.h>
#include <cstdio>
#include <cstdint>
#define FRESH_LANE(v) int v; asm volatile("v_mbcnt_lo_u32_b32 %0, -1, 0\n\tv_mbcnt_hi_u32_b32 %0, -1, %0" : "=v"(v))
template <int M> __device__ __forceinline__ float swz_xor(float v) { return __int_as_float(__builtin_amdgcn_ds_swizzle(__float_as_int(v), 0x1f | (M << 10))); }
__device__ __forceinline__ float half_sum32_(float v) { v += swz_xor<1>(v); v += swz_xor<2>(v); v += swz_xor<4>(v); v += swz_xor<8>(v); v += swz_xor<16>(v); return v; }
__device__ __forceinline__ float wave_sum_(float v) { v = half_sum32_(v); auto rr = __builtin_amdgcn_permlane32_swap(__float_as_uint(v), __float_as_uint(v), false, false); return __uint_as_float(rr[0]) + __uint_as_float(rr[1]); }
namespace pg8 {
#define PG8_LAS __attribute__((address_space(3)))
typedef unsigned short bf16_t;
typedef short bf16x8 __attribute__((ext_vector_type(8)));
typedef float f32x4 __attribute__((ext_vector_type(4)));
typedef unsigned u32x4 __attribute__((ext_vector_type(4)));
constexpr int BM = 256, BK = 64, HALF = 128, HTB = HALF * BK * 2  , STAGE_BYTES = 8 * HTB, NXCD = 8, WGM = 4;

__host__ __device__ __forceinline__ int lds_byte(int r, int c) { const int st = (r >> 4) * 2 + (c >> 5), rr = r & 15, cc = c & 31, ob = rr * 64 + cc * 2; return st * 1024 + (ob ^ (((ob >> 9) & 1) << 5)); }
__host__ __device__ __forceinline__ void stage_rc(int b, int& R, int& C) { const int st = b / 1024, sb = b % 1024, swz = sb ^ (((sb >> 9) & 1) << 5); R = (st >> 1) * 16 + swz / 64; C = (st & 1) * 32 + (swz % 64) / 2; }
__host__ __device__ __forceinline__ int perm32(int rho) { const int n = rho >> 4, i = rho & 15; return 8 * (i >> 2) + 4 * n + (i & 3); }

struct Unit { int pm, pn, pb, aux0, aux1; };
struct Gemm { const bf16_t* A; const bf16_t* Bt; int M, N, K; const int* glist; int lda, ldb; };

struct StaticOrder {
    int nM, nN, nwg, G, c, fixed;
    __host__ __device__ void init(int M, int N, int G_, int c_) { nM = M / BM; nN = N / BM; nwg = nM * nN; G = G_; c = c_; fixed = 0; }
    __host__ __device__ bool next(int i, Unit& u) const {
        const long L = (long)i * G + c; if (L >= nwg) return false;
        int wgid = (int)L; { const int q = nwg / NXCD, r = nwg % NXCD, xcd = wgid % NXCD, off = wgid / NXCD; wgid = (xcd < r ? xcd * (q + 1) : r * (q + 1) + (xcd - r) * q) + off; }
        const int nig = WGM * nN, gid = wgid / nig, fm = gid * WGM, gsz = (nM - fm) < WGM ? (nM - fm) : WGM;
        u.pm = fm + ((wgid % nig) % gsz); u.pn = (wgid % nig) / gsz; if (fixed) { u.pm = 0; u.pn = 0; } u.pb = u.pn; u.aux0 = 0; u.aux1 = 0; return true;
    }
    __device__ __forceinline__ void a_ready(const Unit&) const {}
    __device__ __forceinline__ void done(const Unit&) const {}
};

struct BalancedOrder {
    int nM, nN, nwg, G, c, rem, E, K1;
    __host__ __device__ void init(int M, int N, int G_, int c_, int rem_) { nM = M / BM; nN = N / BM; nwg = nM * nN; G = G_; c = c_; rem = rem_; E = G_ - rem_; K1 = (nwg + E - 1) / E; if (K1 > KMAX) K1 = KMAX; }
    static constexpr int KMAX = 6;
    __host__ __device__ bool next(int i, Unit& u) const {
        long L;
        if (c >= rem) L = i < K1 ? (long)i * E + (c - rem) : (long)K1 * E + (long)(i - K1) * G + c;
        else L = (long)K1 * E + (long)i * G + c;
        if (L >= nwg) return false;
        int wgid = (int)L; { const int q = nwg / NXCD, r = nwg % NXCD, xcd = wgid % NXCD, off = wgid / NXCD; wgid = (xcd < r ? xcd * (q + 1) : r * (q + 1) + (xcd - r) * q) + off; }
        const int nig = WGM * nN, gid = wgid / nig, fm = gid * WGM, gsz = (nM - fm) < WGM ? (nM - fm) : WGM;
        u.pm = fm + ((wgid % nig) % gsz); u.pn = (wgid % nig) / gsz; u.pb = u.pn; u.aux0 = 0; u.aux1 = 0; return true;
    }
    __device__ __forceinline__ void a_ready(const Unit&) const {}
    __device__ __forceinline__ void done(const Unit&) const {}
};

__device__ __forceinline__ unsigned cvt_pk_bf16(float lo, float hi) { unsigned r; asm volatile("v_cvt_pk_bf16_f32 %0, %1, %2" : "=v"(r) : "v"(lo), "v"(hi)); return r; }
typedef float f32x2 __attribute__((ext_vector_type(2)));
#define PG8_FRESH_LANE(fr, fq) int l__; asm volatile("v_mbcnt_lo_u32_b32 %0, -1, 0\n\tv_mbcnt_hi_u32_b32 %0, -1, %0" : "=v"(l__)); const int fr = l__ & 15, fq = l__ >> 4; (void)fr_; (void)fq_
typedef unsigned u32x2 __attribute__((ext_vector_type(2)));
__device__ __forceinline__ float bf_lo(unsigned w) { return __uint_as_float(w << 16); }
__device__ __forceinline__ float bf_hi(unsigned w) { return __uint_as_float(w & 0xffff0000u); }

__device__ __forceinline__ void sp_store_group(bf16_t* sp, int rowg, const u32x4& w0, const u32x4& w1, PG8_LAS unsigned char* sw, int fr, int fq) {
    const int lane = fq * 16 + fr;
    const int wofs0 = fr * 128 + ((fq ^ (fr & 7)) << 4), wofs1 = fr * 128 + (((fq + 4) ^ (fr & 7)) << 4);
    const int rofs0 = (lane >> 3) * 128 + (((lane & 7) ^ ((lane >> 3) & 7)) << 4), rofs1 = rofs0 + 1024;
    *(PG8_LAS u32x4*)(sw + wofs0) = w0; *(PG8_LAS u32x4*)(sw + wofs1) = w1;
    asm volatile("s_waitcnt lgkmcnt(0)" ::: "memory");
    const u32x4 o0 = *(const PG8_LAS u32x4*)(sw + rofs0), o1 = *(const PG8_LAS u32x4*)(sw + rofs1);
    bf16_t* gp = sp + (size_t)rowg * 64 + lane * 8;
    *(u32x4*)gp = o0; *(u32x4*)(gp + 512) = o1;
    asm volatile("" ::: "memory");
}
constexpr size_t SPS = (size_t)32768 * 64;
struct EpiQKV {
    static constexpr bool PERM = true, AFTER_DRAIN = false; static constexpr int NST = 16;
    bf16_t* O; PG8_LAS unsigned char* scr; int skip; float* kmax2;
    __device__ __forceinline__ void operator()(const f32x4 (&acc)[2][2][4][2], const Unit& u, int wr, int wc, int fr_, int fq_) const {
#ifdef PROBE_NOEPI
        if (skip == 1) return;
#endif
        PG8_FRESH_LANE(fr, fq);
        const int lane = fq * 16 + fr;
        const bool rot = (u.pn >= 12) && (u.pn < 20), kd = (u.pn >= 16) && (u.pn < 20);
        constexpr float RV[8] = {0.15915494309189535f, 0.03086376340470123f, 0.005985185712713705f, 0.001160663641240061f, 0.00022507907903927653f, 4.364795279280289e-05f, 8.464330808241401e-06f, 1.6414262627950345e-06f};
        const float sgn = (fq == 0) ? -1.f : ((fq == 1) ? 1.f : 0.f);
        PG8_LAS unsigned char* sw = scr + (wr * 4 + wc) * 2048;
        const int wofs0 = fr * 128 + ((fq ^ (fr & 7)) << 4), wofs1 = fr * 128 + (((fq + 4) ^ (fr & 7)) << 4);
        const int rofs0 = (lane >> 3) * 128 + (((lane & 7) ^ ((lane >> 3) & 7)) << 4), rofs1 = rofs0 + 1024;
        bf16_t* sp = O + (size_t)(u.pn * 4 + wc) * ((size_t)32768 * 64);
#pragma unroll
        for (int ai = 0; ai < 2; ++ai) { float gmax = 0.f;
#pragma unroll
            for (int m = 0; m < 4; ++m) { const int rowg = u.pm * BM + ai * HALF + wr * 64 + m * 16, row = rowg + fr; u32x4 w[2]; float nrm = 0.f;
#pragma unroll
                for (int bj = 0; bj < 2; ++bj) { f32x4 v0 = acc[ai][bj][m][0], v1 = acc[ai][bj][m][1];
                    if (rot && bj == 0) { const float pos = (float)(row & 8191); f32x4 p0, p1;
#pragma unroll
                        for (int j = 0; j < 4; ++j) { p0[j] = swz_xor<16>(v0[j]); p1[j] = swz_xor<16>(v1[j]); }
#pragma unroll
                        for (int j = 0; j < 4; ++j) { const float f0 = __builtin_amdgcn_fractf(pos * RV[j]), f1 = __builtin_amdgcn_fractf(pos * RV[4 + j]);
                            const float c0 = (sgn != 0.f) ? __builtin_amdgcn_cosf(f0) : 1.f, s0 = sgn * __builtin_amdgcn_sinf(f0), c1 = (sgn != 0.f) ? __builtin_amdgcn_cosf(f1) : 1.f, s1 = sgn * __builtin_amdgcn_sinf(f1);
                            v0[j] = v0[j] * c0 + p0[j] * s0; v1[j] = v1[j] * c1 + p1[j] * s1; } }
                    if (kd) nrm += ((v0[0] * v0[0] + v0[1] * v0[1]) + (v0[2] * v0[2] + v0[3] * v0[3])) + ((v1[0] * v1[0] + v1[1] * v1[1]) + (v1[2] * v1[2] + v1[3] * v1[3]));
                    w[bj].x = cvt_pk_bf16(v0[0], v0[1]); w[bj].y = cvt_pk_bf16(v0[2], v0[3]); w[bj].z = cvt_pk_bf16(v1[0], v1[1]); w[bj].w = cvt_pk_bf16(v1[2], v1[3]); }
                gmax = __builtin_fmaxf(gmax, nrm);
#ifdef QKV_DIRECT
                { bf16_t* gp = sp + (size_t)row * 64 + fq * 8; *(u32x4*)gp = w[0]; *(u32x4*)(gp + 32) = w[1]; (void)sw; (void)wofs0; (void)wofs1; (void)rofs0; (void)rofs1; }
                asm volatile("" ::: "memory"); }
#else
                *(PG8_LAS u32x4*)(sw + wofs0) = w[0]; *(PG8_LAS u32x4*)(sw + wofs1) = w[1];
                asm volatile("s_waitcnt lgkmcnt(0)" ::: "memory");
                const u32x4 o0 = *(const PG8_LAS u32x4*)(sw + rofs0), o1 = *(const PG8_LAS u32x4*)(sw + rofs1);
                bf16_t* gp = sp + (size_t)rowg * 64 + lane * 8;
#ifdef PROBE_NOEPI
                if (skip == 2) { asm volatile("" :: "v"(o0), "v"(o1)); } else
#endif
                { *(u32x4*)gp = o0; *(u32x4*)(gp + 512) = o1; }
                asm volatile("" ::: "memory"); }
#endif
            if (kd) {
                gmax += swz_xor<16>(gmax); { auto rr = __builtin_amdgcn_permlane32_swap(__float_as_uint(gmax), __float_as_uint(gmax), false, false); gmax = __uint_as_float(rr[0]) + __uint_as_float(rr[1]); }
                gmax = __builtin_fmaxf(gmax, swz_xor<1>(gmax)); gmax = __builtin_fmaxf(gmax, swz_xor<2>(gmax)); gmax = __builtin_fmaxf(gmax, swz_xor<4>(gmax)); gmax = __builtin_fmaxf(gmax, swz_xor<8>(gmax));
                const int row0 = u.pm * BM + ai * HALF + wr * 64;
                if (lane == 0) kmax2[(size_t)(((row0 >> 13) * 16 + (u.pn - 16) * 4 + wc) * 128 + ((row0 & 8191) >> 6))] = gmax * 1.02f; } }
        (void)skip;
    }
};
struct EpiBf16 {
    static constexpr bool PERM = true, AFTER_DRAIN = false; static constexpr int NST = 16;
    bf16_t* O; PG8_LAS unsigned char* scr;
    __device__ __forceinline__ void operator()(const f32x4 (&acc)[2][2][4][2], const Unit& u, int wr, int wc, int fr_, int fq_) const {
        PG8_FRESH_LANE(fr, fq);
        PG8_LAS unsigned char* sw = scr + (wr * 4 + wc) * 2048; bf16_t* sp = O + (size_t)(u.pn * 4 + wc) * SPS;
#pragma unroll
        for (int ai = 0; ai < 2; ++ai)
#pragma unroll
            for (int m = 0; m < 4; ++m) { u32x4 w[2];
#pragma unroll
                for (int bj = 0; bj < 2; ++bj) { const f32x4 v0 = acc[ai][bj][m][0], v1 = acc[ai][bj][m][1];
                    w[bj].x = cvt_pk_bf16(v0[0], v0[1]); w[bj].y = cvt_pk_bf16(v0[2], v0[3]); w[bj].z = cvt_pk_bf16(v1[0], v1[1]); w[bj].w = cvt_pk_bf16(v1[2], v1[3]); }
                sp_store_group(sp, u.pm * BM + ai * HALF + wr * 64 + m * 16, w[0], w[1], sw, fr, fq); }
    }
};
struct EpiResBf16 {
    static constexpr bool PERM = true, AFTER_DRAIN = false; static constexpr int NST = 16;
    const float* base; bf16_t* O;
    __device__ __forceinline__ void operator()(const f32x4 (&acc)[2][2][4][2], const Unit& u, int wr, int wc, int fr_, int fq_) const {
        PG8_FRESH_LANE(fr, fq);
        const int row0 = u.pm * BM + wr * 64 + fr, col0 = u.pn * BM + wc * 64 + 8 * fq;
        f32x4 bv[2][4];
#define ER_LOAD(buf, it) do { const size_t off_ = (size_t)(row0 + ((it) >> 2) * HALF + ((it) & 3) * 16) * 2048 + col0; \
            bv[buf][0] = *(const f32x4*)(base + off_); bv[buf][1] = *(const f32x4*)(base + off_ + 4); bv[buf][2] = *(const f32x4*)(base + off_ + 32); bv[buf][3] = *(const f32x4*)(base + off_ + 36); } while (0)
        ER_LOAD(0, 0);
#pragma unroll
        for (int it = 0; it < 8; ++it) { const int ai = it >> 2, m = it & 3; const size_t off = (size_t)(row0 + ai * HALF + m * 16) * 2048 + col0;
            if (it + 1 < 8) { if (it & 1) ER_LOAD(0, it + 1); else ER_LOAD(1, it + 1); }
#pragma unroll
            for (int bj = 0; bj < 2; ++bj) { const f32x4 v0 = acc[ai][bj][m][0] + bv[it & 1][2 * bj], v1 = acc[ai][bj][m][1] + bv[it & 1][2 * bj + 1];
                u32x4 w; w.x = cvt_pk_bf16(v0[0], v0[1]); w.y = cvt_pk_bf16(v0[2], v0[3]); w.z = cvt_pk_bf16(v1[0], v1[1]); w.w = cvt_pk_bf16(v1[2], v1[3]);
                *(u32x4*)(O + off + bj * 32) = w; } }
#undef ER_LOAD
    }
};
struct EpiResN {
    static constexpr bool PERM = true, AFTER_DRAIN = false; static constexpr int NST = 16;
    const bf16_t* Xn; int ldx; const float* invr; bf16_t* O;
    __device__ __forceinline__ void operator()(const f32x4 (&acc)[2][2][4][2], const Unit& u, int wr, int wc, int fr_, int fq_) const {
        PG8_FRESH_LANE(fr, fq);
        const int row0 = u.pm * BM + wr * 64 + fr, col0 = u.pn * BM + wc * 64 + 8 * fq;
        float rs[8];
#pragma unroll
        for (int it = 0; it < 8; ++it) rs[it] = invr[row0 + (it >> 2) * HALF + (it & 3) * 16];
        u32x4 lv[2];
#define EN_LOAD(buf, k) do { const int it_ = (k) >> 1, bj_ = (k) & 1; const size_t row_ = (size_t)(row0 + (it_ >> 2) * HALF + (it_ & 3) * 16); \
            lv[buf] = *(const u32x4*)(Xn + row_ * ldx + col0 + bj_ * 32); } while (0)
        EN_LOAD(0, 0);
#pragma unroll
        for (int k = 0; k < 16; ++k) { const int it = k >> 1, bj = k & 1, ai = it >> 2, m = it & 3; const size_t row = (size_t)(row0 + ai * HALF + m * 16);
            if (k + 1 < 16) { if (k & 1) EN_LOAD(0, k + 1); else EN_LOAD(1, k + 1); }
            const u32x4 xw = lv[k & 1]; const float sc = rs[it];
            float r[8];
#pragma unroll
            for (int q = 0; q < 4; ++q) { r[2 * q] = bf_lo(xw[q]) * sc + acc[ai][bj][m][q >> 1][(q & 1) * 2]; r[2 * q + 1] = bf_hi(xw[q]) * sc + acc[ai][bj][m][q >> 1][(q & 1) * 2 + 1]; }
            u32x4 w; w.x = cvt_pk_bf16(r[0], r[1]); w.y = cvt_pk_bf16(r[2], r[3]); w.z = cvt_pk_bf16(r[4], r[5]); w.w = cvt_pk_bf16(r[6], r[7]);
            *(u32x4*)(O + row * 2048 + col0 + bj * 32) = w; }
#undef EN_LOAD
    }
};
struct EpiPle2 {
    static constexpr bool PERM = true, AFTER_DRAIN = false; static constexpr int NST = 16;
    const bf16_t* Hs; const bf16_t* U; const float* rstd; bf16_t* O3; int ld3;
    __device__ __forceinline__ void operator()(const f32x4 (&acc)[2][2][4][2], const Unit& u, int wr, int wc, int fr_, int fq_) const {
        PG8_FRESH_LANE(fr, fq);
        const int row0 = u.pm * BM + wr * 64 + fr, col0 = u.pn * BM + wc * 64 + 8 * fq;
        float rs[8];
#pragma unroll
        for (int it = 0; it < 8; ++it) rs[it] = rstd[row0 + (it >> 2) * HALF + (it & 3) * 16];
        u32x4 lv[2][2];
#define EP_LOAD(buf, k) do { const int it_ = (k) >> 1, bj_ = (k) & 1; const size_t row_ = (size_t)(row0 + (it_ >> 2) * HALF + (it_ & 3) * 16); \
            lv[buf][0] = *(const u32x4*)(Hs + row_ * 2048 + col0 + bj_ * 32); lv[buf][1] = *(const u32x4*)(U + (size_t)(u.pn * 4 + wc) * SPS + row_ * 64 + bj_ * 32 + 8 * fq); } while (0)
        EP_LOAD(0, 0);
#pragma unroll
        for (int k = 0; k < 16; ++k) { const int it = k >> 1, bj = k & 1, ai = it >> 2, m = it & 3; const size_t row = (size_t)(row0 + ai * HALF + m * 16);
            if (k + 1 < 16) { if (k & 1) EP_LOAD(0, k + 1); else EP_LOAD(1, k + 1); }
            const u32x4 hw = lv[k & 1][0], uw = lv[k & 1][1]; const float sc = -1.4426950408889634f * rs[it];
            float r[8];
#pragma unroll
            for (int q = 0; q < 4; ++q) { const float a0 = acc[ai][bj][m][q >> 1][(q & 1) * 2], a1 = acc[ai][bj][m][q >> 1][(q & 1) * 2 + 1];
                const float s0 = __builtin_amdgcn_rcpf(1.f + __builtin_amdgcn_exp2f(sc * a0)), s1 = __builtin_amdgcn_rcpf(1.f + __builtin_amdgcn_exp2f(sc * a1));
                r[2 * q] = bf_lo(hw[q]) + bf_lo(uw[q]) * s0; r[2 * q + 1] = bf_hi(hw[q]) + bf_hi(uw[q]) * s1; }
            u32x4 w; w.x = cvt_pk_bf16(r[0], r[1]); w.y = cvt_pk_bf16(r[2], r[3]); w.z = cvt_pk_bf16(r[4], r[5]); w.w = cvt_pk_bf16(r[6], r[7]);
            *(u32x4*)(O3 + row * ld3 + col0 + bj * 32) = w; }
#undef EP_LOAD
    }
};
struct EpiSwiglu {
    static constexpr bool PERM = true, AFTER_DRAIN = false; static constexpr int NST = 8;
    bf16_t* H; const float* lrstd;
    __device__ __forceinline__ void operator()(const f32x4 (&acc)[2][2][4][2], const Unit& u, int wr, int wc, int fr_, int fq_) const {
        PG8_FRESH_LANE(fr, fq);
        const int row0 = u.pm * BM + wr * 64 + fr, col0 = u.pn * HALF + wc * 32 + 8 * fq, r0 = wr * 64 + fr;
        float rs[8];
#pragma unroll
        for (int it = 0; it < 8; ++it) { const int r = r0 + (it >> 2) * HALF + (it & 3) * 16; rs[it] = (r < u.aux1) ? lrstd[u.aux0 + r] : 0.f; }
#pragma unroll
        for (int ai = 0; ai < 2; ++ai)
#pragma unroll
            for (int m = 0; m < 4; ++m) { bf16_t* rowp = H + (size_t)(row0 + ai * HALF + m * 16) * 576 + col0; float h[8]; const float rr = rs[ai * 4 + m];
#pragma unroll
                for (int n = 0; n < 2; ++n)
#pragma unroll
                    for (int j = 0; j < 4; ++j) { const float g = acc[ai][0][m][n][j] * rr, up = acc[ai][1][m][n][j] * rr;
                        h[n * 4 + j] = g * up * __builtin_amdgcn_rcpf(1.f + __builtin_amdgcn_exp2f(-1.4426950408889634f * g)); }
                u32x4 w; w.x = cvt_pk_bf16(h[0], h[1]); w.y = cvt_pk_bf16(h[2], h[3]); w.z = cvt_pk_bf16(h[4], h[5]); w.w = cvt_pk_bf16(h[6], h[7]);
                *(u32x4*)rowp = w; }
    }
};
struct EpiScatter {
    static constexpr bool PERM = true, AFTER_DRAIN = false; static constexpr int NST = 16;
    bf16_t* Y; const int2* lsg;
    __device__ __forceinline__ void operator()(const f32x4 (&acc)[2][2][4][2], const Unit& u, int wr, int wc, int fr_, int fq_) const {
        PG8_FRESH_LANE(fr, fq);
        const int r0 = wr * 64 + fr, col0 = u.pn * BM + wc * 64 + 8 * fq;
        int sl[8]; float gt[8];
#pragma unroll
        for (int it = 0; it < 8; ++it) { const int r = r0 + (it >> 2) * HALF + (it & 3) * 16; const bool ok = r < u.aux1; int2 sg; sg.x = 65536; sg.y = 0; if (ok) sg = lsg[u.aux0 + r]; sl[it] = sg.x; gt[it] = __int_as_float(sg.y); }
#pragma unroll
        for (int it = 0; it < 8; ++it) { const int ai = it >> 2, m = it & 3;
            { bf16_t* rowp = Y + (size_t)sl[it] * 2048 + col0; const float g = gt[it];
#pragma unroll
                for (int bj = 0; bj < 2; ++bj) { const f32x4 v0 = acc[ai][bj][m][0] * g, v1 = acc[ai][bj][m][1] * g;
                    u32x4 w; w.x = cvt_pk_bf16(v0[0], v0[1]); w.y = cvt_pk_bf16(v0[2], v0[3]); w.z = cvt_pk_bf16(v1[0], v1[1]); w.w = cvt_pk_bf16(v1[2], v1[3]);
                    *(u32x4*)(rowp + bj * 32) = w; } } }
    }
};
struct MoeOrder {
    int nM, nN, nwg, G, c; const PG8_LAS int* tstart; const PG8_LAS int* cnt;
    __device__ void init(int nM_, int nN_, int G_, int c_, const PG8_LAS int* ts, const PG8_LAS int* cn) { nM = nM_; nN = nN_; nwg = nM * nN; G = G_; c = c_; tstart = ts; cnt = cn; }
    __device__ bool next(int i, Unit& u) const {
        const long L = (long)i * G + c; if (L >= nwg) return false;
        int wgid = (int)L; { const int q = nwg / NXCD, r = nwg % NXCD, xcd = wgid % NXCD, off = wgid / NXCD; wgid = (xcd < r ? xcd * (q + 1) : r * (q + 1) + (xcd - r) * q) + off; }
        const int nig = WGM * nN, gid = wgid / nig, fm = gid * WGM, gsz = (nM - fm) < WGM ? (nM - fm) : WGM;
        const int pm = fm + ((wgid % nig) % gsz), pn = (wgid % nig) / gsz;
        int e = 0;
        for (int k = 1; k < 32; ++k) e += (__builtin_amdgcn_readfirstlane(tstart[k]) <= pm) ? 1 : 0;
        const int t = pm - __builtin_amdgcn_readfirstlane(tstart[e]); const int left = __builtin_amdgcn_readfirstlane(cnt[e]) - t * 256;
        u.pm = pm; u.pn = pn; u.pb = e * nN + pn; u.aux0 = e * 65536 + t * 256; u.aux1 = left < 256 ? left : 256; return true;
    }
    __device__ __forceinline__ void a_ready(const Unit&) const {}
    __device__ __forceinline__ void done(const Unit&) const {}
};
template <class Epi, class Sched, bool ALIGN_EPI = false, bool SP2 = false, bool GATHER = false>
__device__ __forceinline__ void gemm_phase(PG8_LAS unsigned char* lds, const Gemm g, const Sched& S, const Epi& E, const int wid) {
    FRESH_LANE(lane); const int tid = wid * 64 + lane, wr = wid >> 2, wc = wid & 3, fr = lane & 15, fq = lane >> 4;
    const int K = g.K, nt = K / BK;
    unsigned voffA[2], voffB[2];
#pragma unroll
    for (int i = 0; i < 2; ++i) { int R, C; stage_rc(tid * 16 + i * 8192, R, C); const int Rb = 2 * (R & ~31) + (Epi::PERM ? perm32(R & 31) : (R & 31));
        voffA[i] = (unsigned)(R * g.lda + C) * 2u; voffB[i] = (unsigned)(Rb * g.ldb + C) * 2u; }
    const size_t kstep = (size_t)(BK * 2);
    const size_t hstepA = (size_t)HALF * g.lda * 2, hstep = (size_t)32 * g.ldb * 2;
    const size_t tstepA = 2 * hstepA, tstep = (size_t)BM * g.ldb * 2;
    const unsigned ldsw = (unsigned)wid * 1024u;
    const int aoff = lds_byte(wr * 64 + fr, fq * 8), boff = lds_byte(wc * 32 + fr, fq * 8);
#define PG8_SA(b, h) (((b) * 2 + (h)) * HTB)
#define PG8_SB(b, h) ((4 + (b) * 2 + (h)) * HTB)
#define PG8_STAGE(bufoff, gbase, voff) do { _Pragma("unroll") for (int _i = 0; _i < 2; ++_i) \
        __builtin_amdgcn_global_load_lds((const unsigned*)((const char*)(gbase) + (voff)[_i]), (PG8_LAS unsigned*)(lds + (bufoff) + ldsw + _i * 8192), 16, 0, 0); } while (0)
#define PG8_STAGE_A(bufoff, nextsel, half, kb) do { _Pragma("unroll") for (int _i = 0; _i < 2; ++_i) { const char* _p; \
        if constexpr (GATHER) _p = (const char*)g.A + (kb) + ((nextsel) ? nx[half][_i] : cu[half][_i]); else _p = ((nextsel) ? nA : cA) + (kb) + (size_t)(half) * hstepA + voffA[_i]; \
        __builtin_amdgcn_global_load_lds((const unsigned*)_p, (PG8_LAS unsigned*)(lds + (bufoff) + ldsw + _i * 8192), 16, 0, 0); } } while (0)
#define PG8_ROWS(u, o) do { _Pragma("unroll") for (int _h = 0; _h < 2; ++_h) _Pragma("unroll") for (int _i = 0; _i < 2; ++_i) { int _R, _C; stage_rc(tid * 16 + _i * 8192, _R, _C); const int _r = _h * HALF + _R; \
        const int _t = (_r < (u).aux1) ? (g.glist[2 * ((u).aux0 + _r)] >> 1) : 0; o[_h][_i] = ((unsigned)_t * (unsigned)g.lda + (unsigned)_C) * 2u; } } while (0)
#define PG8_LDA(dst, b, h) do { _Pragma("unroll") for (int m = 0; m < 4; ++m) _Pragma("unroll") for (int k = 0; k < 2; ++k) dst[m][k] = *(const PG8_LAS bf16x8*)(lds + PG8_SA(b, h) + aoff + m * 2048 + k * 1024); } while (0)
#define PG8_LDB(dst, b, h) do { _Pragma("unroll") for (int n = 0; n < 2; ++n) _Pragma("unroll") for (int k = 0; k < 2; ++k) dst[n][k] = *(const PG8_LAS bf16x8*)(lds + PG8_SB(b, h) + boff + n * 2048 + k * 1024); } while (0)
#define PG8_MMA(ai, bj, At, Bt) do { __builtin_amdgcn_s_setprio(1); _Pragma("unroll") for (int m = 0; m < 4; ++m) _Pragma("unroll") for (int n = 0; n < 2; ++n) _Pragma("unroll") for (int k = 0; k < 2; ++k) \
        acc[ai][bj][m][n] = __builtin_amdgcn_mfma_f32_16x16x32_bf16(Bt[n][k], At[m][k], acc[ai][bj][m][n], 0, 0, 0); __builtin_amdgcn_s_setprio(0); } while (0)
#define PG8_WAIT_V(n) asm volatile("s_waitcnt vmcnt(" #n ")" ::: "memory")
#define PG8_WAIT_VN(n) asm volatile("s_waitcnt vmcnt(%0)" :: "n"(n) : "memory")
#define PG8_WAIT_L(n) asm volatile("s_waitcnt lgkmcnt(" #n ")" ::: "memory")
#define PG8_BAR __builtin_amdgcn_s_barrier()
#define PG8_SCHED __builtin_amdgcn_sched_barrier(0)
    Unit cur, nxt; int ui = 0;
    if (!S.next(0, cur)) return;
    f32x4 acc[2][2][4][2];
#pragma unroll
    for (int a = 0; a < 2; ++a)
#pragma unroll
        for (int b = 0; b < 2; ++b)
#pragma unroll
            for (int m = 0; m < 4; ++m)
#pragma unroll
                for (int n = 0; n < 2; ++n) acc[a][b][m][n] = (f32x4){0.f, 0.f, 0.f, 0.f};
    bf16x8 At[4][2], B0[2][2], B1[2][2];
    const char* cA = (const char*)g.A + (size_t)cur.pm * tstepA; const char* cB = (const char*)g.Bt + (size_t)cur.pb * tstep;
    S.a_ready(cur);
    unsigned cu[2][2] = {{0u, 0u}, {0u, 0u}}, nx[2][2] = {{0u, 0u}, {0u, 0u}}; const char* nA = cA;
    if constexpr (GATHER) PG8_ROWS(cur, cu);
    if constexpr (SP2) {
        PG8_STAGE(PG8_SB(0, 0), cB, voffB); PG8_STAGE(PG8_SB(0, 1), cB + hstep, voffB); PG8_STAGE_A(PG8_SA(0, 0), false, 0, 0); PG8_STAGE_A(PG8_SA(0, 1), false, 1, 0);
        if (wr == 1) PG8_BAR;
        PG8_WAIT_V(2); PG8_BAR;
        PG8_STAGE(PG8_SB(1, 0), cB + kstep, voffB); PG8_STAGE_A(PG8_SA(1, 0), false, 0, kstep); PG8_STAGE(PG8_SB(1, 1), cB + hstep + kstep, voffB);
        PG8_WAIT_V(6); PG8_BAR;
    } else { static_assert(SP2, "only the SP2 loop is kept in this file"); }
    for (;;) {
        const bool has_next = S.next(ui + 1, nxt);
        nA = has_next ? (const char*)g.A + (size_t)nxt.pm * tstepA : cA;
        if constexpr (GATHER) { if (has_next) PG8_ROWS(nxt, nx); else { nx[0][0] = cu[0][0]; nx[0][1] = cu[0][1]; nx[1][0] = cu[1][0]; nx[1][1] = cu[1][1]; } }
        const char* nB = has_next ? (const char*)g.Bt + (size_t)nxt.pb * tstep : cB;
#pragma unroll 1
        for (int t = 0; t < nt; t += 2) {
            const bool last = (t == nt - 2);
            constexpr bool fresh = false;
            const size_t kb1 = (size_t)(t + 1) * kstep;
            const size_t kb2 = last ? 0 : (size_t)(t + 2) * kstep; const char* b2 = last ? nB : cB + (size_t)(t + 2) * kstep;
            const size_t kb3 = kb2 + kstep; const char* b3 = b2 + kstep;
            if (last && has_next) S.a_ready(nxt);
            if constexpr (SP2) {
            PG8_LDB(B0, 0, 0); PG8_LDB(B1, 0, 1); PG8_SCHED; PG8_LDA(At, 0, 0); if (!fresh) { PG8_STAGE_A(PG8_SA(1, 1), false, 1, kb1); PG8_WAIT_V(8); }
            PG8_WAIT_L(0); PG8_BAR; PG8_MMA(0, 0, At, B0); PG8_MMA(0, 1, At, B1); PG8_BAR; PG8_SCHED;
            PG8_LDA(At, 0, 1); PG8_STAGE(PG8_SB(0, 0), b2, voffB); PG8_STAGE(PG8_SB(0, 1), b2 + hstep, voffB); PG8_STAGE_A(PG8_SA(0, 0), last, 0, kb2);
            if (!fresh) PG8_WAIT_V(8);
            PG8_WAIT_L(0); PG8_BAR; PG8_MMA(1, 0, At, B0); PG8_MMA(1, 1, At, B1); PG8_BAR; PG8_SCHED;
            PG8_LDB(B0, 1, 0); PG8_LDB(B1, 1, 1); PG8_SCHED; PG8_LDA(At, 1, 0); PG8_STAGE_A(PG8_SA(0, 1), last, 1, kb2);
            if (fresh) { PG8_WAIT_VN(8 + Epi::NST); } else { PG8_WAIT_V(8); }
            PG8_WAIT_L(0); PG8_BAR; PG8_MMA(0, 0, At, B0); PG8_MMA(0, 1, At, B1); PG8_BAR; PG8_SCHED;
            PG8_LDA(At, 1, 1); PG8_STAGE(PG8_SB(1, 0), b3, voffB); PG8_STAGE(PG8_SB(1, 1), b3 + hstep, voffB); PG8_STAGE_A(PG8_SA(1, 0), last, 0, kb3);
            PG8_WAIT_V(8); PG8_WAIT_L(0); PG8_BAR; PG8_MMA(1, 0, At, B0); PG8_MMA(1, 1, At, B1); PG8_BAR; PG8_SCHED;
            }
        }
        if constexpr (ALIGN_EPI) { if (wr == 0) PG8_BAR; }
        if constexpr (!Epi::AFTER_DRAIN) { E(acc, cur, wr, wc, fr, fq); S.done(cur); }
        if (!has_next) break;
#pragma unroll
        for (int a = 0; a < 2; ++a)
#pragma unroll
            for (int b = 0; b < 2; ++b)
#pragma unroll
                for (int m = 0; m < 4; ++m)
#pragma unroll
                    for (int n = 0; n < 2; ++n) acc[a][b][m][n] = (f32x4){0.f, 0.f, 0.f, 0.f};
        cur = nxt; cA = nA; cB = nB; ++ui;
        if constexpr (GATHER) { cu[0][0] = nx[0][0]; cu[0][1] = nx[0][1]; cu[1][0] = nx[1][0]; cu[1][1] = nx[1][1]; }
        if constexpr (ALIGN_EPI) { if (wr == 1) PG8_BAR; }
    }
    PG8_WAIT_V(0);
    if constexpr (!ALIGN_EPI) { if (wr == 0) PG8_BAR; }
    PG8_BAR;
    if constexpr (Epi::AFTER_DRAIN) { E.fused(acc, cur, wr, wc, fr, fq, lds, wid, lane); S.done(cur); }
#undef PG8_SA
#undef PG8_SB
#undef PG8_STAGE
#undef PG8_STAGE_A
#undef PG8_ROWS
#undef PG8_LDA
#undef PG8_LDB
#undef PG8_MMA
#undef PG8_WAIT_V
#undef PG8_WAIT_VN
#undef PG8_WAIT_L
#undef PG8_BAR
#undef PG8_SCHED
}
}
namespace att {
using bf16 = unsigned short;
using bf16x8 = __attribute__((ext_vector_type(8))) short;
using s16x4  = __attribute__((ext_vector_type(4))) short;
using f32x16 = __attribute__((ext_vector_type(16))) float;
using u32x4  = __attribute__((ext_vector_type(4))) unsigned;
constexpr int LDQKV = 64, LDO = 2112;
constexpr int SEQ_ = 8192;
constexpr size_t OKTS = (size_t)32768 * 64;
constexpr size_t QPS = (size_t)32768 * LDQKV;
#define QCOL(c) ((size_t)((c) >> 6) * QPS + (size_t)((c) & 63))
constexpr size_t SHM_V = 64 * 128 * 2, SHM_K = 64 * 128 * 2, SHM_ATTN = 2 * SHM_V + 2 * SHM_K + 8 * 64 * 4 + 64;
#define KSWZ(row, colB) ((row) * 256 + ((colB) ^ (((row) & 7) << 4)))
#define SBAR() __builtin_amdgcn_sched_barrier(0)
__device__ __forceinline__ int crow(int r, int hi) { return (r & 3) + 8 * (r >> 2) + 4 * hi; }
__device__ __forceinline__ unsigned cvtpk(float lo, float hi) { unsigned r; asm volatile("v_cvt_pk_bf16_f32 %0, %1, %2" : "=v"(r) : "v"(lo), "v"(hi)); return r; }
__device__ __forceinline__ int v_st(int k, int c) { const int kk = (k & ~0xC) | ((k & 4) << 1) | ((k & 8) >> 1); return ((kk >> 3) * 4 + (c >> 5)) * 512 + ((kk & 7) * 32 + (c & 31)) * 2; }
__device__ __forceinline__ int v_rd_base(int lane) { return ((lane & 3) << 3) | (((lane >> 2) & 3) << 6) | (((lane >> 4) & 1) << 5) | (((lane >> 5) & 1) << 8); }
constexpr int v_rd_off(int d0, int ks, int half) { return d0 * 512 + ks * 4096 + half * 2048; }
template <int OFF> __device__ __forceinline__ s16x4 tr_read(int vb) { s16x4 r; asm volatile("ds_read_b64_tr_b16 %0, %1 offset:%2" : "=&v"(r) : "v"(vb), "i"(OFF) : "memory"); return r; }
template <int D0> __device__ __forceinline__ void pv_one(f32x16& od, int vb, bf16x8 pa0, bf16x8 pa1, bf16x8 pa2, bf16x8 pa3) {
  const s16x4 l0 = tr_read<v_rd_off(D0, 0, 0)>(vb), h0 = tr_read<v_rd_off(D0, 0, 1)>(vb), l1 = tr_read<v_rd_off(D0, 1, 0)>(vb), h1 = tr_read<v_rd_off(D0, 1, 1)>(vb);
  const s16x4 l2 = tr_read<v_rd_off(D0, 2, 0)>(vb), h2 = tr_read<v_rd_off(D0, 2, 1)>(vb), l3 = tr_read<v_rd_off(D0, 3, 0)>(vb), h3 = tr_read<v_rd_off(D0, 3, 1)>(vb);
  asm volatile("s_waitcnt lgkmcnt(0)" ::: "memory"); SBAR();
#define PK(L, H) (bf16x8){L[0], L[1], L[2], L[3], H[0], H[1], H[2], H[3]}
  od = __builtin_amdgcn_mfma_f32_32x32x16_bf16(pa0, PK(l0, h0), od, 0, 0, 0);
  od = __builtin_amdgcn_mfma_f32_32x32x16_bf16(pa1, PK(l1, h1), od, 0, 0, 0);
  od = __builtin_amdgcn_mfma_f32_32x32x16_bf16(pa2, PK(l2, h2), od, 0, 0, 0);
  od = __builtin_amdgcn_mfma_f32_32x32x16_bf16(pa3, PK(l3, h3), od, 0, 0, 0);
#undef PK
}
__device__ __forceinline__ void pv_d0(f32x16* o, int vb, bf16x8 pa0, bf16x8 pa1, bf16x8 pa2, bf16x8 pa3) {
  pv_one<0>(o[0], vb, pa0, pa1, pa2, pa3); pv_one<1>(o[1], vb, pa0, pa1, pa2, pa3); pv_one<2>(o[2], vb, pa0, pa1, pa2, pa3); pv_one<3>(o[3], vb, pa0, pa1, pa2, pa3);
}
__device__ __forceinline__ void pack_p(const f32x16& p0, const f32x16& p1, bf16x8& pa0, bf16x8& pa1, bf16x8& pa2, bf16x8& pa3) {
#define PK4(P, BASE, OUT) do { unsigned a0 = cvtpk(P[BASE + 0], P[BASE + 1]), a1 = cvtpk(P[BASE + 2], P[BASE + 3]);   \
    unsigned b0 = cvtpk(P[BASE + 4], P[BASE + 5]), b1 = cvtpk(P[BASE + 6], P[BASE + 7]);                              \
    auto r0 = __builtin_amdgcn_permlane32_swap(a0, b0, false, false); auto r1 = __builtin_amdgcn_permlane32_swap(a1, b1, false, false); \
    u32x4 w = {r0[0], r1[0], r0[1], r1[1]}; OUT = *reinterpret_cast<bf16x8*>(&w); } while (0)
  PK4(p0, 0, pa0); PK4(p0, 8, pa1); PK4(p1, 0, pa2); PK4(p1, 8, pa3);
#undef PK4
}
template <int ND> __device__ __forceinline__ void qkt(f32x16& p0, f32x16& p1, const char* Ks, const bf16x8* qr, int cb0, int r32, int hi) {
  p0 = f32x16{}; p1 = f32x16{};
#pragma unroll
  for (int d0 = 0; d0 < ND; ++d0) { const int cb = cb0 + (d0 * 16 + hi * 8) * 2;
    const bf16x8 b0 = *reinterpret_cast<const bf16x8*>(Ks + KSWZ(r32, cb));
    const bf16x8 b1 = *reinterpret_cast<const bf16x8*>(Ks + KSWZ(32 + r32, cb));
    p0 = __builtin_amdgcn_mfma_f32_32x32x16_bf16(b0, qr[d0], p0, 0, 0, 0);
    p1 = __builtin_amdgcn_mfma_f32_32x32x16_bf16(b1, qr[d0], p1, 0, 0, 0); }
}
constexpr float THRL = 11.5f;
__device__ __forceinline__ void partialSM(f32x16& p0, f32x16& p1, float& m_reg, float& mn, float& alpha) {
  float pmax = p0[0];
#pragma unroll
  for (int r = 1; r < 16; ++r) pmax = fmaxf(pmax, p0[r]);
#pragma unroll
  for (int r = 0; r < 16; ++r) pmax = fmaxf(pmax, p1[r]);
  { auto rr = __builtin_amdgcn_permlane32_swap(__float_as_uint(pmax), __float_as_uint(pmax), false, false); pmax = fmaxf(__uint_as_float(rr[0]), __uint_as_float(rr[1])); }
  if (__builtin_expect(__all(pmax - m_reg <= THRL), 1)) { mn = m_reg; alpha = 1.f; }
  else { mn = fmaxf(m_reg, pmax); alpha = __builtin_amdgcn_exp2f(m_reg - mn); m_reg = mn; }
#pragma unroll
  for (int r = 0; r < 16; ++r) p0[r] = p0[r] - mn;
#pragma unroll
  for (int r = 0; r < 16; ++r) p1[r] = p1[r] - mn;
#pragma unroll
  for (int r = 0; r < 16; ++r) p0[r] = __builtin_amdgcn_exp2f(p0[r]);
}
__device__ __forceinline__ void finishSM(f32x16& p0, f32x16& p1, float alpha, float& l_reg, bf16x8& pa0, bf16x8& pa1, bf16x8& pa2, bf16x8& pa3) {
#pragma unroll
  for (int r = 0; r < 16; ++r) p1[r] = __builtin_amdgcn_exp2f(p1[r]);
  float ps = 0;
#pragma unroll
  for (int r = 0; r < 16; ++r) ps += p0[r];
#pragma unroll
  for (int r = 0; r < 16; ++r) ps += p1[r];
  { auto rr = __builtin_amdgcn_permlane32_swap(__float_as_uint(ps), __float_as_uint(ps), false, false); ps = __uint_as_float(rr[0]) + __uint_as_float(rr[1]); }
  l_reg = l_reg * alpha + ps;
  pack_p(p0, p1, pa0, pa1, pa2, pa3);
}
__device__ __forceinline__ float half_sum32(float v) { return half_sum32_(v); }


__device__ __forceinline__ void store_o_tile(const f32x16 (&o)[4], bf16* Ow  , char* wl  , int lane_e) {
  const int r32e = lane_e & 31, hie = lane_e >> 5;
  float* wf = (float*)wl;
#pragma unroll
  for (int r = 0; r < 16; ++r) { const int orow = crow(r, hie);
#pragma unroll
    for (int d0 = 0; d0 < 4; ++d0) wf[orow * 128 + d0 * 32 + r32e] = o[d0][r]; }
  asm volatile("s_waitcnt lgkmcnt(0)" ::: "memory");
#pragma unroll
  for (int i = 0; i < 8; ++i) { const int row = 4 * i + (lane_e >> 4), ch = lane_e & 15;
    const float* src = wf + row * 128 + ch * 8;
    const float a0 = src[0], a1 = src[1], a2 = src[2], a3 = src[3], a4 = src[4], a5 = src[5], a6 = src[6], a7 = src[7];
    u32x4 w; w.x = cvtpk(a0, a1); w.y = cvtpk(a2, a3); w.z = cvtpk(a4, a5); w.w = cvtpk(a6, a7);
    *(u32x4*)(Ow + (size_t)row * LDO + ch * 8) = w; }
  asm volatile("s_waitcnt lgkmcnt(0)" ::: "memory");
}

__device__ __forceinline__ void diff_unit(int b, int h, int qb, const bf16* __restrict__ QKV, bf16* __restrict__ Oout, const float* __restrict__ gdiff, float lam, float oscale, char* lds) {
  const int tid = threadIdx.x, lane = tid & 63, r32 = lane & 31, hi = lane >> 5; const int wid = __builtin_amdgcn_readfirstlane(tid >> 6);
  const int map = wid >> 2, wq = wid & 3;
  bf16* V_lds = (bf16*)lds; bf16* K_lds = (bf16*)(lds + 2 * SHM_V);
  float* ws = (float*)(lds + 2 * SHM_V + 2 * SHM_K) + wid * 64; float* li_l = ws; float* al_l = ws + 32;
  float m_reg = -1e30f, l_reg = 0; f32x16 o[4] = {}; bf16x8 qr[4];
  const size_t rowb = (size_t)b * SEQ_;
  const bf16* Qw = QKV + (rowb + qb * 128 + wq * 32 + r32) * LDQKV + QCOL(3072 + h * 128) + map * 64 + hi * 8;
#pragma unroll
  for (int d0 = 0; d0 < 4; ++d0) qr[d0] = *reinterpret_cast<const bf16x8*>(Qw + d0 * 16);
  const bf16* Kh = QKV + rowb * LDQKV + QCOL(4096 + h * 128); const bf16* Vh = QKV + rowb * LDQKV + QCOL(5120 + h * 128);
  const int sr = tid >> 4, sc = (tid & 15) * 8, vst0 = v_st(sr, sc), vst1 = v_st(32 + sr, sc);
  const int vb0 = (int)(uintptr_t)V_lds + v_rd_base(lane);
  const int cbm = map * 128;
  struct { bf16x8 vs0, vs1, ks0, ks1; } sr_[1];
  const unsigned toff0 = (unsigned)(sr * LDQKV + sc), toff1 = toff0 + 32u * LDQKV;
#define SLOAD(i, k0) do { const bf16* vt_ = Vh + (size_t)(k0) * LDQKV; const bf16* kt_ = Kh + (size_t)(k0) * LDQKV; \
    sr_[i].vs0 = *reinterpret_cast<const bf16x8*>(vt_ + toff0); sr_[i].vs1 = *reinterpret_cast<const bf16x8*>(vt_ + toff1); \
    sr_[i].ks0 = *reinterpret_cast<const bf16x8*>(kt_ + toff0); sr_[i].ks1 = *reinterpret_cast<const bf16x8*>(kt_ + toff1); } while (0)
#define SWRITE(bb, i) do { *(bf16x8*)((char*)V_lds + (bb) * SHM_V + vst0) = sr_[i].vs0; *(bf16x8*)((char*)V_lds + (bb) * SHM_V + vst1) = sr_[i].vs1; const int kc = sc * 2; \
    *(bf16x8*)((char*)K_lds + (bb) * SHM_K + KSWZ(sr, kc)) = sr_[i].ks0; *(bf16x8*)((char*)K_lds + (bb) * SHM_K + KSWZ(32 + sr, kc)) = sr_[i].ks1; } while (0)
#define SWAIT() asm volatile("s_waitcnt vmcnt(0)" ::: "memory")
#define RESC(a) do { if (__any((a) < 1.f)) { if (hi == 0) al_l[r32] = (a); asm volatile("s_waitcnt lgkmcnt(0)" ::: "memory"); \
    _Pragma("unroll") for (int d = 0; d < 4; ++d) _Pragma("unroll") for (int r = 0; r < 16; ++r) o[d][r] *= al_l[crow(r, hi)]; } } while (0)
  f32x16 pA0, pA1, pB0, pB1; float mnA, mnB, alA, alB; bf16x8 pa0, pa1, pa2, pa3; const int NT = 2 * qb + 2;
  __syncthreads();
  SLOAD(0, 0); asm volatile("s_waitcnt vmcnt(0)" ::: "memory"); SWRITE(0, 0); __syncthreads();
  qkt<4>(pA0, pA1, (const char*)K_lds, qr, cbm, r32, hi); partialSM(pA0, pA1, m_reg, mnA, alA);
  SLOAD(0, 64);
  SWAIT(); SWRITE(1, 0); __syncthreads();
  for (int j = 1; j + 1 < NT; j += 2) {
    SBAR(); qkt<4>(pB0, pB1, (const char*)K_lds + SHM_K, qr, cbm, r32, hi);
    finishSM(pA0, pA1, alA, l_reg, pa0, pa1, pa2, pa3); SBAR();
    SLOAD(0, (j + 1) * 64); SBAR();
    pv_d0(o, vb0, pa0, pa1, pa2, pa3); partialSM(pB0, pB1, m_reg, mnB, alB);
    __syncthreads(); SWAIT(); SWRITE(0, 0);
    RESC(alB); __syncthreads();
    SBAR(); qkt<4>(pA0, pA1, (const char*)K_lds, qr, cbm, r32, hi);
    finishSM(pB0, pB1, alB, l_reg, pa0, pa1, pa2, pa3); SBAR();
    SLOAD(0, (j + 2) * 64); SBAR();
    pv_d0(o, vb0 + (int)SHM_V, pa0, pa1, pa2, pa3); partialSM(pA0, pA1, m_reg, mnA, alA);
    __syncthreads(); SWAIT(); SWRITE(1, 0);
    RESC(alA); __syncthreads();
  }
  SBAR(); qkt<4>(pB0, pB1, (const char*)K_lds + SHM_K, qr, cbm, r32, hi);
  if (wq < 2) {
#pragma unroll
    for (int r = 0; r < 16; ++r) { pB0[r] = -1e30f; pB1[r] = -1e30f; } }
  finishSM(pA0, pA1, alA, l_reg, pa0, pa1, pa2, pa3); SBAR();
  pv_d0(o, vb0, pa0, pa1, pa2, pa3); partialSM(pB0, pB1, m_reg, mnB, alB);
  __syncthreads(); RESC(alB);
  finishSM(pB0, pB1, alB, l_reg, pa0, pa1, pa2, pa3); SBAR();
  pv_d0(o, vb0 + (int)SHM_V, pa0, pa1, pa2, pa3);
  if (hi == 0) li_l[r32] = l_reg; asm volatile("s_waitcnt lgkmcnt(0)" ::: "memory");
  float rli[16];
#pragma unroll
  for (int r = 0; r < 16; ++r) rli[r] = __builtin_amdgcn_rcpf(li_l[crow(r, hi)]);
  __syncthreads();
  float* xch = (float*)lds + (size_t)wq * 4096;
  if (map == 1) {
#pragma unroll
    for (int d0 = 0; d0 < 4; ++d0)
#pragma unroll
      for (int r = 0; r < 16; ++r) xch[(d0 * 16 + r) * 64 + lane] = o[d0][r] * rli[r] * lam;
  }
  __syncthreads();
  if (map == 0) {
    float ss[16];
#pragma unroll
    for (int r = 0; r < 16; ++r) { float s = 0.f;
#pragma unroll
      for (int d0 = 0; d0 < 4; ++d0) { const float v = o[d0][r] * rli[r] - xch[(d0 * 16 + r) * 64 + lane]; o[d0][r] = v; s += v * v; }
      ss[r] = s; }
#pragma unroll
    for (int r = 0; r < 16; ++r) ss[r] = half_sum32(ss[r]);
    bf16* Ow = Oout + (rowb + qb * 128 + wq * 32) * LDO + 1024 + h * 128;
    float gv[4];
#pragma unroll
    for (int d0 = 0; d0 < 4; ++d0) gv[d0] = gdiff[d0 * 32 + r32] * oscale;
#pragma unroll
    for (int r = 0; r < 16; ++r) { const int orow = crow(r, hi); const float rs = rsqrtf(ss[r] * (1.f / 128.f) + 1e-6f);
#pragma unroll
      for (int d0 = 0; d0 < 4; ++d0) { const float y = o[d0][r] * rs * gv[d0]; const unsigned w = cvtpk(y, y); Ow[(size_t)orow * LDO + d0 * 32 + r32] = (bf16)(w & 0xffffu); } }
  }
#undef SLOAD
#undef SWRITE
#undef SWAIT
#undef RESC
}
__device__ __forceinline__ void sb_wave_unit(int b, int h, int wq, const bf16* __restrict__ QKV, bf16* __restrict__ Oout, const float* __restrict__ gsb, char* ldsw) {
  FRESH_LANE(lane);
  const int r32 = lane & 31, hi = lane >> 5;
  char* V_lds = ldsw; char* K_lds = ldsw + 8192;
  f32x16 o[4] = {}; bf16x8 qr[8];
  const size_t rowb = (size_t)b * SEQ_;
  const int Q0 = wq * 32, tq = Q0 + r32;
  const bf16* Qw = QKV + (rowb + tq) * LDQKV + QCOL(h * 128) + hi * 8;
#pragma unroll
  for (int d0 = 0; d0 < 8; ++d0) qr[d0] = *reinterpret_cast<const bf16x8*>(Qw + (size_t)(d0 >> 2) * QPS + (d0 & 3) * 16);
  const bf16* Kh = QKV + rowb * LDQKV + QCOL(1024 + h * 128); const bf16* Vh = QKV + rowb * LDQKV + QCOL(2048 + h * 128);
  const int skey = lane >> 4, scol = (lane & 15) * 8;
  const size_t toff = (size_t)(scol >> 6) * QPS + (size_t)(skey * LDQKV + (scol & 63));
  const int lc0 = (lane & 15) ^ skey, lc1 = (lane & 15) ^ (4 + skey);
  const size_t koff0 = (size_t)(lc0 >> 3) * QPS + (size_t)(skey * LDQKV + (lc0 & 7) * 8), koff1 = (size_t)(lc1 >> 3) * QPS + (size_t)(skey * LDQKV + (lc1 & 7) * 8);
  typedef __attribute__((address_space(3))) unsigned lds_u32;
  lds_u32* kl = (lds_u32*)(K_lds);
  const int vb0 = (int)(uintptr_t)V_lds + v_rd_base(lane);
  bf16x8 vs[8];
#define SB_LOADV(j) do { const bf16* vt_ = Vh + (size_t)(j) * 32 * LDQKV; \
    _Pragma("unroll") for (int i_ = 0; i_ < 8; ++i_) vs[i_] = *reinterpret_cast<const bf16x8*>(vt_ + toff + (unsigned)(4 * i_) * LDQKV); } while (0)
#define SB_DMAK(j) do { const bf16* kt_ = Kh + (size_t)(j) * 32 * LDQKV; \
    _Pragma("unroll") for (int p_ = 0; p_ < 8; ++p_) __builtin_amdgcn_global_load_lds((const unsigned*)(kt_ + (unsigned)(4 * p_) * LDQKV + ((p_ & 1) ? koff1 : koff0)), kl + p_ * 256, 16, 0, 0); } while (0)
  float carry = 0.f;
  SB_DMAK(wq); SB_LOADV(wq);
  for (int j = wq; j >= 0; --j) {
    asm volatile("s_waitcnt vmcnt(0)" ::: "memory");
#pragma unroll
    for (int i = 0; i < 8; ++i) { const int key = 4 * i + skey; *(bf16x8*)(V_lds + v_st(key, scol)) = vs[i]; }
    asm volatile("s_waitcnt lgkmcnt(0)" ::: "memory");
    if (j > 0) SB_LOADV(j - 1);
    f32x16 p0 = f32x16{};
#pragma unroll
    for (int d0 = 0; d0 < 8; ++d0) { const int cb = (d0 * 16 + hi * 8) * 2;
      const bf16x8 b0 = *reinterpret_cast<const bf16x8*>(K_lds + KSWZ(r32, cb));
      p0 = __builtin_amdgcn_mfma_f32_32x32x16_bf16(b0, qr[d0], p0, 0, 0, 0); }
    asm volatile("s_waitcnt lgkmcnt(0)" ::: "memory");
    if (j > 0) SB_DMAK(j - 1);
    const bool diag = (j == wq);
    const int kb = j * 32 + 4 * hi;
    f32x16 q0;
#pragma unroll
    for (int r = 0; r < 16; ++r) {
      const float z0 = __builtin_amdgcn_fmed3f(p0[r], -120.f, 120.f);
      float a0 = -__builtin_amdgcn_logf(1.f + __builtin_amdgcn_exp2f(z0));
      float b0 = z0 + a0;
      if (diag) { const int kv = kb + (r & 3) + 8 * (r >> 2); if (kv >= tq) { a0 = 0.f; b0 = -1e30f; } }
      q0[r] = a0; p0[r] = b0; }
    float G[4], PG[4], SUF[4];
#pragma unroll
    for (int g = 0; g < 4; ++g) G[g] = (q0[4 * g] + q0[4 * g + 1]) + (q0[4 * g + 2] + q0[4 * g + 3]);
    float CS[4];
#pragma unroll
    for (int g = 0; g < 4; ++g) { auto rr = __builtin_amdgcn_permlane32_swap(__float_as_uint(G[g]), __float_as_uint(G[g]), false, false);
      CS[g] = __uint_as_float(rr[0]) + __uint_as_float(rr[1]); PG[g] = __uint_as_float(rr[1]); }
    float run = carry;
#pragma unroll
    for (int g = 3; g >= 0; --g) { SUF[g] = run; run += CS[g]; }
    carry = run;
#pragma unroll
    for (int g = 0; g < 4; ++g) SUF[g] += (hi == 0) ? PG[g] : 0.f;
#pragma unroll
    for (int g = 0; g < 4; ++g) {
      float s = SUF[g];
      p0[4 * g + 3] = __builtin_amdgcn_exp2f(p0[4 * g + 3] + s); s += q0[4 * g + 3];
      p0[4 * g + 2] = __builtin_amdgcn_exp2f(p0[4 * g + 2] + s); s += q0[4 * g + 2];
      p0[4 * g + 1] = __builtin_amdgcn_exp2f(p0[4 * g + 1] + s); s += q0[4 * g + 1];
      p0[4 * g + 0] = __builtin_amdgcn_exp2f(p0[4 * g + 0] + s);
    }
    bf16x8 pa0, pa1;
#define PK4(P, BASE, OUT) do { unsigned a0 = cvtpk(P[BASE + 0], P[BASE + 1]), a1 = cvtpk(P[BASE + 2], P[BASE + 3]);   \
    unsigned b0 = cvtpk(P[BASE + 4], P[BASE + 5]), b1 = cvtpk(P[BASE + 6], P[BASE + 7]);                              \
    auto r0 = __builtin_amdgcn_permlane32_swap(a0, b0, false, false); auto r1 = __builtin_amdgcn_permlane32_swap(a1, b1, false, false); \
    u32x4 w = {r0[0], r1[0], r0[1], r1[1]}; OUT = *reinterpret_cast<bf16x8*>(&w); } while (0)
    PK4(p0, 0, pa0); PK4(p0, 8, pa1);
#undef PK4
#define SB_PV(D0) do { const s16x4 l0 = tr_read<v_rd_off(D0, 0, 0)>(vb0), h0 = tr_read<v_rd_off(D0, 0, 1)>(vb0), l1 = tr_read<v_rd_off(D0, 1, 0)>(vb0), h1 = tr_read<v_rd_off(D0, 1, 1)>(vb0); \
    asm volatile("s_waitcnt lgkmcnt(0)" ::: "memory"); SBAR(); \
    o[D0] = __builtin_amdgcn_mfma_f32_32x32x16_bf16(pa0, (bf16x8){l0[0], l0[1], l0[2], l0[3], h0[0], h0[1], h0[2], h0[3]}, o[D0], 0, 0, 0); \
    o[D0] = __builtin_amdgcn_mfma_f32_32x32x16_bf16(pa1, (bf16x8){l1[0], l1[1], l1[2], l1[3], h1[0], h1[1], h1[2], h1[3]}, o[D0], 0, 0, 0); } while (0)
    SB_PV(0); SB_PV(1); SB_PV(2); SB_PV(3);
#undef SB_PV
    if (__all(carry < -160.f)) break;
  }
#undef SB_LOADV
#undef SB_DMAK
  asm volatile("s_waitcnt vmcnt(0)" ::: "memory");
  { FRESH_LANE(le_); const int r32e = le_ & 31; float gv[4];
#pragma unroll
    for (int d0 = 0; d0 < 4; ++d0) gv[d0] = gsb[d0 * 32 + r32e];
#pragma unroll
    for (int r = 0; r < 16; ++r) { float s = 0.f;
#pragma unroll
      for (int d0 = 0; d0 < 4; ++d0) s += o[d0][r] * o[d0][r];
      const float rs = rsqrtf(half_sum32(s) * (1.f / 128.f) + 1e-6f);
#pragma unroll
      for (int d0 = 0; d0 < 4; ++d0) o[d0][r] = o[d0][r] * rs * gv[d0]; }
    store_o_tile(o, Oout + (rowb + Q0) * LDO + h * 128, ldsw, le_);
  }
  asm volatile("s_waitcnt vmcnt(0)" ::: "memory");
}
#undef KSWZ
#undef SBAR
}
namespace att {
typedef __attribute__((address_space(3))) const char* lds_cptr;
typedef short v4i16_t __attribute__((ext_vector_type(4)));
constexpr int D2_K = 0, D2_V = 49152, D2_WS = 98304, D2_SLOT = 16384;
constexpr float THR2 = 8.f;
__device__ __forceinline__ void glds16(const void* gsrc, unsigned lds_dst) { unsigned keep;
  asm volatile("s_mov_b32 %0, m0\n\ts_mov_b32 m0, %2\n\ts_nop 0\n\tglobal_load_lds_dwordx4 %1, off\n\ts_mov_b32 m0, %0" : "=&s"(keep) : "v"(gsrc), "s"(lds_dst) : "memory"); }
__device__ __forceinline__ s16x4 vtr(lds_cptr p) { return __builtin_bit_cast(s16x4, __builtin_amdgcn_ds_read_tr16_b64_v4i16((__attribute__((address_space(3))) v4i16_t*)p)); }
__device__ __forceinline__ float max3f(float a, float b, float c) { return __builtin_fmaxf(__builtin_fmaxf(a, b), c); }
__device__ __forceinline__ float rowmax2(const f32x16& p0, const f32x16& p1) {
  float a = max3f(p0[0], p0[1], p1[0]), b = max3f(p0[2], p0[3], p1[1]); a = max3f(a, p1[2], p1[3]);
#pragma unroll
  for (int r = 4; r < 16; r += 4) { a = max3f(a, p0[r], p0[r + 1]); b = max3f(b, p0[r + 2], p0[r + 3]); a = max3f(a, p1[r], p1[r + 1]); b = max3f(b, p1[r + 2], p1[r + 3]); }
  const float m = __builtin_fmaxf(a, b);
  auto rr = __builtin_amdgcn_permlane32_swap(__float_as_uint(m), __float_as_uint(m), false, false);
  return __builtin_fmaxf(__uint_as_float(rr[0]), __uint_as_float(rr[1]));
}
#define SBAR2() __builtin_amdgcn_sched_barrier(0)
#define WAIT_BAR2(N) asm volatile("s_waitcnt vmcnt(" #N ") lgkmcnt(0)\n\ts_barrier" ::: "memory")
__device__ __forceinline__ void diff_unit2(int b, int h, int qb, const bf16* __restrict__ QKV, bf16* __restrict__ Oout, const float* __restrict__ gdiff, float lam, float oscale, char* shm, int wid, const float* __restrict__ kmax2, int fixed_tile = 0) {
  const bool nodma_ = (fixed_tile == 2);
  int lane; asm volatile("v_mbcnt_lo_u32_b32 %0, -1, 0\n\tv_mbcnt_hi_u32_b32 %0, -1, %0" : "=v"(lane));
  const int r32 = lane & 31, hi = lane >> 5;
  const int map = wid >> 2, wq = wid & 3;
  const size_t rowb = (size_t)b * SEQ_;
  const bf16* Kh = QKV + rowb * LDQKV + QCOL(4096 + h * 128); const bf16* Vh = QKV + rowb * LDQKV + QCOL(5120 + h * 128);
  const unsigned lds0 = (unsigned)(uintptr_t)shm;
  float* wsf = (float*)(shm + D2_WS) + wid * 64;
  const bf16* ksrc = Kh + (size_t)lane * LDQKV + wid * 8;
  const bf16* vsrc = Vh + (size_t)(16 * (wid & 3) + (lane >> 2)) * LDQKV + (wid >> 2) * 32 + (lane & 3) * 8;
  const unsigned kdst = lds0 + D2_K + wid * 1024, vdst = lds0 + D2_V + wid * 1024;
#define DMA_K(t, slot) do { const bf16* s_ = ksrc + (size_t)(fixed_tile ? 0 : (t)) * 64 * LDQKV; const unsigned d_ = (unsigned)__builtin_amdgcn_readfirstlane(kdst + (slot)); glds16(s_, d_); glds16(s_ + QPS, d_ + 8192); } while (0)
#define DMA_V(t, slot) do { const bf16* s_ = vsrc + (size_t)(fixed_tile ? 0 : (t)) * 64 * LDQKV; const unsigned d_ = (unsigned)__builtin_amdgcn_readfirstlane(vdst + (slot)); glds16(s_, d_); glds16(s_ + QPS, d_ + 8192); } while (0)
  const lds_cptr shm3 = (lds_cptr)shm;
  const lds_cptr kp0 = shm3 + D2_K + (map * 8 + hi) * 1024 + r32 * 16;
  const lds_cptr vp0 = shm3 + D2_V + ((lane >> 4) & 1) * 32 + (lane & 3) * 8 + (4 * hi + ((lane & 15) >> 2)) * 64;
  const int NT = 2 * qb + 2;
  __syncthreads();
  DMA_K(0, 0); DMA_V(0, 0); DMA_K(1, D2_SLOT);
  bf16x8 qr[4];
  { const bf16* Qw = QKV + (rowb + qb * 128 + wq * 32 + r32) * LDQKV + QCOL(3072 + h * 128 + map * 64) + hi * 8;
#pragma unroll
    for (int d0 = 0; d0 < 4; ++d0) qr[d0] = *reinterpret_cast<const bf16x8*>(Qw + d0 * 16); }
  bool fastp;
  { float q2 = 0.f;
#pragma unroll
    for (int d0 = 0; d0 < 4; ++d0) { const u32x4 qw = __builtin_bit_cast(u32x4, qr[d0]);
#pragma unroll
      for (int e2 = 0; e2 < 4; ++e2) { const float a = __uint_as_float(qw[e2] << 16), c = __uint_as_float(qw[e2] & 0xffff0000u); q2 += a * a + c * c; } }
    { auto rr = __builtin_amdgcn_permlane32_swap(__float_as_uint(q2), __float_as_uint(q2), false, false); q2 = __uint_as_float(rr[0]) + __uint_as_float(rr[1]); }
    const float* km = kmax2 + (size_t)(((b * 8 + h) * 2 + map) * 128);
    float k2 = __builtin_fmaxf(km[lane], km[64 + lane]);
    k2 = __builtin_fmaxf(k2, swz_xor<1>(k2)); k2 = __builtin_fmaxf(k2, swz_xor<2>(k2)); k2 = __builtin_fmaxf(k2, swz_xor<4>(k2)); k2 = __builtin_fmaxf(k2, swz_xor<8>(k2)); k2 = __builtin_fmaxf(k2, swz_xor<16>(k2));
    { auto rr = __builtin_amdgcn_permlane32_swap(__float_as_uint(k2), __float_as_uint(k2), false, false); k2 = __builtin_fmaxf(__uint_as_float(rr[0]), __uint_as_float(rr[1])); }
    fastp = __all(q2 * k2 <= 8100.f) != 0; }
  float mhat = 0.f, l_reg = 0.f; f32x16 o[4];
  { float z_ = 0.f; asm volatile("" : "+v"(z_));
#pragma unroll
    for (int d_ = 0; d_ < 4; ++d_)
#pragma unroll
      for (int r = 0; r < 16; ++r) o[d_][r] = z_; }
  bool resc = false;
  f32x16 pA0, pA1, pB0, pB1;
  int sl_prev = 0, sl_cur = 0, sl_next = D2_SLOT;
#define ROT() do { sl_prev = sl_cur; sl_cur = sl_next; sl_next = (sl_next == 2 * D2_SLOT) ? 0 : sl_next + D2_SLOT; } while (0)
#define KF(kp, d0, half) (*(const __attribute__((address_space(3))) bf16x8*)((kp) + (d0) * 2048 + (half) * 512))
#define RESC2() do { if (resc) { asm volatile("s_waitcnt lgkmcnt(0)" ::: "memory"); \
      _Pragma("unroll") for (int d_ = 0; d_ < 4; ++d_) _Pragma("unroll") for (int r = 0; r < 16; ++r) o[d_][r] *= wsf[crow(r, hi)]; } } while (0)
  WAIT_BAR2(0);
  { const lds_cptr kp_ = kp0;
    pA0 = __builtin_amdgcn_mfma_f32_32x32x16_bf16(KF(kp_, 0, 0), qr[0], f32x16{}, 0, 0, 0); pA1 = __builtin_amdgcn_mfma_f32_32x32x16_bf16(KF(kp_, 0, 1), qr[0], f32x16{}, 0, 0, 0);
#pragma unroll
    for (int d0 = 1; d0 < 4; ++d0) { pA0 = __builtin_amdgcn_mfma_f32_32x32x16_bf16(KF(kp_, d0, 0), qr[d0], pA0, 0, 0, 0); pA1 = __builtin_amdgcn_mfma_f32_32x32x16_bf16(KF(kp_, d0, 1), qr[d0], pA1, 0, 0, 0); }
    const float rm = fastp ? 0.f : rowmax2(pA0, pA1); mhat = rm;
#pragma unroll
    for (int r = 0; r < 16; ++r) { pA0[r] = __builtin_amdgcn_exp2f(pA0[r] - rm); pA1[r] = __builtin_amdgcn_exp2f(pA1[r] - rm); }
    if (2 < NT) DMA_K(2, 2 * D2_SLOT);
    DMA_V(1, D2_SLOT);
    asm volatile("s_waitcnt lgkmcnt(0)\n\ts_barrier" ::: "memory");
    ROT(); }
  u32x4 pw0, pw1, pw2, pw3;
#define PKW(P, B) cvtpk(P[B], P[B + 1])
#define PAF(k) __builtin_bit_cast(bf16x8, pw##k)
#define MFQ(C, d0, half, first) C = __builtin_amdgcn_mfma_f32_32x32x16_bf16(KF(kp_, d0, half), qr[d0], (first) ? f32x16{} : C, 0, 0, 0)
#define VRD(i) do { vl[(i) & 3] = vtr(vp_ + ((i) & 3) * 4096 + ((i) >> 2) * 1024); vh[(i) & 3] = vtr(vp_ + ((i) & 3) * 4096 + ((i) >> 2) * 1024 + 512); } while (0)
#define VFR(i) (bf16x8){vl[(i) & 3][0], vl[(i) & 3][1], vl[(i) & 3][2], vl[(i) & 3][3], vh[(i) & 3][0], vh[(i) & 3][1], vh[(i) & 3][2], vh[(i) & 3][3]}
#define PIN2(x) asm volatile("" : "+v"(x))
#define EX2(C, B) do { C[B] = __builtin_amdgcn_exp2f(C[B]); C[(B) + 1] = __builtin_amdgcn_exp2f(C[(B) + 1]); asm volatile("" : "+v"(C)); } while (0)
#define KRD(i) kfr[(i) % 3] = KF(kp_, (i) >> 1, (i) & 1)
#define MFK(C, i, first) C = __builtin_amdgcn_mfma_f32_32x32x16_bf16(kfr[(i) % 3], qr[(i) >> 1], (first) ? f32x16{} : C, 0, 0, 0)
#define STEP2(C0, C1, P0, P1, t, GK, GV, MASKED, FAST) do { SBAR2(); \
    const lds_cptr kp_ = kp0 + sl_cur; const lds_cptr vp_ = vp0 + sl_prev; s16x4 vl[4], vh[4]; bf16x8 kfr[3]; \
    KRD(0); KRD(1); SBAR2(); \
    float sacc = P0[0] + P0[1]; \
    KRD(2); MFK(C0, 0, true);  sacc += P0[2]; sacc += P0[3]; sacc += P0[4]; sacc += P0[5]; asm volatile("" : "+v"(sacc));     pw0[0] = PKW(P0, 0); pw0[1] = PKW(P0, 2); SBAR2(); \
    KRD(3); MFK(C1, 1, true);  sacc += P0[6]; sacc += P0[7]; sacc += P0[8]; sacc += P0[9]; asm volatile("" : "+v"(sacc));     pw0[2] = PKW(P0, 4); pw0[3] = PKW(P0, 6); SBAR2(); \
    KRD(4); MFK(C0, 2, false); sacc += P0[10]; sacc += P0[11]; sacc += P0[12]; sacc += P0[13]; asm volatile("" : "+v"(sacc)); pw1[0] = PKW(P0, 8); pw1[1] = PKW(P0, 10); SBAR2(); \
    KRD(5); MFK(C1, 3, false); sacc += P0[14]; sacc += P0[15]; sacc += P1[0]; sacc += P1[1]; asm volatile("" : "+v"(sacc));   pw1[2] = PKW(P0, 12); pw1[3] = PKW(P0, 14); SBAR2(); \
    KRD(6); MFK(C0, 4, false); sacc += P1[2]; sacc += P1[3]; sacc += P1[4]; sacc += P1[5]; asm volatile("" : "+v"(sacc));     pw2[0] = PKW(P1, 0); pw2[1] = PKW(P1, 2); SBAR2(); \
    KRD(7); MFK(C1, 5, false); sacc += P1[6]; sacc += P1[7]; sacc += P1[8]; sacc += P1[9]; asm volatile("" : "+v"(sacc));     pw2[2] = PKW(P1, 4); pw2[3] = PKW(P1, 6); SBAR2(); \
    VRD(0); MFK(C0, 6, false); sacc += P1[10]; sacc += P1[11]; sacc += P1[12]; sacc += P1[13]; asm volatile("" : "+v"(sacc)); pw3[0] = PKW(P1, 8); pw3[1] = PKW(P1, 10); SBAR2(); \
    VRD(1); MFK(C1, 7, false); sacc += P1[14]; sacc += P1[15]; asm volatile("" : "+v"(sacc));                                 pw3[2] = PKW(P1, 12); pw3[3] = PKW(P1, 14); SBAR2(); \
    VRD(2); \
    l_reg += sacc; \
    if ((GK) && !nodma_) { DMA_K((t) + 2, sl_prev); } if ((GV) && !nodma_) { DMA_V((t) + 1, sl_next); } \
    if (MASKED) { _Pragma("unroll") for (int r = 0; r < 16; ++r) { C0[r] = -1e30f; C1[r] = -1e30f; } } \
    if (FAST) { resc = false; \
    SBAR2(); \
    VRD(3); o[0] = __builtin_amdgcn_mfma_f32_32x32x16_bf16(PAF(0), VFR(0), o[0], 0, 0, 0); C0[0] = __builtin_amdgcn_exp2f(C0[0]); C0[1] = __builtin_amdgcn_exp2f(C0[1]); PIN2(C0); SBAR2(); \
    VRD(4); o[1] = __builtin_amdgcn_mfma_f32_32x32x16_bf16(PAF(0), VFR(1), o[1], 0, 0, 0); C0[2] = __builtin_amdgcn_exp2f(C0[2]); C0[3] = __builtin_amdgcn_exp2f(C0[3]); PIN2(C0); SBAR2(); \
    VRD(5); o[2] = __builtin_amdgcn_mfma_f32_32x32x16_bf16(PAF(0), VFR(2), o[2], 0, 0, 0); C0[4] = __builtin_amdgcn_exp2f(C0[4]); C0[5] = __builtin_amdgcn_exp2f(C0[5]); PIN2(C0); SBAR2(); \
    VRD(6); o[3] = __builtin_amdgcn_mfma_f32_32x32x16_bf16(PAF(0), VFR(3), o[3], 0, 0, 0); C0[6] = __builtin_amdgcn_exp2f(C0[6]); C0[7] = __builtin_amdgcn_exp2f(C0[7]); PIN2(C0); SBAR2(); \
    VRD(7); o[0] = __builtin_amdgcn_mfma_f32_32x32x16_bf16(PAF(1), VFR(4), o[0], 0, 0, 0); C0[8] = __builtin_amdgcn_exp2f(C0[8]); C0[9] = __builtin_amdgcn_exp2f(C0[9]); PIN2(C0); SBAR2(); \
    VRD(8); o[1] = __builtin_amdgcn_mfma_f32_32x32x16_bf16(PAF(1), VFR(5), o[1], 0, 0, 0); C0[10] = __builtin_amdgcn_exp2f(C0[10]); C0[11] = __builtin_amdgcn_exp2f(C0[11]); PIN2(C0); SBAR2(); \
    VRD(9); o[2] = __builtin_amdgcn_mfma_f32_32x32x16_bf16(PAF(1), VFR(6), o[2], 0, 0, 0); C0[12] = __builtin_amdgcn_exp2f(C0[12]); C0[13] = __builtin_amdgcn_exp2f(C0[13]); PIN2(C0); SBAR2(); \
    VRD(10); o[3] = __builtin_amdgcn_mfma_f32_32x32x16_bf16(PAF(1), VFR(7), o[3], 0, 0, 0); C0[14] = __builtin_amdgcn_exp2f(C0[14]); C0[15] = __builtin_amdgcn_exp2f(C0[15]); PIN2(C0); SBAR2(); \
    VRD(11); o[0] = __builtin_amdgcn_mfma_f32_32x32x16_bf16(PAF(2), VFR(8), o[0], 0, 0, 0); C1[0] = __builtin_amdgcn_exp2f(C1[0]); C1[1] = __builtin_amdgcn_exp2f(C1[1]); PIN2(C1); SBAR2(); \
    VRD(12); o[1] = __builtin_amdgcn_mfma_f32_32x32x16_bf16(PAF(2), VFR(9), o[1], 0, 0, 0); C1[2] = __builtin_amdgcn_exp2f(C1[2]); C1[3] = __builtin_amdgcn_exp2f(C1[3]); PIN2(C1); SBAR2(); \
    VRD(13); o[2] = __builtin_amdgcn_mfma_f32_32x32x16_bf16(PAF(2), VFR(10), o[2], 0, 0, 0); C1[4] = __builtin_amdgcn_exp2f(C1[4]); C1[5] = __builtin_amdgcn_exp2f(C1[5]); PIN2(C1); SBAR2(); \
    VRD(14); o[3] = __builtin_amdgcn_mfma_f32_32x32x16_bf16(PAF(2), VFR(11), o[3], 0, 0, 0); C1[6] = __builtin_amdgcn_exp2f(C1[6]); C1[7] = __builtin_amdgcn_exp2f(C1[7]); PIN2(C1); SBAR2(); \
    VRD(15); o[0] = __builtin_amdgcn_mfma_f32_32x32x16_bf16(PAF(3), VFR(12), o[0], 0, 0, 0); C1[8] = __builtin_amdgcn_exp2f(C1[8]); C1[9] = __builtin_amdgcn_exp2f(C1[9]); PIN2(C1); SBAR2(); \
    o[1] = __builtin_amdgcn_mfma_f32_32x32x16_bf16(PAF(3), VFR(13), o[1], 0, 0, 0); C1[10] = __builtin_amdgcn_exp2f(C1[10]); C1[11] = __builtin_amdgcn_exp2f(C1[11]); PIN2(C1); SBAR2(); \
    o[2] = __builtin_amdgcn_mfma_f32_32x32x16_bf16(PAF(3), VFR(14), o[2], 0, 0, 0); C1[12] = __builtin_amdgcn_exp2f(C1[12]); C1[13] = __builtin_amdgcn_exp2f(C1[13]); PIN2(C1); SBAR2(); \
    o[3] = __builtin_amdgcn_mfma_f32_32x32x16_bf16(PAF(3), VFR(15), o[3], 0, 0, 0); C1[14] = __builtin_amdgcn_exp2f(C1[14]); C1[15] = __builtin_amdgcn_exp2f(C1[15]); PIN2(C1); SBAR2(); \
    } else { \
    SBAR2(); float ra_, rb_; \
    VRD(3); o[0] = __builtin_amdgcn_mfma_f32_32x32x16_bf16(PAF(0), VFR(0), o[0], 0, 0, 0); ra_ = max3f(C0[0], C0[1], C1[0]); rb_ = max3f(C0[2], C0[3], C1[1]); ra_ = max3f(ra_, C1[2], C1[3]); ra_ = max3f(ra_, C0[4], C0[5]); rb_ = max3f(rb_, C0[6], C0[7]); ra_ = max3f(ra_, C1[4], C1[5]); rb_ = max3f(rb_, C1[6], C1[7]); PIN2(ra_); PIN2(rb_); SBAR2(); \
    VRD(4); o[1] = __builtin_amdgcn_mfma_f32_32x32x16_bf16(PAF(0), VFR(1), o[1], 0, 0, 0); ra_ = max3f(ra_, C0[8], C0[9]); rb_ = max3f(rb_, C0[10], C0[11]); ra_ = max3f(ra_, C1[8], C1[9]); rb_ = max3f(rb_, C1[10], C1[11]); ra_ = max3f(ra_, C0[12], C0[13]); rb_ = max3f(rb_, C0[14], C0[15]); ra_ = max3f(ra_, C1[12], C1[13]); rb_ = max3f(rb_, C1[14], C1[15]); PIN2(ra_); PIN2(rb_); SBAR2(); \
    VRD(5); o[2] = __builtin_amdgcn_mfma_f32_32x32x16_bf16(PAF(0), VFR(2), o[2], 0, 0, 0); { float rm = __builtin_fmaxf(ra_, rb_); { auto rr = __builtin_amdgcn_permlane32_swap(__float_as_uint(rm), __float_as_uint(rm), false, false); rm = __builtin_fmaxf(__uint_as_float(rr[0]), __uint_as_float(rr[1])); } rm -= mhat; resc = false; \
      if (__builtin_expect(__any(rm > THR2), 0)) { const float dl = __builtin_fmaxf(rm, 0.f); mhat += dl; const float f = __builtin_amdgcn_exp2f(-dl); l_reg *= f; if (hi == 0) wsf[r32] = f; resc = true; } } SBAR2(); \
    VRD(6); o[3] = __builtin_amdgcn_mfma_f32_32x32x16_bf16(PAF(0), VFR(3), o[3], 0, 0, 0); _Pragma("unroll") for (int r = 0; r < 16; ++r) C0[r] -= mhat; PIN2(C0); SBAR2(); \
    VRD(7); o[0] = __builtin_amdgcn_mfma_f32_32x32x16_bf16(PAF(1), VFR(4), o[0], 0, 0, 0); _Pragma("unroll") for (int r = 0; r < 16; ++r) C1[r] -= mhat; PIN2(C1); SBAR2(); \
    VRD(8); o[1] = __builtin_amdgcn_mfma_f32_32x32x16_bf16(PAF(1), VFR(5), o[1], 0, 0, 0); C0[0] = __builtin_amdgcn_exp2f(C0[0]); C0[1] = __builtin_amdgcn_exp2f(C0[1]); C0[2] = __builtin_amdgcn_exp2f(C0[2]); PIN2(C0); SBAR2(); \
    VRD(9); o[2] = __builtin_amdgcn_mfma_f32_32x32x16_bf16(PAF(1), VFR(6), o[2], 0, 0, 0); C0[3] = __builtin_amdgcn_exp2f(C0[3]); C0[4] = __builtin_amdgcn_exp2f(C0[4]); C0[5] = __builtin_amdgcn_exp2f(C0[5]); PIN2(C0); SBAR2(); \
    VRD(10); o[3] = __builtin_amdgcn_mfma_f32_32x32x16_bf16(PAF(1), VFR(7), o[3], 0, 0, 0); C0[6] = __builtin_amdgcn_exp2f(C0[6]); C0[7] = __builtin_amdgcn_exp2f(C0[7]); C0[8] = __builtin_amdgcn_exp2f(C0[8]); PIN2(C0); SBAR2(); \
    VRD(11); o[0] = __builtin_amdgcn_mfma_f32_32x32x16_bf16(PAF(2), VFR(8), o[0], 0, 0, 0); C0[9] = __builtin_amdgcn_exp2f(C0[9]); C0[10] = __builtin_amdgcn_exp2f(C0[10]); C0[11] = __builtin_amdgcn_exp2f(C0[11]); PIN2(C0); SBAR2(); \
    VRD(12); o[1] = __builtin_amdgcn_mfma_f32_32x32x16_bf16(PAF(2), VFR(9), o[1], 0, 0, 0); C0[12] = __builtin_amdgcn_exp2f(C0[12]); C0[13] = __builtin_amdgcn_exp2f(C0[13]); C0[14] = __builtin_amdgcn_exp2f(C0[14]); PIN2(C0); SBAR2(); \
    VRD(13); o[2] = __builtin_amdgcn_mfma_f32_32x32x16_bf16(PAF(2), VFR(10), o[2], 0, 0, 0); C0[15] = __builtin_amdgcn_exp2f(C0[15]); C1[0] = __builtin_amdgcn_exp2f(C1[0]); C1[1] = __builtin_amdgcn_exp2f(C1[1]); PIN2(C0); PIN2(C1); SBAR2(); \
    VRD(14); o[3] = __builtin_amdgcn_mfma_f32_32x32x16_bf16(PAF(2), VFR(11), o[3], 0, 0, 0); C1[2] = __builtin_amdgcn_exp2f(C1[2]); C1[3] = __builtin_amdgcn_exp2f(C1[3]); C1[4] = __builtin_amdgcn_exp2f(C1[4]); PIN2(C1); SBAR2(); \
    VRD(15); o[0] = __builtin_amdgcn_mfma_f32_32x32x16_bf16(PAF(3), VFR(12), o[0], 0, 0, 0); C1[5] = __builtin_amdgcn_exp2f(C1[5]); C1[6] = __builtin_amdgcn_exp2f(C1[6]); C1[7] = __builtin_amdgcn_exp2f(C1[7]); PIN2(C1); SBAR2(); \
    o[1] = __builtin_amdgcn_mfma_f32_32x32x16_bf16(PAF(3), VFR(13), o[1], 0, 0, 0); C1[8] = __builtin_amdgcn_exp2f(C1[8]); C1[9] = __builtin_amdgcn_exp2f(C1[9]); C1[10] = __builtin_amdgcn_exp2f(C1[10]); PIN2(C1); SBAR2(); \
    o[2] = __builtin_amdgcn_mfma_f32_32x32x16_bf16(PAF(3), VFR(14), o[2], 0, 0, 0); C1[11] = __builtin_amdgcn_exp2f(C1[11]); C1[12] = __builtin_amdgcn_exp2f(C1[12]); C1[13] = __builtin_amdgcn_exp2f(C1[13]); PIN2(C1); SBAR2(); \
    o[3] = __builtin_amdgcn_mfma_f32_32x32x16_bf16(PAF(3), VFR(15), o[3], 0, 0, 0); C1[14] = __builtin_amdgcn_exp2f(C1[14]); C1[15] = __builtin_amdgcn_exp2f(C1[15]); PIN2(C1); SBAR2(); \
    } \
  } while (0)
#define TILE_LOOP(FAST) do { int t = 1; \
  for (; t + 3 < NT; t += 2) { \
    STEP2(pB0, pB1, pA0, pA1, t, true, true, false, FAST);     WAIT_BAR2(4); RESC2(); ROT(); \
    STEP2(pA0, pA1, pB0, pB1, t + 1, true, true, false, FAST); WAIT_BAR2(4); RESC2(); ROT(); \
  } \
  if (NT >= 4) { \
    STEP2(pB0, pB1, pA0, pA1, t, true, true, false, FAST);      WAIT_BAR2(4); RESC2(); ROT(); \
    STEP2(pA0, pA1, pB0, pB1, t + 1, false, true, false, FAST); WAIT_BAR2(2); RESC2(); ROT(); \
    t += 2; \
  } \
  { const bool msk_ = (wq < 2); STEP2(pB0, pB1, pA0, pA1, t, false, false, msk_, FAST); } \
  WAIT_BAR2(0); RESC2(); ROT(); } while (0)
  if (fastp) TILE_LOOP(true); else TILE_LOOP(false);
#undef TILE_LOOP
  { float sacc = pB0[0] + pB0[1];
#pragma unroll
    for (int r = 2; r < 16; ++r) sacc += pB0[r];
#pragma unroll
    for (int r = 0; r < 16; ++r) sacc += pB1[r];
    l_reg += sacc;
    pw0 = (u32x4){PKW(pB0, 0), PKW(pB0, 2), PKW(pB0, 4), PKW(pB0, 6)}; pw1 = (u32x4){PKW(pB0, 8), PKW(pB0, 10), PKW(pB0, 12), PKW(pB0, 14)};
    pw2 = (u32x4){PKW(pB1, 0), PKW(pB1, 2), PKW(pB1, 4), PKW(pB1, 6)}; pw3 = (u32x4){PKW(pB1, 8), PKW(pB1, 10), PKW(pB1, 12), PKW(pB1, 14)};
    const lds_cptr vp_ = vp0 + sl_prev; s16x4 vl[4], vh[4];
#pragma unroll
    for (int ks = 0; ks < 4; ++ks) {
#pragma unroll
      for (int d0 = 0; d0 < 4; ++d0) { vl[d0] = vtr(vp_ + d0 * 4096 + ks * 1024); vh[d0] = vtr(vp_ + d0 * 4096 + ks * 1024 + 512); }
      const bf16x8 pa = (ks == 0) ? PAF(0) : (ks == 1) ? PAF(1) : (ks == 2) ? PAF(2) : PAF(3);
#pragma unroll
      for (int d0 = 0; d0 < 4; ++d0) o[d0] = __builtin_amdgcn_mfma_f32_32x32x16_bf16(pa, (bf16x8){vl[d0][0], vl[d0][1], vl[d0][2], vl[d0][3], vh[d0][0], vh[d0][1], vh[d0][2], vh[d0][3]}, o[d0], 0, 0, 0); }
  }
  int lane_e; asm volatile("v_mbcnt_lo_u32_b32 %0, -1, 0\n\tv_mbcnt_hi_u32_b32 %0, -1, %0" : "=v"(lane_e));
  const int r32e = lane_e & 31, hie = lane_e >> 5;
  { auto rr = __builtin_amdgcn_permlane32_swap(__float_as_uint(l_reg), __float_as_uint(l_reg), false, false); l_reg = __uint_as_float(rr[0]) + __uint_as_float(rr[1]); }
  if (hie == 0) wsf[32 + r32e] = l_reg; asm volatile("s_waitcnt lgkmcnt(0)" ::: "memory");
  float rli[16];
#pragma unroll
  for (int r = 0; r < 16; ++r) rli[r] = __builtin_amdgcn_rcpf(wsf[32 + crow(r, hie)]);
  __syncthreads();
  float* xch = (float*)shm + (size_t)wq * 4096;
  if (map == 1) {
#pragma unroll
    for (int d0 = 0; d0 < 4; ++d0)
#pragma unroll
      for (int r = 0; r < 16; ++r) xch[(d0 * 16 + r) * 64 + lane_e] = o[d0][r] * rli[r] * lam;
  }
  __syncthreads();
  if (map == 0) {
    float ss[16];
#pragma unroll
    for (int r = 0; r < 16; ++r) { float s = 0.f;
#pragma unroll
      for (int d0 = 0; d0 < 4; ++d0) { const float v = o[d0][r] * rli[r] - xch[(d0 * 16 + r) * 64 + lane_e]; o[d0][r] = v; s += v * v; }
      ss[r] = s; }
#pragma unroll
    for (int r = 0; r < 16; ++r) ss[r] = half_sum32(ss[r]);
    float gv[4];
#pragma unroll
    for (int d0 = 0; d0 < 4; ++d0) gv[d0] = gdiff[d0 * 32 + r32e] * oscale;
#pragma unroll
    for (int r = 0; r < 16; ++r) { const float rs = rsqrtf(ss[r] * (1.f / 128.f) + 1e-6f);
#pragma unroll
      for (int d0 = 0; d0 < 4; ++d0) o[d0][r] = o[d0][r] * rs * gv[d0]; }
    store_o_tile(o, Oout + (rowb + qb * 128 + wq * 32) * LDO + 1024 + h * 128, (char*)xch, lane_e);
  }
#undef DMA_K
#undef DMA_V
#undef ROT
#undef KF
#undef RESC2
#undef PKW
#undef PAF
#undef MFQ
#undef KRD
#undef MFK
#undef VRD
#undef VFR
#undef EX2
#undef PIN2
#undef STEP2
}
#undef SBAR2
#undef WAIT_BAR2
}
constexpr int NWAVES = 8;
constexpr int BATCH = 4, SEQ = 8192, DM = 2048, NTOK = BATCH * SEQ;
constexpr int QKVC = 6144, NEXP = 32, DEXP = 512, PLED = 256, LCAP = 65536;
constexpr float EPS = 1e-6f;
constexpr int LDA1 = DM + 64, LDQ = QKVC + 64, LDW = DM + 64, LDP = PLED + 64, LDH = DEXP + 64;
constexpr float QSCALE_SB = 0.08838834764831845f * 1.4426950408889634f;
constexpr float QSCALE_DF = 0.125f * 1.4426950408889634f;
constexpr size_t MiB = 1u << 20;
constexpr size_t WS_CTL = 0, CTL_ZERO_BYTES = 1 * MiB;
constexpr size_t WS_ROPE = 1 * MiB;
constexpr size_t WS_WRT = 1 * MiB + 512 * 1024;
constexpr size_t WS_WIN = 2 * MiB;
constexpr size_t WS_WOUT = 27 * MiB;
constexpr size_t WS_WPG = 36 * MiB;
constexpr size_t WS_WPLE = 45 * MiB;
constexpr size_t WS_WGU = 47 * MiB;
constexpr size_t WS_WD = 179 * MiB;
constexpr size_t WS_LSLOT = 251 * MiB;
constexpr size_t WS_LGATE = 259 * MiB;
constexpr size_t WS_PB = 267 * MiB;
constexpr size_t WS_A1 = 287 * MiB;
constexpr size_t WS_QKV = 419 * MiB;
constexpr size_t WS_Y = WS_QKV;
constexpr size_t WS_H = WS_QKV + 288 * MiB;
constexpr size_t WS_U = 815 * MiB;
constexpr size_t WS_LRSTD = 944 * MiB;
constexpr size_t WS_RSTD2 = 952 * MiB;
constexpr size_t WS_END = 953 * MiB;
static_assert(WS_WIN + (size_t)QKVC * LDW * 2 <= WS_WOUT && WS_WOUT + (size_t)DM * LDW * 2 <= WS_WPG && WS_WPG + (size_t)DM * LDW * 2 <= WS_WPLE && WS_WPLE + (size_t)DM * LDP * 2 <= WS_WGU, "ws map 1");
static_assert(WS_WGU + (size_t)32 * 1024 * LDW * 2 <= WS_WD && WS_WD + (size_t)32 * DM * LDH * 2 <= WS_LSLOT && WS_PB + (size_t)NTOK * LDP * 2 <= WS_A1 && WS_A1 + (size_t)NTOK * LDA1 * 2 <= WS_QKV, "ws map 2");
static_assert(WS_QKV + (size_t)96 * NTOK * 64 * 2 <= WS_U && WS_H + (size_t)73728 * LDH * 2 <= WS_U && WS_Y + (size_t)2 * NTOK * DM * 2 <= WS_H, "ws map 3");
constexpr int CW_TMO = 0, CW_CODE = 1;
constexpr int CW_BAR = 4096;
constexpr int CW_CNT = 16384;
constexpr int RING_OFF = 0, RING_BYTES = 131072;
constexpr int LDSCTL_OFF = RING_BYTES;
constexpr int TST_OFF = LDSCTL_OFF;
constexpr int CNT_OFF = LDSCTL_OFF + 160;
constexpr int MISC_OFF = LDSCTL_OFF + 320;
constexpr int ESCR_OFF = LDSCTL_OFF + 1024;
constexpr int LDS_BYTES = 151552;

#define GAS __attribute__((address_space(1)))
#define LAS __attribute__((address_space(3)))
typedef unsigned short bf16;
typedef unsigned v4u __attribute__((ext_vector_type(4)));
typedef unsigned v2u __attribute__((ext_vector_type(2)));
typedef float f32x4 __attribute__((ext_vector_type(4)));
typedef GAS unsigned gu32;
#define RLX_AGENT __ATOMIC_RELAXED, __HIP_MEMORY_SCOPE_AGENT
#define LDS_WAIT() asm volatile("s_waitcnt lgkmcnt(0)" ::: "memory")
#define VM_WAIT() asm volatile("s_waitcnt vmcnt(0)" ::: "memory")
__device__ __forceinline__ unsigned pk2(float lo, float hi) { return pg8::cvt_pk_bf16(lo, hi); }
#define XB_TMO      128
#define XB_XCNT(j)  (256  + 64 * (j))
#define XB_XSUB(j)  (1280 + 64 * (j))
#define XB_XGEN(j)  (2304 + 64 * (j))
#define XB_TOP      3328
#define XB_TOPGEN   3392
#define XCD_BAR_WORDS 3456
#define XB_SPIN_CAP (1u << 18)

__device__ __forceinline__ unsigned xb_ld(unsigned* p)              { return __hip_atomic_load(p, __ATOMIC_RELAXED, __HIP_MEMORY_SCOPE_AGENT); }
__device__ __forceinline__ unsigned xb_add(unsigned* p, unsigned v) { return __hip_atomic_fetch_add(p, v, __ATOMIC_RELAXED, __HIP_MEMORY_SCOPE_AGENT); }
__device__ __forceinline__ unsigned xb_xcc_id() { return (unsigned)__builtin_amdgcn_s_getreg((3 << 11) | 20) & 0xFu; }
#define XB_SPIN(cond, bar) do { unsigned _sp = 0; while (cond) { __builtin_amdgcn_s_sleep(1); \
    if ((++_sp & 255u) == 0u) { if (xb_ld(&(bar)[XB_TMO])) break; if (_sp > XB_SPIN_CAP) { atomicAdd(&(bar)[XB_TMO], 1u); break; } } } } while (0)

struct XcdBarrier {
    unsigned* bar; unsigned x;
    volatile LAS unsigned* st;
};

__device__ __forceinline__ XcdBarrier xcd_barrier_post(unsigned* bar, volatile LAS unsigned* st, bool leader) {
    XcdBarrier b; b.bar = bar; b.x = xb_xcc_id(); b.st = st;
    if (leader) (void)xb_add(&bar[XB_XCNT(b.x)], 1u);
    return b;
}
__device__ __forceinline__ void xcd_barrier_complete(unsigned* bar, unsigned x, unsigned& nloc, unsigned& nx) {
    const unsigned G = gridDim.x * gridDim.y * gridDim.z;
    unsigned sum, cnt, mine, sp = 0u;
    for (;;) {
        sum = 0u; cnt = 0u; mine = 0u;
#pragma unroll
        for (unsigned j = 0; j < 16; ++j) { const unsigned c = xb_ld(&bar[XB_XCNT(j)]); sum += c; cnt += (c > 0u) ? 1u : 0u; mine = (j == x) ? c : mine; }
        if (sum == G) break;
        __builtin_amdgcn_s_sleep(1);
        if ((++sp & 255u) == 0u) { if (xb_ld(&bar[XB_TMO])) break; if (sp > XB_SPIN_CAP) { atomicAdd(&bar[XB_TMO], 1u); break; } }
    }
    nloc = mine > 0u ? mine : 1u; nx = cnt > 0u ? cnt : 1u;
}

__device__ __forceinline__ void xcd_barrier(const XcdBarrier& b, int wave) {
    FRESH_LANE(xl_); const bool leader = (wave == 0) && (xl_ == 0);
    asm volatile("s_waitcnt vmcnt(0)" ::: "memory");
    __syncthreads();
    if (leader) {
        unsigned* bar = b.bar;
        __builtin_amdgcn_s_waitcnt(0);
        unsigned nloc = b.st[0], nx = b.st[1];
        if (nloc == 0u) { xcd_barrier_complete(bar, b.x, nloc, nx); b.st[0] = nloc; b.st[1] = nx; }
        const unsigned old = xb_add(&bar[XB_XSUB(b.x)], 1u);
        const unsigned gen = old / nloc;
        if (old + 1u == (gen + 1u) * nloc) {
            __builtin_amdgcn_fence(__ATOMIC_RELEASE, "agent");
            asm volatile("s_waitcnt vmcnt(0)" ::: "memory");
            const unsigned og = xb_add(&bar[XB_TOP], 1u);
            const unsigned tg = og / nx;
            if (og + 1u == (tg + 1u) * nx) xb_add(&bar[XB_TOPGEN], 1u);
            else XB_SPIN(xb_ld(&bar[XB_TOPGEN]) == tg, bar);
            __builtin_amdgcn_fence(__ATOMIC_ACQUIRE, "agent");
            xb_add(&bar[XB_XGEN(b.x)], 1u);
            asm volatile("s_waitcnt vmcnt(0)" ::: "memory");
        } else {
            XB_SPIN(xb_ld(&bar[XB_XGEN(b.x)]) == gen, bar);
            __builtin_amdgcn_fence(__ATOMIC_ACQUIRE, "agent");
            asm volatile("s_waitcnt vmcnt(0)" ::: "memory");
        }
    }
    __syncthreads();
}
struct Frame {
    LAS unsigned char* lds;
    volatile LAS unsigned* MISC;
    gu32* ctl;
    int tid, lane, wave;
    int vcu, G;
};
__device__ __forceinline__ float wave_sum(float v) { return wave_sum_(v); }
__device__ __forceinline__ void tr_item(const float* W, int ldw, int k0, int n0, bf16* dst, int dpitch, float scale, LAS float* scr, int lane, const float* gk = nullptr) {
    { f32x4 t[8]; const int kr = lane >> 3, nc = 4 * (lane & 7);
#pragma unroll
      for (int i = 0; i < 8; ++i) t[i] = *(const GAS f32x4*)(W + (size_t)(k0 + kr + 8 * i) * ldw + n0 + nc);
#pragma unroll
      for (int i = 0; i < 8; ++i) { LAS float* d = scr + (kr + 8 * i) * 33 + nc; d[0] = t[i].x; d[1] = t[i].y; d[2] = t[i].z; d[3] = t[i].w; } }
    LDS_WAIT(); asm volatile("" ::: "memory");
    const int c = lane & 7;
    float sk[8];
#pragma unroll
    for (int t = 0; t < 8; ++t) sk[t] = gk ? scale * gk[k0 + 8 * c + t] : scale;
#pragma unroll
    for (int j = 0; j < 4; ++j) { const int n = (lane >> 3) + 8 * j; const LAS float* s = scr + (8 * c) * 33 + n;
        v4u o; o.x = pk2(s[0 * 33] * sk[0], s[1 * 33] * sk[1]); o.y = pk2(s[2 * 33] * sk[2], s[3 * 33] * sk[3]); o.z = pk2(s[4 * 33] * sk[4], s[5 * 33] * sk[5]); o.w = pk2(s[6 * 33] * sk[6], s[7 * 33] * sk[7]);
        *(GAS v4u*)(dst + (size_t)n * dpitch + 8 * c) = o; }
    LDS_WAIT(); asm volatile("" ::: "memory");
}
struct ConvDesc { const float* W; int ldw, k0, n0; bf16* dst; int dpitch; float scale; const float* gk; };
__device__ __forceinline__ void tr_load(const ConvDesc& d, f32x4 (&t)[8], f32x4 (&gq)[2], int lane) { const int kr = lane >> 3, nc = 4 * (lane & 7);
#pragma unroll
    for (int i = 0; i < 8; ++i) t[i] = *(const GAS f32x4*)(d.W + (size_t)(d.k0 + kr + 8 * i) * d.ldw + d.n0 + nc);
    if (d.gk) { const GAS f32x4* gp = (const GAS f32x4*)(d.gk + d.k0 + 8 * (lane & 7)); gq[0] = gp[0]; gq[1] = gp[1]; }
    else { gq[0] = (f32x4){1.f, 1.f, 1.f, 1.f}; gq[1] = gq[0]; } }
__device__ __forceinline__ void tr_finish(const ConvDesc& d, const f32x4 (&t)[8], const f32x4 (&gq)[2], LAS float* scr, int lane) { const int kr = lane >> 3, nc = 4 * (lane & 7);
#pragma unroll
    for (int i = 0; i < 8; ++i) { LAS float* q = scr + (kr + 8 * i) * 33 + nc; q[0] = t[i].x; q[1] = t[i].y; q[2] = t[i].z; q[3] = t[i].w; }
    LDS_WAIT(); asm volatile("" ::: "memory");
    const int c = lane & 7;
    float sk[8];
#pragma unroll
    for (int u = 0; u < 8; ++u) sk[u] = d.scale * gq[u >> 2][u & 3];
#pragma unroll
    for (int j = 0; j < 4; ++j) { const int n = (lane >> 3) + 8 * j; const LAS float* q = scr + (8 * c) * 33 + n;
        v4u o; o.x = pk2(q[0 * 33] * sk[0], q[1 * 33] * sk[1]); o.y = pk2(q[2 * 33] * sk[2], q[3 * 33] * sk[3]); o.z = pk2(q[4 * 33] * sk[4], q[5 * 33] * sk[5]); o.w = pk2(q[6 * 33] * sk[6], q[7 * 33] * sk[7]);
        *(GAS v4u*)(d.dst + (size_t)n * d.dpitch + 8 * c) = o; }
    LDS_WAIT(); asm volatile("" ::: "memory");
}
__device__ __forceinline__ void rms_row_to_bf16(const float* xrow, float* invr, bf16* orow, int lane) {
    const GAS f32x4* xr = (const GAS f32x4*)xrow + lane;
    f32x4 v[8]; float s = 0.f;
#pragma unroll
    for (int j = 0; j < 8; ++j) { v[j] = xr[64 * j]; s += (v[j].x * v[j].x + v[j].y * v[j].y) + (v[j].z * v[j].z + v[j].w * v[j].w); }
    const float rstd = rsqrtf(wave_sum(s) * (1.f / DM) + EPS);
    GAS v2u* o8 = (GAS v2u*)orow + lane;
#pragma unroll
    for (int j = 0; j < 8; ++j) { v2u w; w.x = pk2(v[j].x * rstd, v[j].y * rstd); w.y = pk2(v[j].z * rstd, v[j].w * rstd); o8[64 * j] = w; }
    if (lane == 0) *invr = 1.f / rstd;
}

__device__ __forceinline__ void unpack8(const v4u w, float (&f)[8]) {
#pragma unroll
    for (int q = 0; q < 4; ++q) { f[2 * q] = pg8::bf_lo(w[q]); f[2 * q + 1] = pg8::bf_hi(w[q]); }
}
struct Args { const float* in[21]; float* out; unsigned char* ws; int ph_lo, ph_hi; };


#define x_ (args.in[0])
#define p_in (args.in[1])
#define g_attn (args.in[2])
#define w_in (args.in[3])
#define g_sb (args.in[4])
#define g_diff (args.in[5])
#define lam_q1 (args.in[6])
#define lam_k1 (args.in[7])
#define lam_q2 (args.in[8])
#define lam_k2 (args.in[9])
#define w_out (args.in[10])
#define g_moe (args.in[11])
#define w_rg (args.in[12])
#define w_re (args.in[13])
#define w_gate (args.in[14])
#define w_up (args.in[15])
#define w_down (args.in[16])
#define g_ple (args.in[17])
#define w_ple (args.in[18])
#define w_pg (args.in[19])
#define g_final (args.in[20])
#define rope ((float*)(ws + WS_ROPE))
#define wrhl ((bf16*)(ws + WS_WRT))
#define LRSTD ((float*)(ws + WS_LRSTD))
#define RSTD2 ((float*)(ws + WS_RSTD2))
#define WIN ((bf16*)(ws + WS_WIN))
#define WOUT ((bf16*)(ws + WS_WOUT))
#define WPG ((bf16*)(ws + WS_WPG))
#define WPLE ((bf16*)(ws + WS_WPLE))
#define WGU ((bf16*)(ws + WS_WGU))
#define WD ((bf16*)(ws + WS_WD))
#define LSLOT ((int*)(ws + WS_LSLOT))
#define LGATE ((float*)(ws + WS_LGATE))
#define PB ((bf16*)(ws + WS_PB))
#define A1 ((bf16*)(ws + WS_A1))
#define QKV ((bf16*)(ws + WS_QKV))
#define HB ((bf16*)(ws + WS_H))
#define YB ((bf16*)(ws + WS_Y))
#define UB ((bf16*)out)
#define INVR RSTD2
#define OB ((bf16*)out)
#define H1B ((bf16*)(ws + WS_U))
#define ecnt (F.ctl + CW_CNT)
constexpr int I_IN = 32 * 192, I_OUT = 32 * 64, I_PG = 32 * 64, I_PLE = 4 * 64, I_G = 32 * 32 * 16, I_U = I_G, I_D = 32 * 8 * 64;
constexpr int NITEMS = I_IN + I_OUT + I_PG + I_PLE + I_G + I_U + I_D, NCV = 3;
#define CONV_DECODE(it_, d) do { int r = (it_); \
            if (r < I_IN) { const int kb = r / 192, nb = r % 192, n0 = 32 * nb, k0 = 64 * kb; const float sc = (n0 < 1024) ? QSCALE_SB : ((n0 >= 3072 && n0 < 4096) ? QSCALE_DF : 1.f); \
                d = ConvDesc{w_in, QKVC, k0, n0, WIN + (size_t)n0 * LDW + k0, LDW, sc, g_attn}; break; } r -= I_IN; \
            if (r < I_OUT) { const int kb = r / 64, nb = r % 64; d = ConvDesc{w_out, DM, 64 * kb, 32 * nb, WOUT + (size_t)(32 * nb) * LDW + 64 * kb, LDW, 1.f, nullptr}; break; } r -= I_OUT; \
            if (r < I_PG) { const int kb = r / 64, nb = r % 64; d = ConvDesc{w_pg, DM, 64 * kb, 32 * nb, WPG + (size_t)(32 * nb) * LDW + 64 * kb, LDW, 1.f, g_ple}; break; } r -= I_PG; \
            if (r < I_PLE) { const int kb = r / 64, nb = r % 64; d = ConvDesc{w_ple, DM, 64 * kb, 32 * nb, WPLE + (size_t)(32 * nb) * LDP + 64 * kb, LDP, 1.f, nullptr}; break; } r -= I_PLE; \
            if (r < I_G + I_U) { const bool isu = r >= I_G; if (isu) r -= I_G; const int e = r / 512, q = r % 512, kb = q / 16, nb = q % 16, n0 = 32 * nb, k0 = 64 * kb; \
                const int drow = e * 1024 + (n0 >> 7) * 256 + ((n0 & 127) >> 5) * 64 + (isu ? 32 : 0); \
                d = ConvDesc{(isu ? w_up : w_gate) + (size_t)e * DM * DEXP, DEXP, k0, n0, WGU + (size_t)drow * LDW + k0, LDW, 1.f, g_moe}; break; } r -= I_G + I_U; \
            { const int e = r / 512, q = r % 512, kb = q / 64, nb = q % 64, n0 = 32 * nb, k0 = 64 * kb; \
                d = ConvDesc{w_down + (size_t)e * DEXP * DM, DM, k0, n0, WD + ((size_t)e * DM + n0) * LDH + k0, LDH, 1.f, nullptr}; } \
        } while (0)
#define CONV_RANGE(lo_, hi_) do { \
        for (int it = (lo_) + gw; it < (hi_); it += NCV * NGW) { \
            ConvDesc cd[NCV]; f32x4 ct[NCV][8], cg[NCV][2]; \
            _Pragma("unroll") for (int c_ = 0; c_ < NCV; ++c_) if (it + c_ * NGW < (hi_)) { CONV_DECODE(it + c_ * NGW, cd[c_]); tr_load(cd[c_], ct[c_], cg[c_], F.lane); } \
            _Pragma("unroll") for (int c_ = 0; c_ < NCV; ++c_) if (it + c_ * NGW < (hi_)) tr_finish(cd[c_], ct[c_], cg[c_], scr, F.lane); \
        } \
        } while (0)
#define CONV_SMALL() do { \
        for (int i = gw * 64 + F.lane; i < 48 * DM; i += NGW * 64) { const int c = i / DM, k = i % DM; const float w = (c < 4) ? w_rg[k * 4 + c] : ((c < 36) ? w_re[k * 32 + (c - 4)] : 0.f); \
            const float v = w * g_moe[k]; const unsigned hi = pk2(v, v) & 0xffffu; const float lo = v - __uint_as_float(hi << 16); wrhl[i] = (bf16)hi; wrhl[48 * DM + i] = (bf16)(pk2(lo, lo) & 0xffffu); } \
        for (size_t i = (size_t)gw * 64 + F.lane; i < (size_t)NTOK * PLED / 4; i += (size_t)NGW * 64 * 4) { f32x4 v[4]; \
            _Pragma("unroll") for (int q = 0; q < 4; ++q) { const size_t iq = i + (size_t)q * NGW * 64; if (iq < (size_t)NTOK * PLED / 4) v[q] = *((const GAS f32x4*)p_in + iq); } \
            _Pragma("unroll") for (int q = 0; q < 4; ++q) { const size_t iq = i + (size_t)q * NGW * 64; if (iq < (size_t)NTOK * PLED / 4) { v2u w; w.x = pk2(v[q].x, v[q].y); w.y = pk2(v[q].z, v[q].w); \
                const size_t row = iq >> 6, c4 = iq & 63; *((GAS v2u*)(PB + row * LDP) + c4) = w; } } } \
        } while (0)
__global__ void __launch_bounds__(NWAVES * 64, 2) mega_fwd(Args args) {
    extern __shared__ __attribute__((aligned(16))) unsigned char lds[];
    Frame F;
    F.lds = (LAS unsigned char*)lds;
    F.MISC = (volatile LAS unsigned*)(F.lds + MISC_OFF);
    F.tid = threadIdx.x; F.lane = F.tid & 63; F.wave = __builtin_amdgcn_readfirstlane(F.tid >> 6);
    F.G = gridDim.x; { const int bx = blockIdx.x; F.vcu = (F.G % 8 == 0) ? (bx % 8) * (F.G / 8) + bx / 8 : bx; }
    unsigned char* ws = args.ws;
    F.ctl = (gu32*)(ws + WS_CTL);
    float* const out = args.out;
    for (int u = F.tid; u < (LDS_BYTES - LDSCTL_OFF) / 4; u += NWAVES * 64) ((LAS unsigned*)(F.lds + LDSCTL_OFF))[u] = 0u;
    __syncthreads();
    XcdBarrier bar = xcd_barrier_post((unsigned*)(F.ctl + CW_BAR), F.MISC + 8, F.tid == 0);
    const int lo = args.ph_lo, hi = args.ph_hi;
#ifndef PROBE_DBL
#define PROBE_DBL -1
#endif
#define REPS(k) _Pragma("unroll 1") for (int rep_ = 0; rep_ < ((PROBE_DBL == (k)) ? 2 : 1); ++rep_)
#ifndef PH_MASK
#define PH_MASK 0x7ff
#endif
#define IN(k) ((((PH_MASK) >> (k)) & 1) && lo <= (k) && (k) < hi)
#ifdef PROBE_BAR2
#define SEAM(k) do { if (IN(k) && IN((k) + 1)) { xcd_barrier(bar, F.wave); xcd_barrier(bar, F.wave); } } while (0)
#else
#define SEAM(k) do { if (IN(k) && IN((k) + 1)) xcd_barrier(bar, F.wave); } while (0)
#endif
#define PHASE_LANE() do { FRESH_LANE(pl_); F.lane = pl_; F.tid = F.wave * 64 + pl_; } while (0)
    const int gw = F.vcu * NWAVES + F.wave, NGW = F.G * NWAVES;
    LAS int* tstart = (LAS int*)(F.lds + TST_OFF); LAS int* lcnt = (LAS int*)(F.lds + CNT_OFF);

    if (IN(0)) REPS(0) {
        PHASE_LANE();
        LAS float* scr = (LAS float*)(F.lds + RING_OFF + F.wave * 16384);
        CONV_RANGE(0, I_IN);
        for (int m = 2 * gw; m < NTOK; m += 2 * NGW) {
            f32x4 v[2][8]; float ss[2];
#pragma unroll
            for (int q = 0; q < 2; ++q) { const GAS f32x4* xr = (const GAS f32x4*)(x_ + (size_t)(m + q) * DM) + F.lane;
#pragma unroll
                for (int j = 0; j < 8; ++j) v[q][j] = xr[64 * j]; }
#pragma unroll
            for (int q = 0; q < 2; ++q) { float s_ = 0.f;
#pragma unroll
                for (int j = 0; j < 8; ++j) s_ += (v[q][j].x * v[q][j].x + v[q][j].y * v[q][j].y) + (v[q][j].z * v[q][j].z + v[q][j].w * v[q][j].w);
                ss[q] = s_; }
#pragma unroll
            for (int q = 0; q < 2; ++q) { const float rstd = rsqrtf(wave_sum(ss[q]) * (1.f / DM) + EPS);
                GAS v2u* o8 = (GAS v2u*)(A1 + (size_t)(m + q) * LDA1) + F.lane;
#pragma unroll
                for (int j = 0; j < 8; ++j) { v2u w; w.x = pk2(v[q][j].x * rstd, v[q][j].y * rstd); w.y = pk2(v[q][j].z * rstd, v[q][j].w * rstd); o8[64 * j] = w; }
                if (F.lane == 0) INVR[m + q] = 1.f / rstd; }
        }
    }
    SEAM(0);
    if (IN(1)) REPS(1) {
#ifdef SKEW_US
        if (F.vcu >= F.G / 2) { const unsigned long long t0 = __builtin_amdgcn_s_memrealtime(); while (__builtin_amdgcn_s_memrealtime() - t0 < (unsigned long long)(SKEW_US) * 100ull) __builtin_amdgcn_s_sleep(4); }
#endif
        pg8::Gemm g{A1, WIN, NTOK, QKVC, DM, nullptr, LDA1, LDW}; pg8::StaticOrder S; S.init(NTOK, QKVC, F.G, (int)blockIdx.x);
        pg8::EpiQKV E{QKV, F.lds + ESCR_OFF, 0, rope};
#if PROBE_DBL == 1 && defined(PROBE_FIXED)
        S.fixed = rep_;
#endif
#if PROBE_DBL == 1 && defined(PROBE_NOEPI)
        E.skip = rep_ * PROBE_NOEPI; if (rep_ && (PROBE_NOEPI == 2 || PROBE_NOEPI == 7 || PROBE_NOEPI == 8 || PROBE_NOEPI == 9)) E.O = (pg8::bf16_t*)out;
#endif
        pg8::gemm_phase<pg8::EpiQKV, pg8::StaticOrder, true, true>(F.lds + RING_OFF, g, S, E, F.wave);
    }
    SEAM(1);
    if (IN(2)) {
        PHASE_LANE();
        float lam;
        { float a = (F.lane < 64) ? lam_q1[F.lane] * lam_k1[F.lane] : 0.f, b2 = lam_q2[F.lane] * lam_k2[F.lane]; a = wave_sum(a); b2 = wave_sum(b2); lam = expf(a) - expf(b2) + 0.2f; }
#ifndef NO_DIFF
#define CONV_LATE() do { __syncthreads(); { PHASE_LANE(); LAS float* scr = (LAS float*)(F.lds + RING_OFF + F.wave * 16384); CONV_RANGE(I_IN, NITEMS); CONV_SMALL(); } __syncthreads(); } while (0)
        const int conv_at = F.vcu % 3;
        if (conv_at == 0) CONV_LATE();
        REPS(20) for (int L = F.vcu; L < 1024; L += F.G) { const int bh = L >> 5, pr = L & 31;
#pragma unroll 1
            for (int s2 = 0; s2 < 2; ++s2) {
#if PROBE_DBL == 20 && defined(PROBE_FIXED)
                att::diff_unit2(bh >> 3, bh & 7, s2 ? pr : 63 - pr, QKV, OB, g_diff, lam, 0.8f, (char*)lds + RING_OFF, F.wave, rope, rep_ * PROBE_FIXED);
#else
                att::diff_unit2(bh >> 3, bh & 7, s2 ? pr : 63 - pr, QKV, OB, g_diff, lam, 0.8f, (char*)lds + RING_OFF, F.wave, rope);
#endif
            } }
#endif
        if (conv_at == 1) CONV_LATE();
        __syncthreads();
#ifndef NO_SB
        REPS(21) for (int uid = gw; uid < 8192; uid += NGW) { const int bh = uid >> 8, wq = uid & 255;
            att::sb_wave_unit(bh >> 3, bh & 7, wq, QKV, OB, g_sb, (char*)lds + RING_OFF + F.wave * 16384); }
#endif
        if (conv_at == 2) CONV_LATE();
#undef CONV_LATE
    }
    SEAM(2);
    if (IN(3)) REPS(3) {
#ifndef NO_P3A
        { pg8::Gemm g{OB, WOUT, NTOK, DM, DM, nullptr, LDA1, LDW}; pg8::StaticOrder S; S.init(NTOK, DM, F.G, (int)blockIdx.x);
          pg8::EpiResN E{A1, LDA1, INVR, H1B};
          pg8::gemm_phase<pg8::EpiResN, pg8::StaticOrder, true, true>(F.lds + RING_OFF, g, S, E, F.wave); }
#endif
    }
    SEAM(3);
    if (IN(4)) {
        PHASE_LANE();
        constexpr int WPITCH = 520;
        LAS bf16* WB = (LAS bf16*)(F.lds + RING_OFF);
        LAS float* LG = (LAS float*)(F.lds + RING_OFF + 102400) + F.wave * 656;
        LAS int* sel_e = (LAS int*)(F.lds + RING_OFF + 124928); LAS float* sel_g = (LAS float*)(F.lds + RING_OFF + 125952); LAS float* sel_r = (LAS float*)(F.lds + RING_OFF + 126976);
        LAS int* lhist = (LAS int*)(F.lds + RING_OFF + 127488); LAS int* lbase = (LAS int*)(F.lds + RING_OFF + 127616);
        const int mr = F.lane & 15, quad = F.lane >> 4;
        for (int chunk = blockIdx.x; chunk < NTOK / 128; chunk += F.G) {
            if (F.tid < 32) lhist[F.tid] = 0;
            const int row0 = chunk * 128 + F.wave * 16;
            f32x4 acc[3] = {{0.f, 0.f, 0.f, 0.f}, {0.f, 0.f, 0.f, 0.f}, {0.f, 0.f, 0.f, 0.f}}; float ssq = 0.f;
            const GAS v4u* arow = (const GAS v4u*)(H1B + (size_t)(row0 + mr) * DM) + quad;
            v4u av[16];
#define P4_LOAD(kc_) do { _Pragma("unroll") for (int sidx = 0; sidx < 16; ++sidx) av[sidx] = arow[(kc_) * 64 + sidx * 4]; } while (0)
            P4_LOAD(0);
#pragma unroll 1
            for (int kc = 0; kc < 4; ++kc) {
                __syncthreads();
#pragma unroll
                for (int i = 0; i < 12; ++i) { const int p = F.tid + 512 * i, hl = p / 3072, rem = p % 3072, wrow = rem >> 6, pc = rem & 63;
                    *(LAS v4u*)(WB + (size_t)(hl * 48 + wrow) * WPITCH + pc * 8) = *(const GAS v4u*)(wrhl + (size_t)(hl * 48 + wrow) * DM + kc * 512 + pc * 8); }
                v4u ac[16];
#pragma unroll
                for (int sidx = 0; sidx < 16; ++sidx) ac[sidx] = av[sidx];
                if (kc < 3) P4_LOAD(kc + 1);
                __syncthreads();
#pragma unroll
                for (int sidx = 0; sidx < 16; ++sidx) { float f[8]; unpack8(ac[sidx], f);
#pragma unroll
                    for (int i = 0; i < 8; ++i) ssq += f[i] * f[i];
                    const pg8::bf16x8 a = __builtin_bit_cast(pg8::bf16x8, ac[sidx]);
#pragma unroll
                    for (int ct = 0; ct < 3; ++ct) { const pg8::bf16x8 bh = *(const LAS pg8::bf16x8*)(WB + (size_t)(ct * 16 + mr) * WPITCH + sidx * 32 + quad * 8), bl = *(const LAS pg8::bf16x8*)(WB + (size_t)(48 + ct * 16 + mr) * WPITCH + sidx * 32 + quad * 8);
                        acc[ct] = __builtin_amdgcn_mfma_f32_16x16x32_bf16(a, bh, acc[ct], 0, 0, 0); acc[ct] = __builtin_amdgcn_mfma_f32_16x16x32_bf16(a, bl, acc[ct], 0, 0, 0); } }
            }
#undef P4_LOAD
            ssq += swz_xor<16>(ssq); { auto rr = __builtin_amdgcn_permlane32_swap(__float_as_uint(ssq), __float_as_uint(ssq), false, false); ssq = __uint_as_float(rr[0]) + __uint_as_float(rr[1]); }
            const float rstd = rsqrtf(ssq * (1.f / DM) + EPS);
            if (quad == 0) LG[640 + mr] = rstd;
            LDS_WAIT(); asm volatile("" ::: "memory");
#pragma unroll
            for (int v = 0; v < 4; ++v) { const float rs = LG[640 + 4 * quad + v];
#pragma unroll
                for (int ct = 0; ct < 3; ++ct) if (ct < 2 || mr < 4) LG[(4 * quad + v) * 40 + ct * 16 + mr] = acc[ct][v] * rs; }
            LDS_WAIT(); asm volatile("" ::: "memory");
            if (F.lane < 16) { const LAS float* lr = LG + F.lane * 40;
                const float g0 = lr[0], g1 = lr[1], g2 = lr[2], g3 = lr[3];
                int grp = 0; float gm = g0; if (g1 > gm) { gm = g1; grp = 1; } if (g2 > gm) { gm = g2; grp = 2; } if (g3 > gm) { gm = g3; grp = 3; }
                const float psel = 1.f / (expf(g0 - gm) + expf(g1 - gm) + expf(g2 - gm) + expf(g3 - gm));
                float ev[8];
#pragma unroll
                for (int i = 0; i < 8; ++i) ev[i] = lr[4 + grp * 8 + i];
                int i0 = 0; float v0 = ev[0];
#pragma unroll
                for (int i = 1; i < 8; ++i) if (ev[i] > v0) { v0 = ev[i]; i0 = i; }
                int i1 = -1; float v1 = 0.f;
#pragma unroll
                for (int i = 0; i < 8; ++i) if (i != i0 && (i1 < 0 || ev[i] > v1)) { v1 = ev[i]; i1 = i; }
                const float ga = 1.f / (1.f + expf(v1 - v0)), gb = 1.f - ga;
                const int rl = F.wave * 16 + F.lane; sel_e[rl * 2] = grp * 8 + i0; sel_e[rl * 2 + 1] = grp * 8 + i1; sel_g[rl * 2] = ga * psel; sel_g[rl * 2 + 1] = gb * psel; sel_r[rl] = LG[640 + F.lane]; }
            __syncthreads();
            FRESH_LANE(l4_); const int t4 = F.wave * 64 + l4_;
            int my_e = 0, my_rk = 0;
            if (t4 < 256) { my_e = sel_e[t4]; my_rk = atomicAdd((int*)(lhist + my_e), 1); }
            __syncthreads();
            if (t4 < 32) { const int n = lhist[t4]; lbase[t4] = n ? (int)__hip_atomic_fetch_add(ecnt + 64 * t4, (unsigned)n, RLX_AGENT) : 0; }
            __syncthreads();
            if (t4 < 256) { const int pos = lbase[my_e] + my_rk; const size_t li = (size_t)my_e * LCAP + pos; { int2 sg; sg.x = (chunk * 128 + (t4 >> 1)) * 2 + (t4 & 1); sg.y = __float_as_int(sel_g[t4]); ((int2*)LSLOT)[li] = sg; } LRSTD[li] = sel_r[t4 >> 1]; }
            __syncthreads();
        }
    }
    SEAM(4);
    if (IN(6) || IN(7)) {
        PHASE_LANE();
        if (F.tid < 32) lcnt[F.tid] = (int)__hip_atomic_load(ecnt + 64 * F.tid, RLX_AGENT);
        __syncthreads();
        if (F.tid == 0) { int acc = 0; for (int e = 0; e < 32; ++e) { tstart[e] = acc; acc += (lcnt[e] + 255) >> 8; } tstart[32] = acc; }
        __syncthreads();
    }
    const int NTILES = (IN(6) || IN(7)) ? __builtin_amdgcn_readfirstlane(tstart[32]) : 0;
    if (IN(6)) REPS(6) {
        pg8::Gemm g{H1B, WGU, NTILES * 256, 1024, DM, LSLOT, DM, LDW}; pg8::MoeOrder S; S.init(NTILES, 4, F.G, (int)blockIdx.x, tstart, lcnt);
        pg8::EpiSwiglu E{HB, LRSTD};
        pg8::gemm_phase<pg8::EpiSwiglu, pg8::MoeOrder, true, true, true>(F.lds + RING_OFF, g, S, E, F.wave);
        { pg8::Gemm g2{PB, WPLE, NTOK, DM, PLED, nullptr, LDP, LDP}; pg8::BalancedOrder S2; S2.init(NTOK, DM, F.G, (int)blockIdx.x, (NTILES * 4) % F.G);
          pg8::EpiBf16 E2{UB, F.lds + ESCR_OFF};
          pg8::gemm_phase<pg8::EpiBf16, pg8::BalancedOrder, true, true>(F.lds + RING_OFF, g2, S2, E2, F.wave); }
    }
    SEAM(6);
    if (IN(7)) REPS(7) {
        pg8::Gemm g{HB, WD, NTILES * 256, DM, DEXP, nullptr, LDH, LDH}; pg8::MoeOrder S; S.init(NTILES, 8, F.G, (int)blockIdx.x, tstart, lcnt);
        pg8::EpiScatter E{YB, (const int2*)LSLOT};
        pg8::gemm_phase<pg8::EpiScatter, pg8::MoeOrder, true, true>(F.lds + RING_OFF, g, S, E, F.wave);
    }
    SEAM(7);
    if (IN(8)) {
        PHASE_LANE();
        for (int m = 2 * gw; m < NTOK; m += 2 * NGW) {
            v4u hv[2][4], ya[2][4], yb[2][4];
#pragma unroll
            for (int q = 0; q < 2; ++q) { const GAS v4u* hr = (const GAS v4u*)(H1B + (size_t)(m + q) * DM) + F.lane; const GAS v4u* y0 = (const GAS v4u*)(YB + (size_t)(2 * (m + q)) * DM) + F.lane; const GAS v4u* y1 = (const GAS v4u*)(YB + (size_t)(2 * (m + q) + 1) * DM) + F.lane;
#pragma unroll
                for (int j = 0; j < 4; ++j) { hv[q][j] = hr[64 * j]; ya[q][j] = y0[64 * j]; yb[q][j] = y1[64 * j]; } }
#pragma unroll
            for (int q = 0; q < 2; ++q) {
                float s = 0.f; GAS v4u* o8 = (GAS v4u*)(H1B + (size_t)(m + q) * DM) + F.lane;
#pragma unroll
                for (int j = 0; j < 4; ++j) { float v[8], a[8], b[8]; unpack8(hv[q][j], v); unpack8(ya[q][j], a); unpack8(yb[q][j], b);
#pragma unroll
                    for (int i = 0; i < 8; ++i) v[i] += a[i] + b[i];
                    v4u w; w.x = pk2(v[0], v[1]); w.y = pk2(v[2], v[3]); w.z = pk2(v[4], v[5]); w.w = pk2(v[6], v[7]); o8[64 * j] = w;
                    float f[8]; unpack8(w, f);
#pragma unroll
                    for (int i = 0; i < 8; ++i) s += f[i] * f[i]; }
                const float rstd = rsqrtf(wave_sum(s) * (1.f / DM) + EPS);
                if (F.lane == 0) RSTD2[m + q] = rstd; }
        }
    }
    SEAM(8);
    if (IN(9)) {
        pg8::Gemm g{H1B, WPG, NTOK, DM, DM, nullptr, DM, LDW}; pg8::StaticOrder S; S.init(NTOK, DM, F.G, (int)blockIdx.x);
        pg8::EpiPle2 E{H1B, UB, RSTD2, A1, LDA1};
        pg8::gemm_phase<pg8::EpiPle2, pg8::StaticOrder, true, true>(F.lds + RING_OFF, g, S, E, F.wave);
    }
    SEAM(9);
    if (IN(10)) REPS(10) {
        PHASE_LANE();
        for (int m = 4 * gw; m < NTOK; m += 4 * NGW) {
            v4u hv[4][4];
#pragma unroll
            for (int q = 0; q < 4; ++q) { const GAS v4u* hr = (const GAS v4u*)(A1 + (size_t)(m + q) * LDA1) + F.lane;
#pragma unroll
                for (int j = 0; j < 4; ++j) hv[q][j] = hr[64 * j]; }
#pragma unroll
            for (int q = 0; q < 4; ++q) {
                float v[4][8]; float s = 0.f;
#pragma unroll
                for (int j = 0; j < 4; ++j) { unpack8(hv[q][j], v[j]);
#pragma unroll
                    for (int i = 0; i < 8; ++i) s += v[j][i] * v[j][i]; }
                const float rstd = rsqrtf(wave_sum(s) * (1.f / DM) + EPS);
                GAS f32x4* orow = (GAS f32x4*)(out + (size_t)(m + q) * DM) + 2 * F.lane;
#pragma unroll
                for (int j = 0; j < 4; ++j) { const f32x4 g0 = *((const GAS f32x4*)g_final + 2 * F.lane + 128 * j), g1 = *((const GAS f32x4*)g_final + 2 * F.lane + 128 * j + 1);
                    orow[128 * j] = (f32x4){v[j][0] * rstd * g0.x, v[j][1] * rstd * g0.y, v[j][2] * rstd * g0.z, v[j][3] * rstd * g0.w};
                    orow[128 * j + 1] = (f32x4){v[j][4] * rstd * g1.x, v[j][5] * rstd * g1.y, v[j][6] * rstd * g1.z, v[j][7] * rstd * g1.w}; } }
        }
    }
#ifdef PROBE_CLOCK
    {
        typedef float f32x16_ __attribute__((ext_vector_type(16))); typedef short bf16x8_ __attribute__((ext_vector_type(8)));
        f32x16_ c0 = {}, c1 = {}, c2 = {}, c3 = {}; bf16x8_ a = {1, 2, 3, 4, 5, 6, 7, 8}, b = {1, 1, 1, 1, 1, 1, 1, 1};
        const long long t0 = clock64();
        while (clock64() - t0 < PROBE_CLOCK) {
#pragma unroll
            for (int i = 0; i < 8; ++i) { c0 = __builtin_amdgcn_mfma_f32_32x32x16_bf16(a, b, c0, 0, 0, 0); c1 = __builtin_amdgcn_mfma_f32_32x32x16_bf16(a, b, c1, 0, 0, 0); c2 = __builtin_amdgcn_mfma_f32_32x32x16_bf16(a, b, c2, 0, 0, 0); c3 = __builtin_amdgcn_mfma_f32_32x32x16_bf16(a, b, c3, 0, 0, 0); } }
        if (c0[0] + c1[1] + c2[2] + c3[3] == 12345.678f) out[0] = 0.f;
    }
#endif
#undef IN
#undef SEAM
}

#ifndef MK_SPLIT
#define MK_SPLIT 0
#endif
extern "C" void kernel_launch(void* const* d_in, const int* in_sizes, int n_in, void* d_out, int out_size, void* d_ws, size_t ws_size, hipStream_t stream) {
    static int grid = 0;
    if (grid == 0) {
        if (n_in != 21 || in_sizes[0] != NTOK * DM || out_size != NTOK * DM || ws_size < WS_END) { fprintf(stderr, "kernel_launch: shape mismatch (n_in %d in0 %d out %d ws %zu)\n", n_in, n_in > 0 ? in_sizes[0] : -1, out_size, ws_size); grid = -1; return; }
        int dev = 0, cus = 0, per_cu = 0;
        if (hipGetDevice(&dev) != hipSuccess || hipDeviceGetAttribute(&cus, hipDeviceAttributeMultiprocessorCount, dev) != hipSuccess) { grid = -1; return; }
        if (hipFuncSetAttribute((const void*)mega_fwd, hipFuncAttributeMaxDynamicSharedMemorySize, LDS_BYTES) != hipSuccess) { fprintf(stderr, "kernel_launch: hipFuncSetAttribute failed\n"); grid = -1; return; }
        if (hipOccupancyMaxActiveBlocksPerMultiprocessor(&per_cu, (const void*)mega_fwd, NWAVES * 64, LDS_BYTES) != hipSuccess || per_cu < 1) fprintf(stderr, "kernel_launch: occupancy query reports %d\n", per_cu);
        (void)hipGetLastError();
        grid = cus;
    }
    if (grid < 0) return;
    if (hipMemsetAsync((char*)d_ws + WS_CTL, 0, CTL_ZERO_BYTES, stream) != hipSuccess) return;
    Args a{};
    for (int i = 0; i < 21; ++i) a.in[i] = (const float*)d_in[i];
    a.out = (float*)d_out; a.ws = (unsigned char*)d_ws;
#if MK_SPLIT
    for (int ph = 0; ph < 11; ++ph) { a.ph_lo = ph; a.ph_hi = ph + 1; hipLaunchKernelGGL(mega_fwd, dim3(grid), dim3(NWAVES * 64), LDS_BYTES, stream, a); }
#else
    a.ph_lo = 0; a.ph_hi = 11;
    hipLaunchKernelGGL(mega_fwd, dim3(grid), dim3(NWAVES * 64), LDS_BYTES, stream, a);
#endif
    const hipError_t le = hipPeekAtLastError();
    if (le != hipSuccess) fprintf(stderr, "kernel_launch: launch failed: %s\n", hipGetErrorName(le));
}
```

```cpp
#include <hip/hip_runtime.h>
#include <hip/hip_bf16.h>
#include <cstdio>
#include <cstdint>
#define FRESH_LANE(v) int v; asm volatile("v_mbcnt_lo_u32_b32 %0, -1, 0\n\tv_mbcnt_hi_u32_b32 %0, -1, %0" : "=v"(v))
template <int M> __device__ __forceinline__ float swz_xor(float v) { return __int_as_float(__builtin_amdgcn_ds_swizzle(__float_as_int(v), 0x1f | (M << 10))); }
__device__ __forceinline__ float half_sum32_(float v) { v += swz_xor<1>(v); v += swz_xor<2>(v); v += swz_xor<4>(v); v += swz_xor<8>(v); v += swz_xor<16>(v); return v; }
__device__ __forceinline__ float wave_sum_(float v) { v = half_sum32_(v); auto rr = __builtin_amdgcn_permlane32_swap(__float_as_uint(v), __float_as_uint(v), false, false); return __uint_as_float(rr[0]) + __uint_as_float(rr[1]); }
namespace pg8 {
#define PG8_LAS __attribute__((address_space(3)))
typedef unsigned short bf16_t;
typedef short bf16x8 __attribute__((ext_vector_type(8)));
typedef float f32x4 __attribute__((ext_vector_type(4)));
typedef unsigned u32x4 __attribute__((ext_vector_type(4)));
constexpr int BM = 256, BK = 64, HALF = 128, HTB = HALF * BK * 2  , STAGE_BYTES = 8 * HTB, NXCD = 8, WGM = 4;

__host__ __device__ __forceinline__ int lds_byte(int r, int c) { const int st = (r >> 4) * 2 + (c >> 5), rr = r & 15, cc = c & 31, ob = rr * 64 + cc * 2; return st * 1024 + (ob ^ (((ob >> 9) & 1) << 5)); }
__host__ __device__ __forceinline__ void stage_rc(int b, int& R, int& C) { const int st = b / 1024, sb = b % 1024, swz = sb ^ (((sb >> 9) & 1) << 5); R = (st >> 1) * 16 + swz / 64; C = (st & 1) * 32 + (swz % 64) / 2; }
__host__ __device__ __forceinline__ int perm32(int rho) { const int n = rho >> 4, i = rho & 15; return 8 * (i >> 2) + 4 * n + (i & 3); }

struct Unit { int pm, pn, pb, aux0, aux1; };
struct Gemm { const bf16_t* A; const bf16_t* Bt; int M, N, K; const int* glist; int lda, ldb; };

struct StaticOrder {
    int nM, nN, nwg, G, c, fixed;
    __host__ __device__ void init(int M, int N, int G_, int c_) { nM = M / BM; nN = N / BM; nwg = nM * nN; G = G_; c = c_; fixed = 0; }
    __host__ __device__ bool next(int i, Unit& u) const {
        const long L = (long)i * G + c; if (L >= nwg) return false;
        int wgid = (int)L; { const int q = nwg / NXCD, r = nwg % NXCD, xcd = wgid % NXCD, off = wgid / NXCD; wgid = (xcd < r ? xcd * (q + 1) : r * (q + 1) + (xcd - r) * q) + off; }
        const int nig = WGM * nN, gid = wgid / nig, fm = gid * WGM, gsz = (nM - fm) < WGM ? (nM - fm) : WGM;
        u.pm = fm + ((wgid % nig) % gsz); u.pn = (wgid % nig) / gsz; if (fixed) { u.pm = 0; u.pn = 0; } u.pb = u.pn; u.aux0 = 0; u.aux1 = 0; return true;
    }
    __device__ __forceinline__ void a_ready(const Unit&) const {}
    __device__ __forceinline__ void done(const Unit&) const {}
};

struct BalancedOrder {
    int nM, nN, nwg, G, c, rem, E, K1;
    __host__ __device__ void init(int M, int N, int G_, int c_, int rem_) { nM = M / BM; nN = N / BM; nwg = nM * nN; G = G_; c = c_; rem = rem_; E = G_ - rem_; K1 = (nwg + E - 1) / E; if (K1 > KMAX) K1 = KMAX; }
    static constexpr int KMAX = 6;
    __host__ __device__ bool next(int i, Unit& u) const {
        long L;
        if (c >= rem) L = i < K1 ? (long)i * E + (c - rem) : (long)K1 * E + (long)(i - K1) * G + c;
        else L = (long)K1 * E + (long)i * G + c;
        if (L >= nwg) return false;
        int wgid = (int)L; { const int q = nwg / NXCD, r = nwg % NXCD, xcd = wgid % NXCD, off = wgid / NXCD; wgid = (xcd < r ? xcd * (q + 1) : r * (q + 1) + (xcd - r) * q) + off; }
        const int nig = WGM * nN, gid = wgid / nig, fm = gid * WGM, gsz = (nM - fm) < WGM ? (nM - fm) : WGM;
        u.pm = fm + ((wgid % nig) % gsz); u.pn = (wgid % nig) / gsz; u.pb = u.pn; u.aux0 = 0; u.aux1 = 0; return true;
    }
    __device__ __forceinline__ void a_ready(const Unit&) const {}
    __device__ __forceinline__ void done(const Unit&) const {}
};

__device__ __forceinline__ unsigned cvt_pk_bf16(float lo, float hi) { unsigned r; asm volatile("v_cvt_pk_bf16_f32 %0, %1, %2" : "=v"(r) : "v"(lo), "v"(hi)); return r; }
typedef float f32x2 __attribute__((ext_vector_type(2)));
#define PG8_FRESH_LANE(fr, fq) int l__; asm volatile("v_mbcnt_lo_u32_b32 %0, -1, 0\n\tv_mbcnt_hi_u32_b32 %0, -1, %0" : "=v"(l__)); const int fr = l__ & 15, fq = l__ >> 4; (void)fr_; (void)fq_
typedef unsigned u32x2 __attribute__((ext_vector_type(2)));
__device__ __forceinline__ float bf_lo(unsigned w) { return __uint_as_float(w << 16); }
__device__ __forceinline__ float bf_hi(unsigned w) { return __uint_as_float(w & 0xffff0000u); }

__device__ __forceinline__ void sp_store_group(bf16_t* sp, int rowg, const u32x4& w0, const u32x4& w1, PG8_LAS unsigned char* sw, int fr, int fq) {
    const int lane = fq * 16 + fr;
    const int wofs0 = fr * 128 + ((fq ^ (fr & 7)) << 4), wofs1 = fr * 128 + (((fq + 4) ^ (fr & 7)) << 4);
    const int rofs0 = (lane >> 3) * 128 + (((lane & 7) ^ ((lane >> 3) & 7)) << 4), rofs1 = rofs0 + 1024;
    *(PG8_LAS u32x4*)(sw + wofs0) = w0; *(PG8_LAS u32x4*)(sw + wofs1) = w1;
    asm volatile("s_waitcnt lgkmcnt(0)" ::: "memory");
    const u32x4 o0 = *(const PG8_LAS u32x4*)(sw + rofs0), o1 = *(const PG8_LAS u32x4*)(sw + rofs1);
    bf16_t* gp = sp + (size_t)rowg * 64 + lane * 8;
    *(u32x4*)gp = o0; *(u32x4*)(gp + 512) = o1;
    asm volatile("" ::: "memory");
}
constexpr size_t SPS = (size_t)32768 * 64;
struct EpiQKV {
    static constexpr bool PERM = true, AFTER_DRAIN = false; static constexpr int NST = 16;
    bf16_t* O; PG8_LAS unsigned char* scr; int skip; float* kmax2;
    __device__ __forceinline__ void operator()(const f32x4 (&acc)[2][2][4][2], const Unit& u, int wr, int wc, int fr_, int fq_) const {
#ifdef PROBE_NOEPI
        if (skip == 1) return;
#endif
        PG8_FRESH_LANE(fr, fq);
        const int lane = fq * 16 + fr;
        const bool rot = (u.pn >= 12) && (u.pn < 20), kd = (u.pn >= 16) && (u.pn < 20);
        constexpr float RV[8] = {0.15915494309189535f, 0.03086376340470123f, 0.005985185712713705f, 0.001160663641240061f, 0.00022507907903927653f, 4.364795279280289e-05f, 8.464330808241401e-06f, 1.6414262627950345e-06f};
        const float sgn = (fq == 0) ? -1.f : ((fq == 1) ? 1.f : 0.f);
        PG8_LAS unsigned char* sw = scr + (wr * 4 + wc) * 2048;
        const int wofs0 = fr * 128 + ((fq ^ (fr & 7)) << 4), wofs1 = fr * 128 + (((fq + 4) ^ (fr & 7)) << 4);
        const int rofs0 = (lane >> 3) * 128 + (((lane & 7) ^ ((lane >> 3) & 7)) << 4), rofs1 = rofs0 + 1024;
        bf16_t* sp = O + (size_t)(u.pn * 4 + wc) * ((size_t)32768 * 64);
#pragma unroll
        for (int ai = 0; ai < 2; ++ai) { float gmax = 0.f;
#pragma unroll
            for (int m = 0; m < 4; ++m) { const int rowg = u.pm * BM + ai * HALF + wr * 64 + m * 16, row = rowg + fr; u32x4 w[2]; float nrm = 0.f;
#pragma unroll
                for (int bj = 0; bj < 2; ++bj) { f32x4 v0 = acc[ai][bj][m][0], v1 = acc[ai][bj][m][1];
                    if (rot && bj == 0) { const float pos = (float)(row & 8191); f32x4 p0, p1;
#pragma unroll
                        for (int j = 0; j < 4; ++j) { p0[j] = swz_xor<16>(v0[j]); p1[j] = swz_xor<16>(v1[j]); }
#pragma unroll
                        for (int j = 0; j < 4; ++j) { const float f0 = __builtin_amdgcn_fractf(pos * RV[j]), f1 = __builtin_amdgcn_fractf(pos * RV[4 + j]);
                            const float c0 = (sgn != 0.f) ? __builtin_amdgcn_cosf(f0) : 1.f, s0 = sgn * __builtin_amdgcn_sinf(f0), c1 = (sgn != 0.f) ? __builtin_amdgcn_cosf(f1) : 1.f, s1 = sgn * __builtin_amdgcn_sinf(f1);
                            v0[j] = v0[j] * c0 + p0[j] * s0; v1[j] = v1[j] * c1 + p1[j] * s1; } }
                    if (kd) nrm += ((v0[0] * v0[0] + v0[1] * v0[1]) + (v0[2] * v0[2] + v0[3] * v0[3])) + ((v1[0] * v1[0] + v1[1] * v1[1]) + (v1[2] * v1[2] + v1[3] * v1[3]));
                    w[bj].x = cvt_pk_bf16(v0[0], v0[1]); w[bj].y = cvt_pk_bf16(v0[2], v0[3]); w[bj].z = cvt_pk_bf16(v1[0], v1[1]); w[bj].w = cvt_pk_bf16(v1[2], v1[3]); }
                gmax = __builtin_fmaxf(gmax, nrm);
#ifdef QKV_DIRECT
                { bf16_t* gp = sp + (size_t)row * 64 + fq * 8; *(u32x4*)gp = w[0]; *(u32x4*)(gp + 32) = w[1]; (void)sw; (void)wofs0; (void)wofs1; (void)rofs0; (void)rofs1; }
                asm volatile("" ::: "memory"); }
#else
                *(PG8_LAS u32x4*)(sw + wofs0) = w[0]; *(PG8_LAS u32x4*)(sw + wofs1) = w[1];
                asm volatile("s_waitcnt lgkmcnt(0)" ::: "memory");
                const u32x4 o0 = *(const PG8_LAS u32x4*)(sw + rofs0), o1 = *(const PG8_LAS u32x4*)(sw + rofs1);
                bf16_t* gp = sp + (size_t)rowg * 64 + lane * 8;
#ifdef PROBE_NOEPI
                if (skip == 2) { asm volatile("" :: "v"(o0), "v"(o1)); } else
#endif
                { *(u32x4*)gp = o0; *(u32x4*)(gp + 512) = o1; }
                asm volatile("" ::: "memory"); }
#endif
            if (kd) {
                gmax += swz_xor<16>(gmax); { auto rr = __builtin_amdgcn_permlane32_swap(__float_as_uint(gmax), __float_as_uint(gmax), false, false); gmax = __uint_as_float(rr[0]) + __uint_as_float(rr[1]); }
                gmax = __builtin_fmaxf(gmax, swz_xor<1>(gmax)); gmax = __builtin_fmaxf(gmax, swz_xor<2>(gmax)); gmax = __builtin_fmaxf(gmax, swz_xor<4>(gmax)); gmax = __builtin_fmaxf(gmax, swz_xor<8>(gmax));
                const int row0 = u.pm * BM + ai * HALF + wr * 64;
                if (lane == 0) kmax2[(size_t)(((row0 >> 13) * 16 + (u.pn - 16) * 4 + wc) * 128 + ((row0 & 8191) >> 6))] = gmax * 1.02f; } }
        (void)skip;
    }
};
struct EpiBf16 {
    static constexpr bool PERM = true, AFTER_DRAIN = false; static constexpr int NST = 16;
    bf16_t* O; PG8_LAS unsigned char* scr;
    __device__ __forceinline__ void operator()(const f32x4 (&acc)[2][2][4][2], const Unit& u, int wr, int wc, int fr_, int fq_) const {
        PG8_FRESH_LANE(fr, fq);
        PG8_LAS unsigned char* sw = scr + (wr * 4 + wc) * 2048; bf16_t* sp = O + (size_t)(u.pn * 4 + wc) * SPS;
#pragma unroll
        for (int ai = 0; ai < 2; ++ai)
#pragma unroll
            for (int m = 0; m < 4; ++m) { u32x4 w[2];
#pragma unroll
                for (int bj = 0; bj < 2; ++bj) { const f32x4 v0 = acc[ai][bj][m][0], v1 = acc[ai][bj][m][1];
                    w[bj].x = cvt_pk_bf16(v0[0], v0[1]); w[bj].y = cvt_pk_bf16(v0[2], v0[3]); w[bj].z = cvt_pk_bf16(v1[0], v1[1]); w[bj].w = cvt_pk_bf16(v1[2], v1[3]); }
                sp_store_group(sp, u.pm * BM + ai * HALF + wr * 64 + m * 16, w[0], w[1], sw, fr, fq); }
    }
};
struct EpiResBf16 {
    static constexpr bool PERM = true, AFTER_DRAIN = false; static constexpr int NST = 16;
    const float* base; bf16_t* O;
    __device__ __forceinline__ void operator()(const f32x4 (&acc)[2][2][4][2], const Unit& u, int wr, int wc, int fr_, int fq_) const {
        PG8_FRESH_LANE(fr, fq);
        const int row0 = u.pm * BM + wr * 64 + fr, col0 = u.pn * BM + wc * 64 + 8 * fq;
        f32x4 bv[2][4];
#define ER_LOAD(buf, it) do { const size_t off_ = (size_t)(row0 + ((it) >> 2) * HALF + ((it) & 3) * 16) * 2048 + col0; \
            bv[buf][0] = *(const f32x4*)(base + off_); bv[buf][1] = *(const f32x4*)(base + off_ + 4); bv[buf][2] = *(const f32x4*)(base + off_ + 32); bv[buf][3] = *(const f32x4*)(base + off_ + 36); } while (0)
        ER_LOAD(0, 0);
#pragma unroll
        for (int it = 0; it < 8; ++it) { const int ai = it >> 2, m = it & 3; const size_t off = (size_t)(row0 + ai * HALF + m * 16) * 2048 + col0;
            if (it + 1 < 8) { if (it & 1) ER_LOAD(0, it + 1); else ER_LOAD(1, it + 1); }
#pragma unroll
            for (int bj = 0; bj < 2; ++bj) { const f32x4 v0 = acc[ai][bj][m][0] + bv[it & 1][2 * bj], v1 = acc[ai][bj][m][1] + bv[it & 1][2 * bj + 1];
                u32x4 w; w.x = cvt_pk_bf16(v0[0], v0[1]); w.y = cvt_pk_bf16(v0[2], v0[3]); w.z = cvt_pk_bf16(v1[0], v1[1]); w.w = cvt_pk_bf16(v1[2], v1[3]);
                *(u32x4*)(O + off + bj * 32) = w; } }
#undef ER_LOAD
    }
};
struct EpiResN {
    static constexpr bool PERM = true, AFTER_DRAIN = false; static constexpr int NST = 16;
    const bf16_t* Xn; int ldx; const float* invr; bf16_t* O;
    __device__ __forceinline__ void operator()(const f32x4 (&acc)[2][2][4][2], const Unit& u, int wr, int wc, int fr_, int fq_) const {
        PG8_FRESH_LANE(fr, fq);
        const int row0 = u.pm * BM + wr * 64 + fr, col0 = u.pn * BM + wc * 64 + 8 * fq;
        float rs[8];
#pragma unroll
        for (int it = 0; it < 8; ++it) rs[it] = invr[row0 + (it >> 2) * HALF + (it & 3) * 16];
        u32x4 lv[2];
#define EN_LOAD(buf, k) do { const int it_ = (k) >> 1, bj_ = (k) & 1; const size_t row_ = (size_t)(row0 + (it_ >> 2) * HALF + (it_ & 3) * 16); \
            lv[buf] = *(const u32x4*)(Xn + row_ * ldx + col0 + bj_ * 32); } while (0)
        EN_LOAD(0, 0);
#pragma unroll
        for (int k = 0; k < 16; ++k) { const int it = k >> 1, bj = k & 1, ai = it >> 2, m = it & 3; const size_t row = (size_t)(row0 + ai * HALF + m * 16);
            if (k + 1 < 16) { if (k & 1) EN_LOAD(0, k + 1); else EN_LOAD(1, k + 1); }
            const u32x4 xw = lv[k & 1]; const float sc = rs[it];
            float r[8];
#pragma unroll
            for (int q = 0; q < 4; ++q) { r[2 * q] = bf_lo(xw[q]) * sc + acc[ai][bj][m][q >> 1][(q & 1) * 2]; r[2 * q + 1] = bf_hi(xw[q]) * sc + acc[ai][bj][m][q >> 1][(q & 1) * 2 + 1]; }
            u32x4 w; w.x = cvt_pk_bf16(r[0], r[1]); w.y = cvt_pk_bf16(r[2], r[3]); w.z = cvt_pk_bf16(r[4], r[5]); w.w = cvt_pk_bf16(r[6], r[7]);
            *(u32x4*)(O + row * 2048 + col0 + bj * 32) = w; }
#undef EN_LOAD
    }
};
struct EpiPle2 {
    static constexpr bool PERM = true, AFTER_DRAIN = false; static constexpr int NST = 16;
    const bf16_t* Hs; const bf16_t* U; const float* rstd; bf16_t* O3; int ld3;
    __device__ __forceinline__ void operator()(const f32x4 (&acc)[2][2][4][2], const Unit& u, int wr, int wc, int fr_, int fq_) const {
        PG8_FRESH_LANE(fr, fq);
        const int row0 = u.pm * BM + wr * 64 + fr, col0 = u.pn * BM + wc * 64 + 8 * fq;
        float rs[8];
#pragma unroll
        for (int it = 0; it < 8; ++it) rs[it] = rstd[row0 + (it >> 2) * HALF + (it & 3) * 16];
        u32x4 lv[2][2];
#define EP_LOAD(buf, k) do { const int it_ = (k) >> 1, bj_ = (k) & 1; const size_t row_ = (size_t)(row0 + (it_ >> 2) * HALF + (it_ & 3) * 16); \
            lv[buf][0] = *(const u32x4*)(Hs + row_ * 2048 + col0 + bj_ * 32); lv[buf][1] = *(const u32x4*)(U + (size_t)(u.pn * 4 + wc) * SPS + row_ * 64 + bj_ * 32 + 8 * fq); } while (0)
        EP_LOAD(0, 0);
#pragma unroll
        for (int k = 0; k < 16; ++k) { const int it = k >> 1, bj = k & 1, ai = it >> 2, m = it & 3; const size_t row = (size_t)(row0 + ai * HALF + m * 16);
            if (k + 1 < 16) { if (k & 1) EP_LOAD(0, k + 1); else EP_LOAD(1, k + 1); }
            const u32x4 hw = lv[k & 1][0], uw = lv[k & 1][1]; const float sc = -1.4426950408889634f * rs[it];
            float r[8];
#pragma unroll
            for (int q = 0; q < 4; ++q) { const float a0 = acc[ai][bj][m][q >> 1][(q & 1) * 2], a1 = acc[ai][bj][m][q >> 1][(q & 1) * 2 + 1];
                const float s0 = __builtin_amdgcn_rcpf(1.f + __builtin_amdgcn_exp2f(sc * a0)), s1 = __builtin_amdgcn_rcpf(1.f + __builtin_amdgcn_exp2f(sc * a1));
                r[2 * q] = bf_lo(hw[q]) + bf_lo(uw[q]) * s0; r[2 * q + 1] = bf_hi(hw[q]) + bf_hi(uw[q]) * s1; }
            u32x4 w; w.x = cvt_pk_bf16(r[0], r[1]); w.y = cvt_pk_bf16(r[2], r[3]); w.z = cvt_pk_bf16(r[4], r[5]); w.w = cvt_pk_bf16(r[6], r[7]);
            *(u32x4*)(O3 + row * ld3 + col0 + bj * 32) = w; }
#undef EP_LOAD
    }
};
struct EpiSwiglu {
    static constexpr bool PERM = true, AFTER_DRAIN = false; static constexpr int NST = 8;
    bf16_t* H; const float* lrstd;
    __device__ __forceinline__ void operator()(const f32x4 (&acc)[2][2][4][2], const Unit& u, int wr, int wc, int fr_, int fq_) const {
        PG8_FRESH_LANE(fr, fq);
        const int row0 = u.pm * BM + wr * 64 + fr, col0 = u.pn * HALF + wc * 32 + 8 * fq, r0 = wr * 64 + fr;
        float rs[8];
#pragma unroll
        for (int it = 0; it < 8; ++it) { const int r = r0 + (it >> 2) * HALF + (it & 3) * 16; rs[it] = (r < u.aux1) ? lrstd[u.aux0 + r] : 0.f; }
#pragma unroll
        for (int ai = 0; ai < 2; ++ai)
#pragma unroll
            for (int m = 0; m < 4; ++m) { bf16_t* rowp = H + (size_t)(row0 + ai * HALF + m * 16) * 576 + col0; float h[8]; const float rr = rs[ai * 4 + m];
#pragma unroll
                for (int n = 0; n < 2; ++n)
#pragma unroll
                    for (int j = 0; j < 4; ++j) { const float g = acc[ai][0][m][n][j] * rr, up = acc[ai][1][m][n][j] * rr;
                        h[n * 4 + j] = g * up * __builtin_amdgcn_rcpf(1.f + __builtin_amdgcn_exp2f(-1.4426950408889634f * g)); }
                u32x4 w; w.x = cvt_pk_bf16(h[0], h[1]); w.y = cvt_pk_bf16(h[2], h[3]); w.z = cvt_pk_bf16(h[4], h[5]); w.w = cvt_pk_bf16(h[6], h[7]);
                *(u32x4*)rowp = w; }
    }
};
struct EpiScatter {
    static constexpr bool PERM = true, AFTER_DRAIN = false; static constexpr int NST = 16;
    bf16_t* Y; const int2* lsg;
    __device__ __forceinline__ void operator()(const f32x4 (&acc)[2][2][4][2], const Unit& u, int wr, int wc, int fr_, int fq_) const {
        PG8_FRESH_LANE(fr, fq);
        const int r0 = wr * 64 + fr, col0 = u.pn * BM + wc * 64 + 8 * fq;
        int sl[8]; float gt[8];
#pragma unroll
        for (int it = 0; it < 8; ++it) { const int r = r0 + (it >> 2) * HALF + (it & 3) * 16; const bool ok = r < u.aux1; int2 sg; sg.x = 65536; sg.y = 0; if (ok) sg = lsg[u.aux0 + r]; sl[it] = sg.x; gt[it] = __int_as_float(sg.y); }
#pragma unroll
        for (int it = 0; it < 8; ++it) { const int ai = it >> 2, m = it & 3;
            { bf16_t* rowp = Y + (size_t)sl[it] * 2048 + col0; const float g = gt[it];
#pragma unroll
                for (int bj = 0; bj < 2; ++bj) { const f32x4 v0 = acc[ai][bj][m][0] * g, v1 = acc[ai][bj][m][1] * g;
                    u32x4 w; w.x = cvt_pk_bf16(v0[0], v0[1]); w.y = cvt_pk_bf16(v0[2], v0[3]); w.z = cvt_pk_bf16(v1[0], v1[1]); w.w = cvt_pk_bf16(v1[2], v1[3]);
                    *(u32x4*)(rowp + bj * 32) = w; } } }
    }
};
struct MoeOrder {
    int nM, nN, nwg, G, c; const PG8_LAS int* tstart; const PG8_LAS int* cnt;
    __device__ void init(int nM_, int nN_, int G_, int c_, const PG8_LAS int* ts, const PG8_LAS int* cn) { nM = nM_; nN = nN_; nwg = nM * nN; G = G_; c = c_; tstart = ts; cnt = cn; }
    __device__ bool next(int i, Unit& u) const {
        const long L = (long)i * G + c; if (L >= nwg) return false;
        int wgid = (int)L; { const int q = nwg / NXCD, r = nwg % NXCD, xcd = wgid % NXCD, off = wgid / NXCD; wgid = (xcd < r ? xcd * (q + 1) : r * (q + 1) + (xcd - r) * q) + off; }
        const int nig = WGM * nN, gid = wgid / nig, fm = gid * WGM, gsz = (nM - fm) < WGM ? (nM - fm) : WGM;
        const int pm = fm + ((wgid % nig) % gsz), pn = (wgid % nig) / gsz;
        int e = 0;
        for (int k = 1; k < 32; ++k) e += (__builtin_amdgcn_readfirstlane(tstart[k]) <= pm) ? 1 : 0;
        const int t = pm - __builtin_amdgcn_readfirstlane(tstart[e]); const int left = __builtin_amdgcn_readfirstlane(cnt[e]) - t * 256;
        u.pm = pm; u.pn = pn; u.pb = e * nN + pn; u.aux0 = e * 65536 + t * 256; u.aux1 = left < 256 ? left : 256; return true;
    }
    __device__ __forceinline__ void a_ready(const Unit&) const {}
    __device__ __forceinline__ void done(const Unit&) const {}
};
template <class Epi, class Sched, bool ALIGN_EPI = false, bool SP2 = false, bool GATHER = false>
__device__ __forceinline__ void gemm_phase(PG8_LAS unsigned char* lds, const Gemm g, const Sched& S, const Epi& E, const int wid) {
    FRESH_LANE(lane); const int tid = wid * 64 + lane, wr = wid >> 2, wc = wid & 3, fr = lane & 15, fq = lane >> 4;
    const int K = g.K, nt = K / BK;
    unsigned voffA[2], voffB[2];
#pragma unroll
    for (int i = 0; i < 2; ++i) { int R, C; stage_rc(tid * 16 + i * 8192, R, C); const int Rb = 2 * (R & ~31) + (Epi::PERM ? perm32(R & 31) : (R & 31));
        voffA[i] = (unsigned)(R * g.lda + C) * 2u; voffB[i] = (unsigned)(Rb * g.ldb + C) * 2u; }
    const size_t kstep = (size_t)(BK * 2);
    const size_t hstepA = (size_t)HALF * g.lda * 2, hstep = (size_t)32 * g.ldb * 2;
    const size_t tstepA = 2 * hstepA, tstep = (size_t)BM * g.ldb * 2;
    const unsigned ldsw = (unsigned)wid * 1024u;
    const int aoff = lds_byte(wr * 64 + fr, fq * 8), boff = lds_byte(wc * 32 + fr, fq * 8);
#define PG8_SA(b, h) (((b) * 2 + (h)) * HTB)
#define PG8_SB(b, h) ((4 + (b) * 2 + (h)) * HTB)
#define PG8_STAGE(bufoff, gbase, voff) do { _Pragma("unroll") for (int _i = 0; _i < 2; ++_i) \
        __builtin_amdgcn_global_load_lds((const unsigned*)((const char*)(gbase) + (voff)[_i]), (PG8_LAS unsigned*)(lds + (bufoff) + ldsw + _i * 8192), 16, 0, 0); } while (0)
#define PG8_STAGE_A(bufoff, nextsel, half, kb) do { _Pragma("unroll") for (int _i = 0; _i < 2; ++_i) { const char* _p; \
        if constexpr (GATHER) _p = (const char*)g.A + (kb) + ((nextsel) ? nx[half][_i] : cu[half][_i]); else _p = ((nextsel) ? nA : cA) + (kb) + (size_t)(half) * hstepA + voffA[_i]; \
        __builtin_amdgcn_global_load_lds((const unsigned*)_p, (PG8_LAS unsigned*)(lds + (bufoff) + ldsw + _i * 8192), 16, 0, 0); } } while (0)
#define PG8_ROWS(u, o) do { _Pragma("unroll") for (int _h = 0; _h < 2; ++_h) _Pragma("unroll") for (int _i = 0; _i < 2; ++_i) { int _R, _C; stage_rc(tid * 16 + _i * 8192, _R, _C); const int _r = _h * HALF + _R; \
        const int _t = (_r < (u).aux1) ? (g.glist[2 * ((u).aux0 + _r)] >> 1) : 0; o[_h][_i] = ((unsigned)_t * (unsigned)g.lda + (unsigned)_C) * 2u; } } while (0)
#define PG8_LDA(dst, b, h) do { _Pragma("unroll") for (int m = 0; m < 4; ++m) _Pragma("unroll") for (int k = 0; k < 2; ++k) dst[m][k] = *(const PG8_LAS bf16x8*)(lds + PG8_SA(b, h) + aoff + m * 2048 + k * 1024); } while (0)
#define PG8_LDB(dst, b, h) do { _Pragma("unroll") for (int n = 0; n < 2; ++n) _Pragma("unroll") for (int k = 0; k < 2; ++k) dst[n][k] = *(const PG8_LAS bf16x8*)(lds + PG8_SB(b, h) + boff + n * 2048 + k * 1024); } while (0)
#define PG8_MMA(ai, bj, At, Bt) do { __builtin_amdgcn_s_setprio(1); _Pragma("unroll") for (int m = 0; m < 4; ++m) _Pragma("unroll") for (int n = 0; n < 2; ++n) _Pragma("unroll") for (int k = 0; k < 2; ++k) \
        acc[ai][bj][m][n] = __builtin_amdgcn_mfma_f32_16x16x32_bf16(Bt[n][k], At[m][k], acc[ai][bj][m][n], 0, 0, 0); __builtin_amdgcn_s_setprio(0); } while (0)
#define PG8_WAIT_V(n) asm volatile("s_waitcnt vmcnt(" #n ")" ::: "memory")
#define PG8_WAIT_VN(n) asm volatile("s_waitcnt vmcnt(%0)" :: "n"(n) : "memory")
#define PG8_WAIT_L(n) asm volatile("s_waitcnt lgkmcnt(" #n ")" ::: "memory")
#define PG8_BAR __builtin_amdgcn_s_barrier()
#define PG8_SCHED __builtin_amdgcn_sched_barrier(0)
    Unit cur, nxt; int ui = 0;
    if (!S.next(0, cur)) return;
    f32x4 acc[2][2][4][2];
#pragma unroll
    for (int a = 0; a < 2; ++a)
#pragma unroll
        for (int b = 0; b < 2; ++b)
#pragma unroll
            for (int m = 0; m < 4; ++m)
#pragma unroll
                for (int n = 0; n < 2; ++n) acc[a][b][m][n] = (f32x4){0.f, 0.f, 0.f, 0.f};
    bf16x8 At[4][2], B0[2][2], B1[2][2];
    const char* cA = (const char*)g.A + (size_t)cur.pm * tstepA; const char* cB = (const char*)g.Bt + (size_t)cur.pb * tstep;
    S.a_ready(cur);
    unsigned cu[2][2] = {{0u, 0u}, {0u, 0u}}, nx[2][2] = {{0u, 0u}, {0u, 0u}}; const char* nA = cA;
    if constexpr (GATHER) PG8_ROWS(cur, cu);
    if constexpr (SP2) {
        PG8_STAGE(PG8_SB(0, 0), cB, voffB); PG8_STAGE(PG8_SB(0, 1), cB + hstep, voffB); PG8_STAGE_A(PG8_SA(0, 0), false, 0, 0); PG8_STAGE_A(PG8_SA(0, 1), false, 1, 0);
        if (wr == 1) PG8_BAR;
        PG8_WAIT_V(2); PG8_BAR;
        PG8_STAGE(PG8_SB(1, 0), cB + kstep, voffB); PG8_STAGE_A(PG8_SA(1, 0), false, 0, kstep); PG8_STAGE(PG8_SB(1, 1), cB + hstep + kstep, voffB);
        PG8_WAIT_V(6); PG8_BAR;
    } else { static_assert(SP2, "only the SP2 loop is kept in this file"); }
    for (;;) {
        const bool has_next = S.next(ui + 1, nxt);
        nA = has_next ? (const char*)g.A + (size_t)nxt.pm * tstepA : cA;
        if constexpr (GATHER) { if (has_next) PG8_ROWS(nxt, nx); else { nx[0][0] = cu[0][0]; nx[0][1] = cu[0][1]; nx[1][0] = cu[1][0]; nx[1][1] = cu[1][1]; } }
        const char* nB = has_next ? (const char*)g.Bt + (size_t)nxt.pb * tstep : cB;
#pragma unroll 1
        for (int t = 0; t < nt; t += 2) {
            const bool last = (t == nt - 2);
            constexpr bool fresh = false;
            const size_t kb1 = (size_t)(t + 1) * kstep;
            const size_t kb2 = last ? 0 : (size_t)(t + 2) * kstep; const char* b2 = last ? nB : cB + (size_t)(t + 2) * kstep;
            const size_t kb3 = kb2 + kstep; const char* b3 = b2 + kstep;
            if (last && has_next) S.a_ready(nxt);
            if constexpr (SP2) {
            PG8_LDB(B0, 0, 0); PG8_LDB(B1, 0, 1); PG8_SCHED; PG8_LDA(At, 0, 0); if (!fresh) { PG8_STAGE_A(PG8_SA(1, 1), false, 1, kb1); PG8_WAIT_V(8); }
            PG8_WAIT_L(0); PG8_BAR; PG8_MMA(0, 0, At, B0); PG8_MMA(0, 1, At, B1); PG8_BAR; PG8_SCHED;
            PG8_LDA(At, 0, 1); PG8_STAGE(PG8_SB(0, 0), b2, voffB); PG8_STAGE(PG8_SB(0, 1), b2 + hstep, voffB); PG8_STAGE_A(PG8_SA(0, 0), last, 0, kb2);
            if (!fresh) PG8_WAIT_V(8);
            PG8_WAIT_L(0); PG8_BAR; PG8_MMA(1, 0, At, B0); PG8_MMA(1, 1, At, B1); PG8_BAR; PG8_SCHED;
            PG8_LDB(B0, 1, 0); PG8_LDB(B1, 1, 1); PG8_SCHED; PG8_LDA(At, 1, 0); PG8_STAGE_A(PG8_SA(0, 1), last, 1, kb2);
            if (fresh) { PG8_WAIT_VN(8 + Epi::NST); } else { PG8_WAIT_V(8); }
            PG8_WAIT_L(0); PG8_BAR; PG8_MMA(0, 0, At, B0); PG8_MMA(0, 1, At, B1); PG8_BAR; PG8_SCHED;
            PG8_LDA(At, 1, 1); PG8_STAGE(PG8_SB(1, 0), b3, voffB); PG8_STAGE(PG8_SB(1, 1), b3 + hstep, voffB); PG8_STAGE_A(PG8_SA(1, 0), last, 0, kb3);
            PG8_WAIT_V(8); PG8_WAIT_L(0); PG8_BAR; PG8_MMA(1, 0, At, B0); PG8_MMA(1, 1, At, B1); PG8_BAR; PG8_SCHED;
            }
        }
        if constexpr (ALIGN_EPI) { if (wr == 0) PG8_BAR; }
        if constexpr (!Epi::AFTER_DRAIN) { E(acc, cur, wr, wc, fr, fq); S.done(cur); }
        if (!has_next) break;
#pragma unroll
        for (int a = 0; a < 2; ++a)
#pragma unroll
            for (int b = 0; b < 2; ++b)
#pragma unroll
                for (int m = 0; m < 4; ++m)
#pragma unroll
                    for (int n = 0; n < 2; ++n) acc[a][b][m][n] = (f32x4){0.f, 0.f, 0.f, 0.f};
        cur = nxt; cA = nA; cB = nB; ++ui;
        if constexpr (GATHER) { cu[0][0] = nx[0][0]; cu[0][1] = nx[0][1]; cu[1][0] = nx[1][0]; cu[1][1] = nx[1][1]; }
        if constexpr (ALIGN_EPI) { if (wr == 1) PG8_BAR; }
    }
    PG8_WAIT_V(0);
    if constexpr (!ALIGN_EPI) { if (wr == 0) PG8_BAR; }
    PG8_BAR;
    if constexpr (Epi::AFTER_DRAIN) { E.fused(acc, cur, wr, wc, fr, fq, lds, wid, lane); S.done(cur); }
#undef PG8_SA
#undef PG8_SB
#undef PG8_STAGE
#undef PG8_STAGE_A
#undef PG8_ROWS
#undef PG8_LDA
#undef PG8_LDB
#undef PG8_MMA
#undef PG8_WAIT_V
#undef PG8_WAIT_VN
#undef PG8_WAIT_L
#undef PG8_BAR
#undef PG8_SCHED
}
}
namespace att {
using bf16 = unsigned short;
using bf16x8 = __attribute__((ext_vector_type(8))) short;
using s16x4  = __attribute__((ext_vector_type(4))) short;
using f32x16 = __attribute__((ext_vector_type(16))) float;
using u32x4  = __attribute__((ext_vector_type(4))) unsigned;
constexpr int LDQKV = 64, LDO = 2112;
constexpr int SEQ_ = 8192;
constexpr size_t OKTS = (size_t)32768 * 64;
constexpr size_t QPS = (size_t)32768 * LDQKV;
#define QCOL(c) ((size_t)((c) >> 6) * QPS + (size_t)((c) & 63))
constexpr size_t SHM_V = 64 * 128 * 2, SHM_K = 64 * 128 * 2, SHM_ATTN = 2 * SHM_V + 2 * SHM_K + 8 * 64 * 4 + 64;
#define KSWZ(row, colB) ((row) * 256 + ((colB) ^ (((row) & 7) << 4)))
#define SBAR() __builtin_amdgcn_sched_barrier(0)
__device__ __forceinline__ int crow(int r, int hi) { return (r & 3) + 8 * (r >> 2) + 4 * hi; }
__device__ __forceinline__ unsigned cvtpk(float lo, float hi) { unsigned r; asm volatile("v_cvt_pk_bf16_f32 %0, %1, %2" : "=v"(r) : "v"(lo), "v"(hi)); return r; }
__device__ __forceinline__ int v_st(int k, int c) { const int kk = (k & ~0xC) | ((k & 4) << 1) | ((k & 8) >> 1); return ((kk >> 3) * 4 + (c >> 5)) * 512 + ((kk & 7) * 32 + (c & 31)) * 2; }
__device__ __forceinline__ int v_rd_base(int lane) { return ((lane & 3) << 3) | (((lane >> 2) & 3) << 6) | (((lane >> 4) & 1) << 5) | (((lane >> 5) & 1) << 8); }
constexpr int v_rd_off(int d0, int ks, int half) { return d0 * 512 + ks * 4096 + half * 2048; }
template <int OFF> __device__ __forceinline__ s16x4 tr_read(int vb) { s16x4 r; asm volatile("ds_read_b64_tr_b16 %0, %1 offset:%2" : "=&v"(r) : "v"(vb), "i"(OFF) : "memory"); return r; }
template <int D0> __device__ __forceinline__ void pv_one(f32x16& od, int vb, bf16x8 pa0, bf16x8 pa1, bf16x8 pa2, bf16x8 pa3) {
  const s16x4 l0 = tr_read<v_rd_off(D0, 0, 0)>(vb), h0 = tr_read<v_rd_off(D0, 0, 1)>(vb), l1 = tr_read<v_rd_off(D0, 1, 0)>(vb), h1 = tr_read<v_rd_off(D0, 1, 1)>(vb);
  const s16x4 l2 = tr_read<v_rd_off(D0, 2, 0)>(vb), h2 = tr_read<v_rd_off(D0, 2, 1)>(vb), l3 = tr_read<v_rd_off(D0, 3, 0)>(vb), h3 = tr_read<v_rd_off(D0, 3, 1)>(vb);
  asm volatile("s_waitcnt lgkmcnt(0)" ::: "memory"); SBAR();
#define PK(L, H) (bf16x8){L[0], L[1], L[2], L[3], H[0], H[1], H[2], H[3]}
  od = __builtin_amdgcn_mfma_f32_32x32x16_bf16(pa0, PK(l0, h0), od, 0, 0, 0);
  od = __builtin_amdgcn_mfma_f32_32x32x16_bf16(pa1, PK(l1, h1), od, 0, 0, 0);
  od = __builtin_amdgcn_mfma_f32_32x32x16_bf16(pa2, PK(l2, h2), od, 0, 0, 0);
  od = __builtin_amdgcn_mfma_f32_32x32x16_bf16(pa3, PK(l3, h3), od, 0, 0, 0);
#undef PK
}
__device__ __forceinline__ void pv_d0(f32x16* o, int vb, bf16x8 pa0, bf16x8 pa1, bf16x8 pa2, bf16x8 pa3) {
  pv_one<0>(o[0], vb, pa0, pa1, pa2, pa3); pv_one<1>(o[1], vb, pa0, pa1, pa2, pa3); pv_one<2>(o[2], vb, pa0, pa1, pa2, pa3); pv_one<3>(o[3], vb, pa0, pa1, pa2, pa3);
}
__device__ __forceinline__ void pack_p(const f32x16& p0, const f32x16& p1, bf16x8& pa0, bf16x8& pa1, bf16x8& pa2, bf16x8& pa3) {
#define PK4(P, BASE, OUT) do { unsigned a0 = cvtpk(P[BASE + 0], P[BASE + 1]), a1 = cvtpk(P[BASE + 2], P[BASE + 3]);   \
    unsigned b0 = cvtpk(P[BASE + 4], P[BASE + 5]), b1 = cvtpk(P[BASE + 6], P[BASE + 7]);                              \
    auto r0 = __builtin_amdgcn_permlane32_swap(a0, b0, false, false); auto r1 = __builtin_amdgcn_permlane32_swap(a1, b1, false, false); \
    u32x4 w = {r0[0], r1[0], r0[1], r1[1]}; OUT = *reinterpret_cast<bf16x8*>(&w); } while (0)
  PK4(p0, 0, pa0); PK4(p0, 8, pa1); PK4(p1, 0, pa2); PK4(p1, 8, pa3);
#undef PK4
}
template <int ND> __device__ __forceinline__ void qkt(f32x16& p0, f32x16& p1, const char* Ks, const bf16x8* qr, int cb0, int r32, int hi) {
  p0 = f32x16{}; p1 = f32x16{};
#pragma unroll
  for (int d0 = 0; d0 < ND; ++d0) { const int cb = cb0 + (d0 * 16 + hi * 8) * 2;
    const bf16x8 b0 = *reinterpret_cast<const bf16x8*>(Ks + KSWZ(r32, cb));
    const bf16x8 b1 = *reinterpret_cast<const bf16x8*>(Ks + KSWZ(32 + r32, cb));
    p0 = __builtin_amdgcn_mfma_f32_32x32x16_bf16(b0, qr[d0], p0, 0, 0, 0);
    p1 = __builtin_amdgcn_mfma_f32_32x32x16_bf16(b1, qr[d0], p1, 0, 0, 0); }
}
constexpr float THRL = 11.5f;
__device__ __forceinline__ void partialSM(f32x16& p0, f32x16& p1, float& m_reg, float& mn, float& alpha) {
  float pmax = p0[0];
#pragma unroll
  for (int r = 1; r < 16; ++r) pmax = fmaxf(pmax, p0[r]);
#pragma unroll
  for (int r = 0; r < 16; ++r) pmax = fmaxf(pmax, p1[r]);
  { auto rr = __builtin_amdgcn_permlane32_swap(__float_as_uint(pmax), __float_as_uint(pmax), false, false); pmax = fmaxf(__uint_as_float(rr[0]), __uint_as_float(rr[1])); }
  if (__builtin_expect(__all(pmax - m_reg <= THRL), 1)) { mn = m_reg; alpha = 1.f; }
  else { mn = fmaxf(m_reg, pmax); alpha = __builtin_amdgcn_exp2f(m_reg - mn); m_reg = mn; }
#pragma unroll
  for (int r = 0; r < 16; ++r) p0[r] = p0[r] - mn;
#pragma unroll
  for (int r = 0; r < 16; ++r) p1[r] = p1[r] - mn;
#pragma unroll
  for (int r = 0; r < 16; ++r) p0[r] = __builtin_amdgcn_exp2f(p0[r]);
}
__device__ __forceinline__ void finishSM(f32x16& p0, f32x16& p1, float alpha, float& l_reg, bf16x8& pa0, bf16x8& pa1, bf16x8& pa2, bf16x8& pa3) {
#pragma unroll
  for (int r = 0; r < 16; ++r) p1[r] = __builtin_amdgcn_exp2f(p1[r]);
  float ps = 0;
#pragma unroll
  for (int r = 0; r < 16; ++r) ps += p0[r];
#pragma unroll
  for (int r = 0; r < 16; ++r) ps += p1[r];
  { auto rr = __builtin_amdgcn_permlane32_swap(__float_as_uint(ps), __float_as_uint(ps), false, false); ps = __uint_as_float(rr[0]) + __uint_as_float(rr[1]); }
  l_reg = l_reg * alpha + ps;
  pack_p(p0, p1, pa0, pa1, pa2, pa3);
}
__device__ __forceinline__ float half_sum32(float v) { return half_sum32_(v); }


__device__ __forceinline__ void store_o_tile(const f32x16 (&o)[4], bf16* Ow  , char* wl  , int lane_e) {
  const int r32e = lane_e & 31, hie = lane_e >> 5;
  float* wf = (float*)wl;
#pragma unroll
  for (int r = 0; r < 16; ++r) { const int orow = crow(r, hie);
#pragma unroll
    for (int d0 = 0; d0 < 4; ++d0) wf[orow * 128 + d0 * 32 + r32e] = o[d0][r]; }
  asm volatile("s_waitcnt lgkmcnt(0)" ::: "memory");
#pragma unroll
  for (int i = 0; i < 8; ++i) { const int row = 4 * i + (lane_e >> 4), ch = lane_e & 15;
    const float* src = wf + row * 128 + ch * 8;
    const float a0 = src[0], a1 = src[1], a2 = src[2], a3 = src[3], a4 = src[4], a5 = src[5], a6 = src[6], a7 = src[7];
    u32x4 w; w.x = cvtpk(a0, a1); w.y = cvtpk(a2, a3); w.z = cvtpk(a4, a5); w.w = cvtpk(a6, a7);
    *(u32x4*)(Ow + (size_t)row * LDO + ch * 8) = w; }
  asm volatile("s_waitcnt lgkmcnt(0)" ::: "memory");
}

__device__ __forceinline__ void diff_unit(int b, int h, int qb, const bf16* __restrict__ QKV, bf16* __restrict__ Oout, const float* __restrict__ gdiff, float lam, float oscale, char* lds) {
  const int tid = threadIdx.x, lane = tid & 63, r32 = lane & 31, hi = lane >> 5; const int wid = __builtin_amdgcn_readfirstlane(tid >> 6);
  const int map = wid >> 2, wq = wid & 3;
  bf16* V_lds = (bf16*)lds; bf16* K_lds = (bf16*)(lds + 2 * SHM_V);
  float* ws = (float*)(lds + 2 * SHM_V + 2 * SHM_K) + wid * 64; float* li_l = ws; float* al_l = ws + 32;
  float m_reg = -1e30f, l_reg = 0; f32x16 o[4] = {}; bf16x8 qr[4];
  const size_t rowb = (size_t)b * SEQ_;
  const bf16* Qw = QKV + (rowb + qb * 128 + wq * 32 + r32) * LDQKV + QCOL(3072 + h * 128) + map * 64 + hi * 8;
#pragma unroll
  for (int d0 = 0; d0 < 4; ++d0) qr[d0] = *reinterpret_cast<const bf16x8*>(Qw + d0 * 16);
  const bf16* Kh = QKV + rowb * LDQKV + QCOL(4096 + h * 128); const bf16* Vh = QKV + rowb * LDQKV + QCOL(5120 + h * 128);
  const int sr = tid >> 4, sc = (tid & 15) * 8, vst0 = v_st(sr, sc), vst1 = v_st(32 + sr, sc);
  const int vb0 = (int)(uintptr_t)V_lds + v_rd_base(lane);
  const int cbm = map * 128;
  struct { bf16x8 vs0, vs1, ks0, ks1; } sr_[1];
  const unsigned toff0 = (unsigned)(sr * LDQKV + sc), toff1 = toff0 + 32u * LDQKV;
#define SLOAD(i, k0) do { const bf16* vt_ = Vh + (size_t)(k0) * LDQKV; const bf16* kt_ = Kh + (size_t)(k0) * LDQKV; \
    sr_[i].vs0 = *reinterpret_cast<const bf16x8*>(vt_ + toff0); sr_[i].vs1 = *reinterpret_cast<const bf16x8*>(vt_ + toff1); \
    sr_[i].ks0 = *reinterpret_cast<const bf16x8*>(kt_ + toff0); sr_[i].ks1 = *reinterpret_cast<const bf16x8*>(kt_ + toff1); } while (0)
#define SWRITE(bb, i) do { *(bf16x8*)((char*)V_lds + (bb) * SHM_V + vst0) = sr_[i].vs0; *(bf16x8*)((char*)V_lds + (bb) * SHM_V + vst1) = sr_[i].vs1; const int kc = sc * 2; \
    *(bf16x8*)((char*)K_lds + (bb) * SHM_K + KSWZ(sr, kc)) = sr_[i].ks0; *(bf16x8*)((char*)K_lds + (bb) * SHM_K + KSWZ(32 + sr, kc)) = sr_[i].ks1; } while (0)
#define SWAIT() asm volatile("s_waitcnt vmcnt(0)" ::: "memory")
#define RESC(a) do { if (__any((a) < 1.f)) { if (hi == 0) al_l[r32] = (a); asm volatile("s_waitcnt lgkmcnt(0)" ::: "memory"); \
    _Pragma("unroll") for (int d = 0; d < 4; ++d) _Pragma("unroll") for (int r = 0; r < 16; ++r) o[d][r] *= al_l[crow(r, hi)]; } } while (0)
  f32x16 pA0, pA1, pB0, pB1; float mnA, mnB, alA, alB; bf16x8 pa0, pa1, pa2, pa3; const int NT = 2 * qb + 2;
  __syncthreads();
  SLOAD(0, 0); asm volatile("s_waitcnt vmcnt(0)" ::: "memory"); SWRITE(0, 0); __syncthreads();
  qkt<4>(pA0, pA1, (const char*)K_lds, qr, cbm, r32, hi); partialSM(pA0, pA1, m_reg, mnA, alA);
  SLOAD(0, 64);
  SWAIT(); SWRITE(1, 0); __syncthreads();
  for (int j = 1; j + 1 < NT; j += 2) {
    SBAR(); qkt<4>(pB0, pB1, (const char*)K_lds + SHM_K, qr, cbm, r32, hi);
    finishSM(pA0, pA1, alA, l_reg, pa0, pa1, pa2, pa3); SBAR();
    SLOAD(0, (j + 1) * 64); SBAR();
    pv_d0(o, vb0, pa0, pa1, pa2, pa3); partialSM(pB0, pB1, m_reg, mnB, alB);
    __syncthreads(); SWAIT(); SWRITE(0, 0);
    RESC(alB); __syncthreads();
    SBAR(); qkt<4>(pA0, pA1, (const char*)K_lds, qr, cbm, r32, hi);
    finishSM(pB0, pB1, alB, l_reg, pa0, pa1, pa2, pa3); SBAR();
    SLOAD(0, (j + 2) * 64); SBAR();
    pv_d0(o, vb0 + (int)SHM_V, pa0, pa1, pa2, pa3); partialSM(pA0, pA1, m_reg, mnA, alA);
    __syncthreads(); SWAIT(); SWRITE(1, 0);
    RESC(alA); __syncthreads();
  }
  SBAR(); qkt<4>(pB0, pB1, (const char*)K_lds + SHM_K, qr, cbm, r32, hi);
  if (wq < 2) {
#pragma unroll
    for (int r = 0; r < 16; ++r) { pB0[r] = -1e30f; pB1[r] = -1e30f; } }
  finishSM(pA0, pA1, alA, l_reg, pa0, pa1, pa2, pa3); SBAR();
  pv_d0(o, vb0, pa0, pa1, pa2, pa3); partialSM(pB0, pB1, m_reg, mnB, alB);
  __syncthreads(); RESC(alB);
  finishSM(pB0, pB1, alB, l_reg, pa0, pa1, pa2, pa3); SBAR();
  pv_d0(o, vb0 + (int)SHM_V, pa0, pa1, pa2, pa3);
  if (hi == 0) li_l[r32] = l_reg; asm volatile("s_waitcnt lgkmcnt(0)" ::: "memory");
  float rli[16];
#pragma unroll
  for (int r = 0; r < 16; ++r) rli[r] = __builtin_amdgcn_rcpf(li_l[crow(r, hi)]);
  __syncthreads();
  float* xch = (float*)lds + (size_t)wq * 4096;
  if (map == 1) {
#pragma unroll
    for (int d0 = 0; d0 < 4; ++d0)
#pragma unroll
      for (int r = 0; r < 16; ++r) xch[(d0 * 16 + r) * 64 + lane] = o[d0][r] * rli[r] * lam;
  }
  __syncthreads();
  if (map == 0) {
    float ss[16];
#pragma unroll
    for (int r = 0; r < 16; ++r) { float s = 0.f;
#pragma unroll
      for (int d0 = 0; d0 < 4; ++d0) { const float v = o[d0][r] * rli[r] - xch[(d0 * 16 + r) * 64 + lane]; o[d0][r] = v; s += v * v; }
      ss[r] = s; }
#pragma unroll
    for (int r = 0; r < 16; ++r) ss[r] = half_sum32(ss[r]);
    bf16* Ow = Oout + (rowb + qb * 128 + wq * 32) * LDO + 1024 + h * 128;
    float gv[4];
#pragma unroll
    for (int d0 = 0; d0 < 4; ++d0) gv[d0] = gdiff[d0 * 32 + r32] * oscale;
#pragma unroll
    for (int r = 0; r < 16; ++r) { const int orow = crow(r, hi); const float rs = rsqrtf(ss[r] * (1.f / 128.f) + 1e-6f);
#pragma unroll
      for (int d0 = 0; d0 < 4; ++d0) { const float y = o[d0][r] * rs * gv[d0]; const unsigned w = cvtpk(y, y); Ow[(size_t)orow * LDO + d0 * 32 + r32] = (bf16)(w & 0xffffu); } }
  }
#undef SLOAD
#undef SWRITE
#undef SWAIT
#undef RESC
}
__device__ __forceinline__ void sb_wave_unit(int b, int h, int wq, const bf16* __restrict__ QKV, bf16* __restrict__ Oout, const float* __restrict__ gsb, char* ldsw, int maxt = 1 << 30) {
  FRESH_LANE(lane);
  const int r32 = lane & 31, hi = lane >> 5;
  char* V_lds = ldsw; char* K_lds = ldsw + 8192;
  f32x16 o[4] = {}; bf16x8 qr[8];
  const size_t rowb = (size_t)b * SEQ_;
  const int Q0 = wq * 32, tq = Q0 + r32;
  const bf16* Qw = QKV + (rowb + tq) * LDQKV + QCOL(h * 128) + hi * 8;
#pragma unroll
  for (int d0 = 0; d0 < 8; ++d0) qr[d0] = *reinterpret_cast<const bf16x8*>(Qw + (size_t)(d0 >> 2) * QPS + (d0 & 3) * 16);
  const bf16* Kh = QKV + rowb * LDQKV + QCOL(1024 + h * 128); const bf16* Vh = QKV + rowb * LDQKV + QCOL(2048 + h * 128);
  const int skey = lane >> 4, scol = (lane & 15) * 8;
  const size_t toff = (size_t)(scol >> 6) * QPS + (size_t)(skey * LDQKV + (scol & 63));
  const int lc0 = (lane & 15) ^ skey, lc1 = (lane & 15) ^ (4 + skey);
  const size_t koff0 = (size_t)(lc0 >> 3) * QPS + (size_t)(skey * LDQKV + (lc0 & 7) * 8), koff1 = (size_t)(lc1 >> 3) * QPS + (size_t)(skey * LDQKV + (lc1 & 7) * 8);
  typedef __attribute__((address_space(3))) unsigned lds_u32;
  lds_u32* kl = (lds_u32*)(K_lds);
  const int vb0 = (int)(uintptr_t)V_lds + v_rd_base(lane);
  bf16x8 vs[8];
#define SB_LOADV(j) do { const bf16* vt_ = Vh + (size_t)(j) * 32 * LDQKV; \
    _Pragma("unroll") for (int i_ = 0; i_ < 8; ++i_) vs[i_] = *reinterpret_cast<const bf16x8*>(vt_ + toff + (unsigned)(4 * i_) * LDQKV); } while (0)
#define SB_DMAK(j) do { const bf16* kt_ = Kh + (size_t)(j) * 32 * LDQKV; \
    _Pragma("unroll") for (int p_ = 0; p_ < 8; ++p_) __builtin_amdgcn_global_load_lds((const unsigned*)(kt_ + (unsigned)(4 * p_) * LDQKV + ((p_ & 1) ? koff1 : koff0)), kl + p_ * 256, 16, 0, 0); } while (0)
  float carry = 0.f;
  SB_DMAK(wq); SB_LOADV(wq);
  for (int j = wq; j >= 0; --j) {
    asm volatile("s_waitcnt vmcnt(0)" ::: "memory");
#pragma unroll
    for (int i = 0; i < 8; ++i) { const int key = 4 * i + skey; *(bf16x8*)(V_lds + v_st(key, scol)) = vs[i]; }
    asm volatile("s_waitcnt lgkmcnt(0)" ::: "memory");
    if (j > 0) SB_LOADV(j - 1);
    f32x16 p0 = f32x16{};
#pragma unroll
    for (int d0 = 0; d0 < 8; ++d0) { const int cb = (d0 * 16 + hi * 8) * 2;
      const bf16x8 b0 = *reinterpret_cast<const bf16x8*>(K_lds + KSWZ(r32, cb));
      p0 = __builtin_amdgcn_mfma_f32_32x32x16_bf16(b0, qr[d0], p0, 0, 0, 0); }
    asm volatile("s_waitcnt lgkmcnt(0)" ::: "memory");
    if (j > 0) SB_DMAK(j - 1);
    const bool diag = (j == wq);
    const int kb = j * 32 + 4 * hi;
    f32x16 q0;
#pragma unroll
    for (int r = 0; r < 16; ++r) {
      const float z0 = __builtin_amdgcn_fmed3f(p0[r], -120.f, 120.f);
      float a0 = -__builtin_amdgcn_logf(1.f + __builtin_amdgcn_exp2f(z0));
      float b0 = z0 + a0;
      if (diag) { const int kv = kb + (r & 3) + 8 * (r >> 2); if (kv >= tq) { a0 = 0.f; b0 = -1e30f; } }
      q0[r] = a0; p0[r] = b0; }
    float G[4], PG[4], SUF[4];
#pragma unroll
    for (int g = 0; g < 4; ++g) G[g] = (q0[4 * g] + q0[4 * g + 1]) + (q0[4 * g + 2] + q0[4 * g + 3]);
    float CS[4];
#pragma unroll
    for (int g = 0; g < 4; ++g) { auto rr = __builtin_amdgcn_permlane32_swap(__float_as_uint(G[g]), __float_as_uint(G[g]), false, false);
      CS[g] = __uint_as_float(rr[0]) + __uint_as_float(rr[1]); PG[g] = __uint_as_float(rr[1]); }
    float run = carry;
#pragma unroll
    for (int g = 3; g >= 0; --g) { SUF[g] = run; run += CS[g]; }
    carry = run;
#pragma unroll
    for (int g = 0; g < 4; ++g) SUF[g] += (hi == 0) ? PG[g] : 0.f;
#pragma unroll
    for (int g = 0; g < 4; ++g) {
      float s = SUF[g];
      p0[4 * g + 3] = __builtin_amdgcn_exp2f(p0[4 * g + 3] + s); s += q0[4 * g + 3];
      p0[4 * g + 2] = __builtin_amdgcn_exp2f(p0[4 * g + 2] + s); s += q0[4 * g + 2];
      p0[4 * g + 1] = __builtin_amdgcn_exp2f(p0[4 * g + 1] + s); s += q0[4 * g + 1];
      p0[4 * g + 0] = __builtin_amdgcn_exp2f(p0[4 * g + 0] + s);
    }
    bf16x8 pa0, pa1;
#define PK4(P, BASE, OUT) do { unsigned a0 = cvtpk(P[BASE + 0], P[BASE + 1]), a1 = cvtpk(P[BASE + 2], P[BASE + 3]);   \
    unsigned b0 = cvtpk(P[BASE + 4], P[BASE + 5]), b1 = cvtpk(P[BASE + 6], P[BASE + 7]);                              \
    auto r0 = __builtin_amdgcn_permlane32_swap(a0, b0, false, false); auto r1 = __builtin_amdgcn_permlane32_swap(a1, b1, false, false); \
    u32x4 w = {r0[0], r1[0], r0[1], r1[1]}; OUT = *reinterpret_cast<bf16x8*>(&w); } while (0)
    PK4(p0, 0, pa0); PK4(p0, 8, pa1);
#undef PK4
#define SB_PV(D0) do { const s16x4 l0 = tr_read<v_rd_off(D0, 0, 0)>(vb0), h0 = tr_read<v_rd_off(D0, 0, 1)>(vb0), l1 = tr_read<v_rd_off(D0, 1, 0)>(vb0), h1 = tr_read<v_rd_off(D0, 1, 1)>(vb0); \
    asm volatile("s_waitcnt lgkmcnt(0)" ::: "memory"); SBAR(); \
    o[D0] = __builtin_amdgcn_mfma_f32_32x32x16_bf16(pa0, (bf16x8){l0[0], l0[1], l0[2], l0[3], h0[0], h0[1], h0[2], h0[3]}, o[D0], 0, 0, 0); \
    o[D0] = __builtin_amdgcn_mfma_f32_32x32x16_bf16(pa1, (bf16x8){l1[0], l1[1], l1[2], l1[3], h1[0], h1[1], h1[2], h1[3]}, o[D0], 0, 0, 0); } while (0)
    SB_PV(0); SB_PV(1); SB_PV(2); SB_PV(3);
#undef SB_PV
    if (__all(carry < -160.f)) break;
    if (wq - j + 1 >= maxt) break;
  }
#undef SB_LOADV
#undef SB_DMAK
  asm volatile("s_waitcnt vmcnt(0)" ::: "memory");
  { FRESH_LANE(le_); const int r32e = le_ & 31; float gv[4];
#pragma unroll
    for (int d0 = 0; d0 < 4; ++d0) gv[d0] = gsb[d0 * 32 + r32e];
#pragma unroll
    for (int r = 0; r < 16; ++r) { float s = 0.f;
#pragma unroll
      for (int d0 = 0; d0 < 4; ++d0) s += o[d0][r] * o[d0][r];
      const float rs = rsqrtf(half_sum32(s) * (1.f / 128.f) + 1e-6f);
#pragma unroll
      for (int d0 = 0; d0 < 4; ++d0) o[d0][r] = o[d0][r] * rs * gv[d0]; }
    store_o_tile(o, Oout + (rowb + Q0) * LDO + h * 128, ldsw, le_);
  }
  asm volatile("s_waitcnt vmcnt(0)" ::: "memory");
}
__device__ __forceinline__ void sb_wave_seq(int uid0, int stride, int nunits, const bf16* __restrict__ QKV, bf16* __restrict__ Oout, const float* __restrict__ gsb, char* ldsw) {
  if (uid0 >= nunits) return;
  FRESH_LANE(lane);
  const int r32 = lane & 31, hi = lane >> 5;
  char* V_lds = ldsw; char* K_lds = ldsw + 8192;
  const int skey = lane >> 4, scol = (lane & 15) * 8;
  const size_t toff = (size_t)(scol >> 6) * QPS + (size_t)(skey * LDQKV + (scol & 63));
  const int lc0 = (lane & 15) ^ skey, lc1 = (lane & 15) ^ (4 + skey);
  const size_t koff0 = (size_t)(lc0 >> 3) * QPS + (size_t)(skey * LDQKV + (lc0 & 7) * 8), koff1 = (size_t)(lc1 >> 3) * QPS + (size_t)(skey * LDQKV + (lc1 & 7) * 8);
  typedef __attribute__((address_space(3))) unsigned lds_u32;
  lds_u32* kl = (lds_u32*)(K_lds);
  const int vb0 = (int)(uintptr_t)V_lds + v_rd_base(lane);
  bf16x8 vs[8], qr[8];
#define SQ_LOADV(Vh_, j) do { const bf16* vt_ = (Vh_) + (size_t)(j) * 32 * LDQKV; \
    _Pragma("unroll") for (int i_ = 0; i_ < 8; ++i_) vs[i_] = *reinterpret_cast<const bf16x8*>(vt_ + toff + (unsigned)(4 * i_) * LDQKV); } while (0)
#define SQ_DMAK(Kh_, j) do { const bf16* kt_ = (Kh_) + (size_t)(j) * 32 * LDQKV; \
    _Pragma("unroll") for (int p_ = 0; p_ < 8; ++p_) __builtin_amdgcn_global_load_lds((const unsigned*)(kt_ + (unsigned)(4 * p_) * LDQKV + ((p_ & 1) ? koff1 : koff0)), kl + p_ * 256, 16, 0, 0); } while (0)
#define SQ_LOADQ(dst, b_, h_, wq_) do { const bf16* Qw_ = QKV + ((size_t)(b_) * SEQ_ + (wq_) * 32 + r32) * LDQKV + QCOL((h_) * 128) + hi * 8; \
    _Pragma("unroll") for (int d0 = 0; d0 < 8; ++d0) dst[d0] = *reinterpret_cast<const bf16x8*>(Qw_ + (size_t)(d0 >> 2) * QPS + (d0 & 3) * 16); } while (0)
  int uid = uid0, b = uid >> 11, h = (uid >> 8) & 7, wq = uid & 255;
  const bf16* Kh = QKV + (size_t)b * SEQ_ * LDQKV + QCOL(1024 + h * 128); const bf16* Vh = QKV + (size_t)b * SEQ_ * LDQKV + QCOL(2048 + h * 128);
  SQ_LOADQ(qr, b, h, wq); SQ_DMAK(Kh, wq); SQ_LOADV(Vh, wq);
#pragma unroll 1
  for (;;) {
    const size_t rowb = (size_t)b * SEQ_; const int Q0 = wq * 32, tq = Q0 + r32;
    f32x16 o[4] = {};
    float carry = 0.f;
    for (int j = wq; j >= 0; --j) {
      if (j == wq && uid != uid0) asm volatile("s_waitcnt vmcnt(8)" ::: "memory");
      else asm volatile("s_waitcnt vmcnt(0)" ::: "memory");
#pragma unroll
      for (int i = 0; i < 8; ++i) { const int key = 4 * i + skey; *(bf16x8*)(V_lds + v_st(key, scol)) = vs[i]; }
      asm volatile("s_waitcnt lgkmcnt(0)" ::: "memory");
      if (j > 0) SQ_LOADV(Vh, j - 1);
      f32x16 p0 = f32x16{};
#pragma unroll
      for (int d0 = 0; d0 < 8; ++d0) { const int cb = (d0 * 16 + hi * 8) * 2;
        const bf16x8 b0 = *reinterpret_cast<const bf16x8*>(K_lds + KSWZ(r32, cb));
        p0 = __builtin_amdgcn_mfma_f32_32x32x16_bf16(b0, qr[d0], p0, 0, 0, 0); }
      asm volatile("s_waitcnt lgkmcnt(0)" ::: "memory");
      if (j > 0) SQ_DMAK(Kh, j - 1);
      const bool diag = (j == wq);
      const int kb = j * 32 + 4 * hi;
      f32x16 q0;
#pragma unroll
      for (int r = 0; r < 16; ++r) {
        const float z0 = __builtin_amdgcn_fmed3f(p0[r], -120.f, 120.f);
        float a0 = -__builtin_amdgcn_logf(1.f + __builtin_amdgcn_exp2f(z0));
        float b0 = z0 + a0;
        if (diag) { const int kv = kb + (r & 3) + 8 * (r >> 2); if (kv >= tq) { a0 = 0.f; b0 = -1e30f; } }
        q0[r] = a0; p0[r] = b0; }
      float G[4], PG[4], SUF[4];
#pragma unroll
      for (int g = 0; g < 4; ++g) G[g] = (q0[4 * g] + q0[4 * g + 1]) + (q0[4 * g + 2] + q0[4 * g + 3]);
      float CS[4];
#pragma unroll
      for (int g = 0; g < 4; ++g) { auto rr = __builtin_amdgcn_permlane32_swap(__float_as_uint(G[g]), __float_as_uint(G[g]), false, false);
        CS[g] = __uint_as_float(rr[0]) + __uint_as_float(rr[1]); PG[g] = __uint_as_float(rr[1]); }
      float run = carry;
#pragma unroll
      for (int g = 3; g >= 0; --g) { SUF[g] = run; run += CS[g]; }
      carry = run;
#pragma unroll
      for (int g = 0; g < 4; ++g) SUF[g] += (hi == 0) ? PG[g] : 0.f;
#pragma unroll
      for (int g = 0; g < 4; ++g) {
        float s_ = SUF[g];
        p0[4 * g + 3] = __builtin_amdgcn_exp2f(p0[4 * g + 3] + s_); s_ += q0[4 * g + 3];
        p0[4 * g + 2] = __builtin_amdgcn_exp2f(p0[4 * g + 2] + s_); s_ += q0[4 * g + 2];
        p0[4 * g + 1] = __builtin_amdgcn_exp2f(p0[4 * g + 1] + s_); s_ += q0[4 * g + 1];
        p0[4 * g + 0] = __builtin_amdgcn_exp2f(p0[4 * g + 0] + s_);
      }
      bf16x8 pa0, pa1;
#define PK4(P, BASE, OUT) do { unsigned a0 = cvtpk(P[BASE + 0], P[BASE + 1]), a1 = cvtpk(P[BASE + 2], P[BASE + 3]);   \
      unsigned b0 = cvtpk(P[BASE + 4], P[BASE + 5]), b1 = cvtpk(P[BASE + 6], P[BASE + 7]);                              \
      auto r0 = __builtin_amdgcn_permlane32_swap(a0, b0, false, false); auto r1 = __builtin_amdgcn_permlane32_swap(a1, b1, false, false); \
      u32x4 w = {r0[0], r1[0], r0[1], r1[1]}; OUT = *reinterpret_cast<bf16x8*>(&w); } while (0)
      PK4(p0, 0, pa0); PK4(p0, 8, pa1);
#undef PK4
#define SQ_PV(D0) do { const s16x4 l0 = tr_read<v_rd_off(D0, 0, 0)>(vb0), h0 = tr_read<v_rd_off(D0, 0, 1)>(vb0), l1 = tr_read<v_rd_off(D0, 1, 0)>(vb0), h1 = tr_read<v_rd_off(D0, 1, 1)>(vb0); \
      asm volatile("s_waitcnt lgkmcnt(0)" ::: "memory"); SBAR(); \
      o[D0] = __builtin_amdgcn_mfma_f32_32x32x16_bf16(pa0, (bf16x8){l0[0], l0[1], l0[2], l0[3], h0[0], h0[1], h0[2], h0[3]}, o[D0], 0, 0, 0); \
      o[D0] = __builtin_amdgcn_mfma_f32_32x32x16_bf16(pa1, (bf16x8){l1[0], l1[1], l1[2], l1[3], h1[0], h1[1], h1[2], h1[3]}, o[D0], 0, 0, 0); } while (0)
      SQ_PV(0); SQ_PV(1); SQ_PV(2); SQ_PV(3);
#undef SQ_PV
      if (__all(carry < -160.f)) break;
    }
    asm volatile("s_waitcnt vmcnt(0)" ::: "memory");
    const int nuid = uid + stride; const bool has_next = nuid < nunits;
    const int nb = nuid >> 11, nh = (nuid >> 8) & 7, nwq = nuid & 255;
    const bf16* Khn = QKV + (size_t)nb * SEQ_ * LDQKV + QCOL(1024 + nh * 128); const bf16* Vhn = QKV + (size_t)nb * SEQ_ * LDQKV + QCOL(2048 + nh * 128);
    bf16x8 qn[8];
    if (has_next) { SQ_LOADQ(qn, nb, nh, nwq); SQ_DMAK(Khn, nwq); SQ_LOADV(Vhn, nwq); }
    else {
#pragma unroll
      for (int d0 = 0; d0 < 8; ++d0) qn[d0] = bf16x8{}; }
    { FRESH_LANE(le_); const int r32e = le_ & 31, hie = le_ >> 5; float gv[4];
#pragma unroll
      for (int d0 = 0; d0 < 4; ++d0) gv[d0] = gsb[d0 * 32 + r32e];
#pragma unroll
      for (int r = 0; r < 16; ++r) { float s_ = 0.f;
#pragma unroll
        for (int d0 = 0; d0 < 4; ++d0) s_ += o[d0][r] * o[d0][r];
        const float rs = rsqrtf(half_sum32(s_) * (1.f / 128.f) + 1e-6f);
#pragma unroll
        for (int d0 = 0; d0 < 4; ++d0) o[d0][r] = o[d0][r] * rs * gv[d0]; }
      bf16* Ow = Oout + (rowb + Q0) * LDO + h * 128; float* wf = (float*)V_lds;
#pragma unroll
      for (int ps = 0; ps < 2; ++ps) {
#pragma unroll
        for (int r = 8 * ps; r < 8 * ps + 8; ++r) { const int orow = crow(r, hie) - 16 * ps;
#pragma unroll
          for (int d0 = 0; d0 < 4; ++d0) wf[orow * 128 + d0 * 32 + r32e] = o[d0][r]; }
        asm volatile("s_waitcnt lgkmcnt(0)" ::: "memory");
#pragma unroll
        for (int i = 0; i < 4; ++i) { const int row = 4 * i + (le_ >> 4), ch = le_ & 15;
          const float* src = wf + row * 128 + ch * 8;
          const float a0 = src[0], a1 = src[1], a2 = src[2], a3 = src[3], a4 = src[4], a5 = src[5], a6 = src[6], a7 = src[7];
          u32x4 w; w.x = cvtpk(a0, a1); w.y = cvtpk(a2, a3); w.z = cvtpk(a4, a5); w.w = cvtpk(a6, a7);
          *(u32x4*)(Ow + (size_t)(16 * ps + row) * LDO + ch * 8) = w; }
        asm volatile("s_waitcnt lgkmcnt(0)" ::: "memory"); }
    }
    if (!has_next) break;
    uid = nuid; b = nb; h = nh; wq = nwq; Kh = Khn; Vh = Vhn;
#pragma unroll
    for (int d0 = 0; d0 < 8; ++d0) qr[d0] = qn[d0];
  }
  asm volatile("s_waitcnt vmcnt(0)" ::: "memory");
#undef SQ_LOADV
#undef SQ_DMAK
#undef SQ_LOADQ
}
#undef KSWZ
#undef SBAR
}
namespace att {
typedef __attribute__((address_space(3))) const char* lds_cptr;
typedef short v4i16_t __attribute__((ext_vector_type(4)));
constexpr int D2_K = 0, D2_V = 49152, D2_WS = 98304, D2_SLOT = 16384;
constexpr float THR2 = 8.f;
__device__ __forceinline__ void glds16(const void* gsrc, unsigned lds_dst) { unsigned keep;
  asm volatile("s_mov_b32 %0, m0\n\ts_mov_b32 m0, %2\n\ts_nop 0\n\tglobal_load_lds_dwordx4 %1, off\n\ts_mov_b32 m0, %0" : "=&s"(keep) : "v"(gsrc), "s"(lds_dst) : "memory"); }
__device__ __forceinline__ s16x4 vtr(lds_cptr p) { return __builtin_bit_cast(s16x4, __builtin_amdgcn_ds_read_tr16_b64_v4i16((__attribute__((address_space(3))) v4i16_t*)p)); }
__device__ __forceinline__ float max3f(float a, float b, float c) { return __builtin_fmaxf(__builtin_fmaxf(a, b), c); }
__device__ __forceinline__ float rowmax2(const f32x16& p0, const f32x16& p1) {
  float a = max3f(p0[0], p0[1], p1[0]), b = max3f(p0[2], p0[3], p1[1]); a = max3f(a, p1[2], p1[3]);
#pragma unroll
  for (int r = 4; r < 16; r += 4) { a = max3f(a, p0[r], p0[r + 1]); b = max3f(b, p0[r + 2], p0[r + 3]); a = max3f(a, p1[r], p1[r + 1]); b = max3f(b, p1[r + 2], p1[r + 3]); }
  const float m = __builtin_fmaxf(a, b);
  auto rr = __builtin_amdgcn_permlane32_swap(__float_as_uint(m), __float_as_uint(m), false, false);
  return __builtin_fmaxf(__uint_as_float(rr[0]), __uint_as_float(rr[1]));
}
#define SBAR2() __builtin_amdgcn_sched_barrier(0)
#define WAIT_BAR2(N) asm volatile("s_waitcnt vmcnt(" #N ") lgkmcnt(0)\n\ts_barrier" ::: "memory")
__device__ __forceinline__ void diff_unit2(int b, int h, int qb, const bf16* __restrict__ QKV, bf16* __restrict__ Oout, const float* __restrict__ gdiff, float lam, float oscale, char* shm, int wid, const float* __restrict__ kmax2, int fixed_tile = 0) {
  const bool nodma_ = (fixed_tile == 2);
  int lane; asm volatile("v_mbcnt_lo_u32_b32 %0, -1, 0\n\tv_mbcnt_hi_u32_b32 %0, -1, %0" : "=v"(lane));
  const int r32 = lane & 31, hi = lane >> 5;
  const int map = wid >> 2, wq = wid & 3;
  const size_t rowb = (size_t)b * SEQ_;
  const bf16* Kh = QKV + rowb * LDQKV + QCOL(4096 + h * 128); const bf16* Vh = QKV + rowb * LDQKV + QCOL(5120 + h * 128);
  const unsigned lds0 = (unsigned)(uintptr_t)shm;
  float* wsf = (float*)(shm + D2_WS) + wid * 64;
  const bf16* ksrc = Kh + (size_t)lane * LDQKV + wid * 8;
  const bf16* vsrc = Vh + (size_t)(16 * (wid & 3) + (lane >> 2)) * LDQKV + (wid >> 2) * 32 + (lane & 3) * 8;
  const unsigned kdst = lds0 + D2_K + wid * 1024, vdst = lds0 + D2_V + wid * 1024;
#define DMA_K(t, slot) do { const bf16* s_ = ksrc + (size_t)(fixed_tile ? 0 : (t)) * 64 * LDQKV; const unsigned d_ = (unsigned)__builtin_amdgcn_readfirstlane(kdst + (slot)); glds16(s_, d_); glds16(s_ + QPS, d_ + 8192); } while (0)
#define DMA_V(t, slot) do { const bf16* s_ = vsrc + (size_t)(fixed_tile ? 0 : (t)) * 64 * LDQKV; const unsigned d_ = (unsigned)__builtin_amdgcn_readfirstlane(vdst + (slot)); glds16(s_, d_); glds16(s_ + QPS, d_ + 8192); } while (0)
  const lds_cptr shm3 = (lds_cptr)shm;
  const lds_cptr kp0 = shm3 + D2_K + (map * 8 + hi) * 1024 + r32 * 16;
  const lds_cptr vp0 = shm3 + D2_V + ((lane >> 4) & 1) * 32 + (lane & 3) * 8 + (4 * hi + ((lane & 15) >> 2)) * 64;
  const int NT = 2 * qb + 2;
  __syncthreads();
  DMA_K(0, 0); DMA_V(0, 0); DMA_K(1, D2_SLOT);
  bf16x8 qr[4];
  { const bf16* Qw = QKV + (rowb + qb * 128 + wq * 32 + r32) * LDQKV + QCOL(3072 + h * 128 + map * 64) + hi * 8;
#pragma unroll
    for (int d0 = 0; d0 < 4; ++d0) qr[d0] = *reinterpret_cast<const bf16x8*>(Qw + d0 * 16); }
  bool fastp;
  { float q2 = 0.f;
#pragma unroll
    for (int d0 = 0; d0 < 4; ++d0) { const u32x4 qw = __builtin_bit_cast(u32x4, qr[d0]);
#pragma unroll
      for (int e2 = 0; e2 < 4; ++e2) { const float a = __uint_as_float(qw[e2] << 16), c = __uint_as_float(qw[e2] & 0xffff0000u); q2 += a * a + c * c; } }
    { auto rr = __builtin_amdgcn_permlane32_swap(__float_as_uint(q2), __float_as_uint(q2), false, false); q2 = __uint_as_float(rr[0]) + __uint_as_float(rr[1]); }
    const float* km = kmax2 + (size_t)(((b * 8 + h) * 2 + map) * 128);
    float k2 = __builtin_fmaxf(km[lane], km[64 + lane]);
    k2 = __builtin_fmaxf(k2, swz_xor<1>(k2)); k2 = __builtin_fmaxf(k2, swz_xor<2>(k2)); k2 = __builtin_fmaxf(k2, swz_xor<4>(k2)); k2 = __builtin_fmaxf(k2, swz_xor<8>(k2)); k2 = __builtin_fmaxf(k2, swz_xor<16>(k2));
    { auto rr = __builtin_amdgcn_permlane32_swap(__float_as_uint(k2), __float_as_uint(k2), false, false); k2 = __builtin_fmaxf(__uint_as_float(rr[0]), __uint_as_float(rr[1])); }
    fastp = __all(q2 * k2 <= 8100.f) != 0; }
  float mhat = 0.f, l_reg = 0.f; f32x16 o[4];
  { float z_ = 0.f; asm volatile("" : "+v"(z_));
#pragma unroll
    for (int d_ = 0; d_ < 4; ++d_)
#pragma unroll
      for (int r = 0; r < 16; ++r) o[d_][r] = z_; }
  bool resc = false;
  f32x16 pA0, pA1, pB0, pB1;
  int sl_prev = 0, sl_cur = 0, sl_next = D2_SLOT;
#define ROT() do { sl_prev = sl_cur; sl_cur = sl_next; sl_next = (sl_next == 2 * D2_SLOT) ? 0 : sl_next + D2_SLOT; } while (0)
#define KF(kp, d0, half) (*(const __attribute__((address_space(3))) bf16x8*)((kp) + (d0) * 2048 + (half) * 512))
#define RESC2() do { if (resc) { asm volatile("s_waitcnt lgkmcnt(0)" ::: "memory"); \
      _Pragma("unroll") for (int d_ = 0; d_ < 4; ++d_) _Pragma("unroll") for (int r = 0; r < 16; ++r) o[d_][r] *= wsf[crow(r, hi)]; } } while (0)
  WAIT_BAR2(0);
  { const lds_cptr kp_ = kp0;
    pA0 = __builtin_amdgcn_mfma_f32_32x32x16_bf16(KF(kp_, 0, 0), qr[0], f32x16{}, 0, 0, 0); pA1 = __builtin_amdgcn_mfma_f32_32x32x16_bf16(KF(kp_, 0, 1), qr[0], f32x16{}, 0, 0, 0);
#pragma unroll
    for (int d0 = 1; d0 < 4; ++d0) { pA0 = __builtin_amdgcn_mfma_f32_32x32x16_bf16(KF(kp_, d0, 0), qr[d0], pA0, 0, 0, 0); pA1 = __builtin_amdgcn_mfma_f32_32x32x16_bf16(KF(kp_, d0, 1), qr[d0], pA1, 0, 0, 0); }
    const float rm = fastp ? 0.f : rowmax2(pA0, pA1); mhat = rm;
#pragma unroll
    for (int r = 0; r < 16; ++r) { pA0[r] = __builtin_amdgcn_exp2f(pA0[r] - rm); pA1[r] = __builtin_amdgcn_exp2f(pA1[r] - rm); }
    if (2 < NT) DMA_K(2, 2 * D2_SLOT);
    DMA_V(1, D2_SLOT);
    asm volatile("s_waitcnt lgkmcnt(0)\n\ts_barrier" ::: "memory");
    ROT(); }
  u32x4 pw0, pw1, pw2, pw3;
#define PKW(P, B) cvtpk(P[B], P[B + 1])
#define PAF(k) __builtin_bit_cast(bf16x8, pw##k)
#define MFQ(C, d0, half, first) C = __builtin_amdgcn_mfma_f32_32x32x16_bf16(KF(kp_, d0, half), qr[d0], (first) ? f32x16{} : C, 0, 0, 0)
#define VRD(i) do { vl[(i) & 3] = vtr(vp_ + ((i) & 3) * 4096 + ((i) >> 2) * 1024); vh[(i) & 3] = vtr(vp_ + ((i) & 3) * 4096 + ((i) >> 2) * 1024 + 512); } while (0)
#define VFR(i) (bf16x8){vl[(i) & 3][0], vl[(i) & 3][1], vl[(i) & 3][2], vl[(i) & 3][3], vh[(i) & 3][0], vh[(i) & 3][1], vh[(i) & 3][2], vh[(i) & 3][3]}
#define PIN2(x) asm volatile("" : "+v"(x))
#define EX2(C, B) do { C[B] = __builtin_amdgcn_exp2f(C[B]); C[(B) + 1] = __builtin_amdgcn_exp2f(C[(B) + 1]); asm volatile("" : "+v"(C)); } while (0)
#define KRD(i) kfr[(i) % 3] = KF(kp_, (i) >> 1, (i) & 1)
#define MFK(C, i, first) C = __builtin_amdgcn_mfma_f32_32x32x16_bf16(kfr[(i) % 3], qr[(i) >> 1], (first) ? f32x16{} : C, 0, 0, 0)
#define STEP2(C0, C1, P0, P1, t, GK, GV, MASKED, FAST) do { SBAR2(); \
    const lds_cptr kp_ = kp0 + sl_cur; const lds_cptr vp_ = vp0 + sl_prev; s16x4 vl[4], vh[4]; bf16x8 kfr[3]; \
    KRD(0); KRD(1); SBAR2(); \
    float sacc = P0[0] + P0[1]; \
    KRD(2); MFK(C0, 0, true);  sacc += P0[2]; sacc += P0[3]; sacc += P0[4]; sacc += P0[5]; asm volatile("" : "+v"(sacc));     pw0[0] = PKW(P0, 0); pw0[1] = PKW(P0, 2); SBAR2(); \
    KRD(3); MFK(C1, 1, true);  sacc += P0[6]; sacc += P0[7]; sacc += P0[8]; sacc += P0[9]; asm volatile("" : "+v"(sacc));     pw0[2] = PKW(P0, 4); pw0[3] = PKW(P0, 6); SBAR2(); \
    KRD(4); MFK(C0, 2, false); sacc += P0[10]; sacc += P0[11]; sacc += P0[12]; sacc += P0[13]; asm volatile("" : "+v"(sacc)); pw1[0] = PKW(P0, 8); pw1[1] = PKW(P0, 10); SBAR2(); \
    KRD(5); MFK(C1, 3, false); sacc += P0[14]; sacc += P0[15]; sacc += P1[0]; sacc += P1[1]; asm volatile("" : "+v"(sacc));   pw1[2] = PKW(P0, 12); pw1[3] = PKW(P0, 14); SBAR2(); \
    KRD(6); MFK(C0, 4, false); sacc += P1[2]; sacc += P1[3]; sacc += P1[4]; sacc += P1[5]; asm volatile("" : "+v"(sacc));     pw2[0] = PKW(P1, 0); pw2[1] = PKW(P1, 2); SBAR2(); \
    KRD(7); MFK(C1, 5, false); sacc += P1[6]; sacc += P1[7]; sacc += P1[8]; sacc += P1[9]; asm volatile("" : "+v"(sacc));     pw2[2] = PKW(P1, 4); pw2[3] = PKW(P1, 6); SBAR2(); \
    VRD(0); MFK(C0, 6, false); sacc += P1[10]; sacc += P1[11]; sacc += P1[12]; sacc += P1[13]; asm volatile("" : "+v"(sacc)); pw3[0] = PKW(P1, 8); pw3[1] = PKW(P1, 10); SBAR2(); \
    VRD(1); MFK(C1, 7, false); sacc += P1[14]; sacc += P1[15]; asm volatile("" : "+v"(sacc));                                 pw3[2] = PKW(P1, 12); pw3[3] = PKW(P1, 14); SBAR2(); \
    VRD(2); \
    l_reg += sacc; \
    if ((GK) && !nodma_) { DMA_K((t) + 2, sl_prev); } if ((GV) && !nodma_) { DMA_V((t) + 1, sl_next); } \
    if (MASKED) { _Pragma("unroll") for (int r = 0; r < 16; ++r) { C0[r] = -1e30f; C1[r] = -1e30f; } } \
    if (FAST) { resc = false; \
    SBAR2(); \
    VRD(3); o[0] = __builtin_amdgcn_mfma_f32_32x32x16_bf16(PAF(0), VFR(0), o[0], 0, 0, 0); C0[0] = __builtin_amdgcn_exp2f(C0[0]); C0[1] = __builtin_amdgcn_exp2f(C0[1]); PIN2(C0); SBAR2(); \
    VRD(4); o[1] = __builtin_amdgcn_mfma_f32_32x32x16_bf16(PAF(0), VFR(1), o[1], 0, 0, 0); C0[2] = __builtin_amdgcn_exp2f(C0[2]); C0[3] = __builtin_amdgcn_exp2f(C0[3]); PIN2(C0); SBAR2(); \
    VRD(5); o[2] = __builtin_amdgcn_mfma_f32_32x32x16_bf16(PAF(0), VFR(2), o[2], 0, 0, 0); C0[4] = __builtin_amdgcn_exp2f(C0[4]); C0[5] = __builtin_amdgcn_exp2f(C0[5]); PIN2(C0); SBAR2(); \
    VRD(6); o[3] = __builtin_amdgcn_mfma_f32_32x32x16_bf16(PAF(0), VFR(3), o[3], 0, 0, 0); C0[6] = __builtin_amdgcn_exp2f(C0[6]); C0[7] = __builtin_amdgcn_exp2f(C0[7]); PIN2(C0); SBAR2(); \
    VRD(7); o[0] = __builtin_amdgcn_mfma_f32_32x32x16_bf16(PAF(1), VFR(4), o[0], 0, 0, 0); C0[8] = __builtin_amdgcn_exp2f(C0[8]); C0[9] = __builtin_amdgcn_exp2f(C0[9]); PIN2(C0); SBAR2(); \
    VRD(8); o[1] = __builtin_amdgcn_mfma_f32_32x32x16_bf16(PAF(1), VFR(5), o[1], 0, 0, 0); C0[10] = __builtin_amdgcn_exp2f(C0[10]); C0[11] = __builtin_amdgcn_exp2f(C0[11]); PIN2(C0); SBAR2(); \
    VRD(9); o[2] = __builtin_amdgcn_mfma_f32_32x32x16_bf16(PAF(1), VFR(6), o[2], 0, 0, 0); C0[12] = __builtin_amdgcn_exp2f(C0[12]); C0[13] = __builtin_amdgcn_exp2f(C0[13]); PIN2(C0); SBAR2(); \
    VRD(10); o[3] = __builtin_amdgcn_mfma_f32_32x32x16_bf16(PAF(1), VFR(7), o[3], 0, 0, 0); C0[14] = __builtin_amdgcn_exp2f(C0[14]); C0[15] = __builtin_amdgcn_exp2f(C0[15]); PIN2(C0); SBAR2(); \
    VRD(11); o[0] = __builtin_amdgcn_mfma_f32_32x32x16_bf16(PAF(2), VFR(8), o[0], 0, 0, 0); C1[0] = __builtin_amdgcn_exp2f(C1[0]); C1[1] = __builtin_amdgcn_exp2f(C1[1]); PIN2(C1); SBAR2(); \
    VRD(12); o[1] = __builtin_amdgcn_mfma_f32_32x32x16_bf16(PAF(2), VFR(9), o[1], 0, 0, 0); C1[2] = __builtin_amdgcn_exp2f(C1[2]); C1[3] = __builtin_amdgcn_exp2f(C1[3]); PIN2(C1); SBAR2(); \
    VRD(13); o[2] = __builtin_amdgcn_mfma_f32_32x32x16_bf16(PAF(2), VFR(10), o[2], 0, 0, 0); C1[4] = __builtin_amdgcn_exp2f(C1[4]); C1[5] = __builtin_amdgcn_exp2f(C1[5]); PIN2(C1); SBAR2(); \
    VRD(14); o[3] = __builtin_amdgcn_mfma_f32_32x32x16_bf16(PAF(2), VFR(11), o[3], 0, 0, 0); C1[6] = __builtin_amdgcn_exp2f(C1[6]); C1[7] = __builtin_amdgcn_exp2f(C1[7]); PIN2(C1); SBAR2(); \
    VRD(15); o[0] = __builtin_amdgcn_mfma_f32_32x32x16_bf16(PAF(3), VFR(12), o[0], 0, 0, 0); C1[8] = __builtin_amdgcn_exp2f(C1[8]); C1[9] = __builtin_amdgcn_exp2f(C1[9]); PIN2(C1); SBAR2(); \
    o[1] = __builtin_amdgcn_mfma_f32_32x32x16_bf16(PAF(3), VFR(13), o[1], 0, 0, 0); C1[10] = __builtin_amdgcn_exp2f(C1[10]); C1[11] = __builtin_amdgcn_exp2f(C1[11]); PIN2(C1); SBAR2(); \
    o[2] = __builtin_amdgcn_mfma_f32_32x32x16_bf16(PAF(3), VFR(14), o[2], 0, 0, 0); C1[12] = __builtin_amdgcn_exp2f(C1[12]); C1[13] = __builtin_amdgcn_exp2f(C1[13]); PIN2(C1); SBAR2(); \
    o[3] = __builtin_amdgcn_mfma_f32_32x32x16_bf16(PAF(3), VFR(15), o[3], 0, 0, 0); C1[14] = __builtin_amdgcn_exp2f(C1[14]); C1[15] = __builtin_amdgcn_exp2f(C1[15]); PIN2(C1); SBAR2(); \
    } else { \
    SBAR2(); float ra_, rb_; \
    VRD(3); o[0] = __builtin_amdgcn_mfma_f32_32x32x16_bf16(PAF(0), VFR(0), o[0], 0, 0, 0); ra_ = max3f(C0[0], C0[1], C1[0]); rb_ = max3f(C0[2], C0[3], C1[1]); ra_ = max3f(ra_, C1[2], C1[3]); ra_ = max3f(ra_, C0[4], C0[5]); rb_ = max3f(rb_, C0[6], C0[7]); ra_ = max3f(ra_, C1[4], C1[5]); rb_ = max3f(rb_, C1[6], C1[7]); PIN2(ra_); PIN2(rb_); SBAR2(); \
    VRD(4); o[1] = __builtin_amdgcn_mfma_f32_32x32x16_bf16(PAF(0), VFR(1), o[1], 0, 0, 0); ra_ = max3f(ra_, C0[8], C0[9]); rb_ = max3f(rb_, C0[10], C0[11]); ra_ = max3f(ra_, C1[8], C1[9]); rb_ = max3f(rb_, C1[10], C1[11]); ra_ = max3f(ra_, C0[12], C0[13]); rb_ = max3f(rb_, C0[14], C0[15]); ra_ = max3f(ra_, C1[12], C1[13]); rb_ = max3f(rb_, C1[14], C1[15]); PIN2(ra_); PIN2(rb_); SBAR2(); \
    VRD(5); o[2] = __builtin_amdgcn_mfma_f32_32x32x16_bf16(PAF(0), VFR(2), o[2], 0, 0, 0); { float rm = __builtin_fmaxf(ra_, rb_); { auto rr = __builtin_amdgcn_permlane32_swap(__float_as_uint(rm), __float_as_uint(rm), false, false); rm = __builtin_fmaxf(__uint_as_float(rr[0]), __uint_as_float(rr[1])); } rm -= mhat; resc = false; \
      if (__builtin_expect(__any(rm > THR2), 0)) { const float dl = __builtin_fmaxf(rm, 0.f); mhat += dl; const float f = __builtin_amdgcn_exp2f(-dl); l_reg *= f; if (hi == 0) wsf[r32] = f; resc = true; } } SBAR2(); \
    VRD(6); o[3] = __builtin_amdgcn_mfma_f32_32x32x16_bf16(PAF(0), VFR(3), o[3], 0, 0, 0); _Pragma("unroll") for (int r = 0; r < 16; ++r) C0[r] -= mhat; PIN2(C0); SBAR2(); \
    VRD(7); o[0] = __builtin_amdgcn_mfma_f32_32x32x16_bf16(PAF(1), VFR(4), o[0], 0, 0, 0); _Pragma("unroll") for (int r = 0; r < 16; ++r) C1[r] -= mhat; PIN2(C1); SBAR2(); \
    VRD(8); o[1] = __builtin_amdgcn_mfma_f32_32x32x16_bf16(PAF(1), VFR(5), o[1], 0, 0, 0); C0[0] = __builtin_amdgcn_exp2f(C0[0]); C0[1] = __builtin_amdgcn_exp2f(C0[1]); C0[2] = __builtin_amdgcn_exp2f(C0[2]); PIN2(C0); SBAR2(); \
    VRD(9); o[2] = __builtin_amdgcn_mfma_f32_32x32x16_bf16(PAF(1), VFR(6), o[2], 0, 0, 0); C0[3] = __builtin_amdgcn_exp2f(C0[3]); C0[4] = __builtin_amdgcn_exp2f(C0[4]); C0[5] = __builtin_amdgcn_exp2f(C0[5]); PIN2(C0); SBAR2(); \
    VRD(10); o[3] = __builtin_amdgcn_mfma_f32_32x32x16_bf16(PAF(1), VFR(7), o[3], 0, 0, 0); C0[6] = __builtin_amdgcn_exp2f(C0[6]); C0[7] = __builtin_amdgcn_exp2f(C0[7]); C0[8] = __builtin_amdgcn_exp2f(C0[8]); PIN2(C0); SBAR2(); \
    VRD(11); o[0] = __builtin_amdgcn_mfma_f32_32x32x16_bf16(PAF(2), VFR(8), o[0], 0, 0, 0); C0[9] = __builtin_amdgcn_exp2f(C0[9]); C0[10] = __builtin_amdgcn_exp2f(C0[10]); C0[11] = __builtin_amdgcn_exp2f(C0[11]); PIN2(C0); SBAR2(); \
    VRD(12); o[1] = __builtin_amdgcn_mfma_f32_32x32x16_bf16(PAF(2), VFR(9), o[1], 0, 0, 0); C0[12] = __builtin_amdgcn_exp2f(C0[12]); C0[13] = __builtin_amdgcn_exp2f(C0[13]); C0[14] = __builtin_amdgcn_exp2f(C0[14]); PIN2(C0); SBAR2(); \
    VRD(13); o[2] = __builtin_amdgcn_mfma_f32_32x32x16_bf16(PAF(2), VFR(10), o[2], 0, 0, 0); C0[15] = __builtin_amdgcn_exp2f(C0[15]); C1[0] = __builtin_amdgcn_exp2f(C1[0]); C1[1] = __builtin_amdgcn_exp2f(C1[1]); PIN2(C0); PIN2(C1); SBAR2(); \
    VRD(14); o[3] = __builtin_amdgcn_mfma_f32_32x32x16_bf16(PAF(2), VFR(11), o[3], 0, 0, 0); C1[2] = __builtin_amdgcn_exp2f(C1[2]); C1[3] = __builtin_amdgcn_exp2f(C1[3]); C1[4] = __builtin_amdgcn_exp2f(C1[4]); PIN2(C1); SBAR2(); \
    VRD(15); o[0] = __builtin_amdgcn_mfma_f32_32x32x16_bf16(PAF(3), VFR(12), o[0], 0, 0, 0); C1[5] = __builtin_amdgcn_exp2f(C1[5]); C1[6] = __builtin_amdgcn_exp2f(C1[6]); C1[7] = __builtin_amdgcn_exp2f(C1[7]); PIN2(C1); SBAR2(); \
    o[1] = __builtin_amdgcn_mfma_f32_32x32x16_bf16(PAF(3), VFR(13), o[1], 0, 0, 0); C1[8] = __builtin_amdgcn_exp2f(C1[8]); C1[9] = __builtin_amdgcn_exp2f(C1[9]); C1[10] = __builtin_amdgcn_exp2f(C1[10]); PIN2(C1); SBAR2(); \
    o[2] = __builtin_amdgcn_mfma_f32_32x32x16_bf16(PAF(3), VFR(14), o[2], 0, 0, 0); C1[11] = __builtin_amdgcn_exp2f(C1[11]); C1[12] = __builtin_amdgcn_exp2f(C1[12]); C1[13] = __builtin_amdgcn_exp2f(C1[13]); PIN2(C1); SBAR2(); \
    o[3] = __builtin_amdgcn_mfma_f32_32x32x16_bf16(PAF(3), VFR(15), o[3], 0, 0, 0); C1[14] = __builtin_amdgcn_exp2f(C1[14]); C1[15] = __builtin_amdgcn_exp2f(C1[15]); PIN2(C1); SBAR2(); \
    } \
  } while (0)
#define TILE_LOOP(FAST) do { int t = 1; \
  for (; t + 3 < NT; t += 2) { \
    STEP2(pB0, pB1, pA0, pA1, t, true, true, false, FAST);     WAIT_BAR2(4); RESC2(); ROT(); \
    STEP2(pA0, pA1, pB0, pB1, t + 1, true, true, false, FAST); WAIT_BAR2(4); RESC2(); ROT(); \
  } \
  if (NT >= 4) { \
    STEP2(pB0, pB1, pA0, pA1, t, true, true, false, FAST);      WAIT_BAR2(4); RESC2(); ROT(); \
    STEP2(pA0, pA1, pB0, pB1, t + 1, false, true, false, FAST); WAIT_BAR2(2); RESC2(); ROT(); \
    t += 2; \
  } \
  { const bool msk_ = (wq < 2); STEP2(pB0, pB1, pA0, pA1, t, false, false, msk_, FAST); } \
  WAIT_BAR2(0); RESC2(); ROT(); } while (0)
  if (fastp) TILE_LOOP(true); else TILE_LOOP(false);
#undef TILE_LOOP
  { float sacc = pB0[0] + pB0[1];
#pragma unroll
    for (int r = 2; r < 16; ++r) sacc += pB0[r];
#pragma unroll
    for (int r = 0; r < 16; ++r) sacc += pB1[r];
    l_reg += sacc;
    pw0 = (u32x4){PKW(pB0, 0), PKW(pB0, 2), PKW(pB0, 4), PKW(pB0, 6)}; pw1 = (u32x4){PKW(pB0, 8), PKW(pB0, 10), PKW(pB0, 12), PKW(pB0, 14)};
    pw2 = (u32x4){PKW(pB1, 0), PKW(pB1, 2), PKW(pB1, 4), PKW(pB1, 6)}; pw3 = (u32x4){PKW(pB1, 8), PKW(pB1, 10), PKW(pB1, 12), PKW(pB1, 14)};
    const lds_cptr vp_ = vp0 + sl_prev; s16x4 vl[4], vh[4];
#pragma unroll
    for (int ks = 0; ks < 4; ++ks) {
#pragma unroll
      for (int d0 = 0; d0 < 4; ++d0) { vl[d0] = vtr(vp_ + d0 * 4096 + ks * 1024); vh[d0] = vtr(vp_ + d0 * 4096 + ks * 1024 + 512); }
      const bf16x8 pa = (ks == 0) ? PAF(0) : (ks == 1) ? PAF(1) : (ks == 2) ? PAF(2) : PAF(3);
#pragma unroll
      for (int d0 = 0; d0 < 4; ++d0) o[d0] = __builtin_amdgcn_mfma_f32_32x32x16_bf16(pa, (bf16x8){vl[d0][0], vl[d0][1], vl[d0][2], vl[d0][3], vh[d0][0], vh[d0][1], vh[d0][2], vh[d0][3]}, o[d0], 0, 0, 0); }
  }
  int lane_e; asm volatile("v_mbcnt_lo_u32_b32 %0, -1, 0\n\tv_mbcnt_hi_u32_b32 %0, -1, %0" : "=v"(lane_e));
  const int r32e = lane_e & 31, hie = lane_e >> 5;
  { auto rr = __builtin_amdgcn_permlane32_swap(__float_as_uint(l_reg), __float_as_uint(l_reg), false, false); l_reg = __uint_as_float(rr[0]) + __uint_as_float(rr[1]); }
  if (hie == 0) wsf[32 + r32e] = l_reg; asm volatile("s_waitcnt lgkmcnt(0)" ::: "memory");
  float rli[16];
#pragma unroll
  for (int r = 0; r < 16; ++r) rli[r] = __builtin_amdgcn_rcpf(wsf[32 + crow(r, hie)]);
  __syncthreads();
  float* xch = (float*)shm + (size_t)wq * 4096;
  if (map == 1) {
#pragma unroll
    for (int d0 = 0; d0 < 4; ++d0)
#pragma unroll
      for (int r = 0; r < 16; ++r) xch[(d0 * 16 + r) * 64 + lane_e] = o[d0][r] * rli[r] * lam;
  }
  __syncthreads();
  if (map == 0) {
    float ss[16];
#pragma unroll
    for (int r = 0; r < 16; ++r) { float s = 0.f;
#pragma unroll
      for (int d0 = 0; d0 < 4; ++d0) { const float v = o[d0][r] * rli[r] - xch[(d0 * 16 + r) * 64 + lane_e]; o[d0][r] = v; s += v * v; }
      ss[r] = s; }
#pragma unroll
    for (int r = 0; r < 16; ++r) ss[r] = half_sum32(ss[r]);
    float gv[4];
#pragma unroll
    for (int d0 = 0; d0 < 4; ++d0) gv[d0] = gdiff[d0 * 32 + r32e] * oscale;
#pragma unroll
    for (int r = 0; r < 16; ++r) { const float rs = rsqrtf(ss[r] * (1.f / 128.f) + 1e-6f);
#pragma unroll
      for (int d0 = 0; d0 < 4; ++d0) o[d0][r] = o[d0][r] * rs * gv[d0]; }
    store_o_tile(o, Oout + (rowb + qb * 128 + wq * 32) * LDO + 1024 + h * 128, (char*)xch, lane_e);
  }
#undef DMA_K
#undef DMA_V
#undef ROT
#undef KF
#undef RESC2
#undef PKW
#undef PAF
#undef MFQ
#undef KRD
#undef MFK
#undef VRD
#undef VFR
#undef EX2
#undef PIN2
#undef STEP2
}
#undef SBAR2
#undef WAIT_BAR2
}
constexpr int NWAVES = 8;
constexpr int BATCH = 4, SEQ = 8192, DM = 2048, NTOK = BATCH * SEQ;
constexpr int QKVC = 6144, NEXP = 32, DEXP = 512, PLED = 256, LCAP = 65536;
constexpr float EPS = 1e-6f;
constexpr int LDA1 = DM + 64, LDQ = QKVC + 64, LDW = DM + 64, LDP = PLED + 64, LDH = DEXP + 64;
constexpr float QSCALE_SB = 0.08838834764831845f * 1.4426950408889634f;
constexpr float QSCALE_DF = 0.125f * 1.4426950408889634f;
constexpr size_t MiB = 1u << 20;
constexpr size_t WS_CTL = 0, CTL_ZERO_BYTES = 1 * MiB;
constexpr size_t WS_ROPE = 1 * MiB;
constexpr size_t WS_WRT = 1 * MiB + 512 * 1024;
constexpr size_t WS_WIN = 2 * MiB;
constexpr size_t WS_WOUT = 27 * MiB;
constexpr size_t WS_WPG = 36 * MiB;
constexpr size_t WS_WPLE = 45 * MiB;
constexpr size_t WS_WGU = 47 * MiB;
constexpr size_t WS_WD = 179 * MiB;
constexpr size_t WS_LSLOT = 251 * MiB;
constexpr size_t WS_LGATE = 259 * MiB;
constexpr size_t WS_PB = 267 * MiB;
constexpr size_t WS_A1 = 287 * MiB;
constexpr size_t WS_QKV = 419 * MiB;
constexpr size_t WS_Y = WS_QKV;
constexpr size_t WS_H = WS_QKV + 288 * MiB;
constexpr size_t WS_U = 815 * MiB;
constexpr size_t WS_LRSTD = 944 * MiB;
constexpr size_t WS_RSTD2 = 952 * MiB;
constexpr size_t WS_END = 953 * MiB;
static_assert(WS_WIN + (size_t)QKVC * LDW * 2 <= WS_WOUT && WS_WOUT + (size_t)DM * LDW * 2 <= WS_WPG && WS_WPG + (size_t)DM * LDW * 2 <= WS_WPLE && WS_WPLE + (size_t)DM * LDP * 2 <= WS_WGU, "ws map 1");
static_assert(WS_WGU + (size_t)32 * 1024 * LDW * 2 <= WS_WD && WS_WD + (size_t)32 * DM * LDH * 2 <= WS_LSLOT && WS_PB + (size_t)NTOK * LDP * 2 <= WS_A1 && WS_A1 + (size_t)NTOK * LDA1 * 2 <= WS_QKV, "ws map 2");
static_assert(WS_QKV + (size_t)96 * NTOK * 64 * 2 <= WS_U && WS_H + (size_t)73728 * LDH * 2 <= WS_U && WS_Y + (size_t)2 * NTOK * DM * 2 <= WS_H, "ws map 3");
constexpr int CW_TMO = 0, CW_CODE = 1;
constexpr int CW_BAR = 4096;
constexpr int CW_CNT = 16384;
constexpr int RING_OFF = 0, RING_BYTES = 131072;
constexpr int LDSCTL_OFF = RING_BYTES;
constexpr int TST_OFF = LDSCTL_OFF;
constexpr int CNT_OFF = LDSCTL_OFF + 160;
constexpr int MISC_OFF = LDSCTL_OFF + 320;
constexpr int ESCR_OFF = LDSCTL_OFF + 1024;
constexpr int LDS_BYTES = 151552;

#define GAS __attribute__((address_space(1)))
#define LAS __attribute__((address_space(3)))
typedef unsigned short bf16;
typedef unsigned v4u __attribute__((ext_vector_type(4)));
typedef unsigned v2u __attribute__((ext_vector_type(2)));
typedef float f32x4 __attribute__((ext_vector_type(4)));
typedef GAS unsigned gu32;
#define RLX_AGENT __ATOMIC_RELAXED, __HIP_MEMORY_SCOPE_AGENT
#define LDS_WAIT() asm volatile("s_waitcnt lgkmcnt(0)" ::: "memory")
#define VM_WAIT() asm volatile("s_waitcnt vmcnt(0)" ::: "memory")
__device__ __forceinline__ unsigned pk2(float lo, float hi) { return pg8::cvt_pk_bf16(lo, hi); }
#define XB_TMO      128
#define XB_XCNT(j)  (256  + 64 * (j))
#define XB_XSUB(j)  (1280 + 64 * (j))
#define XB_XGEN(j)  (2304 + 64 * (j))
#define XB_TOP      3328
#define XB_TOPGEN   3392
#define XCD_BAR_WORDS 3456
#define XB_SPIN_CAP (1u << 18)

__device__ __forceinline__ unsigned xb_ld(unsigned* p)              { return __hip_atomic_load(p, __ATOMIC_RELAXED, __HIP_MEMORY_SCOPE_AGENT); }
__device__ __forceinline__ unsigned xb_add(unsigned* p, unsigned v) { return __hip_atomic_fetch_add(p, v, __ATOMIC_RELAXED, __HIP_MEMORY_SCOPE_AGENT); }
__device__ __forceinline__ unsigned xb_xcc_id() { return (unsigned)__builtin_amdgcn_s_getreg((3 << 11) | 20) & 0xFu; }
#define XB_SPIN(cond, bar) do { unsigned _sp = 0; while (cond) { __builtin_amdgcn_s_sleep(1); \
    if ((++_sp & 255u) == 0u) { if (xb_ld(&(bar)[XB_TMO])) break; if (_sp > XB_SPIN_CAP) { atomicAdd(&(bar)[XB_TMO], 1u); break; } } } } while (0)

struct XcdBarrier {
    unsigned* bar; unsigned x;
    volatile LAS unsigned* st;
};

__device__ __forceinline__ XcdBarrier xcd_barrier_post(unsigned* bar, volatile LAS unsigned* st, bool leader) {
    XcdBarrier b; b.bar = bar; b.x = xb_xcc_id(); b.st = st;
    if (leader) (void)xb_add(&bar[XB_XCNT(b.x)], 1u);
    return b;
}
__device__ __forceinline__ void xcd_barrier_complete(unsigned* bar, unsigned x, unsigned& nloc, unsigned& nx) {
    const unsigned G = gridDim.x * gridDim.y * gridDim.z;
    unsigned sum, cnt, mine, sp = 0u;
    for (;;) {
        sum = 0u; cnt = 0u; mine = 0u;
#pragma unroll
        for (unsigned j = 0; j < 16; ++j) { const unsigned c = xb_ld(&bar[XB_XCNT(j)]); sum += c; cnt += (c > 0u) ? 1u : 0u; mine = (j == x) ? c : mine; }
        if (sum == G) break;
        __builtin_amdgcn_s_sleep(1);
        if ((++sp & 255u) == 0u) { if (xb_ld(&bar[XB_TMO])) break; if (sp > XB_SPIN_CAP) { atomicAdd(&bar[XB_TMO], 1u); break; } }
    }
    nloc = mine > 0u ? mine : 1u; nx = cnt > 0u ? cnt : 1u;
}

__device__ __forceinline__ void xcd_barrier(const XcdBarrier& b, int wave) {
    FRESH_LANE(xl_); const bool leader = (wave == 0) && (xl_ == 0);
    asm volatile("s_waitcnt vmcnt(0)" ::: "memory");
    __syncthreads();
    if (leader) {
        unsigned* bar = b.bar;
        __builtin_amdgcn_s_waitcnt(0);
        unsigned nloc = b.st[0], nx = b.st[1];
        if (nloc == 0u) { xcd_barrier_complete(bar, b.x, nloc, nx); b.st[0] = nloc; b.st[1] = nx; }
        const unsigned old = xb_add(&bar[XB_XSUB(b.x)], 1u);
        const unsigned gen = old / nloc;
        if (old + 1u == (gen + 1u) * nloc) {
            __builtin_amdgcn_fence(__ATOMIC_RELEASE, "agent");
            asm volatile("s_waitcnt vmcnt(0)" ::: "memory");
            const unsigned og = xb_add(&bar[XB_TOP], 1u);
            const unsigned tg = og / nx;
            if (og + 1u == (tg + 1u) * nx) xb_add(&bar[XB_TOPGEN], 1u);
            else XB_SPIN(xb_ld(&bar[XB_TOPGEN]) == tg, bar);
            __builtin_amdgcn_fence(__ATOMIC_ACQUIRE, "agent");
            xb_add(&bar[XB_XGEN(b.x)], 1u);
            asm volatile("s_waitcnt vmcnt(0)" ::: "memory");
        } else {
            XB_SPIN(xb_ld(&bar[XB_XGEN(b.x)]) == gen, bar);
            __builtin_amdgcn_fence(__ATOMIC_ACQUIRE, "agent");
            asm volatile("s_waitcnt vmcnt(0)" ::: "memory");
        }
    }
    __syncthreads();
}
struct Frame {
    LAS unsigned char* lds;
    volatile LAS unsigned* MISC;
    gu32* ctl;
    int tid, lane, wave;
    int vcu, G;
};
__device__ __forceinline__ float wave_sum(float v) { return wave_sum_(v); }
__device__ __forceinline__ void tr_item(const float* W, int ldw, int k0, int n0, bf16* dst, int dpitch, float scale, LAS float* scr, int lane, const float* gk = nullptr) {
    { f32x4 t[8]; const int kr = lane >> 3, nc = 4 * (lane & 7);
#pragma unroll
      for (int i = 0; i < 8; ++i) t[i] = *(const GAS f32x4*)(W + (size_t)(k0 + kr + 8 * i) * ldw + n0 + nc);
#pragma unroll
      for (int i = 0; i < 8; ++i) { LAS float* d = scr + (kr + 8 * i) * 33 + nc; d[0] = t[i].x; d[1] = t[i].y; d[2] = t[i].z; d[3] = t[i].w; } }
    LDS_WAIT(); asm volatile("" ::: "memory");
    const int c = lane & 7;
    float sk[8];
#pragma unroll
    for (int t = 0; t < 8; ++t) sk[t] = gk ? scale * gk[k0 + 8 * c + t] : scale;
#pragma unroll
    for (int j = 0; j < 4; ++j) { const int n = (lane >> 3) + 8 * j; const LAS float* s = scr + (8 * c) * 33 + n;
        v4u o; o.x = pk2(s[0 * 33] * sk[0], s[1 * 33] * sk[1]); o.y = pk2(s[2 * 33] * sk[2], s[3 * 33] * sk[3]); o.z = pk2(s[4 * 33] * sk[4], s[5 * 33] * sk[5]); o.w = pk2(s[6 * 33] * sk[6], s[7 * 33] * sk[7]);
        *(GAS v4u*)(dst + (size_t)n * dpitch + 8 * c) = o; }
    LDS_WAIT(); asm volatile("" ::: "memory");
}
struct ConvDesc { const float* W; int ldw, k0, n0; bf16* dst; int dpitch; float scale; const float* gk; };
__device__ __forceinline__ void tr_load(const ConvDesc& d, f32x4 (&t)[8], f32x4 (&gq)[2], int lane) { const int kr = lane >> 3, nc = 4 * (lane & 7);
#pragma unroll
    for (int i = 0; i < 8; ++i) t[i] = *(const GAS f32x4*)(d.W + (size_t)(d.k0 + kr + 8 * i) * d.ldw + d.n0 + nc);
    if (d.gk) { const GAS f32x4* gp = (const GAS f32x4*)(d.gk + d.k0 + 8 * (lane & 7)); gq[0] = gp[0]; gq[1] = gp[1]; }
    else { gq[0] = (f32x4){1.f, 1.f, 1.f, 1.f}; gq[1] = gq[0]; } }
__device__ __forceinline__ void tr_finish(const ConvDesc& d, const f32x4 (&t)[8], const f32x4 (&gq)[2], LAS float* scr, int lane) { const int kr = lane >> 3, nc = 4 * (lane & 7);
#pragma unroll
    for (int i = 0; i < 8; ++i) { LAS float* q = scr + (kr + 8 * i) * 33 + nc; q[0] = t[i].x; q[1] = t[i].y; q[2] = t[i].z; q[3] = t[i].w; }
    LDS_WAIT(); asm volatile("" ::: "memory");
    const int c = lane & 7;
    float sk[8];
#pragma unroll
    for (int u = 0; u < 8; ++u) sk[u] = d.scale * gq[u >> 2][u & 3];
#pragma unroll
    for (int j = 0; j < 4; ++j) { const int n = (lane >> 3) + 8 * j; const LAS float* q = scr + (8 * c) * 33 + n;
        v4u o; o.x = pk2(q[0 * 33] * sk[0], q[1 * 33] * sk[1]); o.y = pk2(q[2 * 33] * sk[2], q[3 * 33] * sk[3]); o.z = pk2(q[4 * 33] * sk[4], q[5 * 33] * sk[5]); o.w = pk2(q[6 * 33] * sk[6], q[7 * 33] * sk[7]);
        *(GAS v4u*)(d.dst + (size_t)n * d.dpitch + 8 * c) = o; }
    LDS_WAIT(); asm volatile("" ::: "memory");
}
__device__ __forceinline__ void rms_row_to_bf16(const float* xrow, float* invr, bf16* orow, int lane) {
    const GAS f32x4* xr = (const GAS f32x4*)xrow + lane;
    f32x4 v[8]; float s = 0.f;
#pragma unroll
    for (int j = 0; j < 8; ++j) { v[j] = xr[64 * j]; s += (v[j].x * v[j].x + v[j].y * v[j].y) + (v[j].z * v[j].z + v[j].w * v[j].w); }
    const float rstd = rsqrtf(wave_sum(s) * (1.f / DM) + EPS);
    GAS v2u* o8 = (GAS v2u*)orow + lane;
#pragma unroll
    for (int j = 0; j < 8; ++j) { v2u w; w.x = pk2(v[j].x * rstd, v[j].y * rstd); w.y = pk2(v[j].z * rstd, v[j].w * rstd); o8[64 * j] = w; }
    if (lane == 0) *invr = 1.f / rstd;
}

__device__ __forceinline__ void unpack8(const v4u w, float (&f)[8]) {
#pragma unroll
    for (int q = 0; q < 4; ++q) { f[2 * q] = pg8::bf_lo(w[q]); f[2 * q + 1] = pg8::bf_hi(w[q]); }
}
struct Args { const float* in[21]; float* out; unsigned char* ws; int ph_lo, ph_hi; };


#define x_ (args.in[0])
#define p_in (args.in[1])
#define g_attn (args.in[2])
#define w_in (args.in[3])
#define g_sb (args.in[4])
#define g_diff (args.in[5])
#define lam_q1 (args.in[6])
#define lam_k1 (args.in[7])
#define lam_q2 (args.in[8])
#define lam_k2 (args.in[9])
#define w_out (args.in[10])
#define g_moe (args.in[11])
#define w_rg (args.in[12])
#define w_re (args.in[13])
#define w_gate (args.in[14])
#define w_up (args.in[15])
#define w_down (args.in[16])
#define g_ple (args.in[17])
#define w_ple (args.in[18])
#define w_pg (args.in[19])
#define g_final (args.in[20])
#define rope ((float*)(ws + WS_ROPE))
#define wrhl ((bf16*)(ws + WS_WRT))
#define LRSTD ((float*)(ws + WS_LRSTD))
#define RSTD2 ((float*)(ws + WS_RSTD2))
#define WIN ((bf16*)(ws + WS_WIN))
#define WOUT ((bf16*)(ws + WS_WOUT))
#define WPG ((bf16*)(ws + WS_WPG))
#define WPLE ((bf16*)(ws + WS_WPLE))
#define WGU ((bf16*)(ws + WS_WGU))
#define WD ((bf16*)(ws + WS_WD))
#define LSLOT ((int*)(ws + WS_LSLOT))
#define LGATE ((float*)(ws + WS_LGATE))
#define PB ((bf16*)(ws + WS_PB))
#define A1 ((bf16*)(ws + WS_A1))
#define QKV ((bf16*)(ws + WS_QKV))
#define HB ((bf16*)(ws + WS_H))
#define YB ((bf16*)(ws + WS_Y))
#define UB ((bf16*)out)
#define INVR RSTD2
#define OB ((bf16*)out)
#define H1B ((bf16*)(ws + WS_U))
#define ecnt (F.ctl + CW_CNT)
constexpr int I_IN = 32 * 192, I_OUT = 32 * 64, I_PG = 32 * 64, I_PLE = 4 * 64, I_G = 32 * 32 * 16, I_U = I_G, I_D = 32 * 8 * 64;
constexpr int NITEMS = I_IN + I_OUT + I_PG + I_PLE + I_G + I_U + I_D, NCV = 3;
#define CONV_DECODE(it_, d) do { int r = (it_); \
            if (r < I_IN) { const int kb = r / 192, nb = r % 192, n0 = 32 * nb, k0 = 64 * kb; const float sc = (n0 < 1024) ? QSCALE_SB : ((n0 >= 3072 && n0 < 4096) ? QSCALE_DF : 1.f); \
                d = ConvDesc{w_in, QKVC, k0, n0, WIN + (size_t)n0 * LDW + k0, LDW, sc, g_attn}; break; } r -= I_IN; \
            if (r < I_OUT) { const int kb = r / 64, nb = r % 64; d = ConvDesc{w_out, DM, 64 * kb, 32 * nb, WOUT + (size_t)(32 * nb) * LDW + 64 * kb, LDW, 1.f, nullptr}; break; } r -= I_OUT; \
            if (r < I_PG) { const int kb = r / 64, nb = r % 64; d = ConvDesc{w_pg, DM, 64 * kb, 32 * nb, WPG + (size_t)(32 * nb) * LDW + 64 * kb, LDW, 1.f, g_ple}; break; } r -= I_PG; \
            if (r < I_PLE) { const int kb = r / 64, nb = r % 64; d = ConvDesc{w_ple, DM, 64 * kb, 32 * nb, WPLE + (size_t)(32 * nb) * LDP + 64 * kb, LDP, 1.f, nullptr}; break; } r -= I_PLE; \
            if (r < I_G + I_U) { const bool isu = r >= I_G; if (isu) r -= I_G; const int e = r / 512, q = r % 512, kb = q / 16, nb = q % 16, n0 = 32 * nb, k0 = 64 * kb; \
                const int drow = e * 1024 + (n0 >> 7) * 256 + ((n0 & 127) >> 5) * 64 + (isu ? 32 : 0); \
                d = ConvDesc{(isu ? w_up : w_gate) + (size_t)e * DM * DEXP, DEXP, k0, n0, WGU + (size_t)drow * LDW + k0, LDW, 1.f, g_moe}; break; } r -= I_G + I_U; \
            { const int e = r / 512, q = r % 512, kb = q / 64, nb = q % 64, n0 = 32 * nb, k0 = 64 * kb; \
                d = ConvDesc{w_down + (size_t)e * DEXP * DM, DM, k0, n0, WD + ((size_t)e * DM + n0) * LDH + k0, LDH, 1.f, nullptr}; } \
        } while (0)
#define CONV_RANGE(lo_, hi_) do { \
        for (int it = (lo_) + gw; it < (hi_); it += NCV * NGW) { \
            ConvDesc cd[NCV]; f32x4 ct[NCV][8], cg[NCV][2]; \
            _Pragma("unroll") for (int c_ = 0; c_ < NCV; ++c_) if (it + c_ * NGW < (hi_)) { CONV_DECODE(it + c_ * NGW, cd[c_]); tr_load(cd[c_], ct[c_], cg[c_], F.lane); } \
            _Pragma("unroll") for (int c_ = 0; c_ < NCV; ++c_) if (it + c_ * NGW < (hi_)) tr_finish(cd[c_], ct[c_], cg[c_], scr, F.lane); \
        } \
        } while (0)
#define CONV_SMALL() do { \
        for (int i = gw * 64 + F.lane; i < 48 * DM; i += NGW * 64) { const int c = i / DM, k = i % DM; const float w = (c < 4) ? w_rg[k * 4 + c] : ((c < 36) ? w_re[k * 32 + (c - 4)] : 0.f); \
            const float v = w * g_moe[k]; const unsigned hi = pk2(v, v) & 0xffffu; const float lo = v - __uint_as_float(hi << 16); wrhl[i] = (bf16)hi; wrhl[48 * DM + i] = (bf16)(pk2(lo, lo) & 0xffffu); } \
        for (size_t i = (size_t)gw * 64 + F.lane; i < (size_t)NTOK * PLED / 4; i += (size_t)NGW * 64 * 4) { f32x4 v[4]; \
            _Pragma("unroll") for (int q = 0; q < 4; ++q) { const size_t iq = i + (size_t)q * NGW * 64; if (iq < (size_t)NTOK * PLED / 4) v[q] = *((const GAS f32x4*)p_in + iq); } \
            _Pragma("unroll") for (int q = 0; q < 4; ++q) { const size_t iq = i + (size_t)q * NGW * 64; if (iq < (size_t)NTOK * PLED / 4) { v2u w; w.x = pk2(v[q].x, v[q].y); w.y = pk2(v[q].z, v[q].w); \
                const size_t row = iq >> 6, c4 = iq & 63; *((GAS v2u*)(PB + row * LDP) + c4) = w; } } } \
        } while (0)
__global__ void __launch_bounds__(NWAVES * 64, 2) mega_fwd(Args args) {
    extern __shared__ __attribute__((aligned(16))) unsigned char lds[];
    Frame F;
    F.lds = (LAS unsigned char*)lds;
    F.MISC = (volatile LAS unsigned*)(F.lds + MISC_OFF);
    F.tid = threadIdx.x; F.lane = F.tid & 63; F.wave = __builtin_amdgcn_readfirstlane(F.tid >> 6);
    F.G = gridDim.x; { const int bx = blockIdx.x; F.vcu = (F.G % 8 == 0) ? (bx % 8) * (F.G / 8) + bx / 8 : bx; }
    unsigned char* ws = args.ws;
    F.ctl = (gu32*)(ws + WS_CTL);
    float* const out = args.out;
    for (int u = F.tid; u < (LDS_BYTES - LDSCTL_OFF) / 4; u += NWAVES * 64) ((LAS unsigned*)(F.lds + LDSCTL_OFF))[u] = 0u;
    __syncthreads();
    XcdBarrier bar = xcd_barrier_post((unsigned*)(F.ctl + CW_BAR), F.MISC + 8, F.tid == 0);
    const int lo = args.ph_lo, hi = args.ph_hi;
#ifndef PROBE_DBL
#define PROBE_DBL -1
#endif
#define REPS(k) _Pragma("unroll 1") for (int rep_ = 0; rep_ < ((PROBE_DBL == (k)) ? 2 : 1); ++rep_)
#ifndef PH_MASK
#define PH_MASK 0x7ff
#endif
#define IN(k) ((((PH_MASK) >> (k)) & 1) && lo <= (k) && (k) < hi)
#ifdef PROBE_BAR2
#define SEAM(k) do { if (IN(k) && IN((k) + 1)) { xcd_barrier(bar, F.wave); xcd_barrier(bar, F.wave); } } while (0)
#else
#define SEAM(k) do { if (IN(k) && IN((k) + 1)) xcd_barrier(bar, F.wave); } while (0)
#endif
#define PHASE_LANE() do { FRESH_LANE(pl_); F.lane = pl_; F.tid = F.wave * 64 + pl_; } while (0)
    const int gw = F.vcu * NWAVES + F.wave, NGW = F.G * NWAVES;
    LAS int* tstart = (LAS int*)(F.lds + TST_OFF); LAS int* lcnt = (LAS int*)(F.lds + CNT_OFF);

    if (IN(0)) REPS(0) {
        PHASE_LANE();
        LAS float* scr = (LAS float*)(F.lds + RING_OFF + F.wave * 16384);
        CONV_RANGE(0, I_IN);
        for (int m = 2 * gw; m < NTOK; m += 2 * NGW) {
            f32x4 v[2][8]; float ss[2];
#pragma unroll
            for (int q = 0; q < 2; ++q) { const GAS f32x4* xr = (const GAS f32x4*)(x_ + (size_t)(m + q) * DM) + F.lane;
#pragma unroll
                for (int j = 0; j < 8; ++j) v[q][j] = xr[64 * j]; }
#pragma unroll
            for (int q = 0; q < 2; ++q) { float s_ = 0.f;
#pragma unroll
                for (int j = 0; j < 8; ++j) s_ += (v[q][j].x * v[q][j].x + v[q][j].y * v[q][j].y) + (v[q][j].z * v[q][j].z + v[q][j].w * v[q][j].w);
                ss[q] = s_; }
#pragma unroll
            for (int q = 0; q < 2; ++q) { const float rstd = rsqrtf(wave_sum(ss[q]) * (1.f / DM) + EPS);
                GAS v2u* o8 = (GAS v2u*)(A1 + (size_t)(m + q) * LDA1) + F.lane;
#pragma unroll
                for (int j = 0; j < 8; ++j) { v2u w; w.x = pk2(v[q][j].x * rstd, v[q][j].y * rstd); w.y = pk2(v[q][j].z * rstd, v[q][j].w * rstd); o8[64 * j] = w; }
                if (F.lane == 0) INVR[m + q] = 1.f / rstd; }
        }
    }
    SEAM(0);
    if (IN(1)) REPS(1) {
#ifdef SKEW_US
        if (F.vcu >= F.G / 2) { const unsigned long long t0 = __builtin_amdgcn_s_memrealtime(); while (__builtin_amdgcn_s_memrealtime() - t0 < (unsigned long long)(SKEW_US) * 100ull) __builtin_amdgcn_s_sleep(4); }
#endif
        pg8::Gemm g{A1, WIN, NTOK, QKVC, DM, nullptr, LDA1, LDW}; pg8::StaticOrder S; S.init(NTOK, QKVC, F.G, (int)blockIdx.x);
        pg8::EpiQKV E{QKV, F.lds + ESCR_OFF, 0, rope};
#if PROBE_DBL == 1 && defined(PROBE_FIXED)
        S.fixed = rep_;
#endif
#if PROBE_DBL == 1 && defined(PROBE_NOEPI)
        E.skip = rep_ * PROBE_NOEPI; if (rep_ && (PROBE_NOEPI == 2 || PROBE_NOEPI == 7 || PROBE_NOEPI == 8 || PROBE_NOEPI == 9)) E.O = (pg8::bf16_t*)out;
#endif
        pg8::gemm_phase<pg8::EpiQKV, pg8::StaticOrder, true, true>(F.lds + RING_OFF, g, S, E, F.wave);
    }
    SEAM(1);
    if (IN(2)) {
        PHASE_LANE();
        float lam;
        { float a = (F.lane < 64) ? lam_q1[F.lane] * lam_k1[F.lane] : 0.f, b2 = lam_q2[F.lane] * lam_k2[F.lane]; a = wave_sum(a); b2 = wave_sum(b2); lam = expf(a) - expf(b2) + 0.2f; }
#ifndef NO_DIFF
#define CONV_LATE() do { __syncthreads(); { PHASE_LANE(); LAS float* scr = (LAS float*)(F.lds + RING_OFF + F.wave * 16384); CONV_RANGE(I_IN, NITEMS); CONV_SMALL(); } __syncthreads(); } while (0)
        const int conv_at = F.vcu % 3;
        if (conv_at == 0) CONV_LATE();
        REPS(20) for (int L = F.vcu; L < 1024; L += F.G) { const int bh = L >> 5, pr = L & 31;
#pragma unroll 1
            for (int s2 = 0; s2 < 2; ++s2) {
#if PROBE_DBL == 20 && defined(PROBE_FIXED)
                att::diff_unit2(bh >> 3, bh & 7, s2 ? pr : 63 - pr, QKV, OB, g_diff, lam, 0.8f, (char*)lds + RING_OFF, F.wave, rope, rep_ * PROBE_FIXED);
#else
                att::diff_unit2(bh >> 3, bh & 7, s2 ? pr : 63 - pr, QKV, OB, g_diff, lam, 0.8f, (char*)lds + RING_OFF, F.wave, rope);
#endif
            } }
#endif
        if (conv_at == 1) CONV_LATE();
        __syncthreads();
#ifndef NO_SB
        REPS(21) att::sb_wave_seq(gw, NGW, 8192, QKV, OB, g_sb, (char*)lds + RING_OFF + F.wave * 16384);
#endif
        if (conv_at == 2) CONV_LATE();
#undef CONV_LATE
    }
    SEAM(2);
    if (IN(3)) REPS(3) {
#ifndef NO_P3A
        { pg8::Gemm g{OB, WOUT, NTOK, DM, DM, nullptr, LDA1, LDW}; pg8::StaticOrder S; S.init(NTOK, DM, F.G, (int)blockIdx.x);
          pg8::EpiResN E{A1, LDA1, INVR, H1B};
          pg8::gemm_phase<pg8::EpiResN, pg8::StaticOrder, true, true>(F.lds + RING_OFF, g, S, E, F.wave); }
#endif
    }
    SEAM(3);
    if (IN(4)) {
        PHASE_LANE();
        constexpr int WPITCH = 520;
        LAS bf16* WB = (LAS bf16*)(F.lds + RING_OFF);
        LAS float* LG = (LAS float*)(F.lds + RING_OFF + 102400) + F.wave * 656;
        LAS int* sel_e = (LAS int*)(F.lds + RING_OFF + 124928); LAS float* sel_g = (LAS float*)(F.lds + RING_OFF + 125952); LAS float* sel_r = (LAS float*)(F.lds + RING_OFF + 126976);
        LAS int* lhist = (LAS int*)(F.lds + RING_OFF + 127488); LAS int* lbase = (LAS int*)(F.lds + RING_OFF + 127616);
        const int mr = F.lane & 15, quad = F.lane >> 4;
        for (int chunk = blockIdx.x; chunk < NTOK / 128; chunk += F.G) {
            if (F.tid < 32) lhist[F.tid] = 0;
            const int row0 = chunk * 128 + F.wave * 16;
            f32x4 acc[3] = {{0.f, 0.f, 0.f, 0.f}, {0.f, 0.f, 0.f, 0.f}, {0.f, 0.f, 0.f, 0.f}}; float ssq = 0.f;
            const GAS v4u* arow = (const GAS v4u*)(H1B + (size_t)(row0 + mr) * DM) + quad;
            v4u av[16];
#define P4_LOAD(kc_) do { _Pragma("unroll") for (int sidx = 0; sidx < 16; ++sidx) av[sidx] = arow[(kc_) * 64 + sidx * 4]; } while (0)
            P4_LOAD(0);
#pragma unroll 1
            for (int kc = 0; kc < 4; ++kc) {
                __syncthreads();
#pragma unroll
                for (int i = 0; i < 12; ++i) { const int p = F.tid + 512 * i, hl = p / 3072, rem = p % 3072, wrow = rem >> 6, pc = rem & 63;
                    *(LAS v4u*)(WB + (size_t)(hl * 48 + wrow) * WPITCH + pc * 8) = *(const GAS v4u*)(wrhl + (size_t)(hl * 48 + wrow) * DM + kc * 512 + pc * 8); }
                v4u ac[16];
#pragma unroll
                for (int sidx = 0; sidx < 16; ++sidx) ac[sidx] = av[sidx];
                if (kc < 3) P4_LOAD(kc + 1);
                __syncthreads();
#pragma unroll
                for (int sidx = 0; sidx < 16; ++sidx) { float f[8]; unpack8(ac[sidx], f);
#pragma unroll
                    for (int i = 0; i < 8; ++i) ssq += f[i] * f[i];
                    const pg8::bf16x8 a = __builtin_bit_cast(pg8::bf16x8, ac[sidx]);
#pragma unroll
                    for (int ct = 0; ct < 3; ++ct) { const pg8::bf16x8 bh = *(const LAS pg8::bf16x8*)(WB + (size_t)(ct * 16 + mr) * WPITCH + sidx * 32 + quad * 8), bl = *(const LAS pg8::bf16x8*)(WB + (size_t)(48 + ct * 16 + mr) * WPITCH + sidx * 32 + quad * 8);
                        acc[ct] = __builtin_amdgcn_mfma_f32_16x16x32_bf16(a, bh, acc[ct], 0, 0, 0); acc[ct] = __builtin_amdgcn_mfma_f32_16x16x32_bf16(a, bl, acc[ct], 0, 0, 0); } }
            }
#undef P4_LOAD
            ssq += swz_xor<16>(ssq); { auto rr = __builtin_amdgcn_permlane32_swap(__float_as_uint(ssq), __float_as_uint(ssq), false, false); ssq = __uint_as_float(rr[0]) + __uint_as_float(rr[1]); }
            const float rstd = rsqrtf(ssq * (1.f / DM) + EPS);
            if (quad == 0) LG[640 + mr] = rstd;
            LDS_WAIT(); asm volatile("" ::: "memory");
#pragma unroll
            for (int v = 0; v < 4; ++v) { const float rs = LG[640 + 4 * quad + v];
#pragma unroll
                for (int ct = 0; ct < 3; ++ct) if (ct < 2 || mr < 4) LG[(4 * quad + v) * 40 + ct * 16 + mr] = acc[ct][v] * rs; }
            LDS_WAIT(); asm volatile("" ::: "memory");
            if (F.lane < 16) { const LAS float* lr = LG + F.lane * 40;
                const float g0 = lr[0], g1 = lr[1], g2 = lr[2], g3 = lr[3];
                int grp = 0; float gm = g0; if (g1 > gm) { gm = g1; grp = 1; } if (g2 > gm) { gm = g2; grp = 2; } if (g3 > gm) { gm = g3; grp = 3; }
                const float psel = 1.f / (expf(g0 - gm) + expf(g1 - gm) + expf(g2 - gm) + expf(g3 - gm));
                float ev[8];
#pragma unroll
                for (int i = 0; i < 8; ++i) ev[i] = lr[4 + grp * 8 + i];
                int i0 = 0; float v0 = ev[0];
#pragma unroll
                for (int i = 1; i < 8; ++i) if (ev[i] > v0) { v0 = ev[i]; i0 = i; }
                int i1 = -1; float v1 = 0.f;
#pragma unroll
                for (int i = 0; i < 8; ++i) if (i != i0 && (i1 < 0 || ev[i] > v1)) { v1 = ev[i]; i1 = i; }
                const float ga = 1.f / (1.f + expf(v1 - v0)), gb = 1.f - ga;
                const int rl = F.wave * 16 + F.lane; sel_e[rl * 2] = grp * 8 + i0; sel_e[rl * 2 + 1] = grp * 8 + i1; sel_g[rl * 2] = ga * psel; sel_g[rl * 2 + 1] = gb * psel; sel_r[rl] = LG[640 + F.lane]; }
            __syncthreads();
            FRESH_LANE(l4_); const int t4 = F.wave * 64 + l4_;
            int my_e = 0, my_rk = 0;
            if (t4 < 256) { my_e = sel_e[t4]; my_rk = atomicAdd((int*)(lhist + my_e), 1); }
            __syncthreads();
            if (t4 < 32) { const int n = lhist[t4]; lbase[t4] = n ? (int)__hip_atomic_fetch_add(ecnt + 64 * t4, (unsigned)n, RLX_AGENT) : 0; }
            __syncthreads();
            if (t4 < 256) { const int pos = lbase[my_e] + my_rk; const size_t li = (size_t)my_e * LCAP + pos; { int2 sg; sg.x = (chunk * 128 + (t4 >> 1)) * 2 + (t4 & 1); sg.y = __float_as_int(sel_g[t4]); ((int2*)LSLOT)[li] = sg; } LRSTD[li] = sel_r[t4 >> 1]; }
            __syncthreads();
        }
    }
    SEAM(4);
    if (IN(6) || IN(7)) {
        PHASE_LANE();
        if (F.tid < 32) lcnt[F.tid] = (int)__hip_atomic_load(ecnt + 64 * F.tid, RLX_AGENT);
        __syncthreads();
        if (F.tid == 0) { int acc = 0; for (int e = 0; e < 32; ++e) { tstart[e] = acc; acc += (lcnt[e] + 255) >> 8; } tstart[32] = acc; }
        __syncthreads();
    }
    const int NTILES = (IN(6) || IN(7)) ? __builtin_amdgcn_readfirstlane(tstart[32]) : 0;
    if (IN(6)) REPS(6) {
        pg8::Gemm g{H1B, WGU, NTILES * 256, 1024, DM, LSLOT, DM, LDW}; pg8::MoeOrder S; S.init(NTILES, 4, F.G, (int)blockIdx.x, tstart, lcnt);
        pg8::EpiSwiglu E{HB, LRSTD};
        pg8::gemm_phase<pg8::EpiSwiglu, pg8::MoeOrder, true, true, true>(F.lds + RING_OFF, g, S, E, F.wave);
        { pg8::Gemm g2{PB, WPLE, NTOK, DM, PLED, nullptr, LDP, LDP}; pg8::BalancedOrder S2; S2.init(NTOK, DM, F.G, (int)blockIdx.x, (NTILES * 4) % F.G);
          pg8::EpiBf16 E2{UB, F.lds + ESCR_OFF};
          pg8::gemm_phase<pg8::EpiBf16, pg8::BalancedOrder, true, true>(F.lds + RING_OFF, g2, S2, E2, F.wave); }
    }
    SEAM(6);
    if (IN(7)) REPS(7) {
        pg8::Gemm g{HB, WD, NTILES * 256, DM, DEXP, nullptr, LDH, LDH}; pg8::MoeOrder S; S.init(NTILES, 8, F.G, (int)blockIdx.x, tstart, lcnt);
        pg8::EpiScatter E{YB, (const int2*)LSLOT};
        pg8::gemm_phase<pg8::EpiScatter, pg8::MoeOrder, true, true>(F.lds + RING_OFF, g, S, E, F.wave);
    }
    SEAM(7);
    if (IN(8)) {
        PHASE_LANE();
        for (int m = 2 * gw; m < NTOK; m += 2 * NGW) {
            v4u hv[2][4], ya[2][4], yb[2][4];
#pragma unroll
            for (int q = 0; q < 2; ++q) { const GAS v4u* hr = (const GAS v4u*)(H1B + (size_t)(m + q) * DM) + F.lane; const GAS v4u* y0 = (const GAS v4u*)(YB + (size_t)(2 * (m + q)) * DM) + F.lane; const GAS v4u* y1 = (const GAS v4u*)(YB + (size_t)(2 * (m + q) + 1) * DM) + F.lane;
#pragma unroll
                for (int j = 0; j < 4; ++j) { hv[q][j] = hr[64 * j]; ya[q][j] = y0[64 * j]; yb[q][j] = y1[64 * j]; } }
#pragma unroll
            for (int q = 0; q < 2; ++q) {
                float s = 0.f; GAS v4u* o8 = (GAS v4u*)(H1B + (size_t)(m + q) * DM) + F.lane;
#pragma unroll
                for (int j = 0; j < 4; ++j) { float v[8], a[8], b[8]; unpack8(hv[q][j], v); unpack8(ya[q][j], a); unpack8(yb[q][j], b);
#pragma unroll
                    for (int i = 0; i < 8; ++i) v[i] += a[i] + b[i];
                    v4u w; w.x = pk2(v[0], v[1]); w.y = pk2(v[2], v[3]); w.z = pk2(v[4], v[5]); w.w = pk2(v[6], v[7]); o8[64 * j] = w;
                    float f[8]; unpack8(w, f);
#pragma unroll
                    for (int i = 0; i < 8; ++i) s += f[i] * f[i]; }
                const float rstd = rsqrtf(wave_sum(s) * (1.f / DM) + EPS);
                if (F.lane == 0) RSTD2[m + q] = rstd; }
        }
    }
    SEAM(8);
    if (IN(9)) {
        pg8::Gemm g{H1B, WPG, NTOK, DM, DM, nullptr, DM, LDW}; pg8::StaticOrder S; S.init(NTOK, DM, F.G, (int)blockIdx.x);
        pg8::EpiPle2 E{H1B, UB, RSTD2, A1, LDA1};
        pg8::gemm_phase<pg8::EpiPle2, pg8::StaticOrder, true, true>(F.lds + RING_OFF, g, S, E, F.wave);
    }
    SEAM(9);
    if (IN(10)) REPS(10) {
        PHASE_LANE();
        for (int m = 4 * gw; m < NTOK; m += 4 * NGW) {
            v4u hv[4][4];
#pragma unroll
            for (int q = 0; q < 4; ++q) { const GAS v4u* hr = (const GAS v4u*)(A1 + (size_t)(m + q) * LDA1) + F.lane;
#pragma unroll
                for (int j = 0; j < 4; ++j) hv[q][j] = hr[64 * j]; }
#pragma unroll
            for (int q = 0; q < 4; ++q) {
                float v[4][8]; float s = 0.f;
#pragma unroll
                for (int j = 0; j < 4; ++j) { unpack8(hv[q][j], v[j]);
#pragma unroll
                    for (int i = 0; i < 8; ++i) s += v[j][i] * v[j][i]; }
                const float rstd = rsqrtf(wave_sum(s) * (1.f / DM) + EPS);
                GAS f32x4* orow = (GAS f32x4*)(out + (size_t)(m + q) * DM) + 2 * F.lane;
#pragma unroll
                for (int j = 0; j < 4; ++j) { const f32x4 g0 = *((const GAS f32x4*)g_final + 2 * F.lane + 128 * j), g1 = *((const GAS f32x4*)g_final + 2 * F.lane + 128 * j + 1);
                    orow[128 * j] = (f32x4){v[j][0] * rstd * g0.x, v[j][1] * rstd * g0.y, v[j][2] * rstd * g0.z, v[j][3] * rstd * g0.w};
                    orow[128 * j + 1] = (f32x4){v[j][4] * rstd * g1.x, v[j][5] * rstd * g1.y, v[j][6] * rstd * g1.z, v[j][7] * rstd * g1.w}; } }
        }
    }
#ifdef PROBE_CLOCK
    {
        typedef float f32x16_ __attribute__((ext_vector_type(16))); typedef short bf16x8_ __attribute__((ext_vector_type(8)));
        f32x16_ c0 = {}, c1 = {}, c2 = {}, c3 = {}; bf16x8_ a = {1, 2, 3, 4, 5, 6, 7, 8}, b = {1, 1, 1, 1, 1, 1, 1, 1};
        const long long t0 = clock64();
        while (clock64() - t0 < PROBE_CLOCK) {
#pragma unroll
            for (int i = 0; i < 8; ++i) { c0 = __builtin_amdgcn_mfma_f32_32x32x16_bf16(a, b, c0, 0, 0, 0); c1 = __builtin_amdgcn_mfma_f32_32x32x16_bf16(a, b, c1, 0, 0, 0); c2 = __builtin_amdgcn_mfma_f32_32x32x16_bf16(a, b, c2, 0, 0, 0); c3 = __builtin_amdgcn_mfma_f32_32x32x16_bf16(a, b, c3, 0, 0, 0); } }
        if (c0[0] + c1[1] + c2[2] + c3[3] == 12345.678f) out[0] = 0.f;
    }
#endif
#undef IN
#undef SEAM
}

#ifndef MK_SPLIT
#define MK_SPLIT 0
#endif
extern "C" void kernel_launch(void* const* d_in, const int* in_sizes, int n_in, void* d_out, int out_size, void* d_ws, size_t ws_size, hipStream_t stream) {
    static int grid = 0;
    if (grid == 0) {
        if (n_in != 21 || in_sizes[0] != NTOK * DM || out_size != NTOK * DM || ws_size < WS_END) { fprintf(stderr, "kernel_launch: shape mismatch (n_in %d in0 %d out %d ws %zu)\n", n_in, n_in > 0 ? in_sizes[0] : -1, out_size, ws_size); grid = -1; return; }
        int dev = 0, cus = 0, per_cu = 0;
        if (hipGetDevice(&dev) != hipSuccess || hipDeviceGetAttribute(&cus, hipDeviceAttributeMultiprocessorCount, dev) != hipSuccess) { grid = -1; return; }
        if (hipFuncSetAttribute((const void*)mega_fwd, hipFuncAttributeMaxDynamicSharedMemorySize, LDS_BYTES) != hipSuccess) { fprintf(stderr, "kernel_launch: hipFuncSetAttribute failed\n"); grid = -1; return; }
        if (hipOccupancyMaxActiveBlocksPerMultiprocessor(&per_cu, (const void*)mega_fwd, NWAVES * 64, LDS_BYTES) != hipSuccess || per_cu < 1) fprintf(stderr, "kernel_launch: occupancy query reports %d\n", per_cu);
        (void)hipGetLastError();
        grid = cus;
    }
    if (grid < 0) return;
    if (hipMemsetAsync((char*)d_ws + WS_CTL, 0, CTL_ZERO_BYTES, stream) != hipSuccess) return;
    Args a{};
    for (int i = 0; i < 21; ++i) a.in[i] = (const float*)d_in[i];
    a.out = (float*)d_out; a.ws = (unsigned char*)d_ws;
#if MK_SPLIT
    for (int ph = 0; ph < 11; ++ph) { a.ph_lo = ph; a.ph_hi = ph + 1; hipLaunchKernelGGL(mega_fwd, dim3(grid), dim3(NWAVES * 64), LDS_BYTES, stream, a); }
#else
    a.ph_lo = 0; a.ph_hi = 11;
    hipLaunchKernelGGL(mega_fwd, dim3(grid), dim3(NWAVES * 64), LDS_BYTES, stream, a);
#endif
    const hipError_t le = hipPeekAtLastError();
    if (le != hipSuccess) fprintf(stderr, "kernel_launch: launch failed: %s\n", hipGetErrorName(le));
}
```

```cpp
#include <hip/hip_runtime.h>
#include <hip/hip_bf16.h>
#include <cstdio>
#include <cstdint>
#define FRESH_LANE(v) int v; asm volatile("v_mbcnt_lo_u32_b32 %0, -1, 0\n\tv_mbcnt_hi_u32_b32 %0, -1, %0" : "=v"(v))
template <int M> __device__ __forceinline__ float swz_xor(float v) { return __int_as_float(__builtin_amdgcn_ds_swizzle(__float_as_int(v), 0x1f | (M << 10))); }
__device__ __forceinline__ float half_sum32_(float v) { v += swz_xor<1>(v); v += swz_xor<2>(v); v += swz_xor<4>(v); v += swz_xor<8>(v); v += swz_xor<16>(v); return v; }
__device__ __forceinline__ float wave_sum_(float v) { v = half_sum32_(v); auto rr = __builtin_amdgcn_permlane32_swap(__float_as_uint(v), __float_as_uint(v), false, false); return __uint_as_float(rr[0]) + __uint_as_float(rr[1]); }
namespace pg8 {
#define PG8_LAS __attribute__((address_space(3)))
typedef unsigned short bf16_t;
typedef short bf16x8 __attribute__((ext_vector_type(8)));
typedef float f32x4 __attribute__((ext_vector_type(4)));
typedef unsigned u32x4 __attribute__((ext_vector_type(4)));
constexpr int BM = 256, BK = 64, HALF = 128, HTB = HALF * BK * 2  , STAGE_BYTES = 8 * HTB, NXCD = 8, WGM = 4;

__host__ __device__ __forceinline__ int lds_byte(int r, int c) { const int st = (r >> 4) * 2 + (c >> 5), rr = r & 15, cc = c & 31, ob = rr * 64 + cc * 2; return st * 1024 + (ob ^ (((ob >> 9) & 1) << 5)); }
__host__ __device__ __forceinline__ void stage_rc(int b, int& R, int& C) { const int st = b / 1024, sb = b % 1024, swz = sb ^ (((sb >> 9) & 1) << 5); R = (st >> 1) * 16 + swz / 64; C = (st & 1) * 32 + (swz % 64) / 2; }
__host__ __device__ __forceinline__ int perm32(int rho) { const int n = rho >> 4, i = rho & 15; return 8 * (i >> 2) + 4 * n + (i & 3); }

struct Unit { int pm, pn, pb, aux0, aux1; };
struct Gemm { const bf16_t* A; const bf16_t* Bt; int M, N, K; const int* glist; int lda, ldb; };

struct StaticOrder {
    int nM, nN, nwg, G, c, fixed;
    __host__ __device__ void init(int M, int N, int G_, int c_) { nM = M / BM; nN = N / BM; nwg = nM * nN; G = G_; c = c_; fixed = 0; }
    __host__ __device__ bool next(int i, Unit& u) const {
        const long L = (long)i * G + c; if (L >= nwg) return false;
        int wgid = (int)L; { const int q = nwg / NXCD, r = nwg % NXCD, xcd = wgid % NXCD, off = wgid / NXCD; wgid = (xcd < r ? xcd * (q + 1) : r * (q + 1) + (xcd - r) * q) + off; }
        const int nig = WGM * nN, gid = wgid / nig, fm = gid * WGM, gsz = (nM - fm) < WGM ? (nM - fm) : WGM;
        u.pm = fm + ((wgid % nig) % gsz); u.pn = (wgid % nig) / gsz; if (fixed) { u.pm = 0; u.pn = 0; } u.pb = u.pn; u.aux0 = 0; u.aux1 = 0; return true;
    }
    __device__ __forceinline__ void a_ready(const Unit&) const {}
    __device__ __forceinline__ void done(const Unit&) const {}
};

struct BalancedOrder {
    int nM, nN, nwg, G, c, rem, E, K1;
    __host__ __device__ void init(int M, int N, int G_, int c_, int rem_) { nM = M / BM; nN = N / BM; nwg = nM * nN; G = G_; c = c_; rem = rem_; E = G_ - rem_; K1 = (nwg + E - 1) / E; if (K1 > KMAX) K1 = KMAX; }
    static constexpr int KMAX = 6;
    __host__ __device__ bool next(int i, Unit& u) const {
        long L;
        if (c >= rem) L = i < K1 ? (long)i * E + (c - rem) : (long)K1 * E + (long)(i - K1) * G + c;
        else L = (long)K1 * E + (long)i * G + c;
        if (L >= nwg) return false;
        int wgid = (int)L; { const int q = nwg / NXCD, r = nwg % NXCD, xcd = wgid % NXCD, off = wgid / NXCD; wgid = (xcd < r ? xcd * (q + 1) : r * (q + 1) + (xcd - r) * q) + off; }
        const int nig = WGM * nN, gid = wgid / nig, fm = gid * WGM, gsz = (nM - fm) < WGM ? (nM - fm) : WGM;
        u.pm = fm + ((wgid % nig) % gsz); u.pn = (wgid % nig) / gsz; u.pb = u.pn; u.aux0 = 0; u.aux1 = 0; return true;
    }
    __device__ __forceinline__ void a_ready(const Unit&) const {}
    __device__ __forceinline__ void done(const Unit&) const {}
};

__device__ __forceinline__ unsigned cvt_pk_bf16(float lo, float hi) { unsigned r; asm volatile("v_cvt_pk_bf16_f32 %0, %1, %2" : "=v"(r) : "v"(lo), "v"(hi)); return r; }
typedef float f32x2 __attribute__((ext_vector_type(2)));
#define PG8_FRESH_LANE(fr, fq) int l__; asm volatile("v_mbcnt_lo_u32_b32 %0, -1, 0\n\tv_mbcnt_hi_u32_b32 %0, -1, %0" : "=v"(l__)); const int fr = l__ & 15, fq = l__ >> 4; (void)fr_; (void)fq_
typedef unsigned u32x2 __attribute__((ext_vector_type(2)));
__device__ __forceinline__ float bf_lo(unsigned w) { return __uint_as_float(w << 16); }
__device__ __forceinline__ float bf_hi(unsigned w) { return __uint_as_float(w & 0xffff0000u); }

__device__ __forceinline__ void sp_store_group(bf16_t* sp, int rowg, const u32x4& w0, const u32x4& w1, PG8_LAS unsigned char* sw, int fr, int fq) {
    const int lane = fq * 16 + fr;
    const int wofs0 = fr * 128 + ((fq ^ (fr & 7)) << 4), wofs1 = fr * 128 + (((fq + 4) ^ (fr & 7)) << 4);
    const int rofs0 = (lane >> 3) * 128 + (((lane & 7) ^ ((lane >> 3) & 7)) << 4), rofs1 = rofs0 + 1024;
    *(PG8_LAS u32x4*)(sw + wofs0) = w0; *(PG8_LAS u32x4*)(sw + wofs1) = w1;
    asm volatile("s_waitcnt lgkmcnt(0)" ::: "memory");
    const u32x4 o0 = *(const PG8_LAS u32x4*)(sw + rofs0), o1 = *(const PG8_LAS u32x4*)(sw + rofs1);
    bf16_t* gp = sp + (size_t)rowg * 64 + lane * 8;
    *(u32x4*)gp = o0; *(u32x4*)(gp + 512) = o1;
    asm volatile("" ::: "memory");
}
constexpr size_t SPS = (size_t)32768 * 64;
struct EpiQKV {
    static constexpr bool PERM = true, AFTER_DRAIN = false; static constexpr int NST = 16;
    bf16_t* O; PG8_LAS unsigned char* scr; int skip; float* kmax2;
    __device__ __forceinline__ void operator()(const f32x4 (&acc)[2][2][4][2], const Unit& u, int wr, int wc, int fr_, int fq_) const {
#ifdef PROBE_NOEPI
        if (skip == 1) return;
#endif
        PG8_FRESH_LANE(fr, fq);
        const int lane = fq * 16 + fr;
        const bool rot = (u.pn >= 12) && (u.pn < 20), kd = (u.pn >= 16) && (u.pn < 20);
        constexpr float RV[8] = {0.15915494309189535f, 0.03086376340470123f, 0.005985185712713705f, 0.001160663641240061f, 0.00022507907903927653f, 4.364795279280289e-05f, 8.464330808241401e-06f, 1.6414262627950345e-06f};
        const float sgn = (fq == 0) ? -1.f : ((fq == 1) ? 1.f : 0.f);
        PG8_LAS unsigned char* sw = scr + (wr * 4 + wc) * 2048;
        const int wofs0 = fr * 128 + ((fq ^ (fr & 7)) << 4), wofs1 = fr * 128 + (((fq + 4) ^ (fr & 7)) << 4);
        const int rofs0 = (lane >> 3) * 128 + (((lane & 7) ^ ((lane >> 3) & 7)) << 4), rofs1 = rofs0 + 1024;
        bf16_t* sp = O + (size_t)(u.pn * 4 + wc) * ((size_t)32768 * 64);
#pragma unroll
        for (int ai = 0; ai < 2; ++ai) { float gmax = 0.f;
#pragma unroll
            for (int m = 0; m < 4; ++m) { const int rowg = u.pm * BM + ai * HALF + wr * 64 + m * 16, row = rowg + fr; u32x4 w[2]; float nrm = 0.f;
#pragma unroll
                for (int bj = 0; bj < 2; ++bj) { f32x4 v0 = acc[ai][bj][m][0], v1 = acc[ai][bj][m][1];
                    if (rot && bj == 0) { const float pos = (float)(row & 8191); f32x4 p0, p1;
#pragma unroll
                        for (int j = 0; j < 4; ++j) { p0[j] = swz_xor<16>(v0[j]); p1[j] = swz_xor<16>(v1[j]); }
#pragma unroll
                        for (int j = 0; j < 4; ++j) { const float f0 = __builtin_amdgcn_fractf(pos * RV[j]), f1 = __builtin_amdgcn_fractf(pos * RV[4 + j]);
                            const float c0 = (sgn != 0.f) ? __builtin_amdgcn_cosf(f0) : 1.f, s0 = sgn * __builtin_amdgcn_sinf(f0), c1 = (sgn != 0.f) ? __builtin_amdgcn_cosf(f1) : 1.f, s1 = sgn * __builtin_amdgcn_sinf(f1);
                            v0[j] = v0[j] * c0 + p0[j] * s0; v1[j] = v1[j] * c1 + p1[j] * s1; } }
                    if (kd) nrm += ((v0[0] * v0[0] + v0[1] * v0[1]) + (v0[2] * v0[2] + v0[3] * v0[3])) + ((v1[0] * v1[0] + v1[1] * v1[1]) + (v1[2] * v1[2] + v1[3] * v1[3]));
                    w[bj].x = cvt_pk_bf16(v0[0], v0[1]); w[bj].y = cvt_pk_bf16(v0[2], v0[3]); w[bj].z = cvt_pk_bf16(v1[0], v1[1]); w[bj].w = cvt_pk_bf16(v1[2], v1[3]); }
                gmax = __builtin_fmaxf(gmax, nrm);
#ifdef QKV_DIRECT
                { bf16_t* gp = sp + (size_t)row * 64 + fq * 8; *(u32x4*)gp = w[0]; *(u32x4*)(gp + 32) = w[1]; (void)sw; (void)wofs0; (void)wofs1; (void)rofs0; (void)rofs1; }
                asm volatile("" ::: "memory"); }
#else
                *(PG8_LAS u32x4*)(sw + wofs0) = w[0]; *(PG8_LAS u32x4*)(sw + wofs1) = w[1];
                asm volatile("s_waitcnt lgkmcnt(0)" ::: "memory");
                const u32x4 o0 = *(const PG8_LAS u32x4*)(sw + rofs0), o1 = *(const PG8_LAS u32x4*)(sw + rofs1);
                bf16_t* gp = sp + (size_t)rowg * 64 + lane * 8;
#ifdef PROBE_NOEPI
                if (skip == 2) { asm volatile("" :: "v"(o0), "v"(o1)); } else
#endif
                { *(u32x4*)gp = o0; *(u32x4*)(gp + 512) = o1; }
                asm volatile("" ::: "memory"); }
#endif
            if (kd) {
                gmax += swz_xor<16>(gmax); { auto rr = __builtin_amdgcn_permlane32_swap(__float_as_uint(gmax), __float_as_uint(gmax), false, false); gmax = __uint_as_float(rr[0]) + __uint_as_float(rr[1]); }
                gmax = __builtin_fmaxf(gmax, swz_xor<1>(gmax)); gmax = __builtin_fmaxf(gmax, swz_xor<2>(gmax)); gmax = __builtin_fmaxf(gmax, swz_xor<4>(gmax)); gmax = __builtin_fmaxf(gmax, swz_xor<8>(gmax));
                const int row0 = u.pm * BM + ai * HALF + wr * 64;
                if (lane == 0) kmax2[(size_t)(((row0 >> 13) * 16 + (u.pn - 16) * 4 + wc) * 128 + ((row0 & 8191) >> 6))] = gmax * 1.02f; } }
        (void)skip;
    }
};
struct EpiBf16 {
    static constexpr bool PERM = true, AFTER_DRAIN = false; static constexpr int NST = 16;
    bf16_t* O; PG8_LAS unsigned char* scr;
    __device__ __forceinline__ void operator()(const f32x4 (&acc)[2][2][4][2], const Unit& u, int wr, int wc, int fr_, int fq_) const {
        PG8_FRESH_LANE(fr, fq);
        PG8_LAS unsigned char* sw = scr + (wr * 4 + wc) * 2048; bf16_t* sp = O + (size_t)(u.pn * 4 + wc) * SPS;
#pragma unroll
        for (int ai = 0; ai < 2; ++ai)
#pragma unroll
            for (int m = 0; m < 4; ++m) { u32x4 w[2];
#pragma unroll
                for (int bj = 0; bj < 2; ++bj) { const f32x4 v0 = acc[ai][bj][m][0], v1 = acc[ai][bj][m][1];
                    w[bj].x = cvt_pk_bf16(v0[0], v0[1]); w[bj].y = cvt_pk_bf16(v0[2], v0[3]); w[bj].z = cvt_pk_bf16(v1[0], v1[1]); w[bj].w = cvt_pk_bf16(v1[2], v1[3]); }
                sp_store_group(sp, u.pm * BM + ai * HALF + wr * 64 + m * 16, w[0], w[1], sw, fr, fq); }
    }
};
struct EpiResBf16 {
    static constexpr bool PERM = true, AFTER_DRAIN = false; static constexpr int NST = 16;
    const float* base; bf16_t* O;
    __device__ __forceinline__ void operator()(const f32x4 (&acc)[2][2][4][2], const Unit& u, int wr, int wc, int fr_, int fq_) const {
        PG8_FRESH_LANE(fr, fq);
        const int row0 = u.pm * BM + wr * 64 + fr, col0 = u.pn * BM + wc * 64 + 8 * fq;
        f32x4 bv[2][4];
#define ER_LOAD(buf, it) do { const size_t off_ = (size_t)(row0 + ((it) >> 2) * HALF + ((it) & 3) * 16) * 2048 + col0; \
            bv[buf][0] = *(const f32x4*)(base + off_); bv[buf][1] = *(const f32x4*)(base + off_ + 4); bv[buf][2] = *(const f32x4*)(base + off_ + 32); bv[buf][3] = *(const f32x4*)(base + off_ + 36); } while (0)
        ER_LOAD(0, 0);
#pragma unroll
        for (int it = 0; it < 8; ++it) { const int ai = it >> 2, m = it & 3; const size_t off = (size_t)(row0 + ai * HALF + m * 16) * 2048 + col0;
            if (it + 1 < 8) { if (it & 1) ER_LOAD(0, it + 1); else ER_LOAD(1, it + 1); }
#pragma unroll
            for (int bj = 0; bj < 2; ++bj) { const f32x4 v0 = acc[ai][bj][m][0] + bv[it & 1][2 * bj], v1 = acc[ai][bj][m][1] + bv[it & 1][2 * bj + 1];
                u32x4 w; w.x = cvt_pk_bf16(v0[0], v0[1]); w.y = cvt_pk_bf16(v0[2], v0[3]); w.z = cvt_pk_bf16(v1[0], v1[1]); w.w = cvt_pk_bf16(v1[2], v1[3]);
                *(u32x4*)(O + off + bj * 32) = w; } }
#undef ER_LOAD
    }
};
struct EpiResN {
    static constexpr bool PERM = true, AFTER_DRAIN = false; static constexpr int NST = 16;
    const bf16_t* Xn; int ldx; const float* invr; bf16_t* O;
    __device__ __forceinline__ void operator()(const f32x4 (&acc)[2][2][4][2], const Unit& u, int wr, int wc, int fr_, int fq_) const {
        PG8_FRESH_LANE(fr, fq);
        const int row0 = u.pm * BM + wr * 64 + fr, col0 = u.pn * BM + wc * 64 + 8 * fq;
        float rs[8];
#pragma unroll
        for (int it = 0; it < 8; ++it) rs[it] = invr[row0 + (it >> 2) * HALF + (it & 3) * 16];
        u32x4 lv[2];
#define EN_LOAD(buf, k) do { const int it_ = (k) >> 1, bj_ = (k) & 1; const size_t row_ = (size_t)(row0 + (it_ >> 2) * HALF + (it_ & 3) * 16); \
            lv[buf] = *(const u32x4*)(Xn + row_ * ldx + col0 + bj_ * 32); } while (0)
        EN_LOAD(0, 0);
#pragma unroll
        for (int k = 0; k < 16; ++k) { const int it = k >> 1, bj = k & 1, ai = it >> 2, m = it & 3; const size_t row = (size_t)(row0 + ai * HALF + m * 16);
            if (k + 1 < 16) { if (k & 1) EN_LOAD(0, k + 1); else EN_LOAD(1, k + 1); }
            const u32x4 xw = lv[k & 1]; const float sc = rs[it];
            float r[8];
#pragma unroll
            for (int q = 0; q < 4; ++q) { r[2 * q] = bf_lo(xw[q]) * sc + acc[ai][bj][m][q >> 1][(q & 1) * 2]; r[2 * q + 1] = bf_hi(xw[q]) * sc + acc[ai][bj][m][q >> 1][(q & 1) * 2 + 1]; }
            u32x4 w; w.x = cvt_pk_bf16(r[0], r[1]); w.y = cvt_pk_bf16(r[2], r[3]); w.z = cvt_pk_bf16(r[4], r[5]); w.w = cvt_pk_bf16(r[6], r[7]);
            *(u32x4*)(O + row * 2048 + col0 + bj * 32) = w; }
#undef EN_LOAD
    }
};
struct EpiPle2 {
    static constexpr bool PERM = true, AFTER_DRAIN = false; static constexpr int NST = 16;
    const bf16_t* Hs; const bf16_t* U; const float* rstd; bf16_t* O3; int ld3;
    __device__ __forceinline__ void operator()(const f32x4 (&acc)[2][2][4][2], const Unit& u, int wr, int wc, int fr_, int fq_) const {
        PG8_FRESH_LANE(fr, fq);
        const int row0 = u.pm * BM + wr * 64 + fr, col0 = u.pn * BM + wc * 64 + 8 * fq;
        float rs[8];
#pragma unroll
        for (int it = 0; it < 8; ++it) rs[it] = rstd[row0 + (it >> 2) * HALF + (it & 3) * 16];
        u32x4 lv[2][2];
#define EP_LOAD(buf, k) do { const int it_ = (k) >> 1, bj_ = (k) & 1; const size_t row_ = (size_t)(row0 + (it_ >> 2) * HALF + (it_ & 3) * 16); \
            lv[buf][0] = *(const u32x4*)(Hs + row_ * 2048 + col0 + bj_ * 32); lv[buf][1] = *(const u32x4*)(U + (size_t)(u.pn * 4 + wc) * SPS + row_ * 64 + bj_ * 32 + 8 * fq); } while (0)
        EP_LOAD(0, 0);
#pragma unroll
        for (int k = 0; k < 16; ++k) { const int it = k >> 1, bj = k & 1, ai = it >> 2, m = it & 3; const size_t row = (size_t)(row0 + ai * HALF + m * 16);
            if (k + 1 < 16) { if (k & 1) EP_LOAD(0, k + 1); else EP_LOAD(1, k + 1); }
            const u32x4 hw = lv[k & 1][0], uw = lv[k & 1][1]; const float sc = -1.4426950408889634f * rs[it];
            float r[8];
#pragma unroll
            for (int q = 0; q < 4; ++q) { const float a0 = acc[ai][bj][m][q >> 1][(q & 1) * 2], a1 = acc[ai][bj][m][q >> 1][(q & 1) * 2 + 1];
                const float s0 = __builtin_amdgcn_rcpf(1.f + __builtin_amdgcn_exp2f(sc * a0)), s1 = __builtin_amdgcn_rcpf(1.f + __builtin_amdgcn_exp2f(sc * a1));
                r[2 * q] = bf_lo(hw[q]) + bf_lo(uw[q]) * s0; r[2 * q + 1] = bf_hi(hw[q]) + bf_hi(uw[q]) * s1; }
            u32x4 w; w.x = cvt_pk_bf16(r[0], r[1]); w.y = cvt_pk_bf16(r[2], r[3]); w.z = cvt_pk_bf16(r[4], r[5]); w.w = cvt_pk_bf16(r[6], r[7]);
            *(u32x4*)(O3 + row * ld3 + col0 + bj * 32) = w; }
#undef EP_LOAD
    }
};
struct EpiSwiglu {
    static constexpr bool PERM = true, AFTER_DRAIN = false; static constexpr int NST = 8;
    bf16_t* H; const float* lrstd;
    __device__ __forceinline__ void operator()(const f32x4 (&acc)[2][2][4][2], const Unit& u, int wr, int wc, int fr_, int fq_) const {
        PG8_FRESH_LANE(fr, fq);
        const int row0 = u.pm * BM + wr * 64 + fr, col0 = u.pn * HALF + wc * 32 + 8 * fq, r0 = wr * 64 + fr;
        float rs[8];
#pragma unroll
        for (int it = 0; it < 8; ++it) { const int r = r0 + (it >> 2) * HALF + (it & 3) * 16; rs[it] = (r < u.aux1) ? lrstd[u.aux0 + r] : 0.f; }
#pragma unroll
        for (int ai = 0; ai < 2; ++ai)
#pragma unroll
            for (int m = 0; m < 4; ++m) { bf16_t* rowp = H + (size_t)(row0 + ai * HALF + m * 16) * 576 + col0; float h[8]; const float rr = rs[ai * 4 + m];
#pragma unroll
                for (int n = 0; n < 2; ++n)
#pragma unroll
                    for (int j = 0; j < 4; ++j) { const float g = acc[ai][0][m][n][j] * rr, up = acc[ai][1][m][n][j] * rr;
                        h[n * 4 + j] = g * up * __builtin_amdgcn_rcpf(1.f + __builtin_amdgcn_exp2f(-1.4426950408889634f * g)); }
                u32x4 w; w.x = cvt_pk_bf16(h[0], h[1]); w.y = cvt_pk_bf16(h[2], h[3]); w.z = cvt_pk_bf16(h[4], h[5]); w.w = cvt_pk_bf16(h[6], h[7]);
                *(u32x4*)rowp = w; }
    }
};
struct EpiScatter {
    static constexpr bool PERM = true, AFTER_DRAIN = false; static constexpr int NST = 16;
    bf16_t* Y; const int2* lsg;
    __device__ __forceinline__ void operator()(const f32x4 (&acc)[2][2][4][2], const Unit& u, int wr, int wc, int fr_, int fq_) const {
        PG8_FRESH_LANE(fr, fq);
        const int r0 = wr * 64 + fr, col0 = u.pn * BM + wc * 64 + 8 * fq;
        int sl[8]; float gt[8];
#pragma unroll
        for (int it = 0; it < 8; ++it) { const int r = r0 + (it >> 2) * HALF + (it & 3) * 16; const bool ok = r < u.aux1; int2 sg; sg.x = 65536; sg.y = 0; if (ok) sg = lsg[u.aux0 + r]; sl[it] = sg.x; gt[it] = __int_as_float(sg.y); }
#pragma unroll
        for (int it = 0; it < 8; ++it) { const int ai = it >> 2, m = it & 3;
            { bf16_t* rowp = Y + (size_t)sl[it] * 2048 + col0; const float g = gt[it];
#pragma unroll
                for (int bj = 0; bj < 2; ++bj) { const f32x4 v0 = acc[ai][bj][m][0] * g, v1 = acc[ai][bj][m][1] * g;
                    u32x4 w; w.x = cvt_pk_bf16(v0[0], v0[1]); w.y = cvt_pk_bf16(v0[2], v0[3]); w.z = cvt_pk_bf16(v1[0], v1[1]); w.w = cvt_pk_bf16(v1[2], v1[3]);
                    if (sl[it] != 65536) *(u32x4*)(rowp + bj * 32) = w; } } }
    }
};
struct MoeOrder {
    int nM, nN, nwg, G, c; const PG8_LAS int* tstart; const PG8_LAS int* cnt;
    __device__ void init(int nM_, int nN_, int G_, int c_, const PG8_LAS int* ts, const PG8_LAS int* cn) { nM = nM_; nN = nN_; nwg = nM * nN; G = G_; c = c_; tstart = ts; cnt = cn; }
    __device__ bool next(int i, Unit& u) const {
        const long L = (long)i * G + c; if (L >= nwg) return false;
        int wgid = (int)L; { const int q = nwg / NXCD, r = nwg % NXCD, xcd = wgid % NXCD, off = wgid / NXCD; wgid = (xcd < r ? xcd * (q + 1) : r * (q + 1) + (xcd - r) * q) + off; }
        const int nig = WGM * nN, gid = wgid / nig, fm = gid * WGM, gsz = (nM - fm) < WGM ? (nM - fm) : WGM;
        const int pm = fm + ((wgid % nig) % gsz), pn = (wgid % nig) / gsz;
        int e = 0;
        for (int k = 1; k < 32; ++k) e += (__builtin_amdgcn_readfirstlane(tstart[k]) <= pm) ? 1 : 0;
        const int t = pm - __builtin_amdgcn_readfirstlane(tstart[e]); const int left = __builtin_amdgcn_readfirstlane(cnt[e]) - t * 256;
        u.pm = pm; u.pn = pn; u.pb = e * nN + pn; u.aux0 = e * 65536 + t * 256; u.aux1 = left < 256 ? left : 256; return true;
    }
    __device__ __forceinline__ void a_ready(const Unit&) const {}
    __device__ __forceinline__ void done(const Unit&) const {}
};
template <class Epi, class Sched, bool ALIGN_EPI = false, bool SP2 = false, bool GATHER = false>
__device__ __forceinline__ void gemm_phase(PG8_LAS unsigned char* lds, const Gemm g, const Sched& S, const Epi& E, const int wid) {
    FRESH_LANE(lane); const int tid = wid * 64 + lane, wr = wid >> 2, wc = wid & 3, fr = lane & 15, fq = lane >> 4;
    const int K = g.K, nt = K / BK;
    unsigned voffA[2], voffB[2];
#pragma unroll
    for (int i = 0; i < 2; ++i) { int R, C; stage_rc(tid * 16 + i * 8192, R, C); const int Rb = 2 * (R & ~31) + (Epi::PERM ? perm32(R & 31) : (R & 31));
        voffA[i] = (unsigned)(R * g.lda + C) * 2u; voffB[i] = (unsigned)(Rb * g.ldb + C) * 2u; }
    const size_t kstep = (size_t)(BK * 2);
    const size_t hstepA = (size_t)HALF * g.lda * 2, hstep = (size_t)32 * g.ldb * 2;
    const size_t tstepA = 2 * hstepA, tstep = (size_t)BM * g.ldb * 2;
    const unsigned ldsw = (unsigned)wid * 1024u;
    const int aoff = lds_byte(wr * 64 + fr, fq * 8), boff = lds_byte(wc * 32 + fr, fq * 8);
#define PG8_SA(b, h) (((b) * 2 + (h)) * HTB)
#define PG8_SB(b, h) ((4 + (b) * 2 + (h)) * HTB)
#define PG8_STAGE(bufoff, gbase, voff) do { _Pragma("unroll") for (int _i = 0; _i < 2; ++_i) \
        __builtin_amdgcn_global_load_lds((const unsigned*)((const char*)(gbase) + (voff)[_i]), (PG8_LAS unsigned*)(lds + (bufoff) + ldsw + _i * 8192), 16, 0, 0); } while (0)
#define PG8_STAGE_A(bufoff, nextsel, half, kb) do { _Pragma("unroll") for (int _i = 0; _i < 2; ++_i) { const char* _p; \
        if constexpr (GATHER) _p = (const char*)g.A + (kb) + ((nextsel) ? nx[half][_i] : cu[half][_i]); else _p = ((nextsel) ? nA : cA) + (kb) + (size_t)(half) * hstepA + voffA[_i]; \
        __builtin_amdgcn_global_load_lds((const unsigned*)_p, (PG8_LAS unsigned*)(lds + (bufoff) + ldsw + _i * 8192), 16, 0, 0); } } while (0)
#define PG8_ROWS(u, o) do { _Pragma("unroll") for (int _h = 0; _h < 2; ++_h) _Pragma("unroll") for (int _i = 0; _i < 2; ++_i) { int _R, _C; stage_rc(tid * 16 + _i * 8192, _R, _C); const int _r = _h * HALF + _R; \
        const int _t = (_r < (u).aux1) ? (g.glist[2 * ((u).aux0 + _r)] >> 1) : 0; o[_h][_i] = ((unsigned)_t * (unsigned)g.lda + (unsigned)_C) * 2u; } } while (0)
#define PG8_LDA(dst, b, h) do { _Pragma("unroll") for (int m = 0; m < 4; ++m) _Pragma("unroll") for (int k = 0; k < 2; ++k) dst[m][k] = *(const PG8_LAS bf16x8*)(lds + PG8_SA(b, h) + aoff + m * 2048 + k * 1024); } while (0)
#define PG8_LDB(dst, b, h) do { _Pragma("unroll") for (int n = 0; n < 2; ++n) _Pragma("unroll") for (int k = 0; k < 2; ++k) dst[n][k] = *(const PG8_LAS bf16x8*)(lds + PG8_SB(b, h) + boff + n * 2048 + k * 1024); } while (0)
#define PG8_MMA(ai, bj, At, Bt) do { __builtin_amdgcn_s_setprio(1); _Pragma("unroll") for (int m = 0; m < 4; ++m) _Pragma("unroll") for (int n = 0; n < 2; ++n) _Pragma("unroll") for (int k = 0; k < 2; ++k) \
        acc[ai][bj][m][n] = __builtin_amdgcn_mfma_f32_16x16x32_bf16(Bt[n][k], At[m][k], acc[ai][bj][m][n], 0, 0, 0); __builtin_amdgcn_s_setprio(0); } while (0)
#define PG8_WAIT_V(n) asm volatile("s_waitcnt vmcnt(" #n ")" ::: "memory")
#define PG8_WAIT_VN(n) asm volatile("s_waitcnt vmcnt(%0)" :: "n"(n) : "memory")
#define PG8_WAIT_L(n) asm volatile("s_waitcnt lgkmcnt(" #n ")" ::: "memory")
#define PG8_BAR __builtin_amdgcn_s_barrier()
#define PG8_SCHED __builtin_amdgcn_sched_barrier(0)
    Unit cur, nxt; int ui = 0;
    if (!S.next(0, cur)) return;
    f32x4 acc[2][2][4][2];
#pragma unroll
    for (int a = 0; a < 2; ++a)
#pragma unroll
        for (int b = 0; b < 2; ++b)
#pragma unroll
            for (int m = 0; m < 4; ++m)
#pragma unroll
                for (int n = 0; n < 2; ++n) acc[a][b][m][n] = (f32x4){0.f, 0.f, 0.f, 0.f};
    bf16x8 At[4][2], B0[2][2], B1[2][2];
    const char* cA = (const char*)g.A + (size_t)cur.pm * tstepA; const char* cB = (const char*)g.Bt + (size_t)cur.pb * tstep;
    S.a_ready(cur);
    unsigned cu[2][2] = {{0u, 0u}, {0u, 0u}}, nx[2][2] = {{0u, 0u}, {0u, 0u}}; const char* nA = cA;
    if constexpr (GATHER) PG8_ROWS(cur, cu);
    if constexpr (SP2) {
        PG8_STAGE(PG8_SB(0, 0), cB, voffB); PG8_STAGE(PG8_SB(0, 1), cB + hstep, voffB); PG8_STAGE_A(PG8_SA(0, 0), false, 0, 0); PG8_STAGE_A(PG8_SA(0, 1), false, 1, 0);
        if (wr == 1) PG8_BAR;
        PG8_WAIT_V(2); PG8_BAR;
        PG8_STAGE(PG8_SB(1, 0), cB + kstep, voffB); PG8_STAGE_A(PG8_SA(1, 0), false, 0, kstep); PG8_STAGE(PG8_SB(1, 1), cB + hstep + kstep, voffB);
        PG8_WAIT_V(6); PG8_BAR;
    } else { static_assert(SP2, "only the SP2 loop is kept in this file"); }
    for (;;) {
        const bool has_next = S.next(ui + 1, nxt);
        nA = has_next ? (const char*)g.A + (size_t)nxt.pm * tstepA : cA;
        if constexpr (GATHER) { if (has_next) PG8_ROWS(nxt, nx); else { nx[0][0] = cu[0][0]; nx[0][1] = cu[0][1]; nx[1][0] = cu[1][0]; nx[1][1] = cu[1][1]; } }
        const char* nB = has_next ? (const char*)g.Bt + (size_t)nxt.pb * tstep : cB;
#pragma unroll 1
        for (int t = 0; t < nt; t += 2) {
            const bool last = (t == nt - 2);
            constexpr bool fresh = false;
            const size_t kb1 = (size_t)(t + 1) * kstep;
            const size_t kb2 = last ? 0 : (size_t)(t + 2) * kstep; const char* b2 = last ? nB : cB + (size_t)(t + 2) * kstep;
            const size_t kb3 = kb2 + kstep; const char* b3 = b2 + kstep;
            if (last && has_next) S.a_ready(nxt);
            if constexpr (SP2) {
            PG8_LDB(B0, 0, 0); PG8_LDB(B1, 0, 1); PG8_SCHED; PG8_LDA(At, 0, 0); if (!fresh) { PG8_STAGE_A(PG8_SA(1, 1), false, 1, kb1); PG8_WAIT_V(8); }
            PG8_WAIT_L(0); PG8_BAR; PG8_MMA(0, 0, At, B0); PG8_MMA(0, 1, At, B1); PG8_BAR; PG8_SCHED;
            PG8_LDA(At, 0, 1); PG8_STAGE(PG8_SB(0, 0), b2, voffB); PG8_STAGE(PG8_SB(0, 1), b2 + hstep, voffB); PG8_STAGE_A(PG8_SA(0, 0), last, 0, kb2);
            if (!fresh) PG8_WAIT_V(8);
            PG8_WAIT_L(0); PG8_BAR; PG8_MMA(1, 0, At, B0); PG8_MMA(1, 1, At, B1); PG8_BAR; PG8_SCHED;
            PG8_LDB(B0, 1, 0); PG8_LDB(B1, 1, 1); PG8_SCHED; PG8_LDA(At, 1, 0); PG8_STAGE_A(PG8_SA(0, 1), last, 1, kb2);
            if (fresh) { PG8_WAIT_VN(8 + Epi::NST); } else { PG8_WAIT_V(8); }
            PG8_WAIT_L(0); PG8_BAR; PG8_MMA(0, 0, At, B0); PG8_MMA(0, 1, At, B1); PG8_BAR; PG8_SCHED;
            PG8_LDA(At, 1, 1); PG8_STAGE(PG8_SB(1, 0), b3, voffB); PG8_STAGE(PG8_SB(1, 1), b3 + hstep, voffB); PG8_STAGE_A(PG8_SA(1, 0), last, 0, kb3);
            PG8_WAIT_V(8); PG8_WAIT_L(0); PG8_BAR; PG8_MMA(1, 0, At, B0); PG8_MMA(1, 1, At, B1); PG8_BAR; PG8_SCHED;
            }
        }
        if constexpr (ALIGN_EPI) { if (wr == 0) PG8_BAR; }
        if constexpr (!Epi::AFTER_DRAIN) { E(acc, cur, wr, wc, fr, fq); S.done(cur); }
        if (!has_next) break;
#pragma unroll
        for (int a = 0; a < 2; ++a)
#pragma unroll
            for (int b = 0; b < 2; ++b)
#pragma unroll
                for (int m = 0; m < 4; ++m)
#pragma unroll
                    for (int n = 0; n < 2; ++n) acc[a][b][m][n] = (f32x4){0.f, 0.f, 0.f, 0.f};
        cur = nxt; cA = nA; cB = nB; ++ui;
        if constexpr (GATHER) { cu[0][0] = nx[0][0]; cu[0][1] = nx[0][1]; cu[1][0] = nx[1][0]; cu[1][1] = nx[1][1]; }
        if constexpr (ALIGN_EPI) { if (wr == 1) PG8_BAR; }
    }
    PG8_WAIT_V(0);
    if constexpr (!ALIGN_EPI) { if (wr == 0) PG8_BAR; }
    PG8_BAR;
    if constexpr (Epi::AFTER_DRAIN) { E.fused(acc, cur, wr, wc, fr, fq, lds, wid, lane); S.done(cur); }
#undef PG8_SA
#undef PG8_SB
#undef PG8_STAGE
#undef PG8_STAGE_A
#undef PG8_ROWS
#undef PG8_LDA
#undef PG8_LDB
#undef PG8_MMA
#undef PG8_WAIT_V
#undef PG8_WAIT_VN
#undef PG8_WAIT_L
#undef PG8_BAR
#undef PG8_SCHED
}
}
namespace att {
using bf16 = unsigned short;
using bf16x8 = __attribute__((ext_vector_type(8))) short;
using s16x4  = __attribute__((ext_vector_type(4))) short;
using f32x16 = __attribute__((ext_vector_type(16))) float;
using u32x4  = __attribute__((ext_vector_type(4))) unsigned;
constexpr int LDQKV = 64, LDO = 2112;
constexpr int SEQ_ = 8192;
constexpr size_t OKTS = (size_t)32768 * 64;
constexpr size_t QPS = (size_t)32768 * LDQKV;
#define QCOL(c) ((size_t)((c) >> 6) * QPS + (size_t)((c) & 63))
constexpr size_t SHM_V = 64 * 128 * 2, SHM_K = 64 * 128 * 2, SHM_ATTN = 2 * SHM_V + 2 * SHM_K + 8 * 64 * 4 + 64;
#define KSWZ(row, colB) ((row) * 256 + ((colB) ^ (((row) & 7) << 4)))
#define SBAR() __builtin_amdgcn_sched_barrier(0)
__device__ __forceinline__ int crow(int r, int hi) { return (r & 3) + 8 * (r >> 2) + 4 * hi; }
__device__ __forceinline__ unsigned cvtpk(float lo, float hi) { unsigned r; asm volatile("v_cvt_pk_bf16_f32 %0, %1, %2" : "=v"(r) : "v"(lo), "v"(hi)); return r; }
__device__ __forceinline__ int v_st(int k, int c) { const int kk = (k & ~0xC) | ((k & 4) << 1) | ((k & 8) >> 1); return ((kk >> 3) * 4 + (c >> 5)) * 512 + ((kk & 7) * 32 + (c & 31)) * 2; }
__device__ __forceinline__ int v_rd_base(int lane) { return ((lane & 3) << 3) | (((lane >> 2) & 3) << 6) | (((lane >> 4) & 1) << 5) | (((lane >> 5) & 1) << 8); }
constexpr int v_rd_off(int d0, int ks, int half) { return d0 * 512 + ks * 4096 + half * 2048; }
template <int OFF> __device__ __forceinline__ s16x4 tr_read(int vb) { s16x4 r; asm volatile("ds_read_b64_tr_b16 %0, %1 offset:%2" : "=&v"(r) : "v"(vb), "i"(OFF) : "memory"); return r; }
template <int D0> __device__ __forceinline__ void pv_one(f32x16& od, int vb, bf16x8 pa0, bf16x8 pa1, bf16x8 pa2, bf16x8 pa3) {
  const s16x4 l0 = tr_read<v_rd_off(D0, 0, 0)>(vb), h0 = tr_read<v_rd_off(D0, 0, 1)>(vb), l1 = tr_read<v_rd_off(D0, 1, 0)>(vb), h1 = tr_read<v_rd_off(D0, 1, 1)>(vb);
  const s16x4 l2 = tr_read<v_rd_off(D0, 2, 0)>(vb), h2 = tr_read<v_rd_off(D0, 2, 1)>(vb), l3 = tr_read<v_rd_off(D0, 3, 0)>(vb), h3 = tr_read<v_rd_off(D0, 3, 1)>(vb);
  asm volatile("s_waitcnt lgkmcnt(0)" ::: "memory"); SBAR();
#define PK(L, H) (bf16x8){L[0], L[1], L[2], L[3], H[0], H[1], H[2], H[3]}
  od = __builtin_amdgcn_mfma_f32_32x32x16_bf16(pa0, PK(l0, h0), od, 0, 0, 0);
  od = __builtin_amdgcn_mfma_f32_32x32x16_bf16(pa1, PK(l1, h1), od, 0, 0, 0);
  od = __builtin_amdgcn_mfma_f32_32x32x16_bf16(pa2, PK(l2, h2), od, 0, 0, 0);
  od = __builtin_amdgcn_mfma_f32_32x32x16_bf16(pa3, PK(l3, h3), od, 0, 0, 0);
#undef PK
}
__device__ __forceinline__ void pv_d0(f32x16* o, int vb, bf16x8 pa0, bf16x8 pa1, bf16x8 pa2, bf16x8 pa3) {
  pv_one<0>(o[0], vb, pa0, pa1, pa2, pa3); pv_one<1>(o[1], vb, pa0, pa1, pa2, pa3); pv_one<2>(o[2], vb, pa0, pa1, pa2, pa3); pv_one<3>(o[3], vb, pa0, pa1, pa2, pa3);
}
__device__ __forceinline__ void pack_p(const f32x16& p0, const f32x16& p1, bf16x8& pa0, bf16x8& pa1, bf16x8& pa2, bf16x8& pa3) {
#define PK4(P, BASE, OUT) do { unsigned a0 = cvtpk(P[BASE + 0], P[BASE + 1]), a1 = cvtpk(P[BASE + 2], P[BASE + 3]);   \
    unsigned b0 = cvtpk(P[BASE + 4], P[BASE + 5]), b1 = cvtpk(P[BASE + 6], P[BASE + 7]);                              \
    auto r0 = __builtin_amdgcn_permlane32_swap(a0, b0, false, false); auto r1 = __builtin_amdgcn_permlane32_swap(a1, b1, false, false); \
    u32x4 w = {r0[0], r1[0], r0[1], r1[1]}; OUT = *reinterpret_cast<bf16x8*>(&w); } while (0)
  PK4(p0, 0, pa0); PK4(p0, 8, pa1); PK4(p1, 0, pa2); PK4(p1, 8, pa3);
#undef PK4
}
template <int ND> __device__ __forceinline__ void qkt(f32x16& p0, f32x16& p1, const char* Ks, const bf16x8* qr, int cb0, int r32, int hi) {
  p0 = f32x16{}; p1 = f32x16{};
#pragma unroll
  for (int d0 = 0; d0 < ND; ++d0) { const int cb = cb0 + (d0 * 16 + hi * 8) * 2;
    const bf16x8 b0 = *reinterpret_cast<const bf16x8*>(Ks + KSWZ(r32, cb));
    const bf16x8 b1 = *reinterpret_cast<const bf16x8*>(Ks + KSWZ(32 + r32, cb));
    p0 = __builtin_amdgcn_mfma_f32_32x32x16_bf16(b0, qr[d0], p0, 0, 0, 0);
    p1 = __builtin_amdgcn_mfma_f32_32x32x16_bf16(b1, qr[d0], p1, 0, 0, 0); }
}
constexpr float THRL = 11.5f;
__device__ __forceinline__ void partialSM(f32x16& p0, f32x16& p1, float& m_reg, float& mn, float& alpha) {
  float pmax = p0[0];
#pragma unroll
  for (int r = 1; r < 16; ++r) pmax = fmaxf(pmax, p0[r]);
#pragma unroll
  for (int r = 0; r < 16; ++r) pmax = fmaxf(pmax, p1[r]);
  { auto rr = __builtin_amdgcn_permlane32_swap(__float_as_uint(pmax), __float_as_uint(pmax), false, false); pmax = fmaxf(__uint_as_float(rr[0]), __uint_as_float(rr[1])); }
  if (__builtin_expect(__all(pmax - m_reg <= THRL), 1)) { mn = m_reg; alpha = 1.f; }
  else { mn = fmaxf(m_reg, pmax); alpha = __builtin_amdgcn_exp2f(m_reg - mn); m_reg = mn; }
#pragma unroll
  for (int r = 0; r < 16; ++r) p0[r] = p0[r] - mn;
#pragma unroll
  for (int r = 0; r < 16; ++r) p1[r] = p1[r] - mn;
#pragma unroll
  for (int r = 0; r < 16; ++r) p0[r] = __builtin_amdgcn_exp2f(p0[r]);
}
__device__ __forceinline__ void finishSM(f32x16& p0, f32x16& p1, float alpha, float& l_reg, bf16x8& pa0, bf16x8& pa1, bf16x8& pa2, bf16x8& pa3) {
#pragma unroll
  for (int r = 0; r < 16; ++r) p1[r] = __builtin_amdgcn_exp2f(p1[r]);
  float ps = 0;
#pragma unroll
  for (int r = 0; r < 16; ++r) ps += p0[r];
#pragma unroll
  for (int r = 0; r < 16; ++r) ps += p1[r];
  { auto rr = __builtin_amdgcn_permlane32_swap(__float_as_uint(ps), __float_as_uint(ps), false, false); ps = __uint_as_float(rr[0]) + __uint_as_float(rr[1]); }
  l_reg = l_reg * alpha + ps;
  pack_p(p0, p1, pa0, pa1, pa2, pa3);
}
__device__ __forceinline__ float half_sum32(float v) { return half_sum32_(v); }


__device__ __forceinline__ void store_o_tile(const f32x16 (&o)[4], bf16* Ow  , char* wl  , int lane_e) {
  const int r32e = lane_e & 31, hie = lane_e >> 5;
  float* wf = (float*)wl;
#pragma unroll
  for (int r = 0; r < 16; ++r) { const int orow = crow(r, hie);
#pragma unroll
    for (int d0 = 0; d0 < 4; ++d0) wf[orow * 128 + d0 * 32 + r32e] = o[d0][r]; }
  asm volatile("s_waitcnt lgkmcnt(0)" ::: "memory");
#pragma unroll
  for (int i = 0; i < 8; ++i) { const int row = 4 * i + (lane_e >> 4), ch = lane_e & 15;
    const float* src = wf + row * 128 + ch * 8;
    const float a0 = src[0], a1 = src[1], a2 = src[2], a3 = src[3], a4 = src[4], a5 = src[5], a6 = src[6], a7 = src[7];
    u32x4 w; w.x = cvtpk(a0, a1); w.y = cvtpk(a2, a3); w.z = cvtpk(a4, a5); w.w = cvtpk(a6, a7);
    *(u32x4*)(Ow + (size_t)row * LDO + ch * 8) = w; }
  asm volatile("s_waitcnt lgkmcnt(0)" ::: "memory");
}

__device__ __forceinline__ void diff_unit(int b, int h, int qb, const bf16* __restrict__ QKV, bf16* __restrict__ Oout, const float* __restrict__ gdiff, float lam, float oscale, char* lds) {
  const int tid = threadIdx.x, lane = tid & 63, r32 = lane & 31, hi = lane >> 5; const int wid = __builtin_amdgcn_readfirstlane(tid >> 6);
  const int map = wid >> 2, wq = wid & 3;
  bf16* V_lds = (bf16*)lds; bf16* K_lds = (bf16*)(lds + 2 * SHM_V);
  float* ws = (float*)(lds + 2 * SHM_V + 2 * SHM_K) + wid * 64; float* li_l = ws; float* al_l = ws + 32;
  float m_reg = -1e30f, l_reg = 0; f32x16 o[4] = {}; bf16x8 qr[4];
  const size_t rowb = (size_t)b * SEQ_;
  const bf16* Qw = QKV + (rowb + qb * 128 + wq * 32 + r32) * LDQKV + QCOL(3072 + h * 128) + map * 64 + hi * 8;
#pragma unroll
  for (int d0 = 0; d0 < 4; ++d0) qr[d0] = *reinterpret_cast<const bf16x8*>(Qw + d0 * 16);
  const bf16* Kh = QKV + rowb * LDQKV + QCOL(4096 + h * 128); const bf16* Vh = QKV + rowb * LDQKV + QCOL(5120 + h * 128);
  const int sr = tid >> 4, sc = (tid & 15) * 8, vst0 = v_st(sr, sc), vst1 = v_st(32 + sr, sc);
  const int vb0 = (int)(uintptr_t)V_lds + v_rd_base(lane);
  const int cbm = map * 128;
  struct { bf16x8 vs0, vs1, ks0, ks1; } sr_[1];
  const unsigned toff0 = (unsigned)(sr * LDQKV + sc), toff1 = toff0 + 32u * LDQKV;
#define SLOAD(i, k0) do { const bf16* vt_ = Vh + (size_t)(k0) * LDQKV; const bf16* kt_ = Kh + (size_t)(k0) * LDQKV; \
    sr_[i].vs0 = *reinterpret_cast<const bf16x8*>(vt_ + toff0); sr_[i].vs1 = *reinterpret_cast<const bf16x8*>(vt_ + toff1); \
    sr_[i].ks0 = *reinterpret_cast<const bf16x8*>(kt_ + toff0); sr_[i].ks1 = *reinterpret_cast<const bf16x8*>(kt_ + toff1); } while (0)
#define SWRITE(bb, i) do { *(bf16x8*)((char*)V_lds + (bb) * SHM_V + vst0) = sr_[i].vs0; *(bf16x8*)((char*)V_lds + (bb) * SHM_V + vst1) = sr_[i].vs1; const int kc = sc * 2; \
    *(bf16x8*)((char*)K_lds + (bb) * SHM_K + KSWZ(sr, kc)) = sr_[i].ks0; *(bf16x8*)((char*)K_lds + (bb) * SHM_K + KSWZ(32 + sr, kc)) = sr_[i].ks1; } while (0)
#define SWAIT() asm volatile("s_waitcnt vmcnt(0)" ::: "memory")
#define RESC(a) do { if (__any((a) < 1.f)) { if (hi == 0) al_l[r32] = (a); asm volatile("s_waitcnt lgkmcnt(0)" ::: "memory"); \
    _Pragma("unroll") for (int d = 0; d < 4; ++d) _Pragma("unroll") for (int r = 0; r < 16; ++r) o[d][r] *= al_l[crow(r, hi)]; } } while (0)
  f32x16 pA0, pA1, pB0, pB1; float mnA, mnB, alA, alB; bf16x8 pa0, pa1, pa2, pa3; const int NT = 2 * qb + 2;
  __syncthreads();
  SLOAD(0, 0); asm volatile("s_waitcnt vmcnt(0)" ::: "memory"); SWRITE(0, 0); __syncthreads();
  qkt<4>(pA0, pA1, (const char*)K_lds, qr, cbm, r32, hi); partialSM(pA0, pA1, m_reg, mnA, alA);
  SLOAD(0, 64);
  SWAIT(); SWRITE(1, 0); __syncthreads();
  for (int j = 1; j + 1 < NT; j += 2) {
    SBAR(); qkt<4>(pB0, pB1, (const char*)K_lds + SHM_K, qr, cbm, r32, hi);
    finishSM(pA0, pA1, alA, l_reg, pa0, pa1, pa2, pa3); SBAR();
    SLOAD(0, (j + 1) * 64); SBAR();
    pv_d0(o, vb0, pa0, pa1, pa2, pa3); partialSM(pB0, pB1, m_reg, mnB, alB);
    __syncthreads(); SWAIT(); SWRITE(0, 0);
    RESC(alB); __syncthreads();
    SBAR(); qkt<4>(pA0, pA1, (const char*)K_lds, qr, cbm, r32, hi);
    finishSM(pB0, pB1, alB, l_reg, pa0, pa1, pa2, pa3); SBAR();
    SLOAD(0, (j + 2) * 64); SBAR();
    pv_d0(o, vb0 + (int)SHM_V, pa0, pa1, pa2, pa3); partialSM(pA0, pA1, m_reg, mnA, alA);
    __syncthreads(); SWAIT(); SWRITE(1, 0);
    RESC(alA); __syncthreads();
  }
  SBAR(); qkt<4>(pB0, pB1, (const char*)K_lds + SHM_K, qr, cbm, r32, hi);
  if (wq < 2) {
#pragma unroll
    for (int r = 0; r < 16; ++r) { pB0[r] = -1e30f; pB1[r] = -1e30f; } }
  finishSM(pA0, pA1, alA, l_reg, pa0, pa1, pa2, pa3); SBAR();
  pv_d0(o, vb0, pa0, pa1, pa2, pa3); partialSM(pB0, pB1, m_reg, mnB, alB);
  __syncthreads(); RESC(alB);
  finishSM(pB0, pB1, alB, l_reg, pa0, pa1, pa2, pa3); SBAR();
  pv_d0(o, vb0 + (int)SHM_V, pa0, pa1, pa2, pa3);
  if (hi == 0) li_l[r32] = l_reg; asm volatile("s_waitcnt lgkmcnt(0)" ::: "memory");
  float rli[16];
#pragma unroll
  for (int r = 0; r < 16; ++r) rli[r] = __builtin_amdgcn_rcpf(li_l[crow(r, hi)]);
  __syncthreads();
  float* xch = (float*)lds + (size_t)wq * 4096;
  if (map == 1) {
#pragma unroll
    for (int d0 = 0; d0 < 4; ++d0)
#pragma unroll
      for (int r = 0; r < 16; ++r) xch[(d0 * 16 + r) * 64 + lane] = o[d0][r] * rli[r] * lam;
  }
  __syncthreads();
  if (map == 0) {
    float ss[16];
#pragma unroll
    for (int r = 0; r < 16; ++r) { float s = 0.f;
#pragma unroll
      for (int d0 = 0; d0 < 4; ++d0) { const float v = o[d0][r] * rli[r] - xch[(d0 * 16 + r) * 64 + lane]; o[d0][r] = v; s += v * v; }
      ss[r] = s; }
#pragma unroll
    for (int r = 0; r < 16; ++r) ss[r] = half_sum32(ss[r]);
    bf16* Ow = Oout + (rowb + qb * 128 + wq * 32) * LDO + 1024 + h * 128;
    float gv[4];
#pragma unroll
    for (int d0 = 0; d0 < 4; ++d0) gv[d0] = gdiff[d0 * 32 + r32] * oscale;
#pragma unroll
    for (int r = 0; r < 16; ++r) { const int orow = crow(r, hi); const float rs = rsqrtf(ss[r] * (1.f / 128.f) + 1e-6f);
#pragma unroll
      for (int d0 = 0; d0 < 4; ++d0) { const float y = o[d0][r] * rs * gv[d0]; const unsigned w = cvtpk(y, y); Ow[(size_t)orow * LDO + d0 * 32 + r32] = (bf16)(w & 0xffffu); } }
  }
#undef SLOAD
#undef SWRITE
#undef SWAIT
#undef RESC
}
__device__ __forceinline__ void sb_wave_unit(int b, int h, int wq, const bf16* __restrict__ QKV, bf16* __restrict__ Oout, const float* __restrict__ gsb, char* ldsw, int maxt = 1 << 30) {
  FRESH_LANE(lane);
  const int r32 = lane & 31, hi = lane >> 5;
  char* V_lds = ldsw; char* K_lds = ldsw + 8192;
  f32x16 o[4] = {}; bf16x8 qr[8];
  const size_t rowb = (size_t)b * SEQ_;
  const int Q0 = wq * 32, tq = Q0 + r32;
  const bf16* Qw = QKV + (rowb + tq) * LDQKV + QCOL(h * 128) + hi * 8;
#pragma unroll
  for (int d0 = 0; d0 < 8; ++d0) qr[d0] = *reinterpret_cast<const bf16x8*>(Qw + (size_t)(d0 >> 2) * QPS + (d0 & 3) * 16);
  const bf16* Kh = QKV + rowb * LDQKV + QCOL(1024 + h * 128); const bf16* Vh = QKV + rowb * LDQKV + QCOL(2048 + h * 128);
  const int skey = lane >> 4, scol = (lane & 15) * 8;
  const size_t toff = (size_t)(scol >> 6) * QPS + (size_t)(skey * LDQKV + (scol & 63));
  const int lc0 = (lane & 15) ^ skey, lc1 = (lane & 15) ^ (4 + skey);
  const size_t koff0 = (size_t)(lc0 >> 3) * QPS + (size_t)(skey * LDQKV + (lc0 & 7) * 8), koff1 = (size_t)(lc1 >> 3) * QPS + (size_t)(skey * LDQKV + (lc1 & 7) * 8);
  typedef __attribute__((address_space(3))) unsigned lds_u32;
  lds_u32* kl = (lds_u32*)(K_lds);
  const int vb0 = (int)(uintptr_t)V_lds + v_rd_base(lane);
  bf16x8 vs[8];
#define SB_LOADV(j) do { const bf16* vt_ = Vh + (size_t)(j) * 32 * LDQKV; \
    _Pragma("unroll") for (int i_ = 0; i_ < 8; ++i_) vs[i_] = *reinterpret_cast<const bf16x8*>(vt_ + toff + (unsigned)(4 * i_) * LDQKV); } while (0)
#define SB_DMAK(j) do { const bf16* kt_ = Kh + (size_t)(j) * 32 * LDQKV; \
    _Pragma("unroll") for (int p_ = 0; p_ < 8; ++p_) __builtin_amdgcn_global_load_lds((const unsigned*)(kt_ + (unsigned)(4 * p_) * LDQKV + ((p_ & 1) ? koff1 : koff0)), kl + p_ * 256, 16, 0, 0); } while (0)
  float carry = 0.f;
  SB_DMAK(wq); SB_LOADV(wq);
  for (int j = wq; j >= 0; --j) {
    asm volatile("s_waitcnt vmcnt(0)" ::: "memory");
#pragma unroll
    for (int i = 0; i < 8; ++i) { const int key = 4 * i + skey; *(bf16x8*)(V_lds + v_st(key, scol)) = vs[i]; }
    asm volatile("s_waitcnt lgkmcnt(0)" ::: "memory");
    if (j > 0) SB_LOADV(j - 1);
    f32x16 p0 = f32x16{};
#pragma unroll
    for (int d0 = 0; d0 < 8; ++d0) { const int cb = (d0 * 16 + hi * 8) * 2;
      const bf16x8 b0 = *reinterpret_cast<const bf16x8*>(K_lds + KSWZ(r32, cb));
      p0 = __builtin_amdgcn_mfma_f32_32x32x16_bf16(b0, qr[d0], p0, 0, 0, 0); }
    asm volatile("s_waitcnt lgkmcnt(0)" ::: "memory");
    if (j > 0) SB_DMAK(j - 1);
    const bool diag = (j == wq);
    const int kb = j * 32 + 4 * hi;
    f32x16 q0;
#pragma unroll
    for (int r = 0; r < 16; ++r) {
      const float z0 = __builtin_amdgcn_fmed3f(p0[r], -120.f, 120.f);
      float a0 = -__builtin_amdgcn_logf(1.f + __builtin_amdgcn_exp2f(z0));
      float b0 = z0 + a0;
      if (diag) { const int kv = kb + (r & 3) + 8 * (r >> 2); if (kv >= tq) { a0 = 0.f; b0 = -1e30f; } }
      q0[r] = a0; p0[r] = b0; }
    float G[4], PG[4], SUF[4];
#pragma unroll
    for (int g = 0; g < 4; ++g) G[g] = (q0[4 * g] + q0[4 * g + 1]) + (q0[4 * g + 2] + q0[4 * g + 3]);
    float CS[4];
#pragma unroll
    for (int g = 0; g < 4; ++g) { auto rr = __builtin_amdgcn_permlane32_swap(__float_as_uint(G[g]), __float_as_uint(G[g]), false, false);
      CS[g] = __uint_as_float(rr[0]) + __uint_as_float(rr[1]); PG[g] = __uint_as_float(rr[1]); }
    float run = carry;
#pragma unroll
    for (int g = 3; g >= 0; --g) { SUF[g] = run; run += CS[g]; }
    carry = run;
#pragma unroll
    for (int g = 0; g < 4; ++g) SUF[g] += (hi == 0) ? PG[g] : 0.f;
#pragma unroll
    for (int g = 0; g < 4; ++g) {
      float s = SUF[g];
      p0[4 * g + 3] = __builtin_amdgcn_exp2f(p0[4 * g + 3] + s); s += q0[4 * g + 3];
      p0[4 * g + 2] = __builtin_amdgcn_exp2f(p0[4 * g + 2] + s); s += q0[4 * g + 2];
      p0[4 * g + 1] = __builtin_amdgcn_exp2f(p0[4 * g + 1] + s); s += q0[4 * g + 1];
      p0[4 * g + 0] = __builtin_amdgcn_exp2f(p0[4 * g + 0] + s);
    }
    bf16x8 pa0, pa1;
#define PK4(P, BASE, OUT) do { unsigned a0 = cvtpk(P[BASE + 0], P[BASE + 1]), a1 = cvtpk(P[BASE + 2], P[BASE + 3]);   \
    unsigned b0 = cvtpk(P[BASE + 4], P[BASE + 5]), b1 = cvtpk(P[BASE + 6], P[BASE + 7]);                              \
    auto r0 = __builtin_amdgcn_permlane32_swap(a0, b0, false, false); auto r1 = __builtin_amdgcn_permlane32_swap(a1, b1, false, false); \
    u32x4 w = {r0[0], r1[0], r0[1], r1[1]}; OUT = *reinterpret_cast<bf16x8*>(&w); } while (0)
    PK4(p0, 0, pa0); PK4(p0, 8, pa1);
#undef PK4
#define SB_PV(D0) do { const s16x4 l0 = tr_read<v_rd_off(D0, 0, 0)>(vb0), h0 = tr_read<v_rd_off(D0, 0, 1)>(vb0), l1 = tr_read<v_rd_off(D0, 1, 0)>(vb0), h1 = tr_read<v_rd_off(D0, 1, 1)>(vb0); \
    asm volatile("s_waitcnt lgkmcnt(0)" ::: "memory"); SBAR(); \
    o[D0] = __builtin_amdgcn_mfma_f32_32x32x16_bf16(pa0, (bf16x8){l0[0], l0[1], l0[2], l0[3], h0[0], h0[1], h0[2], h0[3]}, o[D0], 0, 0, 0); \
    o[D0] = __builtin_amdgcn_mfma_f32_32x32x16_bf16(pa1, (bf16x8){l1[0], l1[1], l1[2], l1[3], h1[0], h1[1], h1[2], h1[3]}, o[D0], 0, 0, 0); } while (0)
    SB_PV(0); SB_PV(1); SB_PV(2); SB_PV(3);
#undef SB_PV
    if (__all(carry < -160.f)) break;
    if (wq - j + 1 >= maxt) break;
  }
#undef SB_LOADV
#undef SB_DMAK
  asm volatile("s_waitcnt vmcnt(0)" ::: "memory");
  { FRESH_LANE(le_); const int r32e = le_ & 31; float gv[4];
#pragma unroll
    for (int d0 = 0; d0 < 4; ++d0) gv[d0] = gsb[d0 * 32 + r32e];
#pragma unroll
    for (int r = 0; r < 16; ++r) { float s = 0.f;
#pragma unroll
      for (int d0 = 0; d0 < 4; ++d0) s += o[d0][r] * o[d0][r];
      const float rs = rsqrtf(half_sum32(s) * (1.f / 128.f) + 1e-6f);
#pragma unroll
      for (int d0 = 0; d0 < 4; ++d0) o[d0][r] = o[d0][r] * rs * gv[d0]; }
    store_o_tile(o, Oout + (rowb + Q0) * LDO + h * 128, ldsw, le_);
  }
  asm volatile("s_waitcnt vmcnt(0)" ::: "memory");
}
__device__ __forceinline__ void sb_wave_seq(int uid0, int stride, int nunits, const bf16* __restrict__ QKV, bf16* __restrict__ Oout, const float* __restrict__ gsb, char* ldsw) {
  if (uid0 >= nunits) return;
  FRESH_LANE(lane);
  const int r32 = lane & 31, hi = lane >> 5;
  char* V_lds = ldsw; char* K_lds = ldsw + 8192;
  const int skey = lane >> 4, scol = (lane & 15) * 8;
  const size_t toff = (size_t)(scol >> 6) * QPS + (size_t)(skey * LDQKV + (scol & 63));
  const int lc0 = (lane & 15) ^ skey, lc1 = (lane & 15) ^ (4 + skey);
  const size_t koff0 = (size_t)(lc0 >> 3) * QPS + (size_t)(skey * LDQKV + (lc0 & 7) * 8), koff1 = (size_t)(lc1 >> 3) * QPS + (size_t)(skey * LDQKV + (lc1 & 7) * 8);
  typedef __attribute__((address_space(3))) unsigned lds_u32;
  lds_u32* kl = (lds_u32*)(K_lds);
  const int vb0 = (int)(uintptr_t)V_lds + v_rd_base(lane);
  bf16x8 vs[8], qr[8];
#define SQ_LOADV(Vh_, j) do { const bf16* vt_ = (Vh_) + (size_t)(j) * 32 * LDQKV; \
    _Pragma("unroll") for (int i_ = 0; i_ < 8; ++i_) vs[i_] = *reinterpret_cast<const bf16x8*>(vt_ + toff + (unsigned)(4 * i_) * LDQKV); } while (0)
#define SQ_DMAK(Kh_, j) do { const bf16* kt_ = (Kh_) + (size_t)(j) * 32 * LDQKV; \
    _Pragma("unroll") for (int p_ = 0; p_ < 8; ++p_) __builtin_amdgcn_global_load_lds((const unsigned*)(kt_ + (unsigned)(4 * p_) * LDQKV + ((p_ & 1) ? koff1 : koff0)), kl + p_ * 256, 16, 0, 0); } while (0)
#define SQ_LOADQ(dst, b_, h_, wq_) do { const bf16* Qw_ = QKV + ((size_t)(b_) * SEQ_ + (wq_) * 32 + r32) * LDQKV + QCOL((h_) * 128) + hi * 8; \
    _Pragma("unroll") for (int d0 = 0; d0 < 8; ++d0) dst[d0] = *reinterpret_cast<const bf16x8*>(Qw_ + (size_t)(d0 >> 2) * QPS + (d0 & 3) * 16); } while (0)
  int uid = uid0, b = uid >> 11, h = (uid >> 8) & 7, wq = uid & 255;
  const bf16* Kh = QKV + (size_t)b * SEQ_ * LDQKV + QCOL(1024 + h * 128); const bf16* Vh = QKV + (size_t)b * SEQ_ * LDQKV + QCOL(2048 + h * 128);
  SQ_LOADQ(qr, b, h, wq); SQ_DMAK(Kh, wq); SQ_LOADV(Vh, wq);
#pragma unroll 1
  for (;;) {
    const size_t rowb = (size_t)b * SEQ_; const int Q0 = wq * 32, tq = Q0 + r32;
    f32x16 o[4] = {};
    float carry = 0.f;
    for (int j = wq; j >= 0; --j) {
      if (j == wq && uid != uid0) asm volatile("s_waitcnt vmcnt(8)" ::: "memory");
      else asm volatile("s_waitcnt vmcnt(0)" ::: "memory");
#pragma unroll
      for (int i = 0; i < 8; ++i) { const int key = 4 * i + skey; *(bf16x8*)(V_lds + v_st(key, scol)) = vs[i]; }
      asm volatile("s_waitcnt lgkmcnt(0)" ::: "memory");
      if (j > 0) SQ_LOADV(Vh, j - 1);
      f32x16 p0 = f32x16{};
#pragma unroll
      for (int d0 = 0; d0 < 8; ++d0) { const int cb = (d0 * 16 + hi * 8) * 2;
        const bf16x8 b0 = *reinterpret_cast<const bf16x8*>(K_lds + KSWZ(r32, cb));
        p0 = __builtin_amdgcn_mfma_f32_32x32x16_bf16(b0, qr[d0], p0, 0, 0, 0); }
      asm volatile("s_waitcnt lgkmcnt(0)" ::: "memory");
      if (j > 0) SQ_DMAK(Kh, j - 1);
      const bool diag = (j == wq);
      const int kb = j * 32 + 4 * hi;
      f32x16 q0;
#pragma unroll
      for (int r = 0; r < 16; ++r) {
        const float z0 = __builtin_amdgcn_fmed3f(p0[r], -120.f, 120.f);
        float a0 = -__builtin_amdgcn_logf(1.f + __builtin_amdgcn_exp2f(z0));
        float b0 = z0 + a0;
        if (diag) { const int kv = kb + (r & 3) + 8 * (r >> 2); if (kv >= tq) { a0 = 0.f; b0 = -1e30f; } }
        q0[r] = a0; p0[r] = b0; }
      float G[4], PG[4], SUF[4];
#pragma unroll
      for (int g = 0; g < 4; ++g) G[g] = (q0[4 * g] + q0[4 * g + 1]) + (q0[4 * g + 2] + q0[4 * g + 3]);
      float CS[4];
#pragma unroll
      for (int g = 0; g < 4; ++g) { auto rr = __builtin_amdgcn_permlane32_swap(__float_as_uint(G[g]), __float_as_uint(G[g]), false, false);
        CS[g] = __uint_as_float(rr[0]) + __uint_as_float(rr[1]); PG[g] = __uint_as_float(rr[1]); }
      float run = carry;
#pragma unroll
      for (int g = 3; g >= 0; --g) { SUF[g] = run; run += CS[g]; }
      carry = run;
#pragma unroll
      for (int g = 0; g < 4; ++g) SUF[g] += (hi == 0) ? PG[g] : 0.f;
#pragma unroll
      for (int g = 0; g < 4; ++g) {
        float s_ = SUF[g];
        p0[4 * g + 3] = __builtin_amdgcn_exp2f(p0[4 * g + 3] + s_); s_ += q0[4 * g + 3];
        p0[4 * g + 2] = __builtin_amdgcn_exp2f(p0[4 * g + 2] + s_); s_ += q0[4 * g + 2];
        p0[4 * g + 1] = __builtin_amdgcn_exp2f(p0[4 * g + 1] + s_); s_ += q0[4 * g + 1];
        p0[4 * g + 0] = __builtin_amdgcn_exp2f(p0[4 * g + 0] + s_);
      }
      bf16x8 pa0, pa1;
#define PK4(P, BASE, OUT) do { unsigned a0 = cvtpk(P[BASE + 0], P[BASE + 1]), a1 = cvtpk(P[BASE + 2], P[BASE + 3]);   \
      unsigned b0 = cvtpk(P[BASE + 4], P[BASE + 5]), b1 = cvtpk(P[BASE + 6], P[BASE + 7]);                              \
      auto r0 = __builtin_amdgcn_permlane32_swap(a0, b0, false, false); auto r1 = __builtin_amdgcn_permlane32_swap(a1, b1, false, false); \
      u32x4 w = {r0[0], r1[0], r0[1], r1[1]}; OUT = *reinterpret_cast<bf16x8*>(&w); } while (0)
      PK4(p0, 0, pa0); PK4(p0, 8, pa1);
#undef PK4
#define SQ_PV(D0) do { const s16x4 l0 = tr_read<v_rd_off(D0, 0, 0)>(vb0), h0 = tr_read<v_rd_off(D0, 0, 1)>(vb0), l1 = tr_read<v_rd_off(D0, 1, 0)>(vb0), h1 = tr_read<v_rd_off(D0, 1, 1)>(vb0); \
      asm volatile("s_waitcnt lgkmcnt(0)" ::: "memory"); SBAR(); \
      o[D0] = __builtin_amdgcn_mfma_f32_32x32x16_bf16(pa0, (bf16x8){l0[0], l0[1], l0[2], l0[3], h0[0], h0[1], h0[2], h0[3]}, o[D0], 0, 0, 0); \
      o[D0] = __builtin_amdgcn_mfma_f32_32x32x16_bf16(pa1, (bf16x8){l1[0], l1[1], l1[2], l1[3], h1[0], h1[1], h1[2], h1[3]}, o[D0], 0, 0, 0); } while (0)
      SQ_PV(0); SQ_PV(1); SQ_PV(2); SQ_PV(3);
#undef SQ_PV
      if (__all(carry < -160.f)) break;
    }
    asm volatile("s_waitcnt vmcnt(0)" ::: "memory");
    const int nuid = uid + stride; const bool has_next = nuid < nunits;
    const int nb = nuid >> 11, nh = (nuid >> 8) & 7, nwq = nuid & 255;
    const bf16* Khn = QKV + (size_t)nb * SEQ_ * LDQKV + QCOL(1024 + nh * 128); const bf16* Vhn = QKV + (size_t)nb * SEQ_ * LDQKV + QCOL(2048 + nh * 128);
    bf16x8 qn[8];
    if (has_next) { SQ_LOADQ(qn, nb, nh, nwq); SQ_DMAK(Khn, nwq); SQ_LOADV(Vhn, nwq); }
    else {
#pragma unroll
      for (int d0 = 0; d0 < 8; ++d0) qn[d0] = bf16x8{}; }
    { FRESH_LANE(le_); const int r32e = le_ & 31, hie = le_ >> 5; float gv[4];
#pragma unroll
      for (int d0 = 0; d0 < 4; ++d0) gv[d0] = gsb[d0 * 32 + r32e];
#pragma unroll
      for (int r = 0; r < 16; ++r) { float s_ = 0.f;
#pragma unroll
        for (int d0 = 0; d0 < 4; ++d0) s_ += o[d0][r] * o[d0][r];
        const float rs = rsqrtf(half_sum32(s_) * (1.f / 128.f) + 1e-6f);
#pragma unroll
        for (int d0 = 0; d0 < 4; ++d0) o[d0][r] = o[d0][r] * rs * gv[d0]; }
      bf16* Ow = Oout + (rowb + Q0) * LDO + h * 128; float* wf = (float*)V_lds;
#pragma unroll
      for (int ps = 0; ps < 2; ++ps) {
#pragma unroll
        for (int r = 8 * ps; r < 8 * ps + 8; ++r) { const int orow = crow(r, hie) - 16 * ps;
#pragma unroll
          for (int d0 = 0; d0 < 4; ++d0) wf[orow * 128 + d0 * 32 + r32e] = o[d0][r]; }
        asm volatile("s_waitcnt lgkmcnt(0)" ::: "memory");
#pragma unroll
        for (int i = 0; i < 4; ++i) { const int row = 4 * i + (le_ >> 4), ch = le_ & 15;
          const float* src = wf + row * 128 + ch * 8;
          const float a0 = src[0], a1 = src[1], a2 = src[2], a3 = src[3], a4 = src[4], a5 = src[5], a6 = src[6], a7 = src[7];
          u32x4 w; w.x = cvtpk(a0, a1); w.y = cvtpk(a2, a3); w.z = cvtpk(a4, a5); w.w = cvtpk(a6, a7);
          *(u32x4*)(Ow + (size_t)(16 * ps + row) * LDO + ch * 8) = w; }
        asm volatile("s_waitcnt lgkmcnt(0)" ::: "memory"); }
    }
    if (!has_next) break;
    uid = nuid; b = nb; h = nh; wq = nwq; Kh = Khn; Vh = Vhn;
#pragma unroll
    for (int d0 = 0; d0 < 8; ++d0) qr[d0] = qn[d0];
  }
  asm volatile("s_waitcnt vmcnt(0)" ::: "memory");
#undef SQ_LOADV
#undef SQ_DMAK
#undef SQ_LOADQ
}
__device__ __forceinline__ void sb_wave_queue(unsigned* qc, int xq, int nq, const bf16* __restrict__ QKV, bf16* __restrict__ Oout, const float* __restrict__ gsb, char* ldsw) {
  FRESH_LANE(lane);
  int cq = xq;
#define SQ_DRAW(dst) do { dst = 0u; if (lane == 0) dst = __hip_atomic_fetch_add(qc + 64 * cq, 1u, __ATOMIC_RELAXED, __HIP_MEMORY_SCOPE_AGENT); } while (0)
  unsigned pend; SQ_DRAW(pend);
  int q = (int)__builtin_amdgcn_readfirstlane(pend), qq = cq;
  for (int tr_ = 0; q >= nq && tr_ < 7; ++tr_) { cq = (cq + 1) & 7; unsigned t_; SQ_DRAW(t_); q = (int)__builtin_amdgcn_readfirstlane(t_); qq = cq; }
  if (q >= nq) return;
  int pq = cq; SQ_DRAW(pend);
  bool first = true;
  const int r32 = lane & 31, hi = lane >> 5;
  char* V_lds = ldsw; char* K_lds = ldsw + 8192;
  const int skey = lane >> 4, scol = (lane & 15) * 8;
  const size_t toff = (size_t)(scol >> 6) * QPS + (size_t)(skey * LDQKV + (scol & 63));
  const int lc0 = (lane & 15) ^ skey, lc1 = (lane & 15) ^ (4 + skey);
  const size_t koff0 = (size_t)(lc0 >> 3) * QPS + (size_t)(skey * LDQKV + (lc0 & 7) * 8), koff1 = (size_t)(lc1 >> 3) * QPS + (size_t)(skey * LDQKV + (lc1 & 7) * 8);
  typedef __attribute__((address_space(3))) unsigned lds_u32;
  lds_u32* kl = (lds_u32*)(K_lds);
  const int vb0 = (int)(uintptr_t)V_lds + v_rd_base(lane);
  bf16x8 vs[8], qr[8];
#define SQ_LOADV(Vh_, j) do { const bf16* vt_ = (Vh_) + (size_t)(j) * 32 * LDQKV; \
    _Pragma("unroll") for (int i_ = 0; i_ < 8; ++i_) vs[i_] = *reinterpret_cast<const bf16x8*>(vt_ + toff + (unsigned)(4 * i_) * LDQKV); } while (0)
#define SQ_DMAK(Kh_, j) do { const bf16* kt_ = (Kh_) + (size_t)(j) * 32 * LDQKV; \
    _Pragma("unroll") for (int p_ = 0; p_ < 8; ++p_) __builtin_amdgcn_global_load_lds((const unsigned*)(kt_ + (unsigned)(4 * p_) * LDQKV + ((p_ & 1) ? koff1 : koff0)), kl + p_ * 256, 16, 0, 0); } while (0)
#define SQ_LOADQ(dst, b_, h_, wq_) do { const bf16* Qw_ = QKV + ((size_t)(b_) * SEQ_ + (wq_) * 32 + r32) * LDQKV + QCOL((h_) * 128) + hi * 8; \
    _Pragma("unroll") for (int d0 = 0; d0 < 8; ++d0) dst[d0] = *reinterpret_cast<const bf16x8*>(Qw_ + (size_t)(d0 >> 2) * QPS + (d0 & 3) * 16); } while (0)
  int b = (qq + 8 * (q >> 8)) >> 3, h = (qq + 8 * (q >> 8)) & 7, wq = 255 - (q & 255);
  const bf16* Kh = QKV + (size_t)b * SEQ_ * LDQKV + QCOL(1024 + h * 128); const bf16* Vh = QKV + (size_t)b * SEQ_ * LDQKV + QCOL(2048 + h * 128);
  SQ_LOADQ(qr, b, h, wq); SQ_DMAK(Kh, wq); SQ_LOADV(Vh, wq);
#pragma unroll 1
  for (;;) {
    const size_t rowb = (size_t)b * SEQ_; const int Q0 = wq * 32, tq = Q0 + r32;
    f32x16 o[4] = {};
    float carry = 0.f;
    for (int j = wq; j >= 0; --j) {
      if (j == wq && !first) asm volatile("s_waitcnt vmcnt(8)" ::: "memory");
      else asm volatile("s_waitcnt vmcnt(0)" ::: "memory");
#pragma unroll
      for (int i = 0; i < 8; ++i) { const int key = 4 * i + skey; *(bf16x8*)(V_lds + v_st(key, scol)) = vs[i]; }
      asm volatile("s_waitcnt lgkmcnt(0)" ::: "memory");
      if (j > 0) SQ_LOADV(Vh, j - 1);
      f32x16 p0 = f32x16{};
#pragma unroll
      for (int d0 = 0; d0 < 8; ++d0) { const int cb = (d0 * 16 + hi * 8) * 2;
        const bf16x8 b0 = *reinterpret_cast<const bf16x8*>(K_lds + KSWZ(r32, cb));
        p0 = __builtin_amdgcn_mfma_f32_32x32x16_bf16(b0, qr[d0], p0, 0, 0, 0); }
      asm volatile("s_waitcnt lgkmcnt(0)" ::: "memory");
      if (j > 0) SQ_DMAK(Kh, j - 1);
      const bool diag = (j == wq);
      const int kb = j * 32 + 4 * hi;
      f32x16 q0;
#pragma unroll
      for (int r = 0; r < 16; ++r) {
        const float z0 = __builtin_amdgcn_fmed3f(p0[r], -120.f, 120.f);
        float a0 = -__builtin_amdgcn_logf(1.f + __builtin_amdgcn_exp2f(z0));
        float b0 = z0 + a0;
        if (diag) { const int kv = kb + (r & 3) + 8 * (r >> 2); if (kv >= tq) { a0 = 0.f; b0 = -1e30f; } }
        q0[r] = a0; p0[r] = b0; }
      float G[4], PG[4], SUF[4];
#pragma unroll
      for (int g = 0; g < 4; ++g) G[g] = (q0[4 * g] + q0[4 * g + 1]) + (q0[4 * g + 2] + q0[4 * g + 3]);
      float CS[4];
#pragma unroll
      for (int g = 0; g < 4; ++g) { auto rr = __builtin_amdgcn_permlane32_swap(__float_as_uint(G[g]), __float_as_uint(G[g]), false, false);
        CS[g] = __uint_as_float(rr[0]) + __uint_as_float(rr[1]); PG[g] = __uint_as_float(rr[1]); }
      float run = carry;
#pragma unroll
      for (int g = 3; g >= 0; --g) { SUF[g] = run; run += CS[g]; }
      carry = run;
#pragma unroll
      for (int g = 0; g < 4; ++g) SUF[g] += (hi == 0) ? PG[g] : 0.f;
#pragma unroll
      for (int g = 0; g < 4; ++g) {
        float s_ = SUF[g];
        p0[4 * g + 3] = __builtin_amdgcn_exp2f(p0[4 * g + 3] + s_); s_ += q0[4 * g + 3];
        p0[4 * g + 2] = __builtin_amdgcn_exp2f(p0[4 * g + 2] + s_); s_ += q0[4 * g + 2];
        p0[4 * g + 1] = __builtin_amdgcn_exp2f(p0[4 * g + 1] + s_); s_ += q0[4 * g + 1];
        p0[4 * g + 0] = __builtin_amdgcn_exp2f(p0[4 * g + 0] + s_);
      }
      bf16x8 pa0, pa1;
#define PK4(P, BASE, OUT) do { unsigned a0 = cvtpk(P[BASE + 0], P[BASE + 1]), a1 = cvtpk(P[BASE + 2], P[BASE + 3]);   \
      unsigned b0 = cvtpk(P[BASE + 4], P[BASE + 5]), b1 = cvtpk(P[BASE + 6], P[BASE + 7]);                              \
      auto r0 = __builtin_amdgcn_permlane32_swap(a0, b0, false, false); auto r1 = __builtin_amdgcn_permlane32_swap(a1, b1, false, false); \
      u32x4 w = {r0[0], r1[0], r0[1], r1[1]}; OUT = *reinterpret_cast<bf16x8*>(&w); } while (0)
      PK4(p0, 0, pa0); PK4(p0, 8, pa1);
#undef PK4
#define SQ_PV(D0) do { const s16x4 l0 = tr_read<v_rd_off(D0, 0, 0)>(vb0), h0 = tr_read<v_rd_off(D0, 0, 1)>(vb0), l1 = tr_read<v_rd_off(D0, 1, 0)>(vb0), h1 = tr_read<v_rd_off(D0, 1, 1)>(vb0); \
      asm volatile("s_waitcnt lgkmcnt(0)" ::: "memory"); SBAR(); \
      o[D0] = __builtin_amdgcn_mfma_f32_32x32x16_bf16(pa0, (bf16x8){l0[0], l0[1], l0[2], l0[3], h0[0], h0[1], h0[2], h0[3]}, o[D0], 0, 0, 0); \
      o[D0] = __builtin_amdgcn_mfma_f32_32x32x16_bf16(pa1, (bf16x8){l1[0], l1[1], l1[2], l1[3], h1[0], h1[1], h1[2], h1[3]}, o[D0], 0, 0, 0); } while (0)
      SQ_PV(0); SQ_PV(1); SQ_PV(2); SQ_PV(3);
#undef SQ_PV
      if (__all(carry < -160.f)) break;
    }
    asm volatile("s_waitcnt vmcnt(0)" ::: "memory");
    int nq_ = (int)__builtin_amdgcn_readfirstlane(pend), nqq = pq;
    for (int tr_ = 0; nq_ >= nq && tr_ < 7 && ((cq + 1) & 7) != xq; ++tr_) { cq = (cq + 1) & 7; unsigned t_; SQ_DRAW(t_); nq_ = (int)__builtin_amdgcn_readfirstlane(t_); nqq = cq; }
    const bool has_next = nq_ < nq;
    const int nb = (nqq + 8 * (nq_ >> 8)) >> 3, nh = (nqq + 8 * (nq_ >> 8)) & 7, nwq = 255 - (nq_ & 255);
    pq = cq; pend = 0u; if (has_next) SQ_DRAW(pend);
    const bf16* Khn = QKV + (size_t)nb * SEQ_ * LDQKV + QCOL(1024 + nh * 128); const bf16* Vhn = QKV + (size_t)nb * SEQ_ * LDQKV + QCOL(2048 + nh * 128);
    bf16x8 qn[8];
    if (has_next) { SQ_LOADQ(qn, nb, nh, nwq); SQ_DMAK(Khn, nwq); SQ_LOADV(Vhn, nwq); }
    else {
#pragma unroll
      for (int d0 = 0; d0 < 8; ++d0) qn[d0] = bf16x8{}; }
    { FRESH_LANE(le_); const int r32e = le_ & 31, hie = le_ >> 5; float gv[4];
#pragma unroll
      for (int d0 = 0; d0 < 4; ++d0) gv[d0] = gsb[d0 * 32 + r32e];
#pragma unroll
      for (int r = 0; r < 16; ++r) { float s_ = 0.f;
#pragma unroll
        for (int d0 = 0; d0 < 4; ++d0) s_ += o[d0][r] * o[d0][r];
        const float rs = rsqrtf(half_sum32(s_) * (1.f / 128.f) + 1e-6f);
#pragma unroll
        for (int d0 = 0; d0 < 4; ++d0) o[d0][r] = o[d0][r] * rs * gv[d0]; }
      bf16* Ow = Oout + (rowb + Q0) * LDO + h * 128; float* wf = (float*)V_lds;
#pragma unroll
      for (int ps = 0; ps < 2; ++ps) {
#pragma unroll
        for (int r = 8 * ps; r < 8 * ps + 8; ++r) { const int orow = crow(r, hie) - 16 * ps;
#pragma unroll
          for (int d0 = 0; d0 < 4; ++d0) wf[orow * 128 + d0 * 32 + r32e] = o[d0][r]; }
        asm volatile("s_waitcnt lgkmcnt(0)" ::: "memory");
#pragma unroll
        for (int i = 0; i < 4; ++i) { const int row = 4 * i + (le_ >> 4), ch = le_ & 15;
          const float* src = wf + row * 128 + ch * 8;
          const float a0 = src[0], a1 = src[1], a2 = src[2], a3 = src[3], a4 = src[4], a5 = src[5], a6 = src[6], a7 = src[7];
          u32x4 w; w.x = cvtpk(a0, a1); w.y = cvtpk(a2, a3); w.z = cvtpk(a4, a5); w.w = cvtpk(a6, a7);
          *(u32x4*)(Ow + (size_t)(16 * ps + row) * LDO + ch * 8) = w; }
        asm volatile("s_waitcnt lgkmcnt(0)" ::: "memory"); }
    }
    if (!has_next) break;
    b = nb; h = nh; wq = nwq; Kh = Khn; Vh = Vhn; first = false;
#pragma unroll
    for (int d0 = 0; d0 < 8; ++d0) qr[d0] = qn[d0];
  }
  asm volatile("s_waitcnt vmcnt(0)" ::: "memory");
#undef SQ_LOADV
#undef SQ_DMAK
#undef SQ_LOADQ
#undef SQ_DRAW
}
#undef KSWZ
#undef SBAR
}
namespace att {
typedef __attribute__((address_space(3))) const char* lds_cptr;
typedef short v4i16_t __attribute__((ext_vector_type(4)));
constexpr int D2_K = 0, D2_V = 49152, D2_WS = 98304, D2_SLOT = 16384;
constexpr float THR2 = 8.f;
__device__ __forceinline__ void glds16(const void* gsrc, unsigned lds_dst) { unsigned keep;
  asm volatile("s_mov_b32 %0, m0\n\ts_mov_b32 m0, %2\n\ts_nop 0\n\tglobal_load_lds_dwordx4 %1, off\n\ts_mov_b32 m0, %0" : "=&s"(keep) : "v"(gsrc), "s"(lds_dst) : "memory"); }
__device__ __forceinline__ s16x4 vtr(lds_cptr p) { return __builtin_bit_cast(s16x4, __builtin_amdgcn_ds_read_tr16_b64_v4i16((__attribute__((address_space(3))) v4i16_t*)p)); }
__device__ __forceinline__ float max3f(float a, float b, float c) { return __builtin_fmaxf(__builtin_fmaxf(a, b), c); }
__device__ __forceinline__ float rowmax2(const f32x16& p0, const f32x16& p1) {
  float a = max3f(p0[0], p0[1], p1[0]), b = max3f(p0[2], p0[3], p1[1]); a = max3f(a, p1[2], p1[3]);
#pragma unroll
  for (int r = 4; r < 16; r += 4) { a = max3f(a, p0[r], p0[r + 1]); b = max3f(b, p0[r + 2], p0[r + 3]); a = max3f(a, p1[r], p1[r + 1]); b = max3f(b, p1[r + 2], p1[r + 3]); }
  const float m = __builtin_fmaxf(a, b);
  auto rr = __builtin_amdgcn_permlane32_swap(__float_as_uint(m), __float_as_uint(m), false, false);
  return __builtin_fmaxf(__uint_as_float(rr[0]), __uint_as_float(rr[1]));
}
#define SBAR2() __builtin_amdgcn_sched_barrier(0)
#define WAIT_BAR2(N) asm volatile("s_waitcnt vmcnt(" #N ") lgkmcnt(0)\n\ts_barrier" ::: "memory")
__device__ __forceinline__ void diff_unit2(int b, int h, int qb, const bf16* __restrict__ QKV, bf16* __restrict__ Oout, const float* __restrict__ gdiff, float lam, float oscale, char* shm, int wid, const float* __restrict__ kmax2, int fixed_tile = 0) {
  const bool nodma_ = (fixed_tile == 2);
  int lane; asm volatile("v_mbcnt_lo_u32_b32 %0, -1, 0\n\tv_mbcnt_hi_u32_b32 %0, -1, %0" : "=v"(lane));
  const int r32 = lane & 31, hi = lane >> 5;
  const int map = wid >> 2, wq = wid & 3;
  const size_t rowb = (size_t)b * SEQ_;
  const bf16* Kh = QKV + rowb * LDQKV + QCOL(4096 + h * 128); const bf16* Vh = QKV + rowb * LDQKV + QCOL(5120 + h * 128);
  const unsigned lds0 = (unsigned)(uintptr_t)shm;
  float* wsf = (float*)(shm + D2_WS) + wid * 64;
  const bf16* ksrc = Kh + (size_t)lane * LDQKV + wid * 8;
  const bf16* vsrc = Vh + (size_t)(16 * (wid & 3) + (lane >> 2)) * LDQKV + (wid >> 2) * 32 + (lane & 3) * 8;
  const unsigned kdst = lds0 + D2_K + wid * 1024, vdst = lds0 + D2_V + wid * 1024;
#define DMA_K(t, slot) do { const bf16* s_ = ksrc + (size_t)(fixed_tile ? 0 : (t)) * 64 * LDQKV; const unsigned d_ = (unsigned)__builtin_amdgcn_readfirstlane(kdst + (slot)); glds16(s_, d_); glds16(s_ + QPS, d_ + 8192); } while (0)
#define DMA_V(t, slot) do { const bf16* s_ = vsrc + (size_t)(fixed_tile ? 0 : (t)) * 64 * LDQKV; const unsigned d_ = (unsigned)__builtin_amdgcn_readfirstlane(vdst + (slot)); glds16(s_, d_); glds16(s_ + QPS, d_ + 8192); } while (0)
  const lds_cptr shm3 = (lds_cptr)shm;
  const lds_cptr kp0 = shm3 + D2_K + (map * 8 + hi) * 1024 + r32 * 16;
  const lds_cptr vp0 = shm3 + D2_V + ((lane >> 4) & 1) * 32 + (lane & 3) * 8 + (4 * hi + ((lane & 15) >> 2)) * 64;
  const int NT = 2 * qb + 2;
  __syncthreads();
  DMA_K(0, 0); DMA_V(0, 0); DMA_K(1, D2_SLOT);
  bf16x8 qr[4];
  { const bf16* Qw = QKV + (rowb + qb * 128 + wq * 32 + r32) * LDQKV + QCOL(3072 + h * 128 + map * 64) + hi * 8;
#pragma unroll
    for (int d0 = 0; d0 < 4; ++d0) qr[d0] = *reinterpret_cast<const bf16x8*>(Qw + d0 * 16); }
  bool fastp;
  { float q2 = 0.f;
#pragma unroll
    for (int d0 = 0; d0 < 4; ++d0) { const u32x4 qw = __builtin_bit_cast(u32x4, qr[d0]);
#pragma unroll
      for (int e2 = 0; e2 < 4; ++e2) { const float a = __uint_as_float(qw[e2] << 16), c = __uint_as_float(qw[e2] & 0xffff0000u); q2 += a * a + c * c; } }
    { auto rr = __builtin_amdgcn_permlane32_swap(__float_as_uint(q2), __float_as_uint(q2), false, false); q2 = __uint_as_float(rr[0]) + __uint_as_float(rr[1]); }
    const float* km = kmax2 + (size_t)(((b * 8 + h) * 2 + map) * 128);
    float k2 = __builtin_fmaxf(km[lane], km[64 + lane]);
    k2 = __builtin_fmaxf(k2, swz_xor<1>(k2)); k2 = __builtin_fmaxf(k2, swz_xor<2>(k2)); k2 = __builtin_fmaxf(k2, swz_xor<4>(k2)); k2 = __builtin_fmaxf(k2, swz_xor<8>(k2)); k2 = __builtin_fmaxf(k2, swz_xor<16>(k2));
    { auto rr = __builtin_amdgcn_permlane32_swap(__float_as_uint(k2), __float_as_uint(k2), false, false); k2 = __builtin_fmaxf(__uint_as_float(rr[0]), __uint_as_float(rr[1])); }
    fastp = __all(q2 * k2 <= 8100.f) != 0; }
  float mhat = 0.f, l_reg = 0.f; f32x16 o[4];
  { float z_ = 0.f; asm volatile("" : "+v"(z_));
#pragma unroll
    for (int d_ = 0; d_ < 4; ++d_)
#pragma unroll
      for (int r = 0; r < 16; ++r) o[d_][r] = z_; }
  bool resc = false;
  f32x16 pA0, pA1, pB0, pB1;
  int sl_prev = 0, sl_cur = 0, sl_next = D2_SLOT;
#define ROT() do { sl_prev = sl_cur; sl_cur = sl_next; sl_next = (sl_next == 2 * D2_SLOT) ? 0 : sl_next + D2_SLOT; } while (0)
#define KF(kp, d0, half) (*(const __attribute__((address_space(3))) bf16x8*)((kp) + (d0) * 2048 + (half) * 512))
#define RESC2() do { if (resc) { asm volatile("s_waitcnt lgkmcnt(0)" ::: "memory"); \
      _Pragma("unroll") for (int d_ = 0; d_ < 4; ++d_) _Pragma("unroll") for (int r = 0; r < 16; ++r) o[d_][r] *= wsf[crow(r, hi)]; } } while (0)
  WAIT_BAR2(0);
  { const lds_cptr kp_ = kp0;
    pA0 = __builtin_amdgcn_mfma_f32_32x32x16_bf16(KF(kp_, 0, 0), qr[0], f32x16{}, 0, 0, 0); pA1 = __builtin_amdgcn_mfma_f32_32x32x16_bf16(KF(kp_, 0, 1), qr[0], f32x16{}, 0, 0, 0);
#pragma unroll
    for (int d0 = 1; d0 < 4; ++d0) { pA0 = __builtin_amdgcn_mfma_f32_32x32x16_bf16(KF(kp_, d0, 0), qr[d0], pA0, 0, 0, 0); pA1 = __builtin_amdgcn_mfma_f32_32x32x16_bf16(KF(kp_, d0, 1), qr[d0], pA1, 0, 0, 0); }
    const float rm = fastp ? 0.f : rowmax2(pA0, pA1); mhat = rm;
#pragma unroll
    for (int r = 0; r < 16; ++r) { pA0[r] = __builtin_amdgcn_exp2f(pA0[r] - rm); pA1[r] = __builtin_amdgcn_exp2f(pA1[r] - rm); }
    if (2 < NT) DMA_K(2, 2 * D2_SLOT);
    DMA_V(1, D2_SLOT);
    asm volatile("s_waitcnt lgkmcnt(0)\n\ts_barrier" ::: "memory");
    ROT(); }
  u32x4 pw0, pw1, pw2, pw3;
#define PKW(P, B) cvtpk(P[B], P[B + 1])
#define PAF(k) __builtin_bit_cast(bf16x8, pw##k)
#define MFQ(C, d0, half, first) C = __builtin_amdgcn_mfma_f32_32x32x16_bf16(KF(kp_, d0, half), qr[d0], (first) ? f32x16{} : C, 0, 0, 0)
#define VRD(i) do { vl[(i) & 3] = vtr(vp_ + ((i) & 3) * 4096 + ((i) >> 2) * 1024); vh[(i) & 3] = vtr(vp_ + ((i) & 3) * 4096 + ((i) >> 2) * 1024 + 512); } while (0)
#define VFR(i) (bf16x8){vl[(i) & 3][0], vl[(i) & 3][1], vl[(i) & 3][2], vl[(i) & 3][3], vh[(i) & 3][0], vh[(i) & 3][1], vh[(i) & 3][2], vh[(i) & 3][3]}
#define PIN2(x) asm volatile("" : "+v"(x))
#define EX2(C, B) do { C[B] = __builtin_amdgcn_exp2f(C[B]); C[(B) + 1] = __builtin_amdgcn_exp2f(C[(B) + 1]); asm volatile("" : "+v"(C)); } while (0)
#define KRD(i) kfr[(i) % 3] = KF(kp_, (i) >> 1, (i) & 1)
#define MFK(C, i, first) C = __builtin_amdgcn_mfma_f32_32x32x16_bf16(kfr[(i) % 3], qr[(i) >> 1], (first) ? f32x16{} : C, 0, 0, 0)
#define STEP2(C0, C1, P0, P1, t, GK, GV, MASKED, FAST) do { SBAR2(); \
    const lds_cptr kp_ = kp0 + sl_cur; const lds_cptr vp_ = vp0 + sl_prev; s16x4 vl[4], vh[4]; bf16x8 kfr[3]; \
    KRD(0); KRD(1); SBAR2(); \
    float sacc = P0[0] + P0[1]; \
    KRD(2); MFK(C0, 0, true);  sacc += P0[2]; sacc += P0[3]; sacc += P0[4]; sacc += P0[5]; asm volatile("" : "+v"(sacc));     pw0[0] = PKW(P0, 0); pw0[1] = PKW(P0, 2); SBAR2(); \
    KRD(3); MFK(C1, 1, true);  sacc += P0[6]; sacc += P0[7]; sacc += P0[8]; sacc += P0[9]; asm volatile("" : "+v"(sacc));     pw0[2] = PKW(P0, 4); pw0[3] = PKW(P0, 6); SBAR2(); \
    KRD(4); MFK(C0, 2, false); sacc += P0[10]; sacc += P0[11]; sacc += P0[12]; sacc += P0[13]; asm volatile("" : "+v"(sacc)); pw1[0] = PKW(P0, 8); pw1[1] = PKW(P0, 10); SBAR2(); \
    KRD(5); MFK(C1, 3, false); sacc += P0[14]; sacc += P0[15]; sacc += P1[0]; sacc += P1[1]; asm volatile("" : "+v"(sacc));   pw1[2] = PKW(P0, 12); pw1[3] = PKW(P0, 14); SBAR2(); \
    KRD(6); MFK(C0, 4, false); sacc += P1[2]; sacc += P1[3]; sacc += P1[4]; sacc += P1[5]; asm volatile("" : "+v"(sacc));     pw2[0] = PKW(P1, 0); pw2[1] = PKW(P1, 2); SBAR2(); \
    KRD(7); MFK(C1, 5, false); sacc += P1[6]; sacc += P1[7]; sacc += P1[8]; sacc += P1[9]; asm volatile("" : "+v"(sacc));     pw2[2] = PKW(P1, 4); pw2[3] = PKW(P1, 6); SBAR2(); \
    VRD(0); MFK(C0, 6, false); sacc += P1[10]; sacc += P1[11]; sacc += P1[12]; sacc += P1[13]; asm volatile("" : "+v"(sacc)); pw3[0] = PKW(P1, 8); pw3[1] = PKW(P1, 10); SBAR2(); \
    VRD(1); MFK(C1, 7, false); sacc += P1[14]; sacc += P1[15]; asm volatile("" : "+v"(sacc));                                 pw3[2] = PKW(P1, 12); pw3[3] = PKW(P1, 14); SBAR2(); \
    VRD(2); \
    l_reg += sacc; \
    if ((GK) && !nodma_) { DMA_K((t) + 2, sl_prev); } if ((GV) && !nodma_) { DMA_V((t) + 1, sl_next); } \
    if (MASKED) { _Pragma("unroll") for (int r = 0; r < 16; ++r) { C0[r] = -1e30f; C1[r] = -1e30f; } } \
    if (FAST) { resc = false; \
    SBAR2(); \
    VRD(3); o[0] = __builtin_amdgcn_mfma_f32_32x32x16_bf16(PAF(0), VFR(0), o[0], 0, 0, 0); C0[0] = __builtin_amdgcn_exp2f(C0[0]); C0[1] = __builtin_amdgcn_exp2f(C0[1]); PIN2(C0); SBAR2(); \
    VRD(4); o[1] = __builtin_amdgcn_mfma_f32_32x32x16_bf16(PAF(0), VFR(1), o[1], 0, 0, 0); C0[2] = __builtin_amdgcn_exp2f(C0[2]); C0[3] = __builtin_amdgcn_exp2f(C0[3]); PIN2(C0); SBAR2(); \
    VRD(5); o[2] = __builtin_amdgcn_mfma_f32_32x32x16_bf16(PAF(0), VFR(2), o[2], 0, 0, 0); C0[4] = __builtin_amdgcn_exp2f(C0[4]); C0[5] = __builtin_amdgcn_exp2f(C0[5]); PIN2(C0); SBAR2(); \
    VRD(6); o[3] = __builtin_amdgcn_mfma_f32_32x32x16_bf16(PAF(0), VFR(3), o[3], 0, 0, 0); C0[6] = __builtin_amdgcn_exp2f(C0[6]); C0[7] = __builtin_amdgcn_exp2f(C0[7]); PIN2(C0); SBAR2(); \
    VRD(7); o[0] = __builtin_amdgcn_mfma_f32_32x32x16_bf16(PAF(1), VFR(4), o[0], 0, 0, 0); C0[8] = __builtin_amdgcn_exp2f(C0[8]); C0[9] = __builtin_amdgcn_exp2f(C0[9]); PIN2(C0); SBAR2(); \
    VRD(8); o[1] = __builtin_amdgcn_mfma_f32_32x32x16_bf16(PAF(1), VFR(5), o[1], 0, 0, 0); C0[10] = __builtin_amdgcn_exp2f(C0[10]); C0[11] = __builtin_amdgcn_exp2f(C0[11]); PIN2(C0); SBAR2(); \
    VRD(9); o[2] = __builtin_amdgcn_mfma_f32_32x32x16_bf16(PAF(1), VFR(6), o[2], 0, 0, 0); C0[12] = __builtin_amdgcn_exp2f(C0[12]); C0[13] = __builtin_amdgcn_exp2f(C0[13]); PIN2(C0); SBAR2(); \
    VRD(10); o[3] = __builtin_amdgcn_mfma_f32_32x32x16_bf16(PAF(1), VFR(7), o[3], 0, 0, 0); C0[14] = __builtin_amdgcn_exp2f(C0[14]); C0[15] = __builtin_amdgcn_exp2f(C0[15]); PIN2(C0); SBAR2(); \
    VRD(11); o[0] = __builtin_amdgcn_mfma_f32_32x32x16_bf16(PAF(2), VFR(8), o[0], 0, 0, 0); C1[0] = __builtin_amdgcn_exp2f(C1[0]); C1[1] = __builtin_amdgcn_exp2f(C1[1]); PIN2(C1); SBAR2(); \
    VRD(12); o[1] = __builtin_amdgcn_mfma_f32_32x32x16_bf16(PAF(2), VFR(9), o[1], 0, 0, 0); C1[2] = __builtin_amdgcn_exp2f(C1[2]); C1[3] = __builtin_amdgcn_exp2f(C1[3]); PIN2(C1); SBAR2(); \
    VRD(13); o[2] = __builtin_amdgcn_mfma_f32_32x32x16_bf16(PAF(2), VFR(10), o[2], 0, 0, 0); C1[4] = __builtin_amdgcn_exp2f(C1[4]); C1[5] = __builtin_amdgcn_exp2f(C1[5]); PIN2(C1); SBAR2(); \
    VRD(14); o[3] = __builtin_amdgcn_mfma_f32_32x32x16_bf16(PAF(2), VFR(11), o[3], 0, 0, 0); C1[6] = __builtin_amdgcn_exp2f(C1[6]); C1[7] = __builtin_amdgcn_exp2f(C1[7]); PIN2(C1); SBAR2(); \
    VRD(15); o[0] = __builtin_amdgcn_mfma_f32_32x32x16_bf16(PAF(3), VFR(12), o[0], 0, 0, 0); C1[8] = __builtin_amdgcn_exp2f(C1[8]); C1[9] = __builtin_amdgcn_exp2f(C1[9]); PIN2(C1); SBAR2(); \
    o[1] = __builtin_amdgcn_mfma_f32_32x32x16_bf16(PAF(3), VFR(13), o[1], 0, 0, 0); C1[10] = __builtin_amdgcn_exp2f(C1[10]); C1[11] = __builtin_amdgcn_exp2f(C1[11]); PIN2(C1); SBAR2(); \
    o[2] = __builtin_amdgcn_mfma_f32_32x32x16_bf16(PAF(3), VFR(14), o[2], 0, 0, 0); C1[12] = __builtin_amdgcn_exp2f(C1[12]); C1[13] = __builtin_amdgcn_exp2f(C1[13]); PIN2(C1); SBAR2(); \
    o[3] = __builtin_amdgcn_mfma_f32_32x32x16_bf16(PAF(3), VFR(15), o[3], 0, 0, 0); C1[14] = __builtin_amdgcn_exp2f(C1[14]); C1[15] = __builtin_amdgcn_exp2f(C1[15]); PIN2(C1); SBAR2(); \
    } else { \
    SBAR2(); float ra_, rb_; \
    VRD(3); o[0] = __builtin_amdgcn_mfma_f32_32x32x16_bf16(PAF(0), VFR(0), o[0], 0, 0, 0); ra_ = max3f(C0[0], C0[1], C1[0]); rb_ = max3f(C0[2], C0[3], C1[1]); ra_ = max3f(ra_, C1[2], C1[3]); ra_ = max3f(ra_, C0[4], C0[5]); rb_ = max3f(rb_, C0[6], C0[7]); ra_ = max3f(ra_, C1[4], C1[5]); rb_ = max3f(rb_, C1[6], C1[7]); PIN2(ra_); PIN2(rb_); SBAR2(); \
    VRD(4); o[1] = __builtin_amdgcn_mfma_f32_32x32x16_bf16(PAF(0), VFR(1), o[1], 0, 0, 0); ra_ = max3f(ra_, C0[8], C0[9]); rb_ = max3f(rb_, C0[10], C0[11]); ra_ = max3f(ra_, C1[8], C1[9]); rb_ = max3f(rb_, C1[10], C1[11]); ra_ = max3f(ra_, C0[12], C0[13]); rb_ = max3f(rb_, C0[14], C0[15]); ra_ = max3f(ra_, C1[12], C1[13]); rb_ = max3f(rb_, C1[14], C1[15]); PIN2(ra_); PIN2(rb_); SBAR2(); \
    VRD(5); o[2] = __builtin_amdgcn_mfma_f32_32x32x16_bf16(PAF(0), VFR(2), o[2], 0, 0, 0); { float rm = __builtin_fmaxf(ra_, rb_); { auto rr = __builtin_amdgcn_permlane32_swap(__float_as_uint(rm), __float_as_uint(rm), false, false); rm = __builtin_fmaxf(__uint_as_float(rr[0]), __uint_as_float(rr[1])); } rm -= mhat; resc = false; \
      if (__builtin_expect(__any(rm > THR2), 0)) { const float dl = __builtin_fmaxf(rm, 0.f); mhat += dl; const float f = __builtin_amdgcn_exp2f(-dl); l_reg *= f; if (hi == 0) wsf[r32] = f; resc = true; } } SBAR2(); \
    VRD(6); o[3] = __builtin_amdgcn_mfma_f32_32x32x16_bf16(PAF(0), VFR(3), o[3], 0, 0, 0); _Pragma("unroll") for (int r = 0; r < 16; ++r) C0[r] -= mhat; PIN2(C0); SBAR2(); \
    VRD(7); o[0] = __builtin_amdgcn_mfma_f32_32x32x16_bf16(PAF(1), VFR(4), o[0], 0, 0, 0); _Pragma("unroll") for (int r = 0; r < 16; ++r) C1[r] -= mhat; PIN2(C1); SBAR2(); \
    VRD(8); o[1] = __builtin_amdgcn_mfma_f32_32x32x16_bf16(PAF(1), VFR(5), o[1], 0, 0, 0); C0[0] = __builtin_amdgcn_exp2f(C0[0]); C0[1] = __builtin_amdgcn_exp2f(C0[1]); C0[2] = __builtin_amdgcn_exp2f(C0[2]); PIN2(C0); SBAR2(); \
    VRD(9); o[2] = __builtin_amdgcn_mfma_f32_32x32x16_bf16(PAF(1), VFR(6), o[2], 0, 0, 0); C0[3] = __builtin_amdgcn_exp2f(C0[3]); C0[4] = __builtin_amdgcn_exp2f(C0[4]); C0[5] = __builtin_amdgcn_exp2f(C0[5]); PIN2(C0); SBAR2(); \
    VRD(10); o[3] = __builtin_amdgcn_mfma_f32_32x32x16_bf16(PAF(1), VFR(7), o[3], 0, 0, 0); C0[6] = __builtin_amdgcn_exp2f(C0[6]); C0[7] = __builtin_amdgcn_exp2f(C0[7]); C0[8] = __builtin_amdgcn_exp2f(C0[8]); PIN2(C0); SBAR2(); \
    VRD(11); o[0] = __builtin_amdgcn_mfma_f32_32x32x16_bf16(PAF(2), VFR(8), o[0], 0, 0, 0); C0[9] = __builtin_amdgcn_exp2f(C0[9]); C0[10] = __builtin_amdgcn_exp2f(C0[10]); C0[11] = __builtin_amdgcn_exp2f(C0[11]); PIN2(C0); SBAR2(); \
    VRD(12); o[1] = __builtin_amdgcn_mfma_f32_32x32x16_bf16(PAF(2), VFR(9), o[1], 0, 0, 0); C0[12] = __builtin_amdgcn_exp2f(C0[12]); C0[13] = __builtin_amdgcn_exp2f(C0[13]); C0[14] = __builtin_amdgcn_exp2f(C0[14]); PIN2(C0); SBAR2(); \
    VRD(13); o[2] = __builtin_amdgcn_mfma_f32_32x32x16_bf16(PAF(2), VFR(10), o[2], 0, 0, 0); C0[15] = __builtin_amdgcn_exp2f(C0[15]); C1[0] = __builtin_amdgcn_exp2f(C1[0]); C1[1] = __builtin_amdgcn_exp2f(C1[1]); PIN2(C0); PIN2(C1); SBAR2(); \
    VRD(14); o[3] = __builtin_amdgcn_mfma_f32_32x32x16_bf16(PAF(2), VFR(11), o[3], 0, 0, 0); C1[2] = __builtin_amdgcn_exp2f(C1[2]); C1[3] = __builtin_amdgcn_exp2f(C1[3]); C1[4] = __builtin_amdgcn_exp2f(C1[4]); PIN2(C1); SBAR2(); \
    VRD(15); o[0] = __builtin_amdgcn_mfma_f32_32x32x16_bf16(PAF(3), VFR(12), o[0], 0, 0, 0); C1[5] = __builtin_amdgcn_exp2f(C1[5]); C1[6] = __builtin_amdgcn_exp2f(C1[6]); C1[7] = __builtin_amdgcn_exp2f(C1[7]); PIN2(C1); SBAR2(); \
    o[1] = __builtin_amdgcn_mfma_f32_32x32x16_bf16(PAF(3), VFR(13), o[1], 0, 0, 0); C1[8] = __builtin_amdgcn_exp2f(C1[8]); C1[9] = __builtin_amdgcn_exp2f(C1[9]); C1[10] = __builtin_amdgcn_exp2f(C1[10]); PIN2(C1); SBAR2(); \
    o[2] = __builtin_amdgcn_mfma_f32_32x32x16_bf16(PAF(3), VFR(14), o[2], 0, 0, 0); C1[11] = __builtin_amdgcn_exp2f(C1[11]); C1[12] = __builtin_amdgcn_exp2f(C1[12]); C1[13] = __builtin_amdgcn_exp2f(C1[13]); PIN2(C1); SBAR2(); \
    o[3] = __builtin_amdgcn_mfma_f32_32x32x16_bf16(PAF(3), VFR(15), o[3], 0, 0, 0); C1[14] = __builtin_amdgcn_exp2f(C1[14]); C1[15] = __builtin_amdgcn_exp2f(C1[15]); PIN2(C1); SBAR2(); \
    } \
  } while (0)
#define TILE_LOOP(FAST) do { int t = 1; \
  for (; t + 3 < NT; t += 2) { \
    STEP2(pB0, pB1, pA0, pA1, t, true, true, false, FAST);     WAIT_BAR2(4); RESC2(); ROT(); \
    STEP2(pA0, pA1, pB0, pB1, t + 1, true, true, false, FAST); WAIT_BAR2(4); RESC2(); ROT(); \
  } \
  if (NT >= 4) { \
    STEP2(pB0, pB1, pA0, pA1, t, true, true, false, FAST);      WAIT_BAR2(4); RESC2(); ROT(); \
    STEP2(pA0, pA1, pB0, pB1, t + 1, false, true, false, FAST); WAIT_BAR2(2); RESC2(); ROT(); \
    t += 2; \
  } \
  { const bool msk_ = (wq < 2); STEP2(pB0, pB1, pA0, pA1, t, false, false, msk_, FAST); } \
  WAIT_BAR2(0); RESC2(); ROT(); } while (0)
  if (fastp) TILE_LOOP(true); else TILE_LOOP(false);
#undef TILE_LOOP
  { float sacc = pB0[0] + pB0[1];
#pragma unroll
    for (int r = 2; r < 16; ++r) sacc += pB0[r];
#pragma unroll
    for (int r = 0; r < 16; ++r) sacc += pB1[r];
    l_reg += sacc;
    pw0 = (u32x4){PKW(pB0, 0), PKW(pB0, 2), PKW(pB0, 4), PKW(pB0, 6)}; pw1 = (u32x4){PKW(pB0, 8), PKW(pB0, 10), PKW(pB0, 12), PKW(pB0, 14)};
    pw2 = (u32x4){PKW(pB1, 0), PKW(pB1, 2), PKW(pB1, 4), PKW(pB1, 6)}; pw3 = (u32x4){PKW(pB1, 8), PKW(pB1, 10), PKW(pB1, 12), PKW(pB1, 14)};
    const lds_cptr vp_ = vp0 + sl_prev; s16x4 vl[4], vh[4];
#pragma unroll
    for (int ks = 0; ks < 4; ++ks) {
#pragma unroll
      for (int d0 = 0; d0 < 4; ++d0) { vl[d0] = vtr(vp_ + d0 * 4096 + ks * 1024); vh[d0] = vtr(vp_ + d0 * 4096 + ks * 1024 + 512); }
      const bf16x8 pa = (ks == 0) ? PAF(0) : (ks == 1) ? PAF(1) : (ks == 2) ? PAF(2) : PAF(3);
#pragma unroll
      for (int d0 = 0; d0 < 4; ++d0) o[d0] = __builtin_amdgcn_mfma_f32_32x32x16_bf16(pa, (bf16x8){vl[d0][0], vl[d0][1], vl[d0][2], vl[d0][3], vh[d0][0], vh[d0][1], vh[d0][2], vh[d0][3]}, o[d0], 0, 0, 0); }
  }
  int lane_e; asm volatile("v_mbcnt_lo_u32_b32 %0, -1, 0\n\tv_mbcnt_hi_u32_b32 %0, -1, %0" : "=v"(lane_e));
  const int r32e = lane_e & 31, hie = lane_e >> 5;
  { auto rr = __builtin_amdgcn_permlane32_swap(__float_as_uint(l_reg), __float_as_uint(l_reg), false, false); l_reg = __uint_as_float(rr[0]) + __uint_as_float(rr[1]); }
  if (hie == 0) wsf[32 + r32e] = l_reg; asm volatile("s_waitcnt lgkmcnt(0)" ::: "memory");
  float rli[16];
#pragma unroll
  for (int r = 0; r < 16; ++r) rli[r] = __builtin_amdgcn_rcpf(wsf[32 + crow(r, hie)]);
  __syncthreads();
  float* xch = (float*)shm + (size_t)wq * 4096;
  if (map == 1) {
#pragma unroll
    for (int d0 = 0; d0 < 4; ++d0)
#pragma unroll
      for (int r = 0; r < 16; ++r) xch[(d0 * 16 + r) * 64 + lane_e] = o[d0][r] * rli[r] * lam;
  }
  __syncthreads();
  if (map == 0) {
    float ss[16];
#pragma unroll
    for (int r = 0; r < 16; ++r) { float s = 0.f;
#pragma unroll
      for (int d0 = 0; d0 < 4; ++d0) { const float v = o[d0][r] * rli[r] - xch[(d0 * 16 + r) * 64 + lane_e]; o[d0][r] = v; s += v * v; }
      ss[r] = s; }
#pragma unroll
    for (int r = 0; r < 16; ++r) ss[r] = half_sum32(ss[r]);
    float gv[4];
#pragma unroll
    for (int d0 = 0; d0 < 4; ++d0) gv[d0] = gdiff[d0 * 32 + r32e] * oscale;
#pragma unroll
    for (int r = 0; r < 16; ++r) { const float rs = rsqrtf(ss[r] * (1.f / 128.f) + 1e-6f);
#pragma unroll
      for (int d0 = 0; d0 < 4; ++d0) o[d0][r] = o[d0][r] * rs * gv[d0]; }
    store_o_tile(o, Oout + (rowb + qb * 128 + wq * 32) * LDO + 1024 + h * 128, (char*)xch, lane_e);
  }
#undef DMA_K
#undef DMA_V
#undef ROT
#undef KF
#undef RESC2
#undef PKW
#undef PAF
#undef MFQ
#undef KRD
#undef MFK
#undef VRD
#undef VFR
#undef EX2
#undef PIN2
#undef STEP2
}
#undef SBAR2
#undef WAIT_BAR2
}
constexpr int NWAVES = 8;
constexpr int BATCH = 4, SEQ = 8192, DM = 2048, NTOK = BATCH * SEQ;
constexpr int QKVC = 6144, NEXP = 32, DEXP = 512, PLED = 256, LCAP = 65536;
constexpr float EPS = 1e-6f;
constexpr int LDA1 = DM + 64, LDQ = QKVC + 64, LDW = DM + 64, LDP = PLED + 64, LDH = DEXP + 64;
constexpr float QSCALE_SB = 0.08838834764831845f * 1.4426950408889634f;
constexpr float QSCALE_DF = 0.125f * 1.4426950408889634f;
constexpr size_t MiB = 1u << 20;
constexpr size_t WS_CTL = 0, CTL_ZERO_BYTES = 1 * MiB;
constexpr size_t WS_ROPE = 1 * MiB;
constexpr size_t WS_WRT = 1 * MiB + 512 * 1024;
constexpr size_t WS_WIN = 2 * MiB;
constexpr size_t WS_WOUT = 27 * MiB;
constexpr size_t WS_WPG = 36 * MiB;
constexpr size_t WS_WPLE = 45 * MiB;
constexpr size_t WS_WGU = 47 * MiB;
constexpr size_t WS_WD = 179 * MiB;
constexpr size_t WS_LSLOT = 251 * MiB;
constexpr size_t WS_LGATE = 259 * MiB;
constexpr size_t WS_PB = 267 * MiB;
constexpr size_t WS_A1 = 287 * MiB;
constexpr size_t WS_QKV = 419 * MiB;
constexpr size_t WS_Y = WS_QKV;
constexpr size_t WS_H = WS_QKV + 288 * MiB;
constexpr size_t WS_U = 815 * MiB;
constexpr size_t WS_LRSTD = 944 * MiB;
constexpr size_t WS_RSTD2 = 952 * MiB;
constexpr size_t WS_PSUM = 953 * MiB;
constexpr size_t WS_END = 954 * MiB;
static_assert(WS_WIN + (size_t)QKVC * LDW * 2 <= WS_WOUT && WS_WOUT + (size_t)DM * LDW * 2 <= WS_WPG && WS_WPG + (size_t)DM * LDW * 2 <= WS_WPLE && WS_WPLE + (size_t)DM * LDP * 2 <= WS_WGU, "ws map 1");
static_assert(WS_WGU + (size_t)32 * 1024 * LDW * 2 <= WS_WD && WS_WD + (size_t)32 * DM * LDH * 2 <= WS_LSLOT && WS_PB + (size_t)NTOK * LDP * 2 <= WS_A1 && WS_A1 + (size_t)NTOK * LDA1 * 2 <= WS_QKV, "ws map 2");
static_assert(WS_QKV + (size_t)96 * NTOK * 64 * 2 <= WS_U && WS_H + (size_t)73728 * LDH * 2 <= WS_U && WS_Y + (size_t)2 * NTOK * DM * 2 <= WS_H, "ws map 3");
constexpr int CW_TMO = 0, CW_CODE = 1;
constexpr int CW_BAR = 4096;
constexpr int CW_SBQ = 49152;
constexpr int CW_PAN = 32768;
constexpr int CW_CNT = 16384;
constexpr int RING_OFF = 0, RING_BYTES = 131072;
constexpr int LDSCTL_OFF = RING_BYTES;
constexpr int TST_OFF = LDSCTL_OFF;
constexpr int CNT_OFF = LDSCTL_OFF + 160;
constexpr int MISC_OFF = LDSCTL_OFF + 320;
constexpr int ESCR_OFF = LDSCTL_OFF + 1024;
constexpr int LDS_BYTES = 151552;

#define GAS __attribute__((address_space(1)))
#define LAS __attribute__((address_space(3)))
typedef unsigned short bf16;
typedef unsigned v4u __attribute__((ext_vector_type(4)));
typedef unsigned v2u __attribute__((ext_vector_type(2)));
typedef float f32x4 __attribute__((ext_vector_type(4)));
typedef GAS unsigned gu32;
#define RLX_AGENT __ATOMIC_RELAXED, __HIP_MEMORY_SCOPE_AGENT
#define LDS_WAIT() asm volatile("s_waitcnt lgkmcnt(0)" ::: "memory")
#define VM_WAIT() asm volatile("s_waitcnt vmcnt(0)" ::: "memory")
__device__ __forceinline__ unsigned pk2(float lo, float hi) { return pg8::cvt_pk_bf16(lo, hi); }
#define XB_TMO      128
#define XB_XCNT(j)  (256  + 64 * (j))
#define XB_XSUB(j)  (1280 + 64 * (j))
#define XB_XGEN(j)  (2304 + 64 * (j))
#define XB_TOP      3328
#define XB_TOPGEN   3392
#define XCD_BAR_WORDS 3456
#define XB_SPIN_CAP (1u << 18)

__device__ __forceinline__ unsigned xb_ld(unsigned* p)              { return __hip_atomic_load(p, __ATOMIC_RELAXED, __HIP_MEMORY_SCOPE_AGENT); }
__device__ __forceinline__ unsigned xb_add(unsigned* p, unsigned v) { return __hip_atomic_fetch_add(p, v, __ATOMIC_RELAXED, __HIP_MEMORY_SCOPE_AGENT); }
__device__ __forceinline__ unsigned xb_xcc_id() { return (unsigned)__builtin_amdgcn_s_getreg((3 << 11) | 20) & 0xFu; }
#define XB_SPIN(cond, bar) do { unsigned _sp = 0; while (cond) { __builtin_amdgcn_s_sleep(1); \
    if ((++_sp & 255u) == 0u) { if (xb_ld(&(bar)[XB_TMO])) break; if (_sp > XB_SPIN_CAP) { atomicAdd(&(bar)[XB_TMO], 1u); break; } } } } while (0)

struct XcdBarrier {
    unsigned* bar; unsigned x;
    volatile LAS unsigned* st;
};

__device__ __forceinline__ XcdBarrier xcd_barrier_post(unsigned* bar, volatile LAS unsigned* st, bool leader) {
    XcdBarrier b; b.bar = bar; b.x = xb_xcc_id(); b.st = st;
    if (leader) (void)xb_add(&bar[XB_XCNT(b.x)], 1u);
    return b;
}
__device__ __forceinline__ void xcd_barrier_complete(unsigned* bar, unsigned x, unsigned& nloc, unsigned& nx) {
    const unsigned G = gridDim.x * gridDim.y * gridDim.z;
    unsigned sum, cnt, mine, sp = 0u;
    for (;;) {
        sum = 0u; cnt = 0u; mine = 0u;
#pragma unroll
        for (unsigned j = 0; j < 16; ++j) { const unsigned c = xb_ld(&bar[XB_XCNT(j)]); sum += c; cnt += (c > 0u) ? 1u : 0u; mine = (j == x) ? c : mine; }
        if (sum == G) break;
        __builtin_amdgcn_s_sleep(1);
        if ((++sp & 255u) == 0u) { if (xb_ld(&bar[XB_TMO])) break; if (sp > XB_SPIN_CAP) { atomicAdd(&bar[XB_TMO], 1u); break; } }
    }
    nloc = mine > 0u ? mine : 1u; nx = cnt > 0u ? cnt : 1u;
}

__device__ __forceinline__ void xcd_barrier(const XcdBarrier& b, int wave) {
    FRESH_LANE(xl_); const bool leader = (wave == 0) && (xl_ == 0);
    asm volatile("s_waitcnt vmcnt(0)" ::: "memory");
    __syncthreads();
    if (leader) {
        unsigned* bar = b.bar;
        __builtin_amdgcn_s_waitcnt(0);
        unsigned nloc = b.st[0], nx = b.st[1];
        if (nloc == 0u) { xcd_barrier_complete(bar, b.x, nloc, nx); b.st[0] = nloc; b.st[1] = nx; }
        const unsigned old = xb_add(&bar[XB_XSUB(b.x)], 1u);
        const unsigned gen = old / nloc;
        if (old + 1u == (gen + 1u) * nloc) {
            __builtin_amdgcn_fence(__ATOMIC_RELEASE, "agent");
            asm volatile("s_waitcnt vmcnt(0)" ::: "memory");
            const unsigned og = xb_add(&bar[XB_TOP], 1u);
            const unsigned tg = og / nx;
            if (og + 1u == (tg + 1u) * nx) xb_add(&bar[XB_TOPGEN], 1u);
            else XB_SPIN(xb_ld(&bar[XB_TOPGEN]) == tg, bar);
            __builtin_amdgcn_fence(__ATOMIC_ACQUIRE, "agent");
            xb_add(&bar[XB_XGEN(b.x)], 1u);
            asm volatile("s_waitcnt vmcnt(0)" ::: "memory");
        } else {
            XB_SPIN(xb_ld(&bar[XB_XGEN(b.x)]) == gen, bar);
            __builtin_amdgcn_fence(__ATOMIC_ACQUIRE, "agent");
            asm volatile("s_waitcnt vmcnt(0)" ::: "memory");
        }
    }
    __syncthreads();
}
struct Frame {
    LAS unsigned char* lds;
    volatile LAS unsigned* MISC;
    gu32* ctl;
    int tid, lane, wave;
    int vcu, G;
};
__device__ __forceinline__ float wave_sum(float v) { return wave_sum_(v); }
__device__ __forceinline__ void tr_item(const float* W, int ldw, int k0, int n0, bf16* dst, int dpitch, float scale, LAS float* scr, int lane, const float* gk = nullptr) {
    { f32x4 t[8]; const int kr = lane >> 3, nc = 4 * (lane & 7);
#pragma unroll
      for (int i = 0; i < 8; ++i) t[i] = *(const GAS f32x4*)(W + (size_t)(k0 + kr + 8 * i) * ldw + n0 + nc);
#pragma unroll
      for (int i = 0; i < 8; ++i) { LAS float* d = scr + (kr + 8 * i) * 33 + nc; d[0] = t[i].x; d[1] = t[i].y; d[2] = t[i].z; d[3] = t[i].w; } }
    LDS_WAIT(); asm volatile("" ::: "memory");
    const int c = lane & 7;
    float sk[8];
#pragma unroll
    for (int t = 0; t < 8; ++t) sk[t] = gk ? scale * gk[k0 + 8 * c + t] : scale;
#pragma unroll
    for (int j = 0; j < 4; ++j) { const int n = (lane >> 3) + 8 * j; const LAS float* s = scr + (8 * c) * 33 + n;
        v4u o; o.x = pk2(s[0 * 33] * sk[0], s[1 * 33] * sk[1]); o.y = pk2(s[2 * 33] * sk[2], s[3 * 33] * sk[3]); o.z = pk2(s[4 * 33] * sk[4], s[5 * 33] * sk[5]); o.w = pk2(s[6 * 33] * sk[6], s[7 * 33] * sk[7]);
        *(GAS v4u*)(dst + (size_t)n * dpitch + 8 * c) = o; }
    LDS_WAIT(); asm volatile("" ::: "memory");
}
struct ConvDesc { const float* W; int ldw, k0, n0; bf16* dst; int dpitch; float scale; const float* gk; };
__device__ __forceinline__ void tr_load(const ConvDesc& d, f32x4 (&t)[8], f32x4 (&gq)[2], int lane) { const int kr = lane >> 3, nc = 4 * (lane & 7);
#pragma unroll
    for (int i = 0; i < 8; ++i) t[i] = *(const GAS f32x4*)(d.W + (size_t)(d.k0 + kr + 8 * i) * d.ldw + d.n0 + nc);
    if (d.gk) { const GAS f32x4* gp = (const GAS f32x4*)(d.gk + d.k0 + 8 * (lane & 7)); gq[0] = gp[0]; gq[1] = gp[1]; }
    else { gq[0] = (f32x4){1.f, 1.f, 1.f, 1.f}; gq[1] = gq[0]; } }
__device__ __forceinline__ void tr_finish(const ConvDesc& d, const f32x4 (&t)[8], const f32x4 (&gq)[2], LAS float* scr, int lane) { const int kr = lane >> 3, nc = 4 * (lane & 7);
#pragma unroll
    for (int i = 0; i < 8; ++i) { LAS float* q = scr + (kr + 8 * i) * 33 + nc; q[0] = t[i].x; q[1] = t[i].y; q[2] = t[i].z; q[3] = t[i].w; }
    LDS_WAIT(); asm volatile("" ::: "memory");
    const int c = lane & 7;
    float sk[8];
#pragma unroll
    for (int u = 0; u < 8; ++u) sk[u] = d.scale * gq[u >> 2][u & 3];
#pragma unroll
    for (int j = 0; j < 4; ++j) { const int n = (lane >> 3) + 8 * j; const LAS float* q = scr + (8 * c) * 33 + n;
        v4u o; o.x = pk2(q[0 * 33] * sk[0], q[1 * 33] * sk[1]); o.y = pk2(q[2 * 33] * sk[2], q[3 * 33] * sk[3]); o.z = pk2(q[4 * 33] * sk[4], q[5 * 33] * sk[5]); o.w = pk2(q[6 * 33] * sk[6], q[7 * 33] * sk[7]);
        *(GAS v4u*)(d.dst + (size_t)n * d.dpitch + 8 * c) = o; }
    LDS_WAIT(); asm volatile("" ::: "memory");
}
__device__ __forceinline__ void rms_row_to_bf16(const float* xrow, float* invr, bf16* orow, int lane) {
    const GAS f32x4* xr = (const GAS f32x4*)xrow + lane;
    f32x4 v[8]; float s = 0.f;
#pragma unroll
    for (int j = 0; j < 8; ++j) { v[j] = xr[64 * j]; s += (v[j].x * v[j].x + v[j].y * v[j].y) + (v[j].z * v[j].z + v[j].w * v[j].w); }
    const float rstd = rsqrtf(wave_sum(s) * (1.f / DM) + EPS);
    GAS v2u* o8 = (GAS v2u*)orow + lane;
#pragma unroll
    for (int j = 0; j < 8; ++j) { v2u w; w.x = pk2(v[j].x * rstd, v[j].y * rstd); w.y = pk2(v[j].z * rstd, v[j].w * rstd); o8[64 * j] = w; }
    if (lane == 0) *invr = 1.f / rstd;
}

__device__ __forceinline__ void unpack8(const v4u w, float (&f)[8]) {
#pragma unroll
    for (int q = 0; q < 4; ++q) { f[2 * q] = pg8::bf_lo(w[q]); f[2 * q + 1] = pg8::bf_hi(w[q]); }
}
struct Args { const float* in[21]; float* out; unsigned char* ws; int ph_lo, ph_hi; };


#define x_ (args.in[0])
#define p_in (args.in[1])
#define g_attn (args.in[2])
#define w_in (args.in[3])
#define g_sb (args.in[4])
#define g_diff (args.in[5])
#define lam_q1 (args.in[6])
#define lam_k1 (args.in[7])
#define lam_q2 (args.in[8])
#define lam_k2 (args.in[9])
#define w_out (args.in[10])
#define g_moe (args.in[11])
#define w_rg (args.in[12])
#define w_re (args.in[13])
#define w_gate (args.in[14])
#define w_up (args.in[15])
#define w_down (args.in[16])
#define g_ple (args.in[17])
#define w_ple (args.in[18])
#define w_pg (args.in[19])
#define g_final (args.in[20])
#define rope ((float*)(ws + WS_ROPE))
#define wrhl ((bf16*)(ws + WS_WRT))
#define LRSTD ((float*)(ws + WS_LRSTD))
#define RSTD2 ((float*)(ws + WS_RSTD2))
#define WIN ((bf16*)(ws + WS_WIN))
#define WOUT ((bf16*)(ws + WS_WOUT))
#define WPG ((bf16*)(ws + WS_WPG))
#define WPLE ((bf16*)(ws + WS_WPLE))
#define WGU ((bf16*)(ws + WS_WGU))
#define WD ((bf16*)(ws + WS_WD))
#define LSLOT ((int*)(ws + WS_LSLOT))
#define LGATE ((float*)(ws + WS_LGATE))
#define PB ((bf16*)(ws + WS_PB))
#define A1 ((bf16*)(ws + WS_A1))
#define QKV ((bf16*)(ws + WS_QKV))
#define HB ((bf16*)(ws + WS_H))
#define YB ((bf16*)(ws + WS_Y))
#define UB A1
#define INVR RSTD2
#define OB ((bf16*)out)
#define H1B ((bf16*)(ws + WS_U))
#define ecnt (F.ctl + CW_CNT)
constexpr int I_IN = 32 * 192, I_OUT = 32 * 64, I_PG = 32 * 64, I_PLE = 4 * 64, I_G = 32 * 32 * 16, I_U = I_G, I_D = 32 * 8 * 64;
constexpr int NITEMS = I_IN + I_OUT + I_PG + I_PLE + I_G + I_U + I_D, NCV = 3;
#define CONV_DECODE(it_, d) do { int r = (it_); \
            if (r < I_IN) { const int kb = r / 192, nb = r % 192, n0 = 32 * nb, k0 = 64 * kb; const float sc = (n0 < 1024) ? QSCALE_SB : ((n0 >= 3072 && n0 < 4096) ? QSCALE_DF : 1.f); \
                d = ConvDesc{w_in, QKVC, k0, n0, WIN + (size_t)n0 * LDW + k0, LDW, sc, g_attn}; break; } r -= I_IN; \
            if (r < I_OUT) { const int kb = r / 64, nb = r % 64; d = ConvDesc{w_out, DM, 64 * kb, 32 * nb, WOUT + (size_t)(32 * nb) * LDW + 64 * kb, LDW, 1.f, nullptr}; break; } r -= I_OUT; \
            if (r < I_PG) { const int kb = r / 64, nb = r % 64; d = ConvDesc{w_pg, DM, 64 * kb, 32 * nb, WPG + (size_t)(32 * nb) * LDW + 64 * kb, LDW, 1.f, g_ple}; break; } r -= I_PG; \
            if (r < I_PLE) { const int kb = r / 64, nb = r % 64; d = ConvDesc{w_ple, DM, 64 * kb, 32 * nb, WPLE + (size_t)(32 * nb) * LDP + 64 * kb, LDP, 1.f, nullptr}; break; } r -= I_PLE; \
            if (r < I_G + I_U) { const bool isu = r >= I_G; if (isu) r -= I_G; const int e = r / 512, q = r % 512, kb = q / 16, nb = q % 16, n0 = 32 * nb, k0 = 64 * kb; \
                const int drow = e * 1024 + (n0 >> 7) * 256 + ((n0 & 127) >> 5) * 64 + (isu ? 32 : 0); \
                d = ConvDesc{(isu ? w_up : w_gate) + (size_t)e * DM * DEXP, DEXP, k0, n0, WGU + (size_t)drow * LDW + k0, LDW, 1.f, g_moe}; break; } r -= I_G + I_U; \
            { const int e = r / 512, q = r % 512, kb = q / 64, nb = q % 64, n0 = 32 * nb, k0 = 64 * kb; \
                d = ConvDesc{w_down + (size_t)e * DEXP * DM, DM, k0, n0, WD + ((size_t)e * DM + n0) * LDH + k0, LDH, 1.f, nullptr}; } \
        } while (0)
#define CONV_RANGE(lo_, hi_) do { \
        for (int it = (lo_) + gw; it < (hi_); it += NCV * NGW) { \
            ConvDesc cd[NCV]; f32x4 ct[NCV][8], cg[NCV][2]; \
            _Pragma("unroll") for (int c_ = 0; c_ < NCV; ++c_) if (it + c_ * NGW < (hi_)) { CONV_DECODE(it + c_ * NGW, cd[c_]); tr_load(cd[c_], ct[c_], cg[c_], F.lane); } \
            _Pragma("unroll") for (int c_ = 0; c_ < NCV; ++c_) if (it + c_ * NGW < (hi_)) tr_finish(cd[c_], ct[c_], cg[c_], scr, F.lane); \
        } \
        } while (0)
#define CONV_SMALL() do { \
        for (int i = gw * 64 + F.lane; i < 48 * DM; i += NGW * 64) { const int c = i / DM, k = i % DM; const float w = (c < 4) ? w_rg[k * 4 + c] : ((c < 36) ? w_re[k * 32 + (c - 4)] : 0.f); \
            const float v = w * g_moe[k]; const unsigned hi = pk2(v, v) & 0xffffu; const float lo = v - __uint_as_float(hi << 16); wrhl[i] = (bf16)hi; wrhl[48 * DM + i] = (bf16)(pk2(lo, lo) & 0xffffu); } \
        for (size_t i = (size_t)gw * 64 + F.lane; i < (size_t)NTOK * PLED / 4; i += (size_t)NGW * 64 * 4) { f32x4 v[4]; \
            _Pragma("unroll") for (int q = 0; q < 4; ++q) { const size_t iq = i + (size_t)q * NGW * 64; if (iq < (size_t)NTOK * PLED / 4) v[q] = *((const GAS f32x4*)p_in + iq); } \
            _Pragma("unroll") for (int q = 0; q < 4; ++q) { const size_t iq = i + (size_t)q * NGW * 64; if (iq < (size_t)NTOK * PLED / 4) { v2u w; w.x = pk2(v[q].x, v[q].y); w.y = pk2(v[q].z, v[q].w); \
                const size_t row = iq >> 6, c4 = iq & 63; *((GAS v2u*)(PB + row * LDP) + c4) = w; } } } \
        } while (0)
namespace pg8 {
struct EpiFinal {
    static constexpr bool PERM = true, AFTER_DRAIN = false; static constexpr int NST = 32;
    const bf16_t* Hs; const bf16_t* U; const float* rstd2; const float* gfin; float* O; float* psum; gu32* cnt; PG8_LAS unsigned char* scr;
    __device__ __forceinline__ void operator()(const f32x4 (&acc_)[2][2][4][2], const Unit& u, int wr, int wc, int fr_, int fq_) const {
        f32x4 (&acc)[2][2][4][2] = const_cast<f32x4 (&)[2][2][4][2]>(acc_);
        PG8_FRESH_LANE(fr, fq);
        const int row0 = u.pm * BM + wr * 64 + fr, col0 = u.pn * BM + wc * 64 + 8 * fq;
        float rs[8], ssq[8];
#pragma unroll
        for (int it = 0; it < 8; ++it) { rs[it] = rstd2[row0 + (it >> 2) * HALF + (it & 3) * 16]; ssq[it] = 0.f; }
        f32x4 gl[2][2];
#pragma unroll
        for (int bj = 0; bj < 2; ++bj) { gl[bj][0] = *(const f32x4*)(gfin + col0 + bj * 32); gl[bj][1] = *(const f32x4*)(gfin + col0 + bj * 32 + 4); }
        u32x4 lv[2][2];
#define EF_LOAD(buf, k) do { const int it_ = (k) >> 1, bj_ = (k) & 1; const size_t row_ = (size_t)(row0 + (it_ >> 2) * HALF + (it_ & 3) * 16); \
            lv[buf][0] = *(const u32x4*)(Hs + row_ * 2048 + col0 + bj_ * 32); lv[buf][1] = *(const u32x4*)(U + (size_t)(u.pn * 4 + wc) * SPS + row_ * 64 + bj_ * 32 + 8 * fq); } while (0)
        EF_LOAD(0, 0);
#pragma unroll
        for (int k = 0; k < 16; ++k) { const int it = k >> 1, bj = k & 1, ai = it >> 2, m = it & 3;
            if (k + 1 < 16) { if (k & 1) EF_LOAD(0, k + 1); else EF_LOAD(1, k + 1); }
            const u32x4 hw = lv[k & 1][0], uw = lv[k & 1][1]; const float sc = -1.4426950408889634f * rs[it];
            float s_ = 0.f;
#pragma unroll
            for (int q = 0; q < 4; ++q) { const float a0 = acc[ai][bj][m][q >> 1][(q & 1) * 2], a1 = acc[ai][bj][m][q >> 1][(q & 1) * 2 + 1];
                const float s0 = __builtin_amdgcn_rcpf(1.f + __builtin_amdgcn_exp2f(sc * a0)), s1 = __builtin_amdgcn_rcpf(1.f + __builtin_amdgcn_exp2f(sc * a1));
                const float r0 = bf_lo(hw[q]) + bf_lo(uw[q]) * s0, r1 = bf_hi(hw[q]) + bf_hi(uw[q]) * s1;
                acc[ai][bj][m][q >> 1][(q & 1) * 2] = r0; acc[ai][bj][m][q >> 1][(q & 1) * 2 + 1] = r1; s_ += r0 * r0 + r1 * r1; }
            ssq[it] += s_; }
#undef EF_LOAD
#pragma unroll
        for (int it = 0; it < 8; ++it) { float v = ssq[it]; v += swz_xor<16>(v); auto rr = __builtin_amdgcn_permlane32_swap(__float_as_uint(v), __float_as_uint(v), false, false); ssq[it] = __uint_as_float(rr[0]) + __uint_as_float(rr[1]); }
        PG8_LAS float* ps = (PG8_LAS float*)scr; PG8_LAS float* rl = (PG8_LAS float*)(scr + 4096);
        if (fq == 0) {
#pragma unroll
            for (int it = 0; it < 8; ++it) ps[wc * 256 + wr * 64 + (it >> 2) * HALF + (it & 3) * 16 + fr] = ssq[it]; }
        asm volatile("s_waitcnt lgkmcnt(0)" ::: "memory"); __builtin_amdgcn_s_barrier(); asm volatile("" ::: "memory");
        const int t = (wr * 4 + wc) * 64 + fq * 16 + fr;
        if (t < 256) { const float v = (ps[t] + ps[256 + t]) + (ps[512 + t] + ps[768 + t]);
            __hip_atomic_store(psum + ((size_t)(u.pm * BM + t) * 8 + u.pn), v, RLX_AGENT); }
        asm volatile("s_waitcnt vmcnt(0)" ::: "memory");
        __builtin_amdgcn_s_barrier(); asm volatile("" ::: "memory");
        if (t == 0) (void)__hip_atomic_fetch_add(cnt + 64 * u.pm, 1u, RLX_AGENT);
        if (t < 64) {
            unsigned sp = 0u;
            while ((unsigned)__builtin_amdgcn_readfirstlane(__hip_atomic_load(cnt + 64 * u.pm, RLX_AGENT)) < 8u) { __builtin_amdgcn_s_sleep(1); if (++sp > (1u << 22)) break; }
            __builtin_amdgcn_fence(__ATOMIC_ACQUIRE, "agent"); asm volatile("s_waitcnt vmcnt(0)" ::: "memory"); }
        __builtin_amdgcn_s_barrier(); asm volatile("" ::: "memory");
        if (t < 256) { const f32x4* pp = (const f32x4*)(psum + (size_t)(u.pm * BM + t) * 8); const f32x4 pa = pp[0], pb = pp[1];
            const float v = ((((((pa[0] + pa[1]) + pa[2]) + pa[3]) + pb[0]) + pb[1]) + pb[2]) + pb[3];
            rl[t] = rsqrtf(v * (1.f / 2048.f) + 1e-6f); }
        asm volatile("s_waitcnt lgkmcnt(0)" ::: "memory"); __builtin_amdgcn_s_barrier(); asm volatile("" ::: "memory");
#pragma unroll
        for (int it = 0; it < 8; ++it) { const int ai = it >> 2, m = it & 3; const float rr_ = rl[wr * 64 + ai * HALF + m * 16 + fr]; float* orow = O + (size_t)(row0 + ai * HALF + m * 16) * 2048 + col0;
#pragma unroll
            for (int bj = 0; bj < 2; ++bj) {
                *(f32x4*)(orow + bj * 32) = acc[ai][bj][m][0] * rr_ * gl[bj][0]; *(f32x4*)(orow + bj * 32 + 4) = acc[ai][bj][m][1] * rr_ * gl[bj][1]; } }
        asm volatile("s_waitcnt lgkmcnt(0)" ::: "memory");
    }
};
}
__global__ void __launch_bounds__(NWAVES * 64, 2) mega_fwd(Args args) {
    extern __shared__ __attribute__((aligned(16))) unsigned char lds[];
    Frame F;
    F.lds = (LAS unsigned char*)lds;
    F.MISC = (volatile LAS unsigned*)(F.lds + MISC_OFF);
    F.tid = threadIdx.x; F.lane = F.tid & 63; F.wave = __builtin_amdgcn_readfirstlane(F.tid >> 6);
    F.G = gridDim.x; { const int bx = blockIdx.x; F.vcu = (F.G % 8 == 0) ? (bx % 8) * (F.G / 8) + bx / 8 : bx; }
    unsigned char* ws = args.ws;
    F.ctl = (gu32*)(ws + WS_CTL);
    float* const out = args.out;
    for (int u = F.tid; u < (LDS_BYTES - LDSCTL_OFF) / 4; u += NWAVES * 64) ((LAS unsigned*)(F.lds + LDSCTL_OFF))[u] = 0u;
    __syncthreads();
    XcdBarrier bar = xcd_barrier_post((unsigned*)(F.ctl + CW_BAR), F.MISC + 8, F.tid == 0);
    const int lo = args.ph_lo, hi = args.ph_hi;
#ifndef PROBE_DBL
#define PROBE_DBL -1
#endif
#define REPS(k) _Pragma("unroll 1") for (int rep_ = 0; rep_ < ((PROBE_DBL == (k)) ? 2 : 1); ++rep_)
#ifndef PH_MASK
#define PH_MASK 0x7ff
#endif
#define IN(k) ((((PH_MASK) >> (k)) & 1) && lo <= (k) && (k) < hi)
#ifdef PROBE_SKEW
#ifndef PROBE_SKEW_MEAN
#define PROBE_SKEW_MEAN 0
#endif
#define SEAM(k) do { if (IN(k) && IN((k) + 1)) { \
        if ((k) == PROBE_SKEW && F.tid == 0) __hip_atomic_store((unsigned long long*)(F.ctl + 65536) + blockIdx.x, (unsigned long long)__builtin_amdgcn_s_memrealtime(), RLX_AGENT); \
        xcd_barrier(bar, F.wave); \
        if ((k) == PROBE_SKEW && blockIdx.x == 0 && F.tid == 0) { unsigned long long mn = ~0ull, mx = 0ull, sm = 0ull; \
            for (int q_ = 0; q_ < F.G; ++q_) { const unsigned long long v_ = __hip_atomic_load((unsigned long long*)(F.ctl + 65536) + q_, RLX_AGENT); mn = v_ < mn ? v_ : mn; mx = v_ > mx ? v_ : mx; sm += v_; } \
            const unsigned long long d_ = (PROBE_SKEW_MEAN == 1 ? (mx - sm / (unsigned long long)F.G) : (mx - mn)) * 8ull; \
            const unsigned long long t0_ = __builtin_amdgcn_s_memrealtime(); while (__builtin_amdgcn_s_memrealtime() - t0_ < d_) __builtin_amdgcn_s_sleep(8); } } } while (0)
#elif defined(PROBE_BAR2)
#define SEAM(k) do { if (IN(k) && IN((k) + 1)) { xcd_barrier(bar, F.wave); xcd_barrier(bar, F.wave); } } while (0)
#else
#define SEAM(k) do { if (IN(k) && IN((k) + 1)) xcd_barrier(bar, F.wave); } while (0)
#endif
#define PHASE_LANE() do { FRESH_LANE(pl_); F.lane = pl_; F.tid = F.wave * 64 + pl_; } while (0)
    const int gw = F.vcu * NWAVES + F.wave, NGW = F.G * NWAVES;
    LAS int* tstart = (LAS int*)(F.lds + TST_OFF); LAS int* lcnt = (LAS int*)(F.lds + CNT_OFF);

    if (IN(0)) REPS(0) {
        PHASE_LANE();
        LAS float* scr = (LAS float*)(F.lds + RING_OFF + F.wave * 16384);
        CONV_RANGE(0, I_IN);
        for (int m = 2 * gw; m < NTOK; m += 2 * NGW) {
            f32x4 v[2][8]; float ss[2];
#pragma unroll
            for (int q = 0; q < 2; ++q) { const GAS f32x4* xr = (const GAS f32x4*)(x_ + (size_t)(m + q) * DM) + F.lane;
#pragma unroll
                for (int j = 0; j < 8; ++j) v[q][j] = xr[64 * j]; }
#pragma unroll
            for (int q = 0; q < 2; ++q) { float s_ = 0.f;
#pragma unroll
                for (int j = 0; j < 8; ++j) s_ += (v[q][j].x * v[q][j].x + v[q][j].y * v[q][j].y) + (v[q][j].z * v[q][j].z + v[q][j].w * v[q][j].w);
                ss[q] = s_; }
#pragma unroll
            for (int q = 0; q < 2; ++q) { const float rstd = rsqrtf(wave_sum(ss[q]) * (1.f / DM) + EPS);
                GAS v2u* o8 = (GAS v2u*)(A1 + (size_t)(m + q) * LDA1) + F.lane;
#pragma unroll
                for (int j = 0; j < 8; ++j) { v2u w; w.x = pk2(v[q][j].x * rstd, v[q][j].y * rstd); w.y = pk2(v[q][j].z * rstd, v[q][j].w * rstd); o8[64 * j] = w; }
                if (F.lane == 0) INVR[m + q] = 1.f / rstd; }
        }
    }
    SEAM(0);
    if (IN(1)) REPS(1) {
#ifdef SKEW_US
        if (F.vcu >= F.G / 2) { const unsigned long long t0 = __builtin_amdgcn_s_memrealtime(); while (__builtin_amdgcn_s_memrealtime() - t0 < (unsigned long long)(SKEW_US) * 100ull) __builtin_amdgcn_s_sleep(4); }
#endif
        pg8::Gemm g{A1, WIN, NTOK, QKVC, DM, nullptr, LDA1, LDW}; pg8::StaticOrder S; S.init(NTOK, QKVC, F.G, (int)blockIdx.x);
        pg8::EpiQKV E{QKV, F.lds + ESCR_OFF, 0, rope};
#if PROBE_DBL == 1 && defined(PROBE_FIXED)
        S.fixed = rep_;
#endif
#if PROBE_DBL == 1 && defined(PROBE_NOEPI)
        E.skip = rep_ * PROBE_NOEPI; if (rep_ && (PROBE_NOEPI == 2 || PROBE_NOEPI == 7 || PROBE_NOEPI == 8 || PROBE_NOEPI == 9)) E.O = (pg8::bf16_t*)out;
#endif
        pg8::gemm_phase<pg8::EpiQKV, pg8::StaticOrder, true, true>(F.lds + RING_OFF, g, S, E, F.wave);
    }
    SEAM(1);
    if (IN(2)) {
        PHASE_LANE();
        float lam;
        { float a = (F.lane < 64) ? lam_q1[F.lane] * lam_k1[F.lane] : 0.f, b2 = lam_q2[F.lane] * lam_k2[F.lane]; a = wave_sum(a); b2 = wave_sum(b2); lam = expf(a) - expf(b2) + 0.2f; }
#ifndef NO_DIFF
#define CONV_LATE() do { __syncthreads(); { PHASE_LANE(); LAS float* scr = (LAS float*)(F.lds + RING_OFF + F.wave * 16384); CONV_RANGE(I_IN, NITEMS); CONV_SMALL(); } __syncthreads(); } while (0)
        const int conv_at = F.vcu % 3;
        const int nun = 2 * ((1024 - F.vcu + F.G - 1) / F.G);
#define DIFF_UNITS(i0_, i1_) do { _Pragma("unroll 1") for (int i = (i0_); i < (i1_); ++i) { const int L = F.vcu + F.G * (i >> 1), bh = L >> 5, pr = L & 31; \
            att::diff_unit2(bh >> 3, bh & 7, (i & 1) ? pr : 63 - pr, QKV, OB, g_diff, lam, 0.8f, (char*)lds + RING_OFF, F.wave, rope); } } while (0)
        if (conv_at == 0) CONV_LATE();
        DIFF_UNITS(0, nun / 2);
        if (conv_at == 1) CONV_LATE();
        DIFF_UNITS(nun / 2, nun);
#undef DIFF_UNITS
#endif
        if (conv_at == 2) CONV_LATE();
        __syncthreads();
#ifndef NO_SB
        { const int nxq = 8, xq = (int)(((long)F.vcu * nxq) / F.G);
          att::sb_wave_queue((unsigned*)(F.ctl + CW_SBQ), xq, 8192 / nxq, QKV, OB, g_sb, (char*)lds + RING_OFF + F.wave * 16384); }
#endif
#undef CONV_LATE
    }
    SEAM(2);
    asm volatile("s_nop 0\n\ts_nop 0\n\ts_nop 0\n\ts_nop 0");
    if (IN(3)) REPS(3) {
#ifndef NO_P3A
        { pg8::Gemm g{OB, WOUT, NTOK, DM, DM, nullptr, LDA1, LDW}; pg8::StaticOrder S; S.init(NTOK, DM, F.G, (int)blockIdx.x);
          pg8::EpiResN E{A1, LDA1, INVR, H1B};
          pg8::gemm_phase<pg8::EpiResN, pg8::StaticOrder, true, true>(F.lds + RING_OFF, g, S, E, F.wave); }
#endif
    }
    SEAM(3);
    if (IN(4)) {
        PHASE_LANE();
        constexpr int WPITCH = 520;
        LAS bf16* WB = (LAS bf16*)(F.lds + RING_OFF);
        LAS float* LG = (LAS float*)(F.lds + RING_OFF + 102400) + F.wave * 656;
        LAS int* sel_e = (LAS int*)(F.lds + RING_OFF + 124928); LAS float* sel_g = (LAS float*)(F.lds + RING_OFF + 125952); LAS float* sel_r = (LAS float*)(F.lds + RING_OFF + 126976);
        LAS int* lhist = (LAS int*)(F.lds + RING_OFF + 127488); LAS int* lbase = (LAS int*)(F.lds + RING_OFF + 127616);
        const int mr = F.lane & 15, quad = F.lane >> 4;
        for (int chunk = blockIdx.x; chunk < NTOK / 128; chunk += F.G) {
            if (F.tid < 32) lhist[F.tid] = 0;
            const int row0 = chunk * 128 + F.wave * 16;
            f32x4 acc[3] = {{0.f, 0.f, 0.f, 0.f}, {0.f, 0.f, 0.f, 0.f}, {0.f, 0.f, 0.f, 0.f}}; float ssq = 0.f;
            const GAS v4u* arow = (const GAS v4u*)(H1B + (size_t)(row0 + mr) * DM) + quad;
            v4u av[16];
#define P4_LOAD(kc_) do { _Pragma("unroll") for (int sidx = 0; sidx < 16; ++sidx) av[sidx] = arow[(kc_) * 64 + sidx * 4]; } while (0)
            P4_LOAD(0);
#pragma unroll 1
            for (int kc = 0; kc < 4; ++kc) {
                __syncthreads();
#pragma unroll
                for (int i = 0; i < 12; ++i) { const int p = F.tid + 512 * i, hl = p / 3072, rem = p % 3072, wrow = rem >> 6, pc = rem & 63;
                    *(LAS v4u*)(WB + (size_t)(hl * 48 + wrow) * WPITCH + pc * 8) = *(const GAS v4u*)(wrhl + (size_t)(hl * 48 + wrow) * DM + kc * 512 + pc * 8); }
                v4u ac[16];
#pragma unroll
                for (int sidx = 0; sidx < 16; ++sidx) ac[sidx] = av[sidx];
                if (kc < 3) P4_LOAD(kc + 1);
                __syncthreads();
#pragma unroll
                for (int sidx = 0; sidx < 16; ++sidx) { float f[8]; unpack8(ac[sidx], f);
#pragma unroll
                    for (int i = 0; i < 8; ++i) ssq += f[i] * f[i];
                    const pg8::bf16x8 a = __builtin_bit_cast(pg8::bf16x8, ac[sidx]);
#pragma unroll
                    for (int ct = 0; ct < 3; ++ct) { const pg8::bf16x8 bh = *(const LAS pg8::bf16x8*)(WB + (size_t)(ct * 16 + mr) * WPITCH + sidx * 32 + quad * 8), bl = *(const LAS pg8::bf16x8*)(WB + (size_t)(48 + ct * 16 + mr) * WPITCH + sidx * 32 + quad * 8);
                        acc[ct] = __builtin_amdgcn_mfma_f32_16x16x32_bf16(a, bh, acc[ct], 0, 0, 0); acc[ct] = __builtin_amdgcn_mfma_f32_16x16x32_bf16(a, bl, acc[ct], 0, 0, 0); } }
            }
#undef P4_LOAD
            ssq += swz_xor<16>(ssq); { auto rr = __builtin_amdgcn_permlane32_swap(__float_as_uint(ssq), __float_as_uint(ssq), false, false); ssq = __uint_as_float(rr[0]) + __uint_as_float(rr[1]); }
            const float rstd = rsqrtf(ssq * (1.f / DM) + EPS);
            if (quad == 0) LG[640 + mr] = rstd;
            LDS_WAIT(); asm volatile("" ::: "memory");
#pragma unroll
            for (int v = 0; v < 4; ++v) { const float rs = LG[640 + 4 * quad + v];
#pragma unroll
                for (int ct = 0; ct < 3; ++ct) if (ct < 2 || mr < 4) LG[(4 * quad + v) * 40 + ct * 16 + mr] = acc[ct][v] * rs; }
            LDS_WAIT(); asm volatile("" ::: "memory");
            if (F.lane < 16) { const LAS float* lr = LG + F.lane * 40;
                const float g0 = lr[0], g1 = lr[1], g2 = lr[2], g3 = lr[3];
                int grp = 0; float gm = g0; if (g1 > gm) { gm = g1; grp = 1; } if (g2 > gm) { gm = g2; grp = 2; } if (g3 > gm) { gm = g3; grp = 3; }
                const float psel = 1.f / (expf(g0 - gm) + expf(g1 - gm) + expf(g2 - gm) + expf(g3 - gm));
                float ev[8];
#pragma unroll
                for (int i = 0; i < 8; ++i) ev[i] = lr[4 + grp * 8 + i];
                int i0 = 0; float v0 = ev[0];
#pragma unroll
                for (int i = 1; i < 8; ++i) if (ev[i] > v0) { v0 = ev[i]; i0 = i; }
                int i1 = -1; float v1 = 0.f;
#pragma unroll
                for (int i = 0; i < 8; ++i) if (i != i0 && (i1 < 0 || ev[i] > v1)) { v1 = ev[i]; i1 = i; }
                const float ga = 1.f / (1.f + expf(v1 - v0)), gb = 1.f - ga;
                const int rl = F.wave * 16 + F.lane; sel_e[rl * 2] = grp * 8 + i0; sel_e[rl * 2 + 1] = grp * 8 + i1; sel_g[rl * 2] = ga * psel; sel_g[rl * 2 + 1] = gb * psel; sel_r[rl] = LG[640 + F.lane]; }
            __syncthreads();
            FRESH_LANE(l4_); const int t4 = F.wave * 64 + l4_;
            int my_e = 0, my_rk = 0;
            if (t4 < 256) { my_e = sel_e[t4]; my_rk = atomicAdd((int*)(lhist + my_e), 1); }
            __syncthreads();
            if (t4 < 32) { const int n = lhist[t4]; lbase[t4] = n ? (int)__hip_atomic_fetch_add(ecnt + 64 * t4, (unsigned)n, RLX_AGENT) : 0; }
            __syncthreads();
            if (t4 < 256) { const int pos = lbase[my_e] + my_rk; const size_t li = (size_t)my_e * LCAP + pos; { int2 sg; sg.x = (chunk * 128 + (t4 >> 1)) * 2 + (t4 & 1); sg.y = __float_as_int(sel_g[t4]); ((int2*)LSLOT)[li] = sg; } LRSTD[li] = sel_r[t4 >> 1]; }
            __syncthreads();
        }
    }
    SEAM(4);
    if (IN(6) || IN(7)) {
        PHASE_LANE();
        if (F.tid < 32) lcnt[F.tid] = (int)__hip_atomic_load(ecnt + 64 * F.tid, RLX_AGENT);
        __syncthreads();
        if (F.tid == 0) { int acc = 0; for (int e = 0; e < 32; ++e) { tstart[e] = acc; acc += (lcnt[e] + 255) >> 8; } tstart[32] = acc; }
        __syncthreads();
    }
    const int NTILES = (IN(6) || IN(7)) ? __builtin_amdgcn_readfirstlane(tstart[32]) : 0;
    if (IN(6)) REPS(6) {
        pg8::Gemm g{H1B, WGU, NTILES * 256, 1024, DM, LSLOT, DM, LDW}; pg8::MoeOrder S; S.init(NTILES, 4, F.G, (int)blockIdx.x, tstart, lcnt);
        pg8::EpiSwiglu E{HB, LRSTD};
        pg8::gemm_phase<pg8::EpiSwiglu, pg8::MoeOrder, true, true, true>(F.lds + RING_OFF, g, S, E, F.wave);
        { pg8::Gemm g2{PB, WPLE, NTOK, DM, PLED, nullptr, LDP, LDP}; pg8::BalancedOrder S2; S2.init(NTOK, DM, F.G, (int)blockIdx.x, (NTILES * 4) % F.G);
          pg8::EpiBf16 E2{UB, F.lds + ESCR_OFF};
          pg8::gemm_phase<pg8::EpiBf16, pg8::BalancedOrder, true, true>(F.lds + RING_OFF, g2, S2, E2, F.wave); }
    }
    SEAM(6);
    if (IN(7)) REPS(7) {
        pg8::Gemm g{HB, WD, NTILES * 256, DM, DEXP, nullptr, LDH, LDH}; pg8::MoeOrder S; S.init(NTILES, 8, F.G, (int)blockIdx.x, tstart, lcnt);
        pg8::EpiScatter E{YB, (const int2*)LSLOT};
        pg8::gemm_phase<pg8::EpiScatter, pg8::MoeOrder, true, true>(F.lds + RING_OFF, g, S, E, F.wave);
    }
    SEAM(7);
    if (IN(8)) {
        PHASE_LANE();
        for (int m = 2 * gw; m < NTOK; m += 2 * NGW) {
            v4u hv[2][4], ya[2][4], yb[2][4];
#pragma unroll
            for (int q = 0; q < 2; ++q) { const GAS v4u* hr = (const GAS v4u*)(H1B + (size_t)(m + q) * DM) + F.lane; const GAS v4u* y0 = (const GAS v4u*)(YB + (size_t)(2 * (m + q)) * DM) + F.lane; const GAS v4u* y1 = (const GAS v4u*)(YB + (size_t)(2 * (m + q) + 1) * DM) + F.lane;
#pragma unroll
                for (int j = 0; j < 4; ++j) { hv[q][j] = hr[64 * j]; ya[q][j] = y0[64 * j]; yb[q][j] = y1[64 * j]; } }
#pragma unroll
            for (int q = 0; q < 2; ++q) {
                float s = 0.f; GAS v4u* o8 = (GAS v4u*)(H1B + (size_t)(m + q) * DM) + F.lane;
#pragma unroll
                for (int j = 0; j < 4; ++j) { float v[8], a[8], b[8]; unpack8(hv[q][j], v); unpack8(ya[q][j], a); unpack8(yb[q][j], b);
#pragma unroll
                    for (int i = 0; i < 8; ++i) v[i] += a[i] + b[i];
                    v4u w; w.x = pk2(v[0], v[1]); w.y = pk2(v[2], v[3]); w.z = pk2(v[4], v[5]); w.w = pk2(v[6], v[7]); o8[64 * j] = w;
                    float f[8]; unpack8(w, f);
#pragma unroll
                    for (int i = 0; i < 8; ++i) s += f[i] * f[i]; }
                const float rstd = rsqrtf(wave_sum(s) * (1.f / DM) + EPS);
                if (F.lane == 0) RSTD2[m + q] = rstd; }
        }
    }
    SEAM(8);
    if (IN(9)) {
        pg8::Gemm g{H1B, WPG, NTOK, DM, DM, nullptr, DM, LDW}; pg8::StaticOrder S; S.init(NTOK, DM, F.G, (int)blockIdx.x);
        pg8::EpiFinal E{H1B, UB, RSTD2, g_final, out, (float*)(ws + WS_PSUM), F.ctl + CW_PAN, F.lds + ESCR_OFF};
        pg8::gemm_phase<pg8::EpiFinal, pg8::StaticOrder, true, true>(F.lds + RING_OFF, g, S, E, F.wave);
    }
#ifdef PROBE_CLOCK
    {
        typedef float f32x16_ __attribute__((ext_vector_type(16))); typedef short bf16x8_ __attribute__((ext_vector_type(8)));
        f32x16_ c0 = {}, c1 = {}, c2 = {}, c3 = {}; bf16x8_ a = {1, 2, 3, 4, 5, 6, 7, 8}, b = {1, 1, 1, 1, 1, 1, 1, 1};
        const long long t0 = clock64();
        while (clock64() - t0 < PROBE_CLOCK) {
#pragma unroll
            for (int i = 0; i < 8; ++i) { c0 = __builtin_amdgcn_mfma_f32_32x32x16_bf16(a, b, c0, 0, 0, 0); c1 = __builtin_amdgcn_mfma_f32_32x32x16_bf16(a, b, c1, 0, 0, 0); c2 = __builtin_amdgcn_mfma_f32_32x32x16_bf16(a, b, c2, 0, 0, 0); c3 = __builtin_amdgcn_mfma_f32_32x32x16_bf16(a, b, c3, 0, 0, 0); } }
        if (c0[0] + c1[1] + c2[2] + c3[3] == 12345.678f) out[0] = 0.f;
    }
#endif
#undef IN
#undef SEAM
}

#ifndef MK_SPLIT
#define MK_SPLIT 0
#endif
extern "C" void kernel_launch(void* const* d_in, const int* in_sizes, int n_in, void* d_out, int out_size, void* d_ws, size_t ws_size, hipStream_t stream) {
    static int grid = 0;
    if (grid == 0) {
        if (n_in != 21 || in_sizes[0] != NTOK * DM || out_size != NTOK * DM || ws_size < WS_END) { fprintf(stderr, "kernel_launch: shape mismatch (n_in %d in0 %d out %d ws %zu)\n", n_in, n_in > 0 ? in_sizes[0] : -1, out_size, ws_size); grid = -1; return; }
        int dev = 0, cus = 0, per_cu = 0;
        if (hipGetDevice(&dev) != hipSuccess || hipDeviceGetAttribute(&cus, hipDeviceAttributeMultiprocessorCount, dev) != hipSuccess) { grid = -1; return; }
        if (hipFuncSetAttribute((const void*)mega_fwd, hipFuncAttributeMaxDynamicSharedMemorySize, LDS_BYTES) != hipSuccess) { fprintf(stderr, "kernel_launch: hipFuncSetAttribute failed\n"); grid = -1; return; }
        if (hipOccupancyMaxActiveBlocksPerMultiprocessor(&per_cu, (const void*)mega_fwd, NWAVES * 64, LDS_BYTES) != hipSuccess || per_cu < 1) fprintf(stderr, "kernel_launch: occupancy query reports %d\n", per_cu);
        (void)hipGetLastError();
        grid = cus < 256 ? cus : 256;
    }
    if (grid < 0) return;
    if (hipMemsetAsync((char*)d_ws + WS_CTL, 0, CTL_ZERO_BYTES, stream) != hipSuccess) return;
    Args a{};
    for (int i = 0; i < 21; ++i) a.in[i] = (const float*)d_in[i];
    a.out = (float*)d_out; a.ws = (unsigned char*)d_ws;
#if MK_SPLIT
    for (int ph = 0; ph < 11; ++ph) { a.ph_lo = ph; a.ph_hi = ph + 1; hipLaunchKernelGGL(mega_fwd, dim3(grid), dim3(NWAVES * 64), LDS_BYTES, stream, a); }
#else
    a.ph_lo = 0; a.ph_hi = 11;
    hipLaunchKernelGGL(mega_fwd, dim3(grid), dim3(NWAVES * 64), LDS_BYTES, stream, a);
#endif
    const hipError_t le = hipPeekAtLastError();
    if (le != hipSuccess) fprintf(stderr, "kernel_launch: launch failed: %s\n", hipGetErrorName(le));
}
```
